# Optimizing an MI355X kernel written in HIP

```python
import jax, jax.numpy as jnp
from jax import lax
import numpy as np

D_MODEL = 1024
BATCH = 16
SEQ = 256
DEPTH = 1
DEC_BATCH = 2
DEC_SEQ = 1024
PAST_LEN = 256

GRID_W = 64
HEAD_DIM = 64
RW_HEADS = 8
RW_WIDTH = RW_HEADS * HEAD_DIM
NA_HEADS = 8
NA_WIDTH = NA_HEADS * HEAD_DIM
LORA_DECAY = 64
LORA_ICLR = 64
LORA_GATE = 128
NA_ROWS = 8
NA_COLS = 16
NA_QCOLS = 16
NA_KCOLS = 32
Q_BLOCK = 128
FF_HIDDEN = -(-8 * D_MODEL // (3 * 256)) * 256
RW_COLS = 3 * RW_WIDTH + 2 * LORA_DECAY + 2 * LORA_ICLR + LORA_GATE
NA_IN_COLS = 3 * NA_WIDTH
IN_COLS = RW_COLS + NA_IN_COLS + 2 * D_MODEL
RW_SPLITS = (RW_WIDTH, 2 * RW_WIDTH, 3 * RW_WIDTH,
             3 * RW_WIDTH + 2 * LORA_DECAY,
             3 * RW_WIDTH + 2 * LORA_DECAY + 2 * LORA_ICLR)
IN_SPLITS = (RW_COLS, RW_COLS + NA_IN_COLS, RW_COLS + NA_IN_COLS + D_MODEL)
RMS_EPS = 1e-6
GN_EPS = 64e-5
L2_EPS = 1e-12
NEG_INF = -1e30

kernel_name = "hybrid_rwkv7_natten_prefix_step"


def _rmsnorm(x, g):
    xf = x.astype(jnp.float32)
    y = xf * lax.rsqrt(jnp.mean(xf * xf, axis=-1, keepdims=True) + RMS_EPS)
    return (y * g.astype(jnp.float32)).astype(x.dtype)


def _heads(t):
    return t.reshape(t.shape[:-1] + (t.shape[-1] // HEAD_DIM, HEAD_DIM))


def _centred_shift(u, mu):
    prev = jnp.pad(u[:, :-1], ((0, 0), (1, 0), (0, 0)))
    nxt = jnp.pad(u[:, 1:], ((0, 0), (0, 1), (0, 0)))
    return u + mu[0] * (prev - u) + mu[1] * (nxt - u)


def _wkv_step(s, inp):
    r, w, k, v, a, b = inp
    sa = jnp.einsum("bhvk,bhk->bhv", s, a)
    s = s * w[:, :, None, :] + sa[..., None] * b[:, :, None, :] + v[..., None] * k[:, :, None, :]
    return s, jnp.einsum("bhvk,bhk->bhv", s, r)


def _wkv_scan(s0, r, w, k, v, a, b, reverse):
    xs = tuple(jnp.moveaxis(t.astype(jnp.float32), 1, 0) for t in (r, w, k, v, a, b))
    s, ys = lax.scan(_wkv_step, s0.astype(jnp.float32), xs, reverse=reverse)
    return s, jnp.moveaxis(ys, 0, 1)


def _rwkv_branch(u, s0, mu, w0, w_up, a0, a_up, g_up, k_k, k_a, r_k, ln_g, ln_b):
    u = _centred_shift(u, mu)
    r, k, v, wd, ad, gd = jnp.split(u, RW_SPLITS, axis=-1)
    bsz, t_len = r.shape[:2]
    wd = wd.reshape(bsz, t_len, 2, LORA_DECAY)
    ad = ad.reshape(bsz, t_len, 2, LORA_ICLR)
    w_soft = -jax.nn.softplus(-(w0 + jnp.einsum("btel,elc->btec", jnp.tanh(wd), w_up))) - 0.5
    decay = jnp.exp(-jnp.exp(w_soft.astype(jnp.float32)))
    iclr = jax.nn.sigmoid(a0 + jnp.einsum("btel,elc->btec", ad, a_up))
    gate = jax.nn.sigmoid(gd) @ g_up
    kk = _heads(k * k_k).astype(jnp.float32)
    kk = kk * lax.rsqrt(jnp.sum(kk * kk, axis=-1, keepdims=True) + L2_EPS)
    k_dir = k[:, :, None, :] * (1.0 + (iclr - 1.0) * k_a)
    rh, vh = _heads(r), _heads(v)
    s_f, y_f = _wkv_scan(s0[:, 0], rh, _heads(decay[:, :, 0]), _heads(k_dir[:, :, 0]), vh,
                         -kk, kk * _heads(iclr[:, :, 0]), False)
    s_b, y_b = _wkv_scan(s0[:, 1], rh, _heads(decay[:, :, 1]), _heads(k_dir[:, :, 1]), vh,
                         -kk, kk * _heads(iclr[:, :, 1]), True)
    y = y_f + y_b
    mean = jnp.mean(y, axis=-1, keepdims=True)
    var = jnp.mean(jnp.square(y - mean), axis=-1, keepdims=True)
    y = (y - mean) * lax.rsqrt(var + GN_EPS) * _heads(ln_g).astype(jnp.float32) + _heads(ln_b).astype(jnp.float32)
    k_bonus = _heads(0.5 * (k_dir[:, :, 0] + k_dir[:, :, 1]))
    bonus = jnp.sum(rh * k_bonus * r_k, axis=-1, keepdims=True) * vh
    out = (y.astype(u.dtype) + bonus).reshape(bsz, t_len, RW_WIDTH) * gate
    return out, jnp.stack([s_f, s_b], axis=1).astype(u.dtype)


def _qk_norm(t, g):
    tf = t.astype(jnp.float32)
    y = tf * lax.rsqrt(jnp.mean(tf * tf, axis=-1, keepdims=True) + RMS_EPS)
    return (y * g.astype(jnp.float32)).astype(t.dtype)


def _na_context(q, k, v):
    bsz, c_len, h, d = q.shape
    qb = jnp.moveaxis(q.reshape(bsz, c_len // Q_BLOCK, Q_BLOCK, h, d), 1, 0)

    def block(q_b):
        logits = jnp.einsum("bqhd,bkhd->bhqk", q_b, k).astype(jnp.float32) * (HEAD_DIM ** -0.5)
        p = jax.nn.softmax(logits, axis=-1).astype(v.dtype)
        return jnp.einsum("bhqk,bkhd->bqhd", p, v)

    out = lax.map(block, qb)
    return jnp.moveaxis(out, 0, 1).reshape(bsz, c_len, h * d)


def _na_latent(q, k, v, k_ctx, v_ctx, rpb):
    bsz, t_len, h, d = q.shape
    rows = t_len // GRID_W
    kr = min(NA_ROWS, rows)
    n_cb = GRID_W // NA_QCOLS
    row_start = np.clip(np.arange(rows) - kr // 2, 0, rows - kr)
    dr_idx = row_start[:, None] + np.arange(kr)[None, :] - np.arange(rows)[:, None] + NA_ROWS - 1
    q_col = np.arange(GRID_W).reshape(n_cb, NA_QCOLS)
    band_start = np.clip(q_col[:, 0] - NA_COLS // 2, 0, GRID_W - NA_KCOLS)
    k_col = band_start[:, None] + np.arange(NA_KCOLS)[None, :]
    win_start = np.clip(q_col - NA_COLS // 2, 0, GRID_W - NA_COLS)
    valid = (k_col[:, None, :] >= win_start[..., None]) & (k_col[:, None, :] < win_start[..., None] + NA_COLS)
    dc_idx = np.clip(k_col[:, None, :] - q_col[..., None], -(NA_COLS - 1), NA_COLS - 1) + NA_COLS - 1
    col_bias = rpb[:, :, dc_idx].astype(jnp.float32)
    qg = q.reshape(bsz, rows, n_cb, NA_QCOLS, h, d)
    kg = k.reshape(bsz, rows, GRID_W, h, d)
    vg = v.reshape(bsz, rows, GRID_W, h, d)
    scale = HEAD_DIM ** -0.5
    n_win = kr * NA_KCOLS

    def row_block(args):
        q_r, r0, dr = args
        k_r = lax.dynamic_slice_in_dim(kg, r0, kr, axis=1)[:, :, k_col]
        v_r = lax.dynamic_slice_in_dim(vg, r0, kr, axis=1)[:, :, k_col]
        bias = jnp.transpose(jnp.take(col_bias, dr, axis=1), (0, 2, 3, 1, 4))
        lw = jnp.einsum("bjqhd,bkjchd->bhjqkc", q_r, k_r).astype(jnp.float32) * scale + bias[None]
        lw = jnp.where(valid[:, :, None, :], lw, NEG_INF)
        lc = jnp.einsum("bjqhd,blhd->bhjql", q_r, k_ctx).astype(jnp.float32) * scale
        logits = jnp.concatenate([lw.reshape(bsz, h, n_cb, NA_QCOLS, n_win), lc], axis=-1)
        p = jax.nn.softmax(logits, axis=-1).astype(v.dtype)
        pw = p[..., :n_win].reshape(bsz, h, n_cb, NA_QCOLS, kr, NA_KCOLS)
        pc = p[..., n_win:]
        return (jnp.einsum("bhjqkc,bkjchd->bjqhd", pw, v_r)
                + jnp.einsum("bhjql,blhd->bjqhd", pc, v_ctx))

    out = lax.map(row_block, (jnp.moveaxis(qg, 1, 0), jnp.asarray(row_start, jnp.int32),
                              jnp.asarray(dr_idx, jnp.int32)))
    return jnp.moveaxis(out, 0, 1).reshape(bsz, t_len, h * d)


def _modulation(cvec, w_ada, b_ada):
    m = jax.nn.silu(cvec) @ w_ada + b_ada
    return jnp.split(m[..., None, :], 6, axis=-1)


def _trunk_layer(x, cvec, s0, ctx_k, ctx_v, p):
    sh1, sc1, g1, sh2, sc2, g2 = _modulation(cvec, p["w_ada"], p["b_ada"])
    h = _rmsnorm(x, p["norm1_g"]) * (1.0 + sc1) + sh1
    u_rw, u_na, gate_rw, gate_na = jnp.split(h @ p["w_in"], IN_SPLITS, axis=-1)
    o_rw, s_new = _rwkv_branch(u_rw, s0, p["shift_mu"], p["rw_w0"], p["rw_w_up"], p["rw_a0"],
                               p["rw_a_up"], p["rw_g_up"], p["rw_k_k"], p["rw_k_a"], p["rw_r_k"],
                               p["rw_ln_g"], p["rw_ln_b"])
    q, k, v = jnp.split(u_na, 3, axis=-1)
    q = _qk_norm(_heads(q), p["na_q_g"])
    k = _qk_norm(_heads(k), p["na_k_g"])
    v = _heads(v)
    if ctx_k is None:
        o_na = _na_context(q, k, v)
    else:
        o_na = _na_latent(q, k, v, ctx_k, ctx_v, p["na_rpb"])
    merged = (jax.nn.sigmoid(gate_rw) * (o_rw @ p["w_o_rwkv"])
              + jax.nn.sigmoid(gate_na) * (o_na @ p["w_o_na"]))
    x = x + g1 * (merged @ p["w_out"])
    h2 = _rmsnorm(x, p["norm2_g"]) * (1.0 + sc2) + sh2
    x = x + g2 * ((jax.nn.silu(h2 @ p["ffn_w1"]) * (h2 @ p["ffn_w3"])) @ p["ffn_w2"])
    return x, s_new, k, v


def setup_inputs(seed: int = 0) -> dict:
    key = jax.random.key(seed)
    ks = jax.random.split(key, 40)
    f32 = jnp.float32
    n = lambda i, shape, s: jax.random.normal(ks[i], shape, f32) * s
    return {
        "x_prompt": n(0, (BATCH, SEQ, D_MODEL), 1.0),
        "x_sample": n(1, (DEC_BATCH, DEC_SEQ, D_MODEL), 1.0),
        "state_rwkv": n(2, (DEC_BATCH, DEPTH, 2, RW_HEADS, HEAD_DIM, HEAD_DIM), 0.5),
        "cache_na_k": n(3, (DEC_BATCH, DEPTH, PAST_LEN, NA_HEADS, HEAD_DIM), 1.0),
        "cache_na_v": n(4, (DEC_BATCH, DEPTH, PAST_LEN, NA_HEADS, HEAD_DIM), 1.0),
        "c": n(5, (DEC_BATCH, D_MODEL), 1.0),
        "c_ctx": n(6, (D_MODEL,), 1.0),
        "norm1_g": 1.0 + n(7, (DEPTH, D_MODEL), 0.02),
        "norm2_g": 1.0 + n(8, (DEPTH, D_MODEL), 0.02),
        "w_ada": n(9, (DEPTH, D_MODEL, 6 * D_MODEL), 0.5 * D_MODEL ** -0.5),
        "b_ada": n(10, (DEPTH, 6 * D_MODEL), 0.02),
        "w_in": n(11, (DEPTH, D_MODEL, IN_COLS), D_MODEL ** -0.5),
        "shift_mu": jax.random.uniform(ks[12], (DEPTH, 2, RW_COLS), f32, 0.0, 0.5),
        "rw_w0": -1.0 + n(13, (DEPTH, 2, RW_WIDTH), 0.3),
        "rw_w_up": n(14, (DEPTH, 2, LORA_DECAY, RW_WIDTH), 0.5 * LORA_DECAY ** -0.5),
        "rw_a0": n(15, (DEPTH, 2, RW_WIDTH), 0.1),
        "rw_a_up": n(16, (DEPTH, 2, LORA_ICLR, RW_WIDTH), LORA_ICLR ** -0.5),
        "rw_g_up": n(17, (DEPTH, LORA_GATE, RW_WIDTH), LORA_GATE ** -0.5),
        "rw_k_k": 0.85 + n(18, (DEPTH, RW_WIDTH), 0.02),
        "rw_k_a": 1.0 + n(19, (DEPTH, RW_WIDTH), 0.02),
        "rw_r_k": n(20, (DEPTH, RW_HEADS, HEAD_DIM), 0.1),
        "rw_ln_g": 1.0 + n(21, (DEPTH, RW_WIDTH), 0.02),
        "rw_ln_b": n(22, (DEPTH, RW_WIDTH), 0.02),
        "na_q_g": 1.0 + n(23, (DEPTH, HEAD_DIM), 0.02),
        "na_k_g": 1.0 + n(24, (DEPTH, HEAD_DIM), 0.02),
        "na_rpb": n(25, (DEPTH, NA_HEADS, 2 * NA_ROWS - 1, 2 * NA_COLS - 1), 0.1),
        "w_o_rwkv": n(26, (DEPTH, RW_WIDTH, D_MODEL), RW_WIDTH ** -0.5),
        "w_o_na": n(27, (DEPTH, NA_WIDTH, D_MODEL), NA_WIDTH ** -0.5),
        "w_out": n(28, (DEPTH, D_MODEL, D_MODEL), D_MODEL ** -0.5),
        "ffn_w1": n(29, (DEPTH, D_MODEL, FF_HIDDEN), D_MODEL ** -0.5),
        "ffn_w3": n(30, (DEPTH, D_MODEL, FF_HIDDEN), D_MODEL ** -0.5),
        "ffn_w2": n(31, (DEPTH, FF_HIDDEN, D_MODEL), FF_HIDDEN ** -0.5),
    }


def reference(x_prompt, x_sample, state_rwkv, cache_na_k, cache_na_v, c, c_ctx,
              norm1_g, norm2_g, w_ada, b_ada, w_in, shift_mu, rw_w0, rw_w_up, rw_a0, rw_a_up,
              rw_g_up, rw_k_k, rw_k_a, rw_r_k, rw_ln_g, rw_ln_b, na_q_g, na_k_g, na_rpb,
              w_o_rwkv, w_o_na, w_out, ffn_w1, ffn_w3, ffn_w2):
    y_p, y_s = x_prompt, x_sample
    new_s, new_k, new_v = [], [], []
    for l in range(DEPTH):
        p = dict(norm1_g=norm1_g[l], norm2_g=norm2_g[l], w_ada=w_ada[l], b_ada=b_ada[l],
                 w_in=w_in[l], shift_mu=shift_mu[l], rw_w0=rw_w0[l], rw_w_up=rw_w_up[l],
                 rw_a0=rw_a0[l], rw_a_up=rw_a_up[l], rw_g_up=rw_g_up[l], rw_k_k=rw_k_k[l],
                 rw_k_a=rw_k_a[l], rw_r_k=rw_r_k[l], rw_ln_g=rw_ln_g[l], rw_ln_b=rw_ln_b[l],
                 na_q_g=na_q_g[l], na_k_g=na_k_g[l], na_rpb=na_rpb[l], w_o_rwkv=w_o_rwkv[l],
                 w_o_na=w_o_na[l], w_out=w_out[l], ffn_w1=ffn_w1[l], ffn_w3=ffn_w3[l],
                 ffn_w2=ffn_w2[l])
        s0 = jnp.zeros((y_p.shape[0], 2, RW_HEADS, HEAD_DIM, HEAD_DIM), y_p.dtype)
        y_p, s_l, k_l, v_l = _trunk_layer(y_p, c_ctx, s0, None, None, p)
        new_s.append(s_l)
        new_k.append(k_l)
        new_v.append(v_l)
        y_s, _, _, _ = _trunk_layer(y_s, c, state_rwkv[:, l], cache_na_k[:, l], cache_na_v[:, l], p)
    state_rwkv_new = jnp.stack(new_s, axis=1)
    cache_na_k_new = jnp.stack(new_k, axis=1)
    cache_na_v_new = jnp.stack(new_v, axis=1)
    return (y_prompt_out := y_p, y_s, state_rwkv_new, cache_na_k_new, cache_na_v_new)
```

```cpp
#include <hip/hip_runtime.h>
#include <hip/hip_cooperative_groups.h>
#include <cstdio>
#include <cstdint>
namespace cg = cooperative_groups;

#define DEV __device__ __forceinline__
typedef unsigned short bf16_t;
typedef short bf16x8 __attribute__((ext_vector_type(8)));
typedef short bf16x4 __attribute__((ext_vector_type(4)));
typedef float f32x4 __attribute__((ext_vector_type(4)));

constexpr int D = 1024, NTOK = 6144, NCTX = 4096, RW = 512, FF = 2816, INC = 5504, RWC = 1920;
constexpr int NTHR = 256;
constexpr int LDS_BYTES = 73728;

constexpr size_t OFF_CTL = 0;
constexpr size_t OFF_MOD = 256;
constexpr size_t CTL_ZERO_BYTES = 256 + 3 * 6144 * 4;
constexpr size_t OFF_WIN = 73984;
constexpr size_t OFF_WORW = OFF_WIN + 11272192;
constexpr size_t OFF_WONA = OFF_WORW + 1048576;
constexpr size_t OFF_WOUT = OFF_WONA + 1048576;
constexpr size_t OFF_W13 = OFF_WOUT + 2097152;
constexpr size_t OFF_W2 = OFF_W13 + 11534336;
constexpr size_t OFF_H = OFF_W2 + 5767168;
constexpr size_t OFF_URW = OFF_H + 12582912;
constexpr size_t OFF_UNA = OFF_URW + 47185920;
constexpr size_t OFF_OPS = OFF_UNA + 37748736;
constexpr size_t OPS_ARR = 12582912;
constexpr size_t OFF_BG = OFF_OPS + 9 * OPS_ARR;
constexpr size_t OFF_VT = OFF_BG + 12582912;
constexpr size_t OFF_CKB = OFF_VT + 6291456;
constexpr size_t OFF_CVT = OFF_CKB + 524288;
constexpr size_t WS_END = OFF_CVT + 524288;
constexpr size_t OFF_QB = OFF_H, OFF_KB = OFF_H + 6291456;
constexpr size_t OFF_YF = OFF_URW, OFF_YB = OFF_URW + 12582912;
constexpr size_t OFF_ORW = OFF_UNA, OFF_ONA = OFF_UNA + 6291456;
constexpr size_t OFF_MERGED = OFF_OPS;
constexpr size_t OFF_HID = OFF_URW;
constexpr size_t OUT_STATE = 6291456, OUT_K = 7340032, OUT_V = 9437184;

struct Params {
  const float* in[32];
  float* out;
  unsigned char* ws;
  int ph_lo, ph_hi;
};

DEV unsigned short f2bf(float f) { unsigned u = __float_as_uint(f); u += 0x7fffu + ((u >> 16) & 1u); return (unsigned short)(u >> 16); }
DEV unsigned pk2(float lo, float hi) { return (unsigned)f2bf(lo) | ((unsigned)f2bf(hi) << 16); }
DEV float bf2f(unsigned short b) { return __uint_as_float(((unsigned)b) << 16); }
DEV float sigmoidf_(float x) { return 1.f / (1.f + __expf(-x)); }
DEV float wave_sum(float x) {
#pragma unroll
  for (int o = 32; o > 0; o >>= 1) x += __shfl_xor(x, o);
  return x;
}
template <int CTRL> DEV float dpp_mov(float x) { return __int_as_float(__builtin_amdgcn_update_dpp(0, __float_as_int(x), CTRL, 0xf, 0xf, true)); }
DEV float row16_sum(float x) {
  x += dpp_mov<0xB1>(x); x += dpp_mov<0x4E>(x); x += dpp_mov<0x141>(x); x += dpp_mov<0x140>(x);
  return x;
}
DEV const float* xrow(const Params& p, int t) { return t < NCTX ? p.in[0] + (size_t)t * D : p.in[1] + (size_t)(t - NCTX) * D; }
DEV int modidx(int t) { return t < NCTX ? 0 : 1 + ((t - NCTX) >> 10); }

DEV void conv_job(const Params& p, int j, const float*& src, bf16_t*& dst, int& K, int& N, int& mode, int& base) {
  if (j < 1376) { src = p.in[11]; dst = (bf16_t*)(p.ws + OFF_WIN); K = 1024; N = 5504; mode = 0; base = 0; }
  else if (j < 1504) { src = p.in[26]; dst = (bf16_t*)(p.ws + OFF_WORW); K = 512; N = 1024; mode = 0; base = 1376; }
  else if (j < 1632) { src = p.in[27]; dst = (bf16_t*)(p.ws + OFF_WONA); K = 512; N = 1024; mode = 0; base = 1504; }
  else if (j < 1888) { src = p.in[28]; dst = (bf16_t*)(p.ws + OFF_WOUT); K = 1024; N = 1024; mode = 0; base = 1632; }
  else if (j < 2592) { src = p.in[29]; dst = (bf16_t*)(p.ws + OFF_W13); K = 1024; N = 2816; mode = 1; base = 1888; }
  else if (j < 3296) { src = p.in[30]; dst = (bf16_t*)(p.ws + OFF_W13); K = 1024; N = 2816; mode = 2; base = 2592; }
  else { src = p.in[31]; dst = (bf16_t*)(p.ws + OFF_W2); K = 2816; N = 1024; mode = 0; base = 3296; }
}
constexpr int N_CONV_TILES = 4000, N_MOD_TILES = 768;

DEV void phase0(const Params& p, unsigned char* smem, int bid, int nb) {
  const int tid = threadIdx.x;
  float* T = (float*)smem;
  for (int tile = bid; tile < N_MOD_TILES + N_CONV_TILES; tile += nb) {
    if (tile < N_MOD_TILES) {
      const int cgp = tile % 24, kc = tile / 24;
      if (tid < 96) {
        const int m = tid >> 5, kk = tid & 31, k = kc * 32 + kk;
        const float c = (m == 0) ? p.in[6][k] : p.in[5][(m - 1) * D + k];
        T[tid] = c * sigmoidf_(c);
      }
      __syncthreads();
      const int col = cgp * 256 + tid;
      const float* w = p.in[9] + (size_t)(kc * 32) * 6144 + col;
      float a0 = 0.f, a1 = 0.f, a2 = 0.f;
#pragma unroll 8
      for (int kk = 0; kk < 32; ++kk) {
        const float wv = w[(size_t)kk * 6144];
        a0 += T[kk] * wv; a1 += T[32 + kk] * wv; a2 += T[64 + kk] * wv;
      }
      if (kc == 0) { const float b = p.in[10][col]; a0 += b; a1 += b; a2 += b; }
      float* mod = (float*)(p.ws + OFF_MOD);
      atomicAdd(mod + col, a0); atomicAdd(mod + 6144 + col, a1); atomicAdd(mod + 12288 + col, a2);
      __syncthreads();
    } else {
      const float* src; bf16_t* dst; int K, N, mode, base;
      conv_job(p, tile - N_MOD_TILES, src, dst, K, N, mode, base);
      const int lt = tile - N_MOD_TILES - base;
      const int nN = N >> 6;
      const int k0 = (lt / nN) * 64, n0 = (lt % nN) * 64;
#pragma unroll
      for (int i = 0; i < 4; ++i) {
        const int idx = tid + 256 * i, r = idx >> 4, c4 = idx & 15;
        const float4 v = *(const float4*)(src + (size_t)(k0 + r) * N + n0 + c4 * 4);
        float* tp = T + r * 65 + c4 * 4;
        tp[0] = v.x; tp[1] = v.y; tp[2] = v.z; tp[3] = v.w;
      }
      __syncthreads();
      const int n = tid >> 2, kp = tid & 3;
      unsigned w[8];
#pragma unroll
      for (int i = 0; i < 8; ++i) w[i] = pk2(T[(kp * 16 + 2 * i) * 65 + n], T[(kp * 16 + 2 * i + 1) * 65 + n]);
      const int ng = n0 + n;
      int drow = ng;
      if (mode == 1) drow = (ng >> 4) * 32 + (ng & 15);
      else if (mode == 2) drow = (ng >> 4) * 32 + 16 + (ng & 15);
      uint4* dp = (uint4*)(dst + (size_t)drow * K + k0 + kp * 16);
      dp[0] = make_uint4(w[0], w[1], w[2], w[3]);
      dp[1] = make_uint4(w[4], w[5], w[6], w[7]);
      __syncthreads();
    }
  }
}

template <int WHICH>
DEV void phase_normmod(const Params& p, int bid, int nb) {
  const int lane = threadIdx.x & 63, gw = bid * 4 + (threadIdx.x >> 6), nw = nb * 4;
  const float* g = WHICH == 0 ? p.in[7] : p.in[8];
  const float* mod = (const float*)(p.ws + OFF_MOD);
  const int sh_off = WHICH == 0 ? 0 : 3072, sc_off = WHICH == 0 ? 1024 : 4096;
  bf16_t* dst = (bf16_t*)(p.ws + OFF_H);
  for (int t = gw; t < NTOK; t += nw) {
    const float* xp = WHICH == 0 ? xrow(p, t) : p.out + (size_t)t * D;
    const float* mm = mod + modidx(t) * 6144;
    float4 v[4];
    float ss = 0.f;
#pragma unroll
    for (int i = 0; i < 4; ++i) {
      v[i] = *(const float4*)(xp + (i * 64 + lane) * 4);
      ss += v[i].x * v[i].x + v[i].y * v[i].y + v[i].z * v[i].z + v[i].w * v[i].w;
    }
    ss = wave_sum(ss);
    const float rstd = rsqrtf(ss * (1.f / 1024.f) + 1e-6f);
#pragma unroll
    for (int i = 0; i < 4; ++i) {
      const int col = (i * 64 + lane) * 4;
      const float4 g4 = *(const float4*)(g + col);
      const float4 sc = *(const float4*)(mm + sc_off + col);
      const float4 sh = *(const float4*)(mm + sh_off + col);
      const float y0 = v[i].x * rstd * g4.x * (1.f + sc.x) + sh.x;
      const float y1 = v[i].y * rstd * g4.y * (1.f + sc.y) + sh.y;
      const float y2 = v[i].z * rstd * g4.z * (1.f + sc.z) + sh.z;
      const float y3 = v[i].w * rstd * g4.w * (1.f + sc.w) + sh.w;
      *(uint2*)(dst + (size_t)t * D + col) = make_uint2(pk2(y0, y1), pk2(y2, y3));
    }
  }
}

constexpr int LROW = 144;
constexpr int ATILE = 128 * LROW;
constexpr int STAGE = 2 * ATILE;

DEV void gemm_tile_acc(f32x4 (&acc)[4][4], const bf16_t* __restrict__ A, int lda, const bf16_t* __restrict__ Bt, int ldb,
                       int m0, int n0, int K, unsigned char* smem) {
  const int tid = threadIdx.x, lane = tid & 63, wid = tid >> 6, wr = wid >> 1, wc = wid & 1, fr = lane & 15, fq = lane >> 4;
  const int srow = tid >> 3, sc = tid & 7;
  const bf16_t* ga = A + (size_t)(m0 + srow) * lda + sc * 8;
  const bf16_t* gb = Bt + (size_t)(n0 + srow) * ldb + sc * 8;
  uint4 ra[4], rb[4];
  const int nk = K >> 6;
#pragma unroll
  for (int i = 0; i < 4; ++i) { ra[i] = *(const uint4*)(ga + (size_t)i * 32 * lda); rb[i] = *(const uint4*)(gb + (size_t)i * 32 * ldb); }
#pragma unroll
  for (int i = 0; i < 4; ++i) {
    *(uint4*)(smem + (srow + 32 * i) * LROW + sc * 16) = ra[i];
    *(uint4*)(smem + ATILE + (srow + 32 * i) * LROW + sc * 16) = rb[i];
  }
  __syncthreads();
  for (int kt = 0; kt < nk; ++kt) {
    if (kt + 1 < nk) {
      const int k0 = (kt + 1) * 64;
#pragma unroll
      for (int i = 0; i < 4; ++i) { ra[i] = *(const uint4*)(ga + (size_t)i * 32 * lda + k0); rb[i] = *(const uint4*)(gb + (size_t)i * 32 * ldb + k0); }
    }
    const unsigned char* cur = smem + (kt & 1) * STAGE;
#pragma unroll
    for (int ks = 0; ks < 2; ++ks) {
      bf16x8 af[4], bf[4];
#pragma unroll
      for (int mi = 0; mi < 4; ++mi) af[mi] = *(const bf16x8*)(cur + (wr * 64 + mi * 16 + fr) * LROW + ks * 64 + fq * 16);
#pragma unroll
      for (int ni = 0; ni < 4; ++ni) bf[ni] = *(const bf16x8*)(cur + ATILE + (wc * 64 + ni * 16 + fr) * LROW + ks * 64 + fq * 16);
#pragma unroll
      for (int mi = 0; mi < 4; ++mi)
#pragma unroll
        for (int ni = 0; ni < 4; ++ni) acc[mi][ni] = __builtin_amdgcn_mfma_f32_16x16x32_bf16(bf[ni], af[mi], acc[mi][ni], 0, 0, 0);
    }
    if (kt + 1 < nk) {
      unsigned char* nxt = smem + ((kt + 1) & 1) * STAGE;
#pragma unroll
      for (int i = 0; i < 4; ++i) {
        *(uint4*)(nxt + (srow + 32 * i) * LROW + sc * 16) = ra[i];
        *(uint4*)(nxt + ATILE + (srow + 32 * i) * LROW + sc * 16) = rb[i];
      }
    }
    __syncthreads();
  }
}

DEV void zero_acc(f32x4 (&acc)[4][4]) {
#pragma unroll
  for (int i = 0; i < 4; ++i)
#pragma unroll
    for (int j = 0; j < 4; ++j) acc[i][j] = (f32x4){0.f, 0.f, 0.f, 0.f};
}

#define EPI_COORDS const int lane = threadIdx.x & 63, wid = threadIdx.x >> 6, wr = wid >> 1, wc = wid & 1, fr = lane & 15, fq = lane >> 4

DEV void phase_gemm_in(const Params& p, unsigned char* smem, int bid, int nb) {
  EPI_COORDS;
  const bf16_t* A = (const bf16_t*)(p.ws + OFF_H);
  const bf16_t* Bt = (const bf16_t*)(p.ws + OFF_WIN);
  float* urw = (float*)(p.ws + OFF_URW);
  float* una = (float*)(p.ws + OFF_UNA);
  bf16_t* gates = (bf16_t*)p.out;
  for (int tile = bid; tile < 48 * 43; tile += nb) {
    const int tm = tile % 48, tn = tile / 48, m0 = tm * 128, n0 = tn * 128;
    f32x4 acc[4][4];
    zero_acc(acc);
    gemm_tile_acc(acc, A, D, Bt, D, m0, n0, D, smem);
#pragma unroll
    for (int mi = 0; mi < 4; ++mi) {
      const int row = m0 + wr * 64 + mi * 16 + fr;
#pragma unroll
      for (int ni = 0; ni < 4; ++ni) {
        const int col = n0 + wc * 64 + ni * 16 + fq * 4;
        const f32x4 v = acc[mi][ni];
        if (n0 < 1920) *(f32x4*)(urw + (size_t)row * 1920 + col) = v;
        else if (n0 < 3456) *(f32x4*)(una + (size_t)row * 1536 + (col - 1920)) = v;
        else *(uint2*)(gates + (size_t)row * 2048 + (col - 3456)) = make_uint2(pk2(sigmoidf_(v[0]), sigmoidf_(v[1])), pk2(sigmoidf_(v[2]), sigmoidf_(v[3])));
      }
    }
  }
}

DEV void phase_gemm_merge(const Params& p, unsigned char* smem, int bid, int nb) {
  EPI_COORDS;
  const bf16_t* orw = (const bf16_t*)(p.ws + OFF_ORW);
  const bf16_t* ona = (const bf16_t*)(p.ws + OFF_ONA);
  const bf16_t* w1 = (const bf16_t*)(p.ws + OFF_WORW);
  const bf16_t* w2 = (const bf16_t*)(p.ws + OFF_WONA);
  const bf16_t* gates = (const bf16_t*)p.out;
  bf16_t* merged = (bf16_t*)(p.ws + OFF_MERGED);
  float* mtmp = (float*)(p.ws + OFF_MERGED + 16777216);
  for (int tile = bid; tile < 48 * 8; tile += nb) {
    const int tm = tile % 48, tn = tile / 48, m0 = tm * 128, n0 = tn * 128;
    f32x4 acc[4][4];
    zero_acc(acc);
    gemm_tile_acc(acc, orw, RW, w1, RW, m0, n0, RW, smem);
#pragma unroll
    for (int mi = 0; mi < 4; ++mi) {
      const int row = m0 + wr * 64 + mi * 16 + fr;
#pragma unroll
      for (int ni = 0; ni < 4; ++ni) {
        const int col = n0 + wc * 64 + ni * 16 + fq * 4;
        const uint2 g = *(const uint2*)(gates + (size_t)row * 2048 + col);
        f32x4 r;
        r[0] = acc[mi][ni][0] * bf2f((unsigned short)(g.x & 0xffff));
        r[1] = acc[mi][ni][1] * bf2f((unsigned short)(g.x >> 16));
        r[2] = acc[mi][ni][2] * bf2f((unsigned short)(g.y & 0xffff));
        r[3] = acc[mi][ni][3] * bf2f((unsigned short)(g.y >> 16));
        *(f32x4*)(mtmp + (size_t)row * D + col) = r;
      }
    }
    zero_acc(acc);
    gemm_tile_acc(acc, ona, RW, w2, RW, m0, n0, RW, smem);
#pragma unroll
    for (int mi = 0; mi < 4; ++mi) {
      const int row = m0 + wr * 64 + mi * 16 + fr;
#pragma unroll
      for (int ni = 0; ni < 4; ++ni) {
        const int col = n0 + wc * 64 + ni * 16 + fq * 4;
        const uint2 g = *(const uint2*)(gates + (size_t)row * 2048 + 1024 + col);
        const f32x4 mg = *(const f32x4*)(mtmp + (size_t)row * D + col);
        const float r0 = mg[0] + acc[mi][ni][0] * bf2f((unsigned short)(g.x & 0xffff));
        const float r1 = mg[1] + acc[mi][ni][1] * bf2f((unsigned short)(g.x >> 16));
        const float r2 = mg[2] + acc[mi][ni][2] * bf2f((unsigned short)(g.y & 0xffff));
        const float r3 = mg[3] + acc[mi][ni][3] * bf2f((unsigned short)(g.y >> 16));
        *(uint2*)(merged + (size_t)row * D + col) = make_uint2(pk2(r0, r1), pk2(r2, r3));
      }
    }
  }
}

DEV void phase_gemm_out(const Params& p, unsigned char* smem, int bid, int nb) {
  EPI_COORDS;
  const bf16_t* A = (const bf16_t*)(p.ws + OFF_MERGED);
  const bf16_t* Bt = (const bf16_t*)(p.ws + OFF_WOUT);
  const float* mod = (const float*)(p.ws + OFF_MOD);
  for (int tile = bid; tile < 48 * 8; tile += nb) {
    const int tm = tile % 48, tn = tile / 48, m0 = tm * 128, n0 = tn * 128;
    f32x4 acc[4][4];
    zero_acc(acc);
    gemm_tile_acc(acc, A, D, Bt, D, m0, n0, D, smem);
#pragma unroll
    for (int mi = 0; mi < 4; ++mi) {
      const int row = m0 + wr * 64 + mi * 16 + fr;
      const float* xp = xrow(p, row);
      const float* g1 = mod + modidx(row) * 6144 + 2048;
#pragma unroll
      for (int ni = 0; ni < 4; ++ni) {
        const int col = n0 + wc * 64 + ni * 16 + fq * 4;
        const f32x4 x = *(const f32x4*)(xp + col);
        const f32x4 g = *(const f32x4*)(g1 + col);
        *(f32x4*)(p.out + (size_t)row * D + col) = x + g * acc[mi][ni];
      }
    }
  }
}

DEV void phase_gemm_ffn_up(const Params& p, unsigned char* smem, int bid, int nb) {
  EPI_COORDS;
  const bf16_t* A = (const bf16_t*)(p.ws + OFF_H);
  const bf16_t* Bt = (const bf16_t*)(p.ws + OFF_W13);
  bf16_t* hid = (bf16_t*)(p.ws + OFF_HID);
  for (int tile = bid; tile < 48 * 44; tile += nb) {
    const int tm = tile % 48, tn = tile / 48, m0 = tm * 128, n0 = tn * 128;
    f32x4 acc[4][4];
    zero_acc(acc);
    gemm_tile_acc(acc, A, D, Bt, D, m0, n0, D, smem);
#pragma unroll
    for (int mi = 0; mi < 4; ++mi) {
      const int row = m0 + wr * 64 + mi * 16 + fr;
#pragma unroll
      for (int gp = 0; gp < 2; ++gp) {
        const int hcol = ((n0 + wc * 64) >> 1) + gp * 16 + fq * 4;
        const f32x4 a = acc[mi][2 * gp], b = acc[mi][2 * gp + 1];
        float r[4];
#pragma unroll
        for (int e = 0; e < 4; ++e) r[e] = a[e] * sigmoidf_(a[e]) * b[e];
        *(uint2*)(hid + (size_t)row * FF + hcol) = make_uint2(pk2(r[0], r[1]), pk2(r[2], r[3]));
      }
    }
  }
}

DEV void phase_gemm_ffn_down(const Params& p, unsigned char* smem, int bid, int nb) {
  EPI_COORDS;
  const bf16_t* A = (const bf16_t*)(p.ws + OFF_HID);
  const bf16_t* Bt = (const bf16_t*)(p.ws + OFF_W2);
  const float* mod = (const float*)(p.ws + OFF_MOD);
  for (int tile = bid; tile < 48 * 8; tile += nb) {
    const int tm = tile % 48, tn = tile / 48, m0 = tm * 128, n0 = tn * 128;
    f32x4 acc[4][4];
    zero_acc(acc);
    gemm_tile_acc(acc, A, FF, Bt, FF, m0, n0, FF, smem);
#pragma unroll
    for (int mi = 0; mi < 4; ++mi) {
      const int row = m0 + wr * 64 + mi * 16 + fr;
      const float* g2 = mod + modidx(row) * 6144 + 5120;
#pragma unroll
      for (int ni = 0; ni < 4; ++ni) {
        const int col = n0 + wc * 64 + ni * 16 + fq * 4;
        float* op = p.out + (size_t)row * D + col;
        const f32x4 x = *(const f32x4*)op;
        const f32x4 g = *(const f32x4*)(g2 + col);
        *(f32x4*)op = x + g * acc[mi][ni];
      }
    }
  }
}

DEV void phase_qkprep(const Params& p, unsigned char* smem, int bid, int nb) {
  const int tid = threadIdx.x;
  bf16_t* Vs = (bf16_t*)smem;
  bf16_t* qb = (bf16_t*)(p.ws + OFF_QB);
  bf16_t* kb = (bf16_t*)(p.ws + OFF_KB);
  bf16_t* vT = (bf16_t*)(p.ws + OFF_VT);
  bf16_t* ckb = (bf16_t*)(p.ws + OFF_CKB);
  bf16_t* cvT = (bf16_t*)(p.ws + OFF_CVT);
  const float* una = (const float*)(p.ws + OFF_UNA);
  const int tok = tid >> 2, part = tid & 3;
  for (int item = bid; item < 832; item += nb) {
    if (item < 768) {
      const int tt = item >> 3, h = item & 7, t0 = tt * 64, t = t0 + tok;
      const float* src = una + (size_t)t * 1536 + h * 64 + part * 16;
      {
        float x[16]; float ss = 0.f;
#pragma unroll
        for (int i = 0; i < 4; ++i) { const float4 v = *(const float4*)(src + i * 4); x[4 * i] = v.x; x[4 * i + 1] = v.y; x[4 * i + 2] = v.z; x[4 * i + 3] = v.w; }
#pragma unroll
        for (int i = 0; i < 16; ++i) ss += x[i] * x[i];
        ss += __shfl_xor(ss, 1); ss += __shfl_xor(ss, 2);
        const float rs = rsqrtf(ss * (1.f / 64.f) + 1e-6f) * 0.125f;
        unsigned w[8];
#pragma unroll
        for (int i = 0; i < 8; ++i) w[i] = pk2(x[2 * i] * rs * p.in[23][part * 16 + 2 * i], x[2 * i + 1] * rs * p.in[23][part * 16 + 2 * i + 1]);
        uint4* dp = (uint4*)(qb + (size_t)t * 512 + h * 64 + part * 16);
        dp[0] = make_uint4(w[0], w[1], w[2], w[3]); dp[1] = make_uint4(w[4], w[5], w[6], w[7]);
      }
      {
        float x[16]; float ss = 0.f;
#pragma unroll
        for (int i = 0; i < 4; ++i) { const float4 v = *(const float4*)(src + 512 + i * 4); x[4 * i] = v.x; x[4 * i + 1] = v.y; x[4 * i + 2] = v.z; x[4 * i + 3] = v.w; }
#pragma unroll
        for (int i = 0; i < 16; ++i) ss += x[i] * x[i];
        ss += __shfl_xor(ss, 1); ss += __shfl_xor(ss, 2);
        const float rs = rsqrtf(ss * (1.f / 64.f) + 1e-6f);
#pragma unroll
        for (int i = 0; i < 16; ++i) x[i] = x[i] * rs * p.in[24][part * 16 + i];
        if (t < NCTX) {
          float4* op = (float4*)(p.out + OUT_K + (size_t)t * 512 + h * 64 + part * 16);
#pragma unroll
          for (int i = 0; i < 4; ++i) op[i] = make_float4(x[4 * i], x[4 * i + 1], x[4 * i + 2], x[4 * i + 3]);
        }
        unsigned w[8];
#pragma unroll
        for (int i = 0; i < 8; ++i) w[i] = pk2(x[2 * i], x[2 * i + 1]);
        uint4* dp = (uint4*)(kb + (size_t)t * 512 + h * 64 + part * 16);
        dp[0] = make_uint4(w[0], w[1], w[2], w[3]); dp[1] = make_uint4(w[4], w[5], w[6], w[7]);
      }
      {
        float x[16];
#pragma unroll
        for (int i = 0; i < 4; ++i) { const float4 v = *(const float4*)(src + 1024 + i * 4); x[4 * i] = v.x; x[4 * i + 1] = v.y; x[4 * i + 2] = v.z; x[4 * i + 3] = v.w; }
        if (t < NCTX) {
          float4* op = (float4*)(p.out + OUT_V + (size_t)t * 512 + h * 64 + part * 16);
#pragma unroll
          for (int i = 0; i < 4; ++i) op[i] = make_float4(x[4 * i], x[4 * i + 1], x[4 * i + 2], x[4 * i + 3]);
        }
#pragma unroll
        for (int i = 0; i < 16; ++i) Vs[tok * 72 + part * 16 + i] = f2bf(x[i]);
      }
      __syncthreads();
      {
        const int d = tid >> 2;
        unsigned w[8];
#pragma unroll
        for (int i = 0; i < 8; ++i) w[i] = (unsigned)Vs[(part * 16 + 2 * i) * 72 + d] | ((unsigned)Vs[(part * 16 + 2 * i + 1) * 72 + d] << 16);
        uint4* dp = (uint4*)(vT + (size_t)(h * 64 + d) * NTOK + t0 + part * 16);
        dp[0] = make_uint4(w[0], w[1], w[2], w[3]); dp[1] = make_uint4(w[4], w[5], w[6], w[7]);
      }
      __syncthreads();
    } else {
      const int ci = item - 768, b = ci >> 5, rem = ci & 31, tt = rem >> 3, h = rem & 7, t0 = tt * 64, t = t0 + tok;
      const size_t sidx = (size_t)(b * 256 + t) * 512 + h * 64 + part * 16;
      {
        float x[16];
#pragma unroll
        for (int i = 0; i < 4; ++i) { const float4 v = *(const float4*)(p.in[3] + sidx + i * 4); x[4 * i] = v.x; x[4 * i + 1] = v.y; x[4 * i + 2] = v.z; x[4 * i + 3] = v.w; }
        unsigned w[8];
#pragma unroll
        for (int i = 0; i < 8; ++i) w[i] = pk2(x[2 * i], x[2 * i + 1]);
        uint4* dp = (uint4*)(ckb + sidx);
        dp[0] = make_uint4(w[0], w[1], w[2], w[3]); dp[1] = make_uint4(w[4], w[5], w[6], w[7]);
      }
      {
        float x[16];
#pragma unroll
        for (int i = 0; i < 4; ++i) { const float4 v = *(const float4*)(p.in[4] + sidx + i * 4); x[4 * i] = v.x; x[4 * i + 1] = v.y; x[4 * i + 2] = v.z; x[4 * i + 3] = v.w; }
#pragma unroll
        for (int i = 0; i < 16; ++i) Vs[tok * 72 + part * 16 + i] = f2bf(x[i]);
      }
      __syncthreads();
      {
        const int d = tid >> 2;
        unsigned w[8];
#pragma unroll
        for (int i = 0; i < 8; ++i) w[i] = (unsigned)Vs[(part * 16 + 2 * i) * 72 + d] | ((unsigned)Vs[(part * 16 + 2 * i + 1) * 72 + d] << 16);
        uint4* dp = (uint4*)(cvT + (size_t)((b * 8 + h) * 64 + d) * 256 + t0 + part * 16);
        dp[0] = make_uint4(w[0], w[1], w[2], w[3]); dp[1] = make_uint4(w[4], w[5], w[6], w[7]);
      }
      __syncthreads();
    }
  }
}

DEV float* ops_arr(const Params& p, int i) { return (float*)(p.ws + OFF_OPS + (size_t)i * OPS_ARR); }

DEV void shift_load16(float (&o)[16], const float* urw, int t0, int s_lo, int s_hi, int col, float mu0, float mu1) {
  const float* up = urw + (size_t)(t0 - 1) * RWC + col;
  float prev = (t0 > s_lo) ? up[0] : 0.f;
  float cur = up[RWC];
#pragma unroll
  for (int t = 0; t < 16; ++t) {
    const float nxt = (t0 + t + 1 < s_hi) ? up[(size_t)(t + 2) * RWC] : 0.f;
    o[t] = cur + mu0 * (prev - cur) + mu1 * (nxt - cur);
    prev = cur; cur = nxt;
  }
}

template <int NL>
DEV void lora16(float (&acc)[16], const float* L, const float* W, int c) {
  for (int l = 0; l < NL; l += 4) {
    const float w0 = W[(size_t)l * 512 + c], w1 = W[(size_t)(l + 1) * 512 + c], w2 = W[(size_t)(l + 2) * 512 + c], w3 = W[(size_t)(l + 3) * 512 + c];
#pragma unroll
    for (int t = 0; t < 16; ++t) {
      const float4 x = *(const float4*)(L + t * 128 + l);
      acc[t] += x.x * w0 + x.y * w1 + x.z * w2 + x.w * w3;
    }
  }
}

DEV void phase_rwprep(const Params& p, unsigned char* smem, int bid, int nb) {
  const int tid = threadIdx.x;
  float* L = (float*)smem;
  const float* urw = (const float*)(p.ws + OFF_URW);
  const float* mu = p.in[12];
  bf16_t* bonus = (bf16_t*)(p.ws + OFF_BG);
  bf16_t* gate = (bf16_t*)(p.ws + OFF_BG + 6291456);
  float* o_r = ops_arr(p, 0); float* o_v = ops_arr(p, 1); float* o_a = ops_arr(p, 2);
  for (int tile = bid; tile < 384; tile += nb) {
    const int t0 = tile * 16;
    int s_lo, s_hi;
    if (t0 < NCTX) { s_lo = t0 & ~255; s_hi = s_lo + 256; } else { s_lo = NCTX + ((t0 - NCTX) & ~1023); s_hi = s_lo + 1024; }
    for (int e = tid; e < 6144; e += NTHR) {
      const int cc = e % 384, tl = e / 384, col = 1536 + cc, t = t0 + tl;
      const float* up = urw + (size_t)t * RWC + col;
      const float uc = up[0];
      const float upv = (t > s_lo) ? up[-RWC] : 0.f;
      const float unx = (t + 1 < s_hi) ? up[RWC] : 0.f;
      const float us = uc + mu[col] * (upv - uc) + mu[RWC + col] * (unx - uc);
      const int kind = cc >> 7, l = cc & 127;
      const float val = kind == 0 ? tanhf(us) : (kind == 1 ? us : sigmoidf_(us));
      L[kind * 2048 + tl * 128 + l] = val;
    }
    __syncthreads();
#pragma unroll 1
    for (int jj = 0; jj < 2; ++jj) {
      const int c = tid + 256 * jj;
      float r[16], k[16], v[16], kk[16], bacc[16];
      shift_load16(r, urw, t0, s_lo, s_hi, c, mu[c], mu[RWC + c]);
      shift_load16(k, urw, t0, s_lo, s_hi, 512 + c, mu[512 + c], mu[RWC + 512 + c]);
      shift_load16(v, urw, t0, s_lo, s_hi, 1024 + c, mu[1024 + c], mu[RWC + 1024 + c]);
      const float k_k = p.in[18][c], k_a = p.in[19][c], r_k = p.in[20][c];
#pragma unroll
      for (int t = 0; t < 16; ++t) {
        const float x = k[t] * k_k;
        const float ss = wave_sum(x * x);
        kk[t] = x * rsqrtf(ss + 1e-12f);
        const size_t o = (size_t)(t0 + t) * 512 + c;
        o_r[o] = r[t]; o_v[o] = v[t]; o_a[o] = -kk[t];
        bacc[t] = 0.f;
      }
#pragma unroll 1
      for (int e = 0; e < 2; ++e) {
        float acc[16];
        const float a0 = p.in[15][e * 512 + c];
#pragma unroll
        for (int t = 0; t < 16; ++t) acc[t] = a0;
        lora16<64>(acc, L + 2048 + e * 64, p.in[16] + (size_t)e * 64 * 512, c);
        float* o_k = ops_arr(p, 5 + e); float* o_b = ops_arr(p, 7 + e); float* o_w = ops_arr(p, 3 + e);
#pragma unroll
        for (int t = 0; t < 16; ++t) {
          const float ic = sigmoidf_(acc[t]);
          const float kd = k[t] * (1.f + (ic - 1.f) * k_a);
          const size_t o = (size_t)(t0 + t) * 512 + c;
          o_k[o] = kd; o_b[o] = kk[t] * ic;
          bacc[t] += kd;
        }
        const float w0 = p.in[13][e * 512 + c];
#pragma unroll
        for (int t = 0; t < 16; ++t) acc[t] = w0;
        lora16<64>(acc, L + e * 64, p.in[14] + (size_t)e * 64 * 512, c);
#pragma unroll
        for (int t = 0; t < 16; ++t) {
          const float z = acc[t];
          const float sp = fmaxf(-z, 0.f) + log1pf(__expf(-fabsf(z)));
          const float wsoft = -sp - 0.5f;
          o_w[(size_t)(t0 + t) * 512 + c] = __expf(-__expf(wsoft));
        }
      }
#pragma unroll
      for (int t = 0; t < 16; ++t) {
        const float s = wave_sum(r[t] * 0.5f * bacc[t] * r_k);
        bonus[(size_t)(t0 + t) * 512 + c] = f2bf(s * v[t]);
      }
      {
        float acc[16];
#pragma unroll
        for (int t = 0; t < 16; ++t) acc[t] = 0.f;
        lora16<128>(acc, L + 4096, p.in[17], c);
#pragma unroll
        for (int t = 0; t < 16; ++t) gate[(size_t)(t0 + t) * 512 + c] = f2bf(acc[t]);
      }
    }
    __syncthreads();
  }
}

constexpr int TC = 16;
DEV void scan_item(const Params& p, unsigned char* smem, int item) {
  const int tid = threadIdx.x, lane = tid & 63, w = tid >> 6, riw = lane >> 4, kq = lane & 15;
  int seq, h, dir, rg;
  {
    int rem;
    if (item < 128) { seq = 16 + (item >> 6); rem = item & 63; }
    else { const int i2 = item - 128; seq = i2 >> 6; rem = i2 & 63; }
    h = rem >> 3; dir = (rem >> 2) & 1; rg = rem & 3;
  }
  const int T = seq < 16 ? 256 : 1024;
  const int tok0 = seq < 16 ? seq * 256 : NCTX + (seq - 16) * 1024;
  const int vrow_l = w * 4 + riw;
  const int vrow = rg * 16 + vrow_l;
  float S0, S1, S2, S3;
  if (seq >= 16) {
    const float4 s = *(const float4*)(p.in[2] + ((size_t)(((seq - 16) * 2 + dir) * 8 + h) * 64 + vrow) * 64 + kq * 4);
    S0 = s.x; S1 = s.y; S2 = s.z; S3 = s.w;
  } else { S0 = S1 = S2 = S3 = 0.f; }
  const int lstep = tid >> 4, l16 = tid & 15;
  const float* pr = ops_arr(p, 0) + h * 64 + l16 * 4;
  const float* pw = ops_arr(p, 3 + dir) + h * 64 + l16 * 4;
  const float* pk = ops_arr(p, 5 + dir) + h * 64 + l16 * 4;
  const float* pa = ops_arr(p, 2) + h * 64 + l16 * 4;
  const float* pb = ops_arr(p, 7 + dir) + h * 64 + l16 * 4;
  const float* pv = ops_arr(p, 1) + h * 64 + rg * 16 + l16;
  float* yout = (float*)(p.ws + (dir ? OFF_YB : OFF_YF));
  const int nc = T / TC;
  float4 g_r, g_w, g_k, g_a, g_b; float rv;
#define gload(c) do { const int ts_ = (c) * TC + lstep; const size_t t_ = (size_t)(tok0 + (dir ? T - 1 - ts_ : ts_)) * 512; \
    g_r = *(const float4*)(pr + t_); g_w = *(const float4*)(pw + t_); g_k = *(const float4*)(pk + t_); \
    g_a = *(const float4*)(pa + t_); g_b = *(const float4*)(pb + t_); rv = pv[t_]; } while (0)
  gload(0);
  for (int c = 0; c < nc; ++c) {
    unsigned char* st = smem + (c & 1) * 21504;
    *(float4*)(st + 0 * 4096 + lstep * 256 + l16 * 16) = g_r;
    *(float4*)(st + 1 * 4096 + lstep * 256 + l16 * 16) = g_w;
    *(float4*)(st + 2 * 4096 + lstep * 256 + l16 * 16) = g_k;
    *(float4*)(st + 3 * 4096 + lstep * 256 + l16 * 16) = g_a;
    *(float4*)(st + 4 * 4096 + lstep * 256 + l16 * 16) = g_b;
    *(float*)(st + 20480 + lstep * 64 + l16 * 4) = rv;
    __syncthreads();
    if (c > 0) {
      const float* yb = (const float*)(smem + 43008 + ((c - 1) & 1) * 1024);
      const int ts = (c - 1) * TC + lstep;
      const int t = tok0 + (dir ? T - 1 - ts : ts);
      yout[(size_t)t * 512 + h * 64 + rg * 16 + l16] = yb[lstep * 16 + l16];
    }
    if (c + 1 < nc) gload(c + 1);
    float* ybw = (float*)(smem + 43008 + (c & 1) * 1024);
#pragma unroll
    for (int s = 0; s < TC; ++s) {
      const float4 r4 = *(const float4*)(st + 0 * 4096 + s * 256 + kq * 16);
      const float4 w4 = *(const float4*)(st + 1 * 4096 + s * 256 + kq * 16);
      const float4 k4 = *(const float4*)(st + 2 * 4096 + s * 256 + kq * 16);
      const float4 a4 = *(const float4*)(st + 3 * 4096 + s * 256 + kq * 16);
      const float4 b4 = *(const float4*)(st + 4 * 4096 + s * 256 + kq * 16);
      const float vv = *(const float*)(st + 20480 + s * 64 + vrow_l * 4);
      float sa = S0 * a4.x + S1 * a4.y + S2 * a4.z + S3 * a4.w;
      sa = row16_sum(sa);
      S0 = S0 * w4.x + sa * b4.x + vv * k4.x;
      S1 = S1 * w4.y + sa * b4.y + vv * k4.y;
      S2 = S2 * w4.z + sa * b4.z + vv * k4.z;
      S3 = S3 * w4.w + sa * b4.w + vv * k4.w;
      float y = S0 * r4.x + S1 * r4.y + S2 * r4.z + S3 * r4.w;
      y = row16_sum(y);
      if (kq == 0) ybw[s * 16 + vrow_l] = y;
    }
  }
  __syncthreads();
  {
    const float* yb = (const float*)(smem + 43008 + ((nc - 1) & 1) * 1024);
    const int ts = (nc - 1) * TC + lstep;
    const int t = tok0 + (dir ? T - 1 - ts : ts);
    yout[(size_t)t * 512 + h * 64 + rg * 16 + l16] = yb[lstep * 16 + l16];
  }
  if (seq < 16) {
    float* so = p.out + OUT_STATE + ((size_t)((seq * 2 + dir) * 8 + h) * 64 + vrow) * 64 + kq * 4;
    *(float4*)so = make_float4(S0, S1, S2, S3);
  }
  __syncthreads();
}

DEV void attn_wave_item(const Params& p, int witem) {
  const int lane = threadIdx.x & 63, fr = lane & 15, fq = lane >> 4;
  const bf16_t* qb = (const bf16_t*)(p.ws + OFF_QB);
  const bf16_t* kb = (const bf16_t*)(p.ws + OFF_KB);
  const bf16_t* vT = (const bf16_t*)(p.ws + OFF_VT);
  const bf16_t* ckb = (const bf16_t*)(p.ws + OFF_CKB);
  const bf16_t* cvT = (const bf16_t*)(p.ws + OFF_CVT);
  bf16_t* ona = (bf16_t*)(p.ws + OFF_ONA);
  int h, tq0, nsub;
  bool latent;
  int b = 0, r = 0, jb = 0, row_start = 0, band = 0, seq = 0;
  if (witem < 1024) {
    latent = true;
    b = witem >> 9; const int rem = witem & 511; r = rem >> 5; jb = (rem >> 3) & 3; h = rem & 7;
    tq0 = NCTX + b * 1024 + r * 64 + jb * 16;
    row_start = min(max(r - 4, 0), 8); band = min(max(jb * 16 - 8, 0), 32);
    nsub = 4;
  } else {
    latent = false;
    const int w2 = witem - 1024; const int qt = w2 >> 3; h = w2 & 7;
    tq0 = qt * 16; seq = tq0 >> 8; nsub = 2;
  }
  const bf16_t* qp = qb + (size_t)(tq0 + fr) * 512 + h * 64 + fq * 8;
  const bf16x8 qf0 = *(const bf16x8*)qp, qf1 = *(const bf16x8*)(qp + 32);
  float m = -INFINITY, l = 0.f;
  f32x4 O[4];
#pragma unroll
  for (int i = 0; i < 4; ++i) O[i] = (f32x4){0.f, 0.f, 0.f, 0.f};
#pragma unroll 1
  for (int sc = 0; sc < nsub; ++sc) {
    const int half = sc & 1;
    const bf16_t* kbase; const bf16_t* vbase; int KS, ldv;
    const bool win = latent && sc < 2;
    if (win) {
      const int tb = NCTX + b * 1024 + (row_start + half * 4) * 64 + band;
      kbase = kb + (size_t)tb * 512 + h * 64; vbase = vT + (size_t)(h * 64) * NTOK + tb; KS = 64; ldv = NTOK;
    } else if (latent) {
      kbase = ckb + (size_t)(b * 256 + half * 128) * 512 + h * 64; vbase = cvT + (size_t)((b * 8 + h) * 64) * 256 + half * 128; KS = 32; ldv = 256;
    } else {
      const int tb = seq * 256 + half * 128;
      kbase = kb + (size_t)tb * 512 + h * 64; vbase = vT + (size_t)(h * 64) * NTOK + tb; KS = 32; ldv = NTOK;
    }
    f32x4 st[8];
#pragma unroll
    for (int i = 0; i < 8; ++i) {
      const int tokrel = (i >> 1) * KS + (i & 1) * 16 + fr;
      const bf16_t* kp = kbase + (size_t)tokrel * 512 + fq * 8;
      const bf16x8 kf0 = *(const bf16x8*)kp, kf1 = *(const bf16x8*)(kp + 32);
      f32x4 z = (f32x4){0.f, 0.f, 0.f, 0.f};
      z = __builtin_amdgcn_mfma_f32_16x16x32_bf16(kf0, qf0, z, 0, 0, 0);
      st[i] = __builtin_amdgcn_mfma_f32_16x16x32_bf16(kf1, qf1, z, 0, 0, 0);
    }
    if (win) {
      const int q_col = jb * 16 + fr;
      const int win_start = min(max(q_col - 8, 0), 48);
      const float* rpb = p.in[25] + h * 465;
#pragma unroll
      for (int i = 0; i < 8; ++i) {
        const int dr = row_start + half * 4 + (i >> 1) - r + 7;
#pragma unroll
        for (int e = 0; e < 4; ++e) {
          const int k_col = band + (i & 1) * 16 + fq * 4 + e;
          const bool valid = (k_col >= win_start) && (k_col < win_start + 16);
          const int dc = min(max(k_col - q_col, -15), 15) + 15;
          st[i][e] = valid ? st[i][e] + rpb[dr * 31 + dc] : -1e30f;
        }
      }
    }
    float cmax = -1e30f;
#pragma unroll
    for (int i = 0; i < 8; ++i)
#pragma unroll
      for (int e = 0; e < 4; ++e) cmax = fmaxf(cmax, st[i][e]);
    cmax = fmaxf(cmax, __shfl_xor(cmax, 16)); cmax = fmaxf(cmax, __shfl_xor(cmax, 32));
    const float mnew = fmaxf(m, cmax);
    const float alpha = __expf(m - mnew);
    float psum = 0.f;
#pragma unroll
    for (int i = 0; i < 8; ++i)
#pragma unroll
      for (int e = 0; e < 4; ++e) { const float pv = __expf(st[i][e] - mnew); st[i][e] = pv; psum += pv; }
    psum += __shfl_xor(psum, 16); psum += __shfl_xor(psum, 32);
    l = l * alpha + psum;
#pragma unroll
    for (int i = 0; i < 4; ++i) O[i] = O[i] * alpha;
    m = mnew;
#pragma unroll
    for (int s = 0; s < 4; ++s) {
      union { bf16x8 v; unsigned u[4]; } pb;
      pb.u[0] = pk2(st[2 * s][0], st[2 * s][1]); pb.u[1] = pk2(st[2 * s][2], st[2 * s][3]);
      pb.u[2] = pk2(st[2 * s + 1][0], st[2 * s + 1][1]); pb.u[3] = pk2(st[2 * s + 1][2], st[2 * s + 1][3]);
#pragma unroll
      for (int dt = 0; dt < 4; ++dt) {
        const bf16_t* vp = vbase + (size_t)(dt * 16 + fr) * ldv + s * KS + fq * 4;
        union { bf16x8 v; uint2 u[2]; } va;
        va.u[0] = *(const uint2*)vp; va.u[1] = *(const uint2*)(vp + 16);
        O[dt] = __builtin_amdgcn_mfma_f32_16x16x32_bf16(va.v, pb.v, O[dt], 0, 0, 0);
      }
    }
  }
  const float inv = 1.f / l;
#pragma unroll
  for (int dt = 0; dt < 4; ++dt) {
    bf16_t* op = ona + (size_t)(tq0 + fr) * 512 + h * 64 + dt * 16 + fq * 4;
    *(uint2*)op = make_uint2(pk2(O[dt][0] * inv, O[dt][1] * inv), pk2(O[dt][2] * inv, O[dt][3] * inv));
  }
}

constexpr int N_SCAN_ITEMS = 1152, N_ATTN_BLK = 768;
DEV void phase_scan_attn(const Params& p, unsigned char* smem, int* s_item) {
  unsigned* counter = (unsigned*)(p.ws + OFF_CTL);
  for (;;) {
    if (threadIdx.x == 0) *s_item = (int)atomicAdd(counter, 1u);
    __syncthreads();
    const int item = *s_item;
    __syncthreads();
    if (item >= N_SCAN_ITEMS + N_ATTN_BLK) break;
    if (item < N_SCAN_ITEMS) scan_item(p, smem, item);
    else attn_wave_item(p, (item - N_SCAN_ITEMS) * 4 + (threadIdx.x >> 6));
  }
}

DEV void phase_finalize_rw(const Params& p, int bid, int nb) {
  const int lane = threadIdx.x & 63, gw = bid * 4 + (threadIdx.x >> 6), nw = nb * 4;
  const float* yf = (const float*)(p.ws + OFF_YF);
  const float* yb = (const float*)(p.ws + OFF_YB);
  const bf16_t* bonus = (const bf16_t*)(p.ws + OFF_BG);
  const bf16_t* gate = (const bf16_t*)(p.ws + OFF_BG + 6291456);
  bf16_t* orw = (bf16_t*)(p.ws + OFF_ORW);
  for (int it = gw; it < NTOK * 8; it += nw) {
    const size_t o = (size_t)it * 64 + lane;
    const int c = (it & 7) * 64 + lane;
    const float y = yf[o] + yb[o];
    const float mean = wave_sum(y) * (1.f / 64.f);
    const float d = y - mean;
    const float var = wave_sum(d * d) * (1.f / 64.f);
    const float yn = d * rsqrtf(var + 64e-5f) * p.in[21][c] + p.in[22][c];
    orw[o] = f2bf((yn + bf2f(bonus[o])) * bf2f(gate[o]));
  }
}

__global__ void __launch_bounds__(NTHR, 2) fwd_megakernel(Params p) {
  extern __shared__ __attribute__((aligned(16))) unsigned char smem[];
  __shared__ int s_item;
  cg::grid_group grid = cg::this_grid();
  const int bid = blockIdx.x, nb = gridDim.x;
#define PH(n, body) if (p.ph_lo <= n && n < p.ph_hi) { body; if (n + 1 < p.ph_hi) grid.sync(); }
  PH(0, phase0(p, smem, bid, nb))
  PH(1, phase_normmod<0>(p, bid, nb))
  PH(2, phase_gemm_in(p, smem, bid, nb))
  PH(3, phase_qkprep(p, smem, bid, nb); phase_rwprep(p, smem, bid, nb))
  PH(4, phase_scan_attn(p, smem, &s_item))
  PH(5, phase_finalize_rw(p, bid, nb))
  PH(6, phase_gemm_merge(p, smem, bid, nb))
  PH(7, phase_gemm_out(p, smem, bid, nb))
  PH(8, phase_normmod<1>(p, bid, nb))
  PH(9, phase_gemm_ffn_up(p, smem, bid, nb))
  PH(10, phase_gemm_ffn_down(p, smem, bid, nb))
}

extern "C" void kernel_launch(void* const* d_in, const int* in_sizes, int n_in, void* d_out, int out_size, void* d_ws, size_t ws_size,
                              hipStream_t stream) {
  static int grid_blocks = 0;
  if (grid_blocks == 0) {
    if (n_in != 32 || ws_size < WS_END) { fprintf(stderr, "kernel_launch: unexpected n_in %d / ws_size %zu (need %zu)\n", n_in, ws_size, (size_t)WS_END); grid_blocks = -1; return; }
    int dev = 0, cus = 0, per_cu = 0;
    hipGetDevice(&dev);
    hipDeviceGetAttribute(&cus, hipDeviceAttributeMultiprocessorCount, dev);
    if (hipFuncSetAttribute((const void*)fwd_megakernel, hipFuncAttributeMaxDynamicSharedMemorySize, LDS_BYTES) != hipSuccess) { fprintf(stderr, "hipFuncSetAttribute failed\n"); grid_blocks = -1; return; }
    if (hipOccupancyMaxActiveBlocksPerMultiprocessor(&per_cu, (const void*)fwd_megakernel, NTHR, LDS_BYTES) != hipSuccess || per_cu < 1) { fprintf(stderr, "occupancy query failed (%d)\n", per_cu); grid_blocks = -1; return; }
    if (per_cu > 2) per_cu = 2;
    grid_blocks = cus * per_cu;
    fprintf(stderr, "kernel_launch: cus %d per_cu %d grid %d\n", cus, per_cu, grid_blocks);
  }
  if (grid_blocks < 0) return;
  hipMemsetAsync((char*)d_ws + OFF_CTL, 0, CTL_ZERO_BYTES, stream);
  Params p{};
  for (int i = 0; i < 32; ++i) p.in[i] = (const float*)d_in[i];
  p.out = (float*)d_out; p.ws = (unsigned char*)d_ws; p.ph_lo = 0; p.ph_hi = 11;
  void* args[] = {&p};
  hipError_t e = hipLaunchCooperativeKernel((const void*)fwd_megakernel, dim3(grid_blocks), dim3(NTHR), args, LDS_BYTES, stream);
  if (e != hipSuccess) fprintf(stderr, "cooperative launch failed: %s (grid %d)\n", hipGetErrorString(e), grid_blocks);
}
```

```cpp
#include <hip/hip_runtime.h>
#include <hip/hip_cooperative_groups.h>
#include <cstdio>
#include <cstdint>
namespace cg = cooperative_groups;

#define DEV __device__ __forceinline__
typedef unsigned short bf16_t;
typedef short bf16x8 __attribute__((ext_vector_type(8)));
typedef short bf16x4 __attribute__((ext_vector_type(4)));
typedef float f32x4 __attribute__((ext_vector_type(4)));

constexpr int D = 1024, NTOK = 6144, NCTX = 4096, RW = 512, FF = 2816, INC = 5504, RWC = 1920;
constexpr int NTHR = 256;
constexpr int LDS_BYTES = 73728;

constexpr size_t OFF_CTL = 0;
constexpr size_t OFF_MOD = 16384;
constexpr size_t CTL_ZERO_BYTES = 16384 + 3 * 6144 * 4;
constexpr size_t OFF_WIN = 90112;
constexpr size_t OFF_WORW = OFF_WIN + 11272192;
constexpr size_t OFF_WONA = OFF_WORW + 1048576;
constexpr size_t OFF_WOUT = OFF_WONA + 1048576;
constexpr size_t OFF_W13 = OFF_WOUT + 2097152;
constexpr size_t OFF_W2 = OFF_W13 + 11534336;
constexpr size_t OFF_H = OFF_W2 + 5767168;
constexpr size_t OFF_URW = OFF_H + 12582912;
constexpr size_t OFF_UNA = OFF_URW + 47185920;
constexpr size_t OFF_OPS = OFF_UNA + 37748736;
constexpr size_t OPS_ARR = 12582912;
constexpr size_t OFF_BG = OFF_OPS + 9 * OPS_ARR;
constexpr size_t OFF_VT = OFF_BG + 12582912;
constexpr size_t OFF_CKB = OFF_VT + 6291456;
constexpr size_t OFF_CVT = OFF_CKB + 524288;
constexpr size_t WS_END = OFF_CVT + 524288;
constexpr size_t OFF_QB = OFF_H, OFF_KB = OFF_H + 6291456;
constexpr size_t OFF_YF = OFF_URW, OFF_YB = OFF_URW + 12582912;
constexpr size_t OFF_ORW = OFF_UNA, OFF_ONA = OFF_UNA + 6291456;
constexpr size_t OFF_MERGED = OFF_OPS;
constexpr size_t OFF_HID = OFF_URW;
constexpr size_t OUT_STATE = 6291456, OUT_K = 7340032, OUT_V = 9437184;

struct Params {
  const float* in[32];
  float* out;
  unsigned char* ws;
  int ph_lo, ph_hi;
};

DEV unsigned short f2bf(float f) { unsigned u = __float_as_uint(f); u += 0x7fffu + ((u >> 16) & 1u); return (unsigned short)(u >> 16); }
DEV unsigned pk2(float lo, float hi) { return (unsigned)f2bf(lo) | ((unsigned)f2bf(hi) << 16); }
DEV float bf2f(unsigned short b) { return __uint_as_float(((unsigned)b) << 16); }
DEV float sigmoidf_(float x) { return 1.f / (1.f + __expf(-x)); }
DEV float wave_sum(float x) {
#pragma unroll
  for (int o = 32; o > 0; o >>= 1) x += __shfl_xor(x, o);
  return x;
}
template <int CTRL> DEV float dpp_mov(float x) { return __int_as_float(__builtin_amdgcn_update_dpp(0, __float_as_int(x), CTRL, 0xf, 0xf, true)); }
DEV float row16_sum(float x) {
  x += dpp_mov<0xB1>(x); x += dpp_mov<0x4E>(x); x += dpp_mov<0x141>(x); x += dpp_mov<0x140>(x);
  return x;
}
DEV const float* xrow(const Params& p, int t) { return t < NCTX ? p.in[0] + (size_t)t * D : p.in[1] + (size_t)(t - NCTX) * D; }
DEV int modidx(int t) { return t < NCTX ? 0 : 1 + ((t - NCTX) >> 10); }

DEV void conv_job(const Params& p, int j, const float*& src, bf16_t*& dst, int& K, int& N, int& mode, int& base) {
  if (j < 1376) { src = p.in[11]; dst = (bf16_t*)(p.ws + OFF_WIN); K = 1024; N = 5504; mode = 0; base = 0; }
  else if (j < 1504) { src = p.in[26]; dst = (bf16_t*)(p.ws + OFF_WORW); K = 512; N = 1024; mode = 0; base = 1376; }
  else if (j < 1632) { src = p.in[27]; dst = (bf16_t*)(p.ws + OFF_WONA); K = 512; N = 1024; mode = 0; base = 1504; }
  else if (j < 1888) { src = p.in[28]; dst = (bf16_t*)(p.ws + OFF_WOUT); K = 1024; N = 1024; mode = 0; base = 1632; }
  else if (j < 2592) { src = p.in[29]; dst = (bf16_t*)(p.ws + OFF_W13); K = 1024; N = 2816; mode = 1; base = 1888; }
  else if (j < 3296) { src = p.in[30]; dst = (bf16_t*)(p.ws + OFF_W13); K = 1024; N = 2816; mode = 2; base = 2592; }
  else { src = p.in[31]; dst = (bf16_t*)(p.ws + OFF_W2); K = 2816; N = 1024; mode = 0; base = 3296; }
}
constexpr int N_CONV_TILES = 4000, N_MOD_TILES = 768;

DEV void phase0(const Params& p, unsigned char* smem, int bid, int nb, int rep) {
  const int tid = threadIdx.x;
  float* T = (float*)smem;
  for (int tile = bid + (rep ? N_MOD_TILES : 0); tile < N_MOD_TILES + N_CONV_TILES; tile += nb) {
    if (tile < N_MOD_TILES) {
      const int cgp = tile % 24, kc = tile / 24;
      if (tid < 96) {
        const int m = tid >> 5, kk = tid & 31, k = kc * 32 + kk;
        const float c = (m == 0) ? p.in[6][k] : p.in[5][(m - 1) * D + k];
        T[tid] = c * sigmoidf_(c);
      }
      __syncthreads();
      const int col = cgp * 256 + tid;
      const float* w = p.in[9] + (size_t)(kc * 32) * 6144 + col;
      float a0 = 0.f, a1 = 0.f, a2 = 0.f;
#pragma unroll 8
      for (int kk = 0; kk < 32; ++kk) {
        const float wv = w[(size_t)kk * 6144];
        a0 += T[kk] * wv; a1 += T[32 + kk] * wv; a2 += T[64 + kk] * wv;
      }
      if (kc == 0) { const float b = p.in[10][col]; a0 += b; a1 += b; a2 += b; }
      float* mod = (float*)(p.ws + OFF_MOD);
      atomicAdd(mod + col, a0); atomicAdd(mod + 6144 + col, a1); atomicAdd(mod + 12288 + col, a2);
      __syncthreads();
    } else {
      const float* src; bf16_t* dst; int K, N, mode, base;
      conv_job(p, tile - N_MOD_TILES, src, dst, K, N, mode, base);
      const int lt = tile - N_MOD_TILES - base;
      const int nN = N >> 6;
      const int k0 = (lt / nN) * 64, n0 = (lt % nN) * 64;
#pragma unroll
      for (int i = 0; i < 4; ++i) {
        const int idx = tid + 256 * i, r = idx >> 4, c4 = idx & 15;
        const float4 v = *(const float4*)(src + (size_t)(k0 + r) * N + n0 + c4 * 4);
        float* tp = T + r * 65 + c4 * 4;
        tp[0] = v.x; tp[1] = v.y; tp[2] = v.z; tp[3] = v.w;
      }
      __syncthreads();
      const int n = tid >> 2, kp = tid & 3;
      unsigned w[8];
#pragma unroll
      for (int i = 0; i < 8; ++i) w[i] = pk2(T[(kp * 16 + 2 * i) * 65 + n], T[(kp * 16 + 2 * i + 1) * 65 + n]);
      const int ng = n0 + n;
      int drow = ng;
      if (mode == 1) drow = (ng >> 4) * 32 + (ng & 15);
      else if (mode == 2) drow = (ng >> 4) * 32 + 16 + (ng & 15);
      uint4* dp = (uint4*)(dst + (size_t)drow * K + k0 + kp * 16);
      dp[0] = make_uint4(w[0], w[1], w[2], w[3]);
      dp[1] = make_uint4(w[4], w[5], w[6], w[7]);
      __syncthreads();
    }
  }
}

template <int WHICH>
DEV void phase_normmod(const Params& p, int bid, int nb) {
  const int lane = threadIdx.x & 63, gw = bid * 4 + (threadIdx.x >> 6), nw = nb * 4;
  const float* g = WHICH == 0 ? p.in[7] : p.in[8];
  const float* mod = (const float*)(p.ws + OFF_MOD);
  const int sh_off = WHICH == 0 ? 0 : 3072, sc_off = WHICH == 0 ? 1024 : 4096;
  bf16_t* dst = (bf16_t*)(p.ws + OFF_H);
  for (int t = gw; t < NTOK; t += nw) {
    const float* xp = WHICH == 0 ? xrow(p, t) : p.out + (size_t)t * D;
    const float* mm = mod + modidx(t) * 6144;
    float4 v[4];
    float ss = 0.f;
#pragma unroll
    for (int i = 0; i < 4; ++i) {
      v[i] = *(const float4*)(xp + (i * 64 + lane) * 4);
      ss += v[i].x * v[i].x + v[i].y * v[i].y + v[i].z * v[i].z + v[i].w * v[i].w;
    }
    ss = wave_sum(ss);
    const float rstd = rsqrtf(ss * (1.f / 1024.f) + 1e-6f);
#pragma unroll
    for (int i = 0; i < 4; ++i) {
      const int col = (i * 64 + lane) * 4;
      const float4 g4 = *(const float4*)(g + col);
      const float4 sc = *(const float4*)(mm + sc_off + col);
      const float4 sh = *(const float4*)(mm + sh_off + col);
      const float y0 = v[i].x * rstd * g4.x * (1.f + sc.x) + sh.x;
      const float y1 = v[i].y * rstd * g4.y * (1.f + sc.y) + sh.y;
      const float y2 = v[i].z * rstd * g4.z * (1.f + sc.z) + sh.z;
      const float y3 = v[i].w * rstd * g4.w * (1.f + sc.w) + sh.w;
      *(uint2*)(dst + (size_t)t * D + col) = make_uint2(pk2(y0, y1), pk2(y2, y3));
    }
  }
}

constexpr int LROW = 144;
constexpr int ATILE = 128 * LROW;
constexpr int STAGE = 2 * ATILE;

DEV void gemm_tile_acc(f32x4 (&acc)[4][4], const bf16_t* __restrict__ A, int lda, const bf16_t* __restrict__ Bt, int ldb,
                       int m0, int n0, int K, unsigned char* smem) {
  const int tid = threadIdx.x, lane = tid & 63, wid = tid >> 6, wr = wid >> 1, wc = wid & 1, fr = lane & 15, fq = lane >> 4;
  const int srow = tid >> 3, sc = tid & 7;
  const bf16_t* ga = A + (size_t)(m0 + srow) * lda + sc * 8;
  const bf16_t* gb = Bt + (size_t)(n0 + srow) * ldb + sc * 8;
  uint4 ra[4], rb[4];
  const int nk = K >> 6;
#pragma unroll
  for (int i = 0; i < 4; ++i) { ra[i] = *(const uint4*)(ga + (size_t)i * 32 * lda); rb[i] = *(const uint4*)(gb + (size_t)i * 32 * ldb); }
#pragma unroll
  for (int i = 0; i < 4; ++i) {
    *(uint4*)(smem + (srow + 32 * i) * LROW + sc * 16) = ra[i];
    *(uint4*)(smem + ATILE + (srow + 32 * i) * LROW + sc * 16) = rb[i];
  }
  __syncthreads();
  for (int kt = 0; kt < nk; ++kt) {
    if (kt + 1 < nk) {
      const int k0 = (kt + 1) * 64;
#pragma unroll
      for (int i = 0; i < 4; ++i) { ra[i] = *(const uint4*)(ga + (size_t)i * 32 * lda + k0); rb[i] = *(const uint4*)(gb + (size_t)i * 32 * ldb + k0); }
    }
    const unsigned char* cur = smem + (kt & 1) * STAGE;
#pragma unroll
    for (int ks = 0; ks < 2; ++ks) {
      bf16x8 af[4], bf[4];
#pragma unroll
      for (int mi = 0; mi < 4; ++mi) af[mi] = *(const bf16x8*)(cur + (wr * 64 + mi * 16 + fr) * LROW + ks * 64 + fq * 16);
#pragma unroll
      for (int ni = 0; ni < 4; ++ni) bf[ni] = *(const bf16x8*)(cur + ATILE + (wc * 64 + ni * 16 + fr) * LROW + ks * 64 + fq * 16);
#pragma unroll
      for (int mi = 0; mi < 4; ++mi)
#pragma unroll
        for (int ni = 0; ni < 4; ++ni) acc[mi][ni] = __builtin_amdgcn_mfma_f32_16x16x32_bf16(bf[ni], af[mi], acc[mi][ni], 0, 0, 0);
    }
    if (kt + 1 < nk) {
      unsigned char* nxt = smem + ((kt + 1) & 1) * STAGE;
#pragma unroll
      for (int i = 0; i < 4; ++i) {
        *(uint4*)(nxt + (srow + 32 * i) * LROW + sc * 16) = ra[i];
        *(uint4*)(nxt + ATILE + (srow + 32 * i) * LROW + sc * 16) = rb[i];
      }
    }
    __syncthreads();
  }
}

DEV void zero_acc(f32x4 (&acc)[4][4]) {
#pragma unroll
  for (int i = 0; i < 4; ++i)
#pragma unroll
    for (int j = 0; j < 4; ++j) acc[i][j] = (f32x4){0.f, 0.f, 0.f, 0.f};
}

#define EPI_COORDS const int lane = threadIdx.x & 63, wid = threadIdx.x >> 6, wr = wid >> 1, wc = wid & 1, fr = lane & 15, fq = lane >> 4

DEV void phase_gemm_in(const Params& p, unsigned char* smem, int bid, int nb) {
  EPI_COORDS;
  const bf16_t* A = (const bf16_t*)(p.ws + OFF_H);
  const bf16_t* Bt = (const bf16_t*)(p.ws + OFF_WIN);
  float* urw = (float*)(p.ws + OFF_URW);
  float* una = (float*)(p.ws + OFF_UNA);
  bf16_t* gates = (bf16_t*)p.out;
  for (int tile = bid; tile < 48 * 43; tile += nb) {
    const int tm = tile % 48, tn = tile / 48, m0 = tm * 128, n0 = tn * 128;
    f32x4 acc[4][4];
    zero_acc(acc);
    gemm_tile_acc(acc, A, D, Bt, D, m0, n0, D, smem);
#pragma unroll
    for (int mi = 0; mi < 4; ++mi) {
      const int row = m0 + wr * 64 + mi * 16 + fr;
#pragma unroll
      for (int ni = 0; ni < 4; ++ni) {
        const int col = n0 + wc * 64 + ni * 16 + fq * 4;
        const f32x4 v = acc[mi][ni];
        if (n0 < 1920) *(f32x4*)(urw + (size_t)row * 1920 + col) = v;
        else if (n0 < 3456) *(f32x4*)(una + (size_t)row * 1536 + (col - 1920)) = v;
        else *(uint2*)(gates + (size_t)row * 2048 + (col - 3456)) = make_uint2(pk2(sigmoidf_(v[0]), sigmoidf_(v[1])), pk2(sigmoidf_(v[2]), sigmoidf_(v[3])));
      }
    }
  }
}

DEV void phase_gemm_merge(const Params& p, unsigned char* smem, int bid, int nb) {
  EPI_COORDS;
  const bf16_t* orw = (const bf16_t*)(p.ws + OFF_ORW);
  const bf16_t* ona = (const bf16_t*)(p.ws + OFF_ONA);
  const bf16_t* w1 = (const bf16_t*)(p.ws + OFF_WORW);
  const bf16_t* w2 = (const bf16_t*)(p.ws + OFF_WONA);
  const bf16_t* gates = (const bf16_t*)p.out;
  bf16_t* merged = (bf16_t*)(p.ws + OFF_MERGED);
  float* mtmp = (float*)(p.ws + OFF_MERGED + 16777216);
  for (int tile = bid; tile < 48 * 8; tile += nb) {
    const int tm = tile % 48, tn = tile / 48, m0 = tm * 128, n0 = tn * 128;
    f32x4 acc[4][4];
    zero_acc(acc);
    gemm_tile_acc(acc, orw, RW, w1, RW, m0, n0, RW, smem);
#pragma unroll
    for (int mi = 0; mi < 4; ++mi) {
      const int row = m0 + wr * 64 + mi * 16 + fr;
#pragma unroll
      for (int ni = 0; ni < 4; ++ni) {
        const int col = n0 + wc * 64 + ni * 16 + fq * 4;
        const uint2 g = *(const uint2*)(gates + (size_t)row * 2048 + col);
        f32x4 r;
        r[0] = acc[mi][ni][0] * bf2f((unsigned short)(g.x & 0xffff));
        r[1] = acc[mi][ni][1] * bf2f((unsigned short)(g.x >> 16));
        r[2] = acc[mi][ni][2] * bf2f((unsigned short)(g.y & 0xffff));
        r[3] = acc[mi][ni][3] * bf2f((unsigned short)(g.y >> 16));
        *(f32x4*)(mtmp + (size_t)row * D + col) = r;
      }
    }
    zero_acc(acc);
    gemm_tile_acc(acc, ona, RW, w2, RW, m0, n0, RW, smem);
#pragma unroll
    for (int mi = 0; mi < 4; ++mi) {
      const int row = m0 + wr * 64 + mi * 16 + fr;
#pragma unroll
      for (int ni = 0; ni < 4; ++ni) {
        const int col = n0 + wc * 64 + ni * 16 + fq * 4;
        const uint2 g = *(const uint2*)(gates + (size_t)row * 2048 + 1024 + col);
        const f32x4 mg = *(const f32x4*)(mtmp + (size_t)row * D + col);
        const float r0 = mg[0] + acc[mi][ni][0] * bf2f((unsigned short)(g.x & 0xffff));
        const float r1 = mg[1] + acc[mi][ni][1] * bf2f((unsigned short)(g.x >> 16));
        const float r2 = mg[2] + acc[mi][ni][2] * bf2f((unsigned short)(g.y & 0xffff));
        const float r3 = mg[3] + acc[mi][ni][3] * bf2f((unsigned short)(g.y >> 16));
        *(uint2*)(merged + (size_t)row * D + col) = make_uint2(pk2(r0, r1), pk2(r2, r3));
      }
    }
  }
}

DEV void phase_gemm_out(const Params& p, unsigned char* smem, int bid, int nb) {
  EPI_COORDS;
  const bf16_t* A = (const bf16_t*)(p.ws + OFF_MERGED);
  const bf16_t* Bt = (const bf16_t*)(p.ws + OFF_WOUT);
  const float* mod = (const float*)(p.ws + OFF_MOD);
  for (int tile = bid; tile < 48 * 8; tile += nb) {
    const int tm = tile % 48, tn = tile / 48, m0 = tm * 128, n0 = tn * 128;
    f32x4 acc[4][4];
    zero_acc(acc);
    gemm_tile_acc(acc, A, D, Bt, D, m0, n0, D, smem);
#pragma unroll
    for (int mi = 0; mi < 4; ++mi) {
      const int row = m0 + wr * 64 + mi * 16 + fr;
      const float* xp = xrow(p, row);
      const float* g1 = mod + modidx(row) * 6144 + 2048;
#pragma unroll
      for (int ni = 0; ni < 4; ++ni) {
        const int col = n0 + wc * 64 + ni * 16 + fq * 4;
        const f32x4 x = *(const f32x4*)(xp + col);
        const f32x4 g = *(const f32x4*)(g1 + col);
        *(f32x4*)(p.out + (size_t)row * D + col) = x + g * acc[mi][ni];
      }
    }
  }
}

DEV void phase_gemm_ffn_up(const Params& p, unsigned char* smem, int bid, int nb) {
  EPI_COORDS;
  const bf16_t* A = (const bf16_t*)(p.ws + OFF_H);
  const bf16_t* Bt = (const bf16_t*)(p.ws + OFF_W13);
  bf16_t* hid = (bf16_t*)(p.ws + OFF_HID);
  for (int tile = bid; tile < 48 * 44; tile += nb) {
    const int tm = tile % 48, tn = tile / 48, m0 = tm * 128, n0 = tn * 128;
    f32x4 acc[4][4];
    zero_acc(acc);
    gemm_tile_acc(acc, A, D, Bt, D, m0, n0, D, smem);
#pragma unroll
    for (int mi = 0; mi < 4; ++mi) {
      const int row = m0 + wr * 64 + mi * 16 + fr;
#pragma unroll
      for (int gp = 0; gp < 2; ++gp) {
        const int hcol = ((n0 + wc * 64) >> 1) + gp * 16 + fq * 4;
        const f32x4 a = acc[mi][2 * gp], b = acc[mi][2 * gp + 1];
        float r[4];
#pragma unroll
        for (int e = 0; e < 4; ++e) r[e] = a[e] * sigmoidf_(a[e]) * b[e];
        *(uint2*)(hid + (size_t)row * FF + hcol) = make_uint2(pk2(r[0], r[1]), pk2(r[2], r[3]));
      }
    }
  }
}

DEV void phase_gemm_ffn_down(const Params& p, unsigned char* smem, int bid, int nb) {
  EPI_COORDS;
  const bf16_t* A = (const bf16_t*)(p.ws + OFF_HID);
  const bf16_t* Bt = (const bf16_t*)(p.ws + OFF_W2);
  const float* mod = (const float*)(p.ws + OFF_MOD);
  for (int tile = bid; tile < 48 * 8; tile += nb) {
    const int tm = tile % 48, tn = tile / 48, m0 = tm * 128, n0 = tn * 128;
    f32x4 acc[4][4];
    zero_acc(acc);
    gemm_tile_acc(acc, A, FF, Bt, FF, m0, n0, FF, smem);
#pragma unroll
    for (int mi = 0; mi < 4; ++mi) {
      const int row = m0 + wr * 64 + mi * 16 + fr;
      const float* g2 = mod + modidx(row) * 6144 + 5120;
#pragma unroll
      for (int ni = 0; ni < 4; ++ni) {
        const int col = n0 + wc * 64 + ni * 16 + fq * 4;
        float* op = p.out + (size_t)row * D + col;
        const f32x4 x = *(const f32x4*)op;
        const f32x4 g = *(const f32x4*)(g2 + col);
        *(f32x4*)op = x + g * acc[mi][ni];
      }
    }
  }
}

DEV void phase_qkprep(const Params& p, unsigned char* smem, int bid, int nb) {
  const int tid = threadIdx.x;
  bf16_t* Vs = (bf16_t*)smem;
  bf16_t* qb = (bf16_t*)(p.ws + OFF_QB);
  bf16_t* kb = (bf16_t*)(p.ws + OFF_KB);
  bf16_t* vT = (bf16_t*)(p.ws + OFF_VT);
  bf16_t* ckb = (bf16_t*)(p.ws + OFF_CKB);
  bf16_t* cvT = (bf16_t*)(p.ws + OFF_CVT);
  const float* una = (const float*)(p.ws + OFF_UNA);
  const int tok = tid >> 2, part = tid & 3;
  for (int item = bid; item < 832; item += nb) {
    if (item < 768) {
      const int tt = item >> 3, h = item & 7, t0 = tt * 64, t = t0 + tok;
      const float* src = una + (size_t)t * 1536 + h * 64 + part * 16;
      {
        float x[16]; float ss = 0.f;
#pragma unroll
        for (int i = 0; i < 4; ++i) { const float4 v = *(const float4*)(src + i * 4); x[4 * i] = v.x; x[4 * i + 1] = v.y; x[4 * i + 2] = v.z; x[4 * i + 3] = v.w; }
#pragma unroll
        for (int i = 0; i < 16; ++i) ss += x[i] * x[i];
        ss += __shfl_xor(ss, 1); ss += __shfl_xor(ss, 2);
        const float rs = rsqrtf(ss * (1.f / 64.f) + 1e-6f) * 0.125f;
        unsigned w[8];
#pragma unroll
        for (int i = 0; i < 8; ++i) w[i] = pk2(x[2 * i] * rs * p.in[23][part * 16 + 2 * i], x[2 * i + 1] * rs * p.in[23][part * 16 + 2 * i + 1]);
        uint4* dp = (uint4*)(qb + (size_t)t * 512 + h * 64 + part * 16);
        dp[0] = make_uint4(w[0], w[1], w[2], w[3]); dp[1] = make_uint4(w[4], w[5], w[6], w[7]);
      }
      {
        float x[16]; float ss = 0.f;
#pragma unroll
        for (int i = 0; i < 4; ++i) { const float4 v = *(const float4*)(src + 512 + i * 4); x[4 * i] = v.x; x[4 * i + 1] = v.y; x[4 * i + 2] = v.z; x[4 * i + 3] = v.w; }
#pragma unroll
        for (int i = 0; i < 16; ++i) ss += x[i] * x[i];
        ss += __shfl_xor(ss, 1); ss += __shfl_xor(ss, 2);
        const float rs = rsqrtf(ss * (1.f / 64.f) + 1e-6f);
#pragma unroll
        for (int i = 0; i < 16; ++i) x[i] = x[i] * rs * p.in[24][part * 16 + i];
        if (t < NCTX) {
          float4* op = (float4*)(p.out + OUT_K + (size_t)t * 512 + h * 64 + part * 16);
#pragma unroll
          for (int i = 0; i < 4; ++i) op[i] = make_float4(x[4 * i], x[4 * i + 1], x[4 * i + 2], x[4 * i + 3]);
        }
        unsigned w[8];
#pragma unroll
        for (int i = 0; i < 8; ++i) w[i] = pk2(x[2 * i], x[2 * i + 1]);
        uint4* dp = (uint4*)(kb + (size_t)t * 512 + h * 64 + part * 16);
        dp[0] = make_uint4(w[0], w[1], w[2], w[3]); dp[1] = make_uint4(w[4], w[5], w[6], w[7]);
      }
      {
        float x[16];
#pragma unroll
        for (int i = 0; i < 4; ++i) { const float4 v = *(const float4*)(src + 1024 + i * 4); x[4 * i] = v.x; x[4 * i + 1] = v.y; x[4 * i + 2] = v.z; x[4 * i + 3] = v.w; }
        if (t < NCTX) {
          float4* op = (float4*)(p.out + OUT_V + (size_t)t * 512 + h * 64 + part * 16);
#pragma unroll
          for (int i = 0; i < 4; ++i) op[i] = make_float4(x[4 * i], x[4 * i + 1], x[4 * i + 2], x[4 * i + 3]);
        }
#pragma unroll
        for (int i = 0; i < 16; ++i) Vs[tok * 72 + part * 16 + i] = f2bf(x[i]);
      }
      __syncthreads();
      {
        const int d = tid >> 2;
        unsigned w[8];
#pragma unroll
        for (int i = 0; i < 8; ++i) w[i] = (unsigned)Vs[(part * 16 + 2 * i) * 72 + d] | ((unsigned)Vs[(part * 16 + 2 * i + 1) * 72 + d] << 16);
        uint4* dp = (uint4*)(vT + (size_t)(h * 64 + d) * NTOK + t0 + part * 16);
        dp[0] = make_uint4(w[0], w[1], w[2], w[3]); dp[1] = make_uint4(w[4], w[5], w[6], w[7]);
      }
      __syncthreads();
    } else {
      const int ci = item - 768, b = ci >> 5, rem = ci & 31, tt = rem >> 3, h = rem & 7, t0 = tt * 64, t = t0 + tok;
      const size_t sidx = (size_t)(b * 256 + t) * 512 + h * 64 + part * 16;
      {
        float x[16];
#pragma unroll
        for (int i = 0; i < 4; ++i) { const float4 v = *(const float4*)(p.in[3] + sidx + i * 4); x[4 * i] = v.x; x[4 * i + 1] = v.y; x[4 * i + 2] = v.z; x[4 * i + 3] = v.w; }
        unsigned w[8];
#pragma unroll
        for (int i = 0; i < 8; ++i) w[i] = pk2(x[2 * i], x[2 * i + 1]);
        uint4* dp = (uint4*)(ckb + sidx);
        dp[0] = make_uint4(w[0], w[1], w[2], w[3]); dp[1] = make_uint4(w[4], w[5], w[6], w[7]);
      }
      {
        float x[16];
#pragma unroll
        for (int i = 0; i < 4; ++i) { const float4 v = *(const float4*)(p.in[4] + sidx + i * 4); x[4 * i] = v.x; x[4 * i + 1] = v.y; x[4 * i + 2] = v.z; x[4 * i + 3] = v.w; }
#pragma unroll
        for (int i = 0; i < 16; ++i) Vs[tok * 72 + part * 16 + i] = f2bf(x[i]);
      }
      __syncthreads();
      {
        const int d = tid >> 2;
        unsigned w[8];
#pragma unroll
        for (int i = 0; i < 8; ++i) w[i] = (unsigned)Vs[(part * 16 + 2 * i) * 72 + d] | ((unsigned)Vs[(part * 16 + 2 * i + 1) * 72 + d] << 16);
        uint4* dp = (uint4*)(cvT + (size_t)((b * 8 + h) * 64 + d) * 256 + t0 + part * 16);
        dp[0] = make_uint4(w[0], w[1], w[2], w[3]); dp[1] = make_uint4(w[4], w[5], w[6], w[7]);
      }
      __syncthreads();
    }
  }
}

DEV float* ops_arr(const Params& p, int i) { return (float*)(p.ws + OFF_OPS + (size_t)i * OPS_ARR); }

DEV void shift_load16(float (&o)[16], const float* urw, int t0, int s_lo, int s_hi, int col, float mu0, float mu1) {
  const float* up = urw + (size_t)(t0 - 1) * RWC + col;
  float prev = (t0 > s_lo) ? up[0] : 0.f;
  float cur = up[RWC];
#pragma unroll
  for (int t = 0; t < 16; ++t) {
    const float nxt = (t0 + t + 1 < s_hi) ? up[(size_t)(t + 2) * RWC] : 0.f;
    o[t] = cur + mu0 * (prev - cur) + mu1 * (nxt - cur);
    prev = cur; cur = nxt;
  }
}

template <int NL>
DEV void lora16(float (&acc)[16], const float* L, const float* W, int c) {
  for (int l = 0; l < NL; l += 4) {
    const float w0 = W[(size_t)l * 512 + c], w1 = W[(size_t)(l + 1) * 512 + c], w2 = W[(size_t)(l + 2) * 512 + c], w3 = W[(size_t)(l + 3) * 512 + c];
#pragma unroll
    for (int t = 0; t < 16; ++t) {
      const float4 x = *(const float4*)(L + t * 128 + l);
      acc[t] += x.x * w0 + x.y * w1 + x.z * w2 + x.w * w3;
    }
  }
}

DEV void phase_rwprep(const Params& p, unsigned char* smem, int bid, int nb) {
  const int tid = threadIdx.x;
  float* L = (float*)smem;
  const float* urw = (const float*)(p.ws + OFF_URW);
  const float* mu = p.in[12];
  bf16_t* bonus = (bf16_t*)(p.ws + OFF_BG);
  bf16_t* gate = (bf16_t*)(p.ws + OFF_BG + 6291456);
  float* o_r = ops_arr(p, 0); float* o_v = ops_arr(p, 1); float* o_a = ops_arr(p, 2);
  for (int tile = bid; tile < 384; tile += nb) {
    const int t0 = tile * 16;
    int s_lo, s_hi;
    if (t0 < NCTX) { s_lo = t0 & ~255; s_hi = s_lo + 256; } else { s_lo = NCTX + ((t0 - NCTX) & ~1023); s_hi = s_lo + 1024; }
    for (int e = tid; e < 6144; e += NTHR) {
      const int cc = e % 384, tl = e / 384, col = 1536 + cc, t = t0 + tl;
      const float* up = urw + (size_t)t * RWC + col;
      const float uc = up[0];
      const float upv = (t > s_lo) ? up[-RWC] : 0.f;
      const float unx = (t + 1 < s_hi) ? up[RWC] : 0.f;
      const float us = uc + mu[col] * (upv - uc) + mu[RWC + col] * (unx - uc);
      const int kind = cc >> 7, l = cc & 127;
      const float val = kind == 0 ? tanhf(us) : (kind == 1 ? us : sigmoidf_(us));
      L[kind * 2048 + tl * 128 + l] = val;
    }
    __syncthreads();
#pragma unroll 1
    for (int jj = 0; jj < 2; ++jj) {
      const int c = tid + 256 * jj;
      float r[16], k[16], v[16], kk[16], bacc[16];
      shift_load16(r, urw, t0, s_lo, s_hi, c, mu[c], mu[RWC + c]);
      shift_load16(k, urw, t0, s_lo, s_hi, 512 + c, mu[512 + c], mu[RWC + 512 + c]);
      shift_load16(v, urw, t0, s_lo, s_hi, 1024 + c, mu[1024 + c], mu[RWC + 1024 + c]);
      const float k_k = p.in[18][c], k_a = p.in[19][c], r_k = p.in[20][c];
#pragma unroll
      for (int t = 0; t < 16; ++t) {
        const float x = k[t] * k_k;
        const float ss = wave_sum(x * x);
        kk[t] = x * rsqrtf(ss + 1e-12f);
        const size_t o = (size_t)(t0 + t) * 512 + c;
        o_r[o] = r[t]; o_v[o] = v[t]; o_a[o] = -kk[t];
        bacc[t] = 0.f;
      }
#pragma unroll 1
      for (int e = 0; e < 2; ++e) {
        float acc[16];
        const float a0 = p.in[15][e * 512 + c];
#pragma unroll
        for (int t = 0; t < 16; ++t) acc[t] = a0;
        lora16<64>(acc, L + 2048 + e * 64, p.in[16] + (size_t)e * 64 * 512, c);
        float* o_k = ops_arr(p, 5 + e); float* o_b = ops_arr(p, 7 + e); float* o_w = ops_arr(p, 3 + e);
#pragma unroll
        for (int t = 0; t < 16; ++t) {
          const float ic = sigmoidf_(acc[t]);
          const float kd = k[t] * (1.f + (ic - 1.f) * k_a);
          const size_t o = (size_t)(t0 + t) * 512 + c;
          o_k[o] = kd; o_b[o] = kk[t] * ic;
          bacc[t] += kd;
        }
        const float w0 = p.in[13][e * 512 + c];
#pragma unroll
        for (int t = 0; t < 16; ++t) acc[t] = w0;
        lora16<64>(acc, L + e * 64, p.in[14] + (size_t)e * 64 * 512, c);
#pragma unroll
        for (int t = 0; t < 16; ++t) {
          const float z = acc[t];
          const float sp = fmaxf(-z, 0.f) + log1pf(__expf(-fabsf(z)));
          const float wsoft = -sp - 0.5f;
          o_w[(size_t)(t0 + t) * 512 + c] = __expf(-__expf(wsoft));
        }
      }
#pragma unroll
      for (int t = 0; t < 16; ++t) {
        const float s = wave_sum(r[t] * 0.5f * bacc[t] * r_k);
        bonus[(size_t)(t0 + t) * 512 + c] = f2bf(s * v[t]);
      }
      {
        float acc[16];
#pragma unroll
        for (int t = 0; t < 16; ++t) acc[t] = 0.f;
        lora16<128>(acc, L + 4096, p.in[17], c);
#pragma unroll
        for (int t = 0; t < 16; ++t) gate[(size_t)(t0 + t) * 512 + c] = f2bf(acc[t]);
      }
    }
    __syncthreads();
  }
}

constexpr int TC = 16;
DEV void scan_item(const Params& p, unsigned char* smem, int item) {
  const int tid = threadIdx.x, lane = tid & 63, w = tid >> 6, riw = lane >> 4, kq = lane & 15;
  int seq, h, dir, rg;
  {
    int rem;
    if (item < 128) { seq = 16 + (item >> 6); rem = item & 63; }
    else { const int i2 = item - 128; seq = i2 >> 6; rem = i2 & 63; }
    h = rem >> 3; dir = (rem >> 2) & 1; rg = rem & 3;
  }
  const int T = seq < 16 ? 256 : 1024;
  const int tok0 = seq < 16 ? seq * 256 : NCTX + (seq - 16) * 1024;
  const int vrow_l = w * 4 + riw;
  const int vrow = rg * 16 + vrow_l;
  float S0, S1, S2, S3;
  if (seq >= 16) {
    const float4 s = *(const float4*)(p.in[2] + ((size_t)(((seq - 16) * 2 + dir) * 8 + h) * 64 + vrow) * 64 + kq * 4);
    S0 = s.x; S1 = s.y; S2 = s.z; S3 = s.w;
  } else { S0 = S1 = S2 = S3 = 0.f; }
  const int lstep = tid >> 4, l16 = tid & 15;
  const float* pr = ops_arr(p, 0) + h * 64 + l16 * 4;
  const float* pw = ops_arr(p, 3 + dir) + h * 64 + l16 * 4;
  const float* pk = ops_arr(p, 5 + dir) + h * 64 + l16 * 4;
  const float* pa = ops_arr(p, 2) + h * 64 + l16 * 4;
  const float* pb = ops_arr(p, 7 + dir) + h * 64 + l16 * 4;
  const float* pv = ops_arr(p, 1) + h * 64 + rg * 16 + l16;
  float* yout = (float*)(p.ws + (dir ? OFF_YB : OFF_YF));
  const int nc = T / TC;
  float4 g_r, g_w, g_k, g_a, g_b; float rv;
#define gload(c) do { const int ts_ = (c) * TC + lstep; const size_t t_ = (size_t)(tok0 + (dir ? T - 1 - ts_ : ts_)) * 512; \
    g_r = *(const float4*)(pr + t_); g_w = *(const float4*)(pw + t_); g_k = *(const float4*)(pk + t_); \
    g_a = *(const float4*)(pa + t_); g_b = *(const float4*)(pb + t_); rv = pv[t_]; } while (0)
  gload(0);
  for (int c = 0; c < nc; ++c) {
    unsigned char* st = smem + (c & 1) * 21504;
    *(float4*)(st + 0 * 4096 + lstep * 256 + l16 * 16) = g_r;
    *(float4*)(st + 1 * 4096 + lstep * 256 + l16 * 16) = g_w;
    *(float4*)(st + 2 * 4096 + lstep * 256 + l16 * 16) = g_k;
    *(float4*)(st + 3 * 4096 + lstep * 256 + l16 * 16) = g_a;
    *(float4*)(st + 4 * 4096 + lstep * 256 + l16 * 16) = g_b;
    *(float*)(st + 20480 + lstep * 64 + l16 * 4) = rv;
    __syncthreads();
    if (c > 0) {
      const float* yb = (const float*)(smem + 43008 + ((c - 1) & 1) * 1024);
      const int ts = (c - 1) * TC + lstep;
      const int t = tok0 + (dir ? T - 1 - ts : ts);
      yout[(size_t)t * 512 + h * 64 + rg * 16 + l16] = yb[lstep * 16 + l16];
    }
    if (c + 1 < nc) gload(c + 1);
    float* ybw = (float*)(smem + 43008 + (c & 1) * 1024);
#pragma unroll
    for (int s = 0; s < TC; ++s) {
      const float4 r4 = *(const float4*)(st + 0 * 4096 + s * 256 + kq * 16);
      const float4 w4 = *(const float4*)(st + 1 * 4096 + s * 256 + kq * 16);
      const float4 k4 = *(const float4*)(st + 2 * 4096 + s * 256 + kq * 16);
      const float4 a4 = *(const float4*)(st + 3 * 4096 + s * 256 + kq * 16);
      const float4 b4 = *(const float4*)(st + 4 * 4096 + s * 256 + kq * 16);
      const float vv = *(const float*)(st + 20480 + s * 64 + vrow_l * 4);
      float sa = S0 * a4.x + S1 * a4.y + S2 * a4.z + S3 * a4.w;
      sa = row16_sum(sa);
      S0 = S0 * w4.x + sa * b4.x + vv * k4.x;
      S1 = S1 * w4.y + sa * b4.y + vv * k4.y;
      S2 = S2 * w4.z + sa * b4.z + vv * k4.z;
      S3 = S3 * w4.w + sa * b4.w + vv * k4.w;
      float y = S0 * r4.x + S1 * r4.y + S2 * r4.z + S3 * r4.w;
      y = row16_sum(y);
      if (kq == 0) ybw[s * 16 + vrow_l] = y;
    }
  }
  __syncthreads();
  {
    const float* yb = (const float*)(smem + 43008 + ((nc - 1) & 1) * 1024);
    const int ts = (nc - 1) * TC + lstep;
    const int t = tok0 + (dir ? T - 1 - ts : ts);
    yout[(size_t)t * 512 + h * 64 + rg * 16 + l16] = yb[lstep * 16 + l16];
  }
  if (seq < 16) {
    float* so = p.out + OUT_STATE + ((size_t)((seq * 2 + dir) * 8 + h) * 64 + vrow) * 64 + kq * 4;
    *(float4*)so = make_float4(S0, S1, S2, S3);
  }
  __syncthreads();
}

DEV void attn_wave_item(const Params& p, int witem) {
  const int lane = threadIdx.x & 63, fr = lane & 15, fq = lane >> 4;
  const bf16_t* qb = (const bf16_t*)(p.ws + OFF_QB);
  const bf16_t* kb = (const bf16_t*)(p.ws + OFF_KB);
  const bf16_t* vT = (const bf16_t*)(p.ws + OFF_VT);
  const bf16_t* ckb = (const bf16_t*)(p.ws + OFF_CKB);
  const bf16_t* cvT = (const bf16_t*)(p.ws + OFF_CVT);
  bf16_t* ona = (bf16_t*)(p.ws + OFF_ONA);
  int h, tq0, nsub;
  bool latent;
  int b = 0, r = 0, jb = 0, row_start = 0, band = 0, seq = 0;
  if (witem < 1024) {
    latent = true;
    b = witem >> 9; const int rem = witem & 511; r = rem >> 5; jb = (rem >> 3) & 3; h = rem & 7;
    tq0 = NCTX + b * 1024 + r * 64 + jb * 16;
    row_start = min(max(r - 4, 0), 8); band = min(max(jb * 16 - 8, 0), 32);
    nsub = 4;
  } else {
    latent = false;
    const int w2 = witem - 1024; const int qt = w2 >> 3; h = w2 & 7;
    tq0 = qt * 16; seq = tq0 >> 8; nsub = 2;
  }
  const bf16_t* qp = qb + (size_t)(tq0 + fr) * 512 + h * 64 + fq * 8;
  const bf16x8 qf0 = *(const bf16x8*)qp, qf1 = *(const bf16x8*)(qp + 32);
  float m = -INFINITY, l = 0.f;
  f32x4 O[4];
#pragma unroll
  for (int i = 0; i < 4; ++i) O[i] = (f32x4){0.f, 0.f, 0.f, 0.f};
#pragma unroll 1
  for (int sc = 0; sc < nsub; ++sc) {
    const int half = sc & 1;
    const bf16_t* kbase; const bf16_t* vbase; int KS, ldv;
    const bool win = latent && sc < 2;
    if (win) {
      const int tb = NCTX + b * 1024 + (row_start + half * 4) * 64 + band;
      kbase = kb + (size_t)tb * 512 + h * 64; vbase = vT + (size_t)(h * 64) * NTOK + tb; KS = 64; ldv = NTOK;
    } else if (latent) {
      kbase = ckb + (size_t)(b * 256 + half * 128) * 512 + h * 64; vbase = cvT + (size_t)((b * 8 + h) * 64) * 256 + half * 128; KS = 32; ldv = 256;
    } else {
      const int tb = seq * 256 + half * 128;
      kbase = kb + (size_t)tb * 512 + h * 64; vbase = vT + (size_t)(h * 64) * NTOK + tb; KS = 32; ldv = NTOK;
    }
    f32x4 st[8];
#pragma unroll
    for (int i = 0; i < 8; ++i) {
      const int tokrel = (i >> 1) * KS + (i & 1) * 16 + fr;
      const bf16_t* kp = kbase + (size_t)tokrel * 512 + fq * 8;
      const bf16x8 kf0 = *(const bf16x8*)kp, kf1 = *(const bf16x8*)(kp + 32);
      f32x4 z = (f32x4){0.f, 0.f, 0.f, 0.f};
      z = __builtin_amdgcn_mfma_f32_16x16x32_bf16(kf0, qf0, z, 0, 0, 0);
      st[i] = __builtin_amdgcn_mfma_f32_16x16x32_bf16(kf1, qf1, z, 0, 0, 0);
    }
    if (win) {
      const int q_col = jb * 16 + fr;
      const int win_start = min(max(q_col - 8, 0), 48);
      const float* rpb = p.in[25] + h * 465;
#pragma unroll
      for (int i = 0; i < 8; ++i) {
        const int dr = row_start + half * 4 + (i >> 1) - r + 7;
#pragma unroll
        for (int e = 0; e < 4; ++e) {
          const int k_col = band + (i & 1) * 16 + fq * 4 + e;
          const bool valid = (k_col >= win_start) && (k_col < win_start + 16);
          const int dc = min(max(k_col - q_col, -15), 15) + 15;
          st[i][e] = valid ? st[i][e] + rpb[dr * 31 + dc] : -1e30f;
        }
      }
    }
    float cmax = -1e30f;
#pragma unroll
    for (int i = 0; i < 8; ++i)
#pragma unroll
      for (int e = 0; e < 4; ++e) cmax = fmaxf(cmax, st[i][e]);
    cmax = fmaxf(cmax, __shfl_xor(cmax, 16)); cmax = fmaxf(cmax, __shfl_xor(cmax, 32));
    const float mnew = fmaxf(m, cmax);
    const float alpha = __expf(m - mnew);
    float psum = 0.f;
#pragma unroll
    for (int i = 0; i < 8; ++i)
#pragma unroll
      for (int e = 0; e < 4; ++e) { const float pv = __expf(st[i][e] - mnew); st[i][e] = pv; psum += pv; }
    psum += __shfl_xor(psum, 16); psum += __shfl_xor(psum, 32);
    l = l * alpha + psum;
#pragma unroll
    for (int i = 0; i < 4; ++i) O[i] = O[i] * alpha;
    m = mnew;
#pragma unroll
    for (int s = 0; s < 4; ++s) {
      union { bf16x8 v; unsigned u[4]; } pb;
      pb.u[0] = pk2(st[2 * s][0], st[2 * s][1]); pb.u[1] = pk2(st[2 * s][2], st[2 * s][3]);
      pb.u[2] = pk2(st[2 * s + 1][0], st[2 * s + 1][1]); pb.u[3] = pk2(st[2 * s + 1][2], st[2 * s + 1][3]);
#pragma unroll
      for (int dt = 0; dt < 4; ++dt) {
        const bf16_t* vp = vbase + (size_t)(dt * 16 + fr) * ldv + s * KS + fq * 4;
        union { bf16x8 v; uint2 u[2]; } va;
        va.u[0] = *(const uint2*)vp; va.u[1] = *(const uint2*)(vp + 16);
        O[dt] = __builtin_amdgcn_mfma_f32_16x16x32_bf16(va.v, pb.v, O[dt], 0, 0, 0);
      }
    }
  }
  const float inv = 1.f / l;
#pragma unroll
  for (int dt = 0; dt < 4; ++dt) {
    bf16_t* op = ona + (size_t)(tq0 + fr) * 512 + h * 64 + dt * 16 + fq * 4;
    *(uint2*)op = make_uint2(pk2(O[dt][0] * inv, O[dt][1] * inv), pk2(O[dt][2] * inv, O[dt][3] * inv));
  }
}

constexpr int N_SCAN_ITEMS = 1152, N_ATTN_BLK = 768;
DEV void phase_scan_attn(const Params& p, unsigned char* smem, int* s_item, int rep) {
  unsigned* counter = (unsigned*)(p.ws + OFF_CTL) + rep;
  for (;;) {
    if (threadIdx.x == 0) *s_item = (int)atomicAdd(counter, 1u);
    __syncthreads();
    const int item = *s_item;
    __syncthreads();
    if (item >= N_SCAN_ITEMS + N_ATTN_BLK) break;
    if (item < N_SCAN_ITEMS) scan_item(p, smem, item);
    else attn_wave_item(p, (item - N_SCAN_ITEMS) * 4 + (threadIdx.x >> 6));
  }
}

DEV void phase_finalize_rw(const Params& p, int bid, int nb) {
  const int lane = threadIdx.x & 63, gw = bid * 4 + (threadIdx.x >> 6), nw = nb * 4;
  const float* yf = (const float*)(p.ws + OFF_YF);
  const float* yb = (const float*)(p.ws + OFF_YB);
  const bf16_t* bonus = (const bf16_t*)(p.ws + OFF_BG);
  const bf16_t* gate = (const bf16_t*)(p.ws + OFF_BG + 6291456);
  bf16_t* orw = (bf16_t*)(p.ws + OFF_ORW);
  for (int it = gw; it < NTOK * 8; it += nw) {
    const size_t o = (size_t)it * 64 + lane;
    const int c = (it & 7) * 64 + lane;
    const float y = yf[o] + yb[o];
    const float mean = wave_sum(y) * (1.f / 64.f);
    const float d = y - mean;
    const float var = wave_sum(d * d) * (1.f / 64.f);
    const float yn = d * rsqrtf(var + 64e-5f) * p.in[21][c] + p.in[22][c];
    orw[o] = f2bf((yn + bf2f(bonus[o])) * bf2f(gate[o]));
  }
}

#define XB_TMO      128
#define XB_XCNT(j)  (256  + 64 * (j))
#define XB_XSUB(j)  (1280 + 64 * (j))
#define XB_XGEN(j)  (2304 + 64 * (j))
#define XB_TOP      3328
#define XB_TOPGEN   3392
#define XCD_BAR_WORDS 3456
#define XB_SPIN_CAP (1u << 18)
#define LAS __attribute__((address_space(3)))
DEV unsigned xb_ld(unsigned* p)              { return __hip_atomic_load(p, __ATOMIC_RELAXED, __HIP_MEMORY_SCOPE_AGENT); }
DEV unsigned xb_add(unsigned* p, unsigned v) { return __hip_atomic_fetch_add(p, v, __ATOMIC_RELAXED, __HIP_MEMORY_SCOPE_AGENT); }
DEV unsigned xb_xcc_id() { return (unsigned)__builtin_amdgcn_s_getreg((3 << 11) | 20) & 0xFu; }
#define XB_SPIN(cond, bar) do { unsigned _sp = 0; while (cond) { __builtin_amdgcn_s_sleep(1); \
    if ((++_sp & 255u) == 0u) { if (xb_ld(&(bar)[XB_TMO])) break; if (_sp > XB_SPIN_CAP) { atomicAdd(&(bar)[XB_TMO], 1u); break; } } } } while (0)
struct XcdBarrier { unsigned* bar; unsigned x; volatile LAS unsigned* st; };
DEV XcdBarrier xcd_barrier_post(unsigned* bar, volatile LAS unsigned* st) {
  XcdBarrier b; b.bar = bar; b.x = xb_xcc_id(); b.st = st;
  if (threadIdx.x == 0) (void)xb_add(&bar[XB_XCNT(b.x)], 1u);
  return b;
}
DEV void xcd_barrier_complete(unsigned* bar, unsigned x, unsigned& nloc, unsigned& nx) {
  const unsigned G = gridDim.x * gridDim.y * gridDim.z;
  unsigned sum, cnt, mine, sp = 0u;
  for (;;) {
    sum = 0u; cnt = 0u; mine = 0u;
#pragma unroll
    for (unsigned j = 0; j < 16; ++j) { const unsigned c = xb_ld(&bar[XB_XCNT(j)]); sum += c; cnt += (c > 0u) ? 1u : 0u; mine = (j == x) ? c : mine; }
    if (sum == G) break;
    __builtin_amdgcn_s_sleep(1);
    if ((++sp & 255u) == 0u) { if (xb_ld(&bar[XB_TMO])) break; if (sp > XB_SPIN_CAP) { atomicAdd(&bar[XB_TMO], 1u); break; } }
  }
  nloc = mine > 0u ? mine : 1u; nx = cnt > 0u ? cnt : 1u;
}
DEV void xcd_barrier(const XcdBarrier& b) {
  asm volatile("s_waitcnt vmcnt(0)" ::: "memory");
  __syncthreads();
  if (threadIdx.x == 0) {
    unsigned* bar = b.bar;
    __builtin_amdgcn_s_waitcnt(0);
    unsigned nloc = b.st[0], nx = b.st[1];
    if (nloc == 0u) { xcd_barrier_complete(bar, b.x, nloc, nx); b.st[0] = nloc; b.st[1] = nx; }
    const unsigned old = xb_add(&bar[XB_XSUB(b.x)], 1u);
    const unsigned gen = old / nloc;
    if (old + 1u == (gen + 1u) * nloc) {
      __builtin_amdgcn_fence(__ATOMIC_RELEASE, "agent");
      asm volatile("s_waitcnt vmcnt(0)" ::: "memory");
      const unsigned og = xb_add(&bar[XB_TOP], 1u);
      const unsigned tg = og / nx;
      if (og + 1u == (tg + 1u) * nx) xb_add(&bar[XB_TOPGEN], 1u);
      else XB_SPIN(xb_ld(&bar[XB_TOPGEN]) == tg, bar);
      __builtin_amdgcn_fence(__ATOMIC_ACQUIRE, "agent");
      xb_add(&bar[XB_XGEN(b.x)], 1u);
      asm volatile("s_waitcnt vmcnt(0)" ::: "memory");
    } else {
      XB_SPIN(xb_ld(&bar[XB_XGEN(b.x)]) == gen, bar);
      __builtin_amdgcn_fence(__ATOMIC_ACQUIRE, "agent");
      asm volatile("s_waitcnt vmcnt(0)" ::: "memory");
    }
  }
  __syncthreads();
}

__global__ void __launch_bounds__(NTHR, 2) fwd_megakernel(Params p) {
  extern __shared__ __attribute__((aligned(16))) unsigned char smem[];
  __shared__ __attribute__((aligned(16))) unsigned sh_ctl[8];
  cg::grid_group grid = cg::this_grid();
  const int bid = blockIdx.x, nb = gridDim.x;
  if (threadIdx.x < 8) sh_ctl[threadIdx.x] = 0u;
  __syncthreads();
  const XcdBarrier xb = xcd_barrier_post((unsigned*)(p.ws + OFF_CTL), (volatile LAS unsigned*)sh_ctl);
  int* s_item_p = (int*)&sh_ctl[4];
  if (p.ph_hi > 1000) grid.sync();
#define GSYNC() xcd_barrier(xb)
#ifndef DUP
#define DUP -1
#endif
#define PH(n, body) if (p.ph_lo <= n && n < p.ph_hi) { { const int rep = 0; (void)rep; body; } if (DUP == n) { GSYNC(); const int rep = 1; (void)rep; body; } if (n + 1 < p.ph_hi) GSYNC(); }
  PH(0, phase0(p, smem, bid, nb, rep))
  PH(1, phase_normmod<0>(p, bid, nb))
  PH(2, phase_gemm_in(p, smem, bid, nb))
  PH(3, phase_qkprep(p, smem, bid, nb); phase_rwprep(p, smem, bid, nb))
  PH(4, phase_scan_attn(p, smem, s_item_p, rep))
  PH(5, phase_finalize_rw(p, bid, nb))
  PH(6, phase_gemm_merge(p, smem, bid, nb))
  PH(7, phase_gemm_out(p, smem, bid, nb))
  PH(8, phase_normmod<1>(p, bid, nb))
  PH(9, phase_gemm_ffn_up(p, smem, bid, nb))
  PH(10, phase_gemm_ffn_down(p, smem, bid, nb))
}

extern "C" void kernel_launch(void* const* d_in, const int* in_sizes, int n_in, void* d_out, int out_size, void* d_ws, size_t ws_size,
                              hipStream_t stream) {
  static int grid_blocks = 0;
  if (grid_blocks == 0) {
    if (n_in != 32 || ws_size < WS_END) { fprintf(stderr, "kernel_launch: unexpected n_in %d / ws_size %zu (need %zu)\n", n_in, ws_size, (size_t)WS_END); grid_blocks = -1; return; }
    int dev = 0, cus = 0, per_cu = 0;
    hipGetDevice(&dev);
    hipDeviceGetAttribute(&cus, hipDeviceAttributeMultiprocessorCount, dev);
    if (hipFuncSetAttribute((const void*)fwd_megakernel, hipFuncAttributeMaxDynamicSharedMemorySize, LDS_BYTES) != hipSuccess) { fprintf(stderr, "hipFuncSetAttribute failed\n"); grid_blocks = -1; return; }
    if (hipOccupancyMaxActiveBlocksPerMultiprocessor(&per_cu, (const void*)fwd_megakernel, NTHR, LDS_BYTES) != hipSuccess || per_cu < 1) { fprintf(stderr, "occupancy query failed (%d)\n", per_cu); grid_blocks = -1; return; }
    if (per_cu > 2) per_cu = 2;
    grid_blocks = cus * per_cu;
    fprintf(stderr, "kernel_launch: cus %d per_cu %d grid %d\n", cus, per_cu, grid_blocks);
  }
  if (grid_blocks < 0) return;
  hipMemsetAsync((char*)d_ws + OFF_CTL, 0, CTL_ZERO_BYTES, stream);
  Params p{};
  for (int i = 0; i < 32; ++i) p.in[i] = (const float*)d_in[i];
  p.out = (float*)d_out; p.ws = (unsigned char*)d_ws; p.ph_lo = 0; p.ph_hi = 11;
  void* args[] = {&p};
  hipError_t e = hipLaunchCooperativeKernel((const void*)fwd_megakernel, dim3(grid_blocks), dim3(NTHR), args, LDS_BYTES, stream);
  if (e != hipSuccess) fprintf(stderr, "cooperative launch failed: %s (grid %d)\n", hipGetErrorString(e), grid_blocks);
}
```

```cpp
#include <hip/hip_runtime.h>
#include <hip/hip_cooperative_groups.h>
#include <cstdio>
#include <cstdint>
namespace cg = cooperative_groups;

#define DEV __device__ __forceinline__
typedef unsigned short bf16_t;
typedef short bf16x8 __attribute__((ext_vector_type(8)));
typedef short bf16x4 __attribute__((ext_vector_type(4)));
typedef float f32x4 __attribute__((ext_vector_type(4)));

constexpr int D = 1024, NTOK = 6144, NCTX = 4096, RW = 512, FF = 2816, INC = 5504, RWC = 1920;
constexpr int NTHR = 256;
constexpr int LDS_BYTES = 65536;

constexpr size_t OFF_CTL = 0;
constexpr size_t OFF_MOD = 16384;
constexpr size_t CTL_ZERO_BYTES = 16384 + 3 * 6144 * 4;
constexpr size_t OFF_WIN = 90112;
constexpr size_t OFF_WORW = OFF_WIN + 11272192;
constexpr size_t OFF_WONA = OFF_WORW + 1048576;
constexpr size_t OFF_WOUT = OFF_WONA + 1048576;
constexpr size_t OFF_W13 = OFF_WOUT + 2097152;
constexpr size_t OFF_W2 = OFF_W13 + 11534336;
constexpr size_t OFF_H = OFF_W2 + 5767168;
constexpr size_t OFF_URW = OFF_H + 12582912;
constexpr size_t OFF_UNA = OFF_URW + 47185920;
constexpr size_t OFF_OPS = OFF_UNA + 37748736;
constexpr size_t OPS_ARR = 12582912;
constexpr size_t OFF_BG = OFF_OPS + 9 * OPS_ARR;
constexpr size_t OFF_VT = OFF_BG + 12582912;
constexpr size_t OFF_CKB = OFF_VT + 6291456;
constexpr size_t OFF_CVT = OFF_CKB + 524288;
constexpr size_t OFF_LORA = OFF_CVT + 524288;
constexpr size_t WS_END = OFF_LORA + 393216;
constexpr size_t OFF_QB = OFF_H, OFF_KB = OFF_H + 6291456;
constexpr size_t OFF_YF = OFF_URW, OFF_YB = OFF_URW + 12582912;
constexpr size_t OFF_ORW = OFF_UNA, OFF_ONA = OFF_UNA + 6291456;
constexpr size_t OFF_MERGED = OFF_OPS;
constexpr size_t OFF_HID = OFF_URW;
constexpr size_t OUT_STATE = 6291456, OUT_K = 7340032, OUT_V = 9437184;

struct Params {
  const float* in[32];
  float* out;
  unsigned char* ws;
  int ph_lo, ph_hi;
};

DEV unsigned short f2bf(float f) { unsigned u = __float_as_uint(f); u += 0x7fffu + ((u >> 16) & 1u); return (unsigned short)(u >> 16); }
DEV unsigned pk2(float lo, float hi) { return (unsigned)f2bf(lo) | ((unsigned)f2bf(hi) << 16); }
DEV float bf2f(unsigned short b) { return __uint_as_float(((unsigned)b) << 16); }
DEV float sigmoidf_(float x) { return 1.f / (1.f + __expf(-x)); }
DEV float wave_sum(float x) {
#pragma unroll
  for (int o = 32; o > 0; o >>= 1) x += __shfl_xor(x, o);
  return x;
}
template <int CTRL> DEV float dpp_mov(float x) { return __int_as_float(__builtin_amdgcn_update_dpp(0, __float_as_int(x), CTRL, 0xf, 0xf, true)); }
DEV float row16_sum(float x) {
  x += dpp_mov<0xB1>(x); x += dpp_mov<0x4E>(x); x += dpp_mov<0x141>(x); x += dpp_mov<0x140>(x);
  return x;
}
#define BAR_LDS() do { asm volatile("s_waitcnt lgkmcnt(0)" ::: "memory"); __builtin_amdgcn_s_barrier(); asm volatile("" ::: "memory"); } while (0)
DEV const float* xrow(const Params& p, int t) { return t < NCTX ? p.in[0] + (size_t)t * D : p.in[1] + (size_t)(t - NCTX) * D; }
DEV int modidx(int t) { return t < NCTX ? 0 : 1 + ((t - NCTX) >> 10); }

DEV void conv_job(const Params& p, int j, const float*& src, bf16_t*& dst, int& K, int& N, int& mode, int& base) {
  if (j < 1376) { src = p.in[11]; dst = (bf16_t*)(p.ws + OFF_WIN); K = 1024; N = 5504; mode = 0; base = 0; }
  else if (j < 1504) { src = p.in[26]; dst = (bf16_t*)(p.ws + OFF_WORW); K = 512; N = 1024; mode = 0; base = 1376; }
  else if (j < 1632) { src = p.in[27]; dst = (bf16_t*)(p.ws + OFF_WONA); K = 512; N = 1024; mode = 0; base = 1504; }
  else if (j < 1888) { src = p.in[28]; dst = (bf16_t*)(p.ws + OFF_WOUT); K = 1024; N = 1024; mode = 0; base = 1632; }
  else if (j < 2592) { src = p.in[29]; dst = (bf16_t*)(p.ws + OFF_W13); K = 1024; N = 2816; mode = 1; base = 1888; }
  else if (j < 3296) { src = p.in[30]; dst = (bf16_t*)(p.ws + OFF_W13); K = 1024; N = 2816; mode = 2; base = 2592; }
  else if (j < 4000) { src = p.in[31]; dst = (bf16_t*)(p.ws + OFF_W2); K = 2816; N = 1024; mode = 0; base = 3296; }
  else if (j < 4016) { const int e = (j - 4000) >> 3; src = p.in[14] + e * 32768; dst = (bf16_t*)(p.ws + OFF_LORA) + e * 32768; K = 64; N = 512; mode = 0; base = 4000 + e * 8; }
  else if (j < 4032) { const int e = (j - 4016) >> 3; src = p.in[16] + e * 32768; dst = (bf16_t*)(p.ws + OFF_LORA) + 65536 + e * 32768; K = 64; N = 512; mode = 0; base = 4016 + e * 8; }
  else { src = p.in[17]; dst = (bf16_t*)(p.ws + OFF_LORA) + 131072; K = 128; N = 512; mode = 0; base = 4032; }
}
constexpr int N_CONV_TILES = 4048, N_MOD_TILES = 768;

DEV void phase0(const Params& p, unsigned char* smem, int bid, int nb, int rep) {
  const int tid = threadIdx.x;
  float* T = (float*)smem;
  for (int tile = bid; tile < N_MOD_TILES && rep == 0; tile += nb) {
    const int cgp = tile % 24, kc = tile / 24;
    if (tid < 96) {
      const int m = tid >> 5, kk = tid & 31, k = kc * 32 + kk;
      const float c = (m == 0) ? p.in[6][k] : p.in[5][(m - 1) * D + k];
      T[tid] = c * sigmoidf_(c);
    }
    __syncthreads();
    const int col = cgp * 256 + tid;
    const float* w = p.in[9] + (size_t)(kc * 32) * 6144 + col;
    float a0 = 0.f, a1 = 0.f, a2 = 0.f;
#pragma unroll
    for (int kk = 0; kk < 32; ++kk) {
      const float wv = w[(size_t)kk * 6144];
      a0 += T[kk] * wv; a1 += T[32 + kk] * wv; a2 += T[64 + kk] * wv;
    }
    if (kc == 0) { const float b = p.in[10][col]; a0 += b; a1 += b; a2 += b; }
    float* mod = (float*)(p.ws + OFF_MOD);
    atomicAdd(mod + col, a0); atomicAdd(mod + 6144 + col, a1); atomicAdd(mod + 12288 + col, a2);
    __syncthreads();
  }
  const int r_ = tid >> 4, c4_ = tid & 15;
  float4 v[4];
  const float* src; bf16_t* dst; int K, N, mode, base;
  int tile = bid;
  if (tile < N_CONV_TILES) {
    conv_job(p, tile, src, dst, K, N, mode, base);
    const int lt = tile - base, nN = N >> 6, k0 = (lt / nN) * 64, n0 = (lt % nN) * 64;
#pragma unroll
    for (int i = 0; i < 4; ++i) v[i] = *(const float4*)(src + (size_t)(k0 + r_ + 16 * i) * N + n0 + c4_ * 4);
  }
  while (tile < N_CONV_TILES) {
    const int lt = tile - base, nN = N >> 6, k0 = (lt / nN) * 64, n0 = (lt % nN) * 64;
    bf16_t* cdst = dst; const int cK = K, cmode = mode;
#pragma unroll
    for (int i = 0; i < 4; ++i) {
      float* tp = T + (r_ + 16 * i) * 65 + c4_ * 4;
      tp[0] = v[i].x; tp[1] = v[i].y; tp[2] = v[i].z; tp[3] = v[i].w;
    }
    BAR_LDS();
    tile += nb;
    if (tile < N_CONV_TILES) {
      conv_job(p, tile, src, dst, K, N, mode, base);
      const int lt2 = tile - base, nN2 = N >> 6, k2 = (lt2 / nN2) * 64, n2 = (lt2 % nN2) * 64;
#pragma unroll
      for (int i = 0; i < 4; ++i) v[i] = *(const float4*)(src + (size_t)(k2 + r_ + 16 * i) * N + n2 + c4_ * 4);
    }
    const int n = tid >> 2, kp = tid & 3;
    unsigned w[8];
#pragma unroll
    for (int i = 0; i < 8; ++i) w[i] = pk2(T[(kp * 16 + 2 * i) * 65 + n], T[(kp * 16 + 2 * i + 1) * 65 + n]);
    const int ng = n0 + n;
    int drow = ng;
    if (cmode == 1) drow = (ng >> 4) * 32 + (ng & 15);
    else if (cmode == 2) drow = (ng >> 4) * 32 + 16 + (ng & 15);
    uint4* dp = (uint4*)(cdst + (size_t)drow * cK + k0 + kp * 16);
    dp[0] = make_uint4(w[0], w[1], w[2], w[3]);
    dp[1] = make_uint4(w[4], w[5], w[6], w[7]);
    BAR_LDS();
  }
}

template <int WHICH>
DEV void phase_normmod(const Params& p, int bid, int nb) {
  const int lane = threadIdx.x & 63, gw = bid * 4 + (threadIdx.x >> 6), nw = nb * 4;
  const float* g = WHICH == 0 ? p.in[7] : p.in[8];
  const float* mod = (const float*)(p.ws + OFF_MOD);
  const int sh_off = WHICH == 0 ? 0 : 3072, sc_off = WHICH == 0 ? 1024 : 4096;
  bf16_t* dst = (bf16_t*)(p.ws + OFF_H);
  for (int t = gw; t < NTOK; t += nw) {
    const float* xp = WHICH == 0 ? xrow(p, t) : p.out + (size_t)t * D;
    const float* mm = mod + modidx(t) * 6144;
    float4 v[4];
    float ss = 0.f;
#pragma unroll
    for (int i = 0; i < 4; ++i) {
      v[i] = *(const float4*)(xp + (i * 64 + lane) * 4);
      ss += v[i].x * v[i].x + v[i].y * v[i].y + v[i].z * v[i].z + v[i].w * v[i].w;
    }
    ss = wave_sum(ss);
    const float rstd = rsqrtf(ss * (1.f / 1024.f) + 1e-6f);
#pragma unroll
    for (int i = 0; i < 4; ++i) {
      const int col = (i * 64 + lane) * 4;
      const float4 g4 = *(const float4*)(g + col);
      const float4 sc = *(const float4*)(mm + sc_off + col);
      const float4 sh = *(const float4*)(mm + sh_off + col);
      const float y0 = v[i].x * rstd * g4.x * (1.f + sc.x) + sh.x;
      const float y1 = v[i].y * rstd * g4.y * (1.f + sc.y) + sh.y;
      const float y2 = v[i].z * rstd * g4.z * (1.f + sc.z) + sh.z;
      const float y3 = v[i].w * rstd * g4.w * (1.f + sc.w) + sh.w;
      *(uint2*)(dst + (size_t)t * D + col) = make_uint2(pk2(y0, y1), pk2(y2, y3));
    }
  }
}

template <int MI>
DEV void gemm_tile_acc(f32x4 (&acc)[MI][4], const bf16_t* __restrict__ A, int lda, const bf16_t* __restrict__ Bt, int ldb,
                       int m0, int n0, int K, unsigned char* smem) {
  constexpr int AT = 2 * MI * 16 * 128, BT = 16384, STG = AT + BT;
  const int tid = threadIdx.x, lane = tid & 63, wid = tid >> 6, wr = wid >> 1, wc = wid & 1, fr = lane & 15, fq = lane >> 4;
  const int gkc = (tid & 7) ^ ((tid >> 4) & 7);
  const bf16_t* ga = A + (size_t)(m0 + (tid >> 3)) * lda + gkc * 8;
  const bf16_t* gb = Bt + (size_t)(n0 + (tid >> 3)) * ldb + gkc * 8;
  const int swz = (fr >> 1) & 7;
  const int nk = K >> 6;
#define GLDS_TILE(kt_, buf_) do { unsigned char* sb_ = smem + (buf_) * STG; const int k0_ = (kt_) * 64; \
    _Pragma("unroll") for (int i_ = 0; i_ < (2 * MI * 16) / 32; ++i_) \
      __builtin_amdgcn_global_load_lds((const unsigned*)(ga + (size_t)i_ * 32 * lda + k0_), (__attribute__((address_space(3))) unsigned*)(sb_ + (i_ * 256 + tid) * 16), 16, 0, 0); \
    _Pragma("unroll") for (int i_ = 0; i_ < 4; ++i_) \
      __builtin_amdgcn_global_load_lds((const unsigned*)(gb + (size_t)i_ * 32 * ldb + k0_), (__attribute__((address_space(3))) unsigned*)(sb_ + AT + (i_ * 256 + tid) * 16), 16, 0, 0); \
  } while (0)
  GLDS_TILE(0, 0);
  asm volatile("s_waitcnt vmcnt(0)" ::: "memory");
  __syncthreads();
  for (int kt = 0; kt < nk; ++kt) {
    if (kt + 1 < nk) GLDS_TILE(kt + 1, (kt + 1) & 1);
    const unsigned char* cur = smem + (kt & 1) * STG;
#pragma unroll
    for (int ks = 0; ks < 2; ++ks) {
      bf16x8 af[MI], bf[4];
      const int co = ((ks * 4 + fq) ^ swz) << 4;
#pragma unroll
      for (int mi = 0; mi < MI; ++mi) af[mi] = *(const bf16x8*)(cur + (wr * MI * 16 + mi * 16 + fr) * 128 + co);
#pragma unroll
      for (int ni = 0; ni < 4; ++ni) bf[ni] = *(const bf16x8*)(cur + AT + (wc * 64 + ni * 16 + fr) * 128 + co);
#pragma unroll
      for (int mi = 0; mi < MI; ++mi)
#pragma unroll
        for (int ni = 0; ni < 4; ++ni) acc[mi][ni] = __builtin_amdgcn_mfma_f32_16x16x32_bf16(bf[ni], af[mi], acc[mi][ni], 0, 0, 0);
    }
    asm volatile("s_waitcnt vmcnt(0)" ::: "memory");
    __syncthreads();
  }
#undef GLDS_TILE
}

template <int MI>
DEV void zero_acc(f32x4 (&acc)[MI][4]) {
#pragma unroll
  for (int i = 0; i < MI; ++i)
#pragma unroll
    for (int j = 0; j < 4; ++j) acc[i][j] = (f32x4){0.f, 0.f, 0.f, 0.f};
}

#ifndef DYN_TILES
#define DYN_TILES 0
#endif
DEV int grab_tile(const Params& p, int word, int* slot) {
#if DYN_TILES
  if (threadIdx.x == 0) *slot = (int)atomicAdd((unsigned*)(p.ws + OFF_CTL) + word, 1u);
  __syncthreads();
  const int t = *slot;
  __syncthreads();
  return t;
#else
  const int t = slot[1];
  __syncthreads();
  if (threadIdx.x == 0) slot[1] = t + gridDim.x;
  __syncthreads();
  return t;
#endif
}
DEV void reset_tiles(int* slot) { if (threadIdx.x == 0) slot[1] = blockIdx.x; __syncthreads(); }

#define EPI_COORDS const int lane = threadIdx.x & 63, wid = threadIdx.x >> 6, wr = wid >> 1, wc = wid & 1, fr = lane & 15, fq = lane >> 4

DEV void phase_gemm_in(const Params& p, unsigned char* smem, int* slot) {
  EPI_COORDS;
  const bf16_t* A = (const bf16_t*)(p.ws + OFF_H);
  const bf16_t* Bt = (const bf16_t*)(p.ws + OFF_WIN);
  float* urw = (float*)(p.ws + OFF_URW);
  float* una = (float*)(p.ws + OFF_UNA);
  bf16_t* gates = (bf16_t*)p.out;
  for (;;) {
    const int tile = grab_tile(p, 8, slot);
    if (tile >= 48 * 43) break;
    const int tm = tile % 48, tn = tile / 48, m0 = tm * 128, n0 = tn * 128;
    f32x4 acc[4][4];
    zero_acc<4>(acc);
    gemm_tile_acc<4>(acc, A, D, Bt, D, m0, n0, D, smem);
#pragma unroll
    for (int mi = 0; mi < 4; ++mi) {
      const int row = m0 + wr * 64 + mi * 16 + fr;
#pragma unroll
      for (int ni = 0; ni < 4; ++ni) {
        const int col = n0 + wc * 64 + ni * 16 + fq * 4;
        const f32x4 v = acc[mi][ni];
        if (n0 < 1920) *(f32x4*)(urw + (size_t)row * 1920 + col) = v;
        else if (n0 < 3456) *(f32x4*)(una + (size_t)row * 1536 + (col - 1920)) = v;
        else *(uint2*)(gates + (size_t)row * 2048 + (col - 3456)) = make_uint2(pk2(sigmoidf_(v[0]), sigmoidf_(v[1])), pk2(sigmoidf_(v[2]), sigmoidf_(v[3])));
      }
    }
  }
}

DEV void phase_gemm_merge(const Params& p, unsigned char* smem, int* slot) {
  EPI_COORDS;
  const bf16_t* orw = (const bf16_t*)(p.ws + OFF_ORW);
  const bf16_t* ona = (const bf16_t*)(p.ws + OFF_ONA);
  const bf16_t* w1 = (const bf16_t*)(p.ws + OFF_WORW);
  const bf16_t* w2 = (const bf16_t*)(p.ws + OFF_WONA);
  const bf16_t* gates = (const bf16_t*)p.out;
  bf16_t* merged = (bf16_t*)(p.ws + OFF_MERGED);
  float* mtmp = (float*)(p.ws + OFF_MERGED + 16777216);
  for (;;) {
    const int tile = grab_tile(p, 9, slot);
    if (tile >= 96 * 8) break;
    const int tm = tile % 96, tn = tile / 96, m0 = tm * 64, n0 = tn * 128;
    f32x4 acc[2][4];
    zero_acc<2>(acc);
    gemm_tile_acc<2>(acc, orw, RW, w1, RW, m0, n0, RW, smem);
#pragma unroll
    for (int mi = 0; mi < 2; ++mi) {
      const int row = m0 + wr * 32 + mi * 16 + fr;
#pragma unroll
      for (int ni = 0; ni < 4; ++ni) {
        const int col = n0 + wc * 64 + ni * 16 + fq * 4;
        const uint2 g = *(const uint2*)(gates + (size_t)row * 2048 + col);
        f32x4 r;
        r[0] = acc[mi][ni][0] * bf2f((unsigned short)(g.x & 0xffff));
        r[1] = acc[mi][ni][1] * bf2f((unsigned short)(g.x >> 16));
        r[2] = acc[mi][ni][2] * bf2f((unsigned short)(g.y & 0xffff));
        r[3] = acc[mi][ni][3] * bf2f((unsigned short)(g.y >> 16));
        *(f32x4*)(mtmp + (size_t)row * D + col) = r;
      }
    }
    zero_acc<2>(acc);
    gemm_tile_acc<2>(acc, ona, RW, w2, RW, m0, n0, RW, smem);
#pragma unroll
    for (int mi = 0; mi < 2; ++mi) {
      const int row = m0 + wr * 32 + mi * 16 + fr;
#pragma unroll
      for (int ni = 0; ni < 4; ++ni) {
        const int col = n0 + wc * 64 + ni * 16 + fq * 4;
        const uint2 g = *(const uint2*)(gates + (size_t)row * 2048 + 1024 + col);
        const f32x4 mg = *(const f32x4*)(mtmp + (size_t)row * D + col);
        const float r0 = mg[0] + acc[mi][ni][0] * bf2f((unsigned short)(g.x & 0xffff));
        const float r1 = mg[1] + acc[mi][ni][1] * bf2f((unsigned short)(g.x >> 16));
        const float r2 = mg[2] + acc[mi][ni][2] * bf2f((unsigned short)(g.y & 0xffff));
        const float r3 = mg[3] + acc[mi][ni][3] * bf2f((unsigned short)(g.y >> 16));
        *(uint2*)(merged + (size_t)row * D + col) = make_uint2(pk2(r0, r1), pk2(r2, r3));
      }
    }
  }
}

DEV void phase_gemm_out(const Params& p, unsigned char* smem, int* slot) {
  EPI_COORDS;
  const bf16_t* A = (const bf16_t*)(p.ws + OFF_MERGED);
  const bf16_t* Bt = (const bf16_t*)(p.ws + OFF_WOUT);
  const float* mod = (const float*)(p.ws + OFF_MOD);
  for (;;) {
    const int tile = grab_tile(p, 10, slot);
    if (tile >= 96 * 8) break;
    const int tm = tile % 96, tn = tile / 96, m0 = tm * 64, n0 = tn * 128;
    f32x4 acc[2][4];
    zero_acc<2>(acc);
    gemm_tile_acc<2>(acc, A, D, Bt, D, m0, n0, D, smem);
#pragma unroll
    for (int mi = 0; mi < 2; ++mi) {
      const int row = m0 + wr * 32 + mi * 16 + fr;
      const float* xp = xrow(p, row);
      const float* g1 = mod + modidx(row) * 6144 + 2048;
#pragma unroll
      for (int ni = 0; ni < 4; ++ni) {
        const int col = n0 + wc * 64 + ni * 16 + fq * 4;
        const f32x4 x = *(const f32x4*)(xp + col);
        const f32x4 g = *(const f32x4*)(g1 + col);
        *(f32x4*)(p.out + (size_t)row * D + col) = x + g * acc[mi][ni];
      }
    }
  }
}

DEV void phase_gemm_ffn_up(const Params& p, unsigned char* smem, int* slot) {
  EPI_COORDS;
  const bf16_t* A = (const bf16_t*)(p.ws + OFF_H);
  const bf16_t* Bt = (const bf16_t*)(p.ws + OFF_W13);
  bf16_t* hid = (bf16_t*)(p.ws + OFF_HID);
  for (;;) {
    const int tile = grab_tile(p, 11, slot);
    if (tile >= 48 * 44) break;
    const int tm = tile % 48, tn = tile / 48, m0 = tm * 128, n0 = tn * 128;
    f32x4 acc[4][4];
    zero_acc<4>(acc);
    gemm_tile_acc<4>(acc, A, D, Bt, D, m0, n0, D, smem);
#pragma unroll
    for (int mi = 0; mi < 4; ++mi) {
      const int row = m0 + wr * 64 + mi * 16 + fr;
#pragma unroll
      for (int gp = 0; gp < 2; ++gp) {
        const int hcol = ((n0 + wc * 64) >> 1) + gp * 16 + fq * 4;
        const f32x4 a = acc[mi][2 * gp], b = acc[mi][2 * gp + 1];
        float r[4];
#pragma unroll
        for (int e = 0; e < 4; ++e) r[e] = a[e] * sigmoidf_(a[e]) * b[e];
        *(uint2*)(hid + (size_t)row * FF + hcol) = make_uint2(pk2(r[0], r[1]), pk2(r[2], r[3]));
      }
    }
  }
}

DEV void phase_gemm_ffn_down(const Params& p, unsigned char* smem, int* slot) {
  EPI_COORDS;
  const bf16_t* A = (const bf16_t*)(p.ws + OFF_HID);
  const bf16_t* Bt = (const bf16_t*)(p.ws + OFF_W2);
  const float* mod = (const float*)(p.ws + OFF_MOD);
  for (;;) {
    const int tile = grab_tile(p, 12, slot);
    if (tile >= 96 * 8) break;
    const int tm = tile % 96, tn = tile / 96, m0 = tm * 64, n0 = tn * 128;
    f32x4 acc[2][4];
    zero_acc<2>(acc);
    gemm_tile_acc<2>(acc, A, FF, Bt, FF, m0, n0, FF, smem);
#pragma unroll
    for (int mi = 0; mi < 2; ++mi) {
      const int row = m0 + wr * 32 + mi * 16 + fr;
      const float* g2 = mod + modidx(row) * 6144 + 5120;
#pragma unroll
      for (int ni = 0; ni < 4; ++ni) {
        const int col = n0 + wc * 64 + ni * 16 + fq * 4;
        float* op = p.out + (size_t)row * D + col;
        const f32x4 x = *(const f32x4*)op;
        const f32x4 g = *(const f32x4*)(g2 + col);
        *(f32x4*)op = x + g * acc[mi][ni];
      }
    }
  }
}

DEV void phase_qkprep(const Params& p, unsigned char* smem, int bid, int nb) {
  const int tid = threadIdx.x;
  bf16_t* Vs = (bf16_t*)smem;
  bf16_t* qb = (bf16_t*)(p.ws + OFF_QB);
  bf16_t* kb = (bf16_t*)(p.ws + OFF_KB);
  bf16_t* vT = (bf16_t*)(p.ws + OFF_VT);
  bf16_t* ckb = (bf16_t*)(p.ws + OFF_CKB);
  bf16_t* cvT = (bf16_t*)(p.ws + OFF_CVT);
  const float* una = (const float*)(p.ws + OFF_UNA);
  const int tok = tid >> 2, part = tid & 3;
  for (int item = bid; item < 832; item += nb) {
    if (item < 768) {
      const int tt = item >> 3, h = item & 7, t0 = tt * 64, t = t0 + tok;
      const float* src = una + (size_t)t * 1536 + h * 64 + part * 16;
      {
        float x[16]; float ss = 0.f;
#pragma unroll
        for (int i = 0; i < 4; ++i) { const float4 v = *(const float4*)(src + i * 4); x[4 * i] = v.x; x[4 * i + 1] = v.y; x[4 * i + 2] = v.z; x[4 * i + 3] = v.w; }
#pragma unroll
        for (int i = 0; i < 16; ++i) ss += x[i] * x[i];
        ss += __shfl_xor(ss, 1); ss += __shfl_xor(ss, 2);
        const float rs = rsqrtf(ss * (1.f / 64.f) + 1e-6f) * 0.125f;
        unsigned w[8];
#pragma unroll
        for (int i = 0; i < 8; ++i) w[i] = pk2(x[2 * i] * rs * p.in[23][part * 16 + 2 * i], x[2 * i + 1] * rs * p.in[23][part * 16 + 2 * i + 1]);
        uint4* dp = (uint4*)(qb + (size_t)t * 512 + h * 64 + part * 16);
        dp[0] = make_uint4(w[0], w[1], w[2], w[3]); dp[1] = make_uint4(w[4], w[5], w[6], w[7]);
      }
      {
        float x[16]; float ss = 0.f;
#pragma unroll
        for (int i = 0; i < 4; ++i) { const float4 v = *(const float4*)(src + 512 + i * 4); x[4 * i] = v.x; x[4 * i + 1] = v.y; x[4 * i + 2] = v.z; x[4 * i + 3] = v.w; }
#pragma unroll
        for (int i = 0; i < 16; ++i) ss += x[i] * x[i];
        ss += __shfl_xor(ss, 1); ss += __shfl_xor(ss, 2);
        const float rs = rsqrtf(ss * (1.f / 64.f) + 1e-6f);
#pragma unroll
        for (int i = 0; i < 16; ++i) x[i] = x[i] * rs * p.in[24][part * 16 + i];
        if (t < NCTX) {
          float4* op = (float4*)(p.out + OUT_K + (size_t)t * 512 + h * 64 + part * 16);
#pragma unroll
          for (int i = 0; i < 4; ++i) op[i] = make_float4(x[4 * i], x[4 * i + 1], x[4 * i + 2], x[4 * i + 3]);
        }
        unsigned w[8];
#pragma unroll
        for (int i = 0; i < 8; ++i) w[i] = pk2(x[2 * i], x[2 * i + 1]);
        uint4* dp = (uint4*)(kb + (size_t)t * 512 + h * 64 + part * 16);
        dp[0] = make_uint4(w[0], w[1], w[2], w[3]); dp[1] = make_uint4(w[4], w[5], w[6], w[7]);
      }
      {
        float x[16];
#pragma unroll
        for (int i = 0; i < 4; ++i) { const float4 v = *(const float4*)(src + 1024 + i * 4); x[4 * i] = v.x; x[4 * i + 1] = v.y; x[4 * i + 2] = v.z; x[4 * i + 3] = v.w; }
        if (t < NCTX) {
          float4* op = (float4*)(p.out + OUT_V + (size_t)t * 512 + h * 64 + part * 16);
#pragma unroll
          for (int i = 0; i < 4; ++i) op[i] = make_float4(x[4 * i], x[4 * i + 1], x[4 * i + 2], x[4 * i + 3]);
        }
#pragma unroll
        for (int i = 0; i < 16; ++i) Vs[tok * 72 + part * 16 + i] = f2bf(x[i]);
      }
      __syncthreads();
      {
        const int d = tid >> 2;
        unsigned w[8];
#pragma unroll
        for (int i = 0; i < 8; ++i) w[i] = (unsigned)Vs[(part * 16 + 2 * i) * 72 + d] | ((unsigned)Vs[(part * 16 + 2 * i + 1) * 72 + d] << 16);
        uint4* dp = (uint4*)(vT + (size_t)(h * 64 + d) * NTOK + t0 + part * 16);
        dp[0] = make_uint4(w[0], w[1], w[2], w[3]); dp[1] = make_uint4(w[4], w[5], w[6], w[7]);
      }
      __syncthreads();
    } else {
      const int ci = item - 768, b = ci >> 5, rem = ci & 31, tt = rem >> 3, h = rem & 7, t0 = tt * 64, t = t0 + tok;
      const size_t sidx = (size_t)(b * 256 + t) * 512 + h * 64 + part * 16;
      {
        float x[16];
#pragma unroll
        for (int i = 0; i < 4; ++i) { const float4 v = *(const float4*)(p.in[3] + sidx + i * 4); x[4 * i] = v.x; x[4 * i + 1] = v.y; x[4 * i + 2] = v.z; x[4 * i + 3] = v.w; }
        unsigned w[8];
#pragma unroll
        for (int i = 0; i < 8; ++i) w[i] = pk2(x[2 * i], x[2 * i + 1]);
        uint4* dp = (uint4*)(ckb + sidx);
        dp[0] = make_uint4(w[0], w[1], w[2], w[3]); dp[1] = make_uint4(w[4], w[5], w[6], w[7]);
      }
      {
        float x[16];
#pragma unroll
        for (int i = 0; i < 4; ++i) { const float4 v = *(const float4*)(p.in[4] + sidx + i * 4); x[4 * i] = v.x; x[4 * i + 1] = v.y; x[4 * i + 2] = v.z; x[4 * i + 3] = v.w; }
#pragma unroll
        for (int i = 0; i < 16; ++i) Vs[tok * 72 + part * 16 + i] = f2bf(x[i]);
      }
      __syncthreads();
      {
        const int d = tid >> 2;
        unsigned w[8];
#pragma unroll
        for (int i = 0; i < 8; ++i) w[i] = (unsigned)Vs[(part * 16 + 2 * i) * 72 + d] | ((unsigned)Vs[(part * 16 + 2 * i + 1) * 72 + d] << 16);
        uint4* dp = (uint4*)(cvT + (size_t)((b * 8 + h) * 64 + d) * 256 + t0 + part * 16);
        dp[0] = make_uint4(w[0], w[1], w[2], w[3]); dp[1] = make_uint4(w[4], w[5], w[6], w[7]);
      }
      __syncthreads();
    }
  }
}

DEV float* ops_arr(const Params& p, int i) { return (float*)(p.ws + OFF_OPS + (size_t)i * OPS_ARR); }

DEV f32x4 shiftvec(f32x4 cur, f32x4 hal, f32x4 mu0, f32x4 mu1, int fr) {
  f32x4 prev, next;
#pragma unroll
  for (int i = 0; i < 4; ++i) {
    prev[i] = dpp_mov<0x111>(cur[i]);
    next[i] = dpp_mov<0x101>(cur[i]);
  }
  if (fr == 0) prev = hal;
  if (fr == 15) next = hal;
  return cur + mu0 * (prev - cur) + mu1 * (next - cur);
}
DEV float quad_sum(float x) { x += __shfl_xor(x, 16); x += __shfl_xor(x, 32); return x; }
DEV f32x4 ld4(const float* p) { return *(const f32x4*)p; }

constexpr int LROWB = 392;
DEV void phase_rwprep(const Params& p, unsigned char* smem, int bid, int nb) {
  const int tid = threadIdx.x, lane = tid & 63, w = tid >> 6, fr = lane & 15, fq = lane >> 4;
  bf16_t* Lb = (bf16_t*)smem;
  const float* urw = (const float*)(p.ws + OFF_URW);
  const float* mu = p.in[12];
  bf16_t* bonus = (bf16_t*)(p.ws + OFF_BG);
  bf16_t* gate = (bf16_t*)(p.ws + OFF_BG + 6291456);
  const bf16_t* WUPT = (const bf16_t*)(p.ws + OFF_LORA);
  const bf16_t* AUPT = WUPT + 65536;
  const bf16_t* GUPT = WUPT + 131072;
  float* o_r = ops_arr(p, 0); float* o_v = ops_arr(p, 1); float* o_a = ops_arr(p, 2);
  for (int item = bid; item < 768; item += nb) {
    const int t0 = (item >> 1) * 16, h = (item & 1) * 4 + w;
    int s_lo, s_hi;
    if (t0 < NCTX) { s_lo = t0 & ~255; s_hi = s_lo + 256; } else { s_lo = NCTX + ((t0 - NCTX) & ~1023); s_hi = s_lo + 1024; }
#pragma unroll 8
    for (int e = tid; e < 6144; e += NTHR) {
      const int cc = e % 384, tl = e / 384, col = 1536 + cc, t = t0 + tl;
      const float* up = urw + (size_t)t * RWC + col;
      const float uc = up[0];
      const float upv = (t > s_lo) ? up[-RWC] : 0.f;
      const float unx = (t + 1 < s_hi) ? up[RWC] : 0.f;
      const float us = uc + mu[col] * (upv - uc) + mu[RWC + col] * (unx - uc);
      const int kind = cc >> 7;
      const float val = kind == 0 ? tanhf(us) : (kind == 1 ? us : sigmoidf_(us));
      Lb[tl * LROWB + cc] = f2bf(val);
    }
    __syncthreads();
    const int t = t0 + fr;
    const bool lo_ok = (fr == 0) && (t > s_lo), hi_ok = (fr == 15) && (t + 1 < s_hi);
    const float* urow = urw + (size_t)t * RWC;
    const float* hrow = lo_ok ? urow - RWC : (hi_ok ? urow + RWC : urow);
    const bool hal_ok = lo_ok || hi_ok;
    const f32x4 z4 = (f32x4){0.f, 0.f, 0.f, 0.f};
    float ss = 0.f;
#pragma unroll
    for (int ni = 0; ni < 4; ++ni) {
      const int c = h * 64 + ni * 16 + fq * 4;
      const f32x4 kx = shiftvec(ld4(urow + 512 + c), hal_ok ? ld4(hrow + 512 + c) : z4, ld4(mu + 512 + c), ld4(mu + RWC + 512 + c), fr) * ld4(p.in[18] + c);
      ss += kx[0] * kx[0] + kx[1] * kx[1] + kx[2] * kx[2] + kx[3] * kx[3];
    }
    ss = quad_sum(ss);
    const float rn = rsqrtf(ss + 1e-12f);
    float bs = 0.f;
#pragma unroll 1
    for (int ni = 0; ni < 4; ++ni) {
      const int c = h * 64 + ni * 16 + fq * 4;
      const size_t o = (size_t)t * 512 + c;
      const f32x4 r4 = shiftvec(ld4(urow + c), hal_ok ? ld4(hrow + c) : z4, ld4(mu + c), ld4(mu + RWC + c), fr);
      const f32x4 k4 = shiftvec(ld4(urow + 512 + c), hal_ok ? ld4(hrow + 512 + c) : z4, ld4(mu + 512 + c), ld4(mu + RWC + 512 + c), fr);
      const f32x4 v4 = shiftvec(ld4(urow + 1024 + c), hal_ok ? ld4(hrow + 1024 + c) : z4, ld4(mu + 1024 + c), ld4(mu + RWC + 1024 + c), fr);
      const f32x4 kk4 = k4 * ld4(p.in[18] + c) * rn;
      *(f32x4*)(o_r + o) = r4; *(f32x4*)(o_v + o) = v4; *(f32x4*)(o_a + o) = -kk4;
      const f32x4 ka = ld4(p.in[19] + c);
      f32x4 bacc = z4;
#pragma unroll
      for (int e = 0; e < 2; ++e) {
        float* o_k = ops_arr(p, 5 + e); float* o_b = ops_arr(p, 7 + e); float* o_w = ops_arr(p, 3 + e);
        f32x4 acc = z4, acw = z4;
#pragma unroll
        for (int ks = 0; ks < 2; ++ks) {
          const bf16x8 wa = *(const bf16x8*)(AUPT + (size_t)(e * 512 + h * 64 + ni * 16 + fr) * 64 + ks * 32 + fq * 8);
          const bf16x8 la = *(const bf16x8*)(Lb + fr * LROWB + 128 + e * 64 + ks * 32 + fq * 8);
          acc = __builtin_amdgcn_mfma_f32_16x16x32_bf16(wa, la, acc, 0, 0, 0);
          const bf16x8 ww = *(const bf16x8*)(WUPT + (size_t)(e * 512 + h * 64 + ni * 16 + fr) * 64 + ks * 32 + fq * 8);
          const bf16x8 lw = *(const bf16x8*)(Lb + fr * LROWB + e * 64 + ks * 32 + fq * 8);
          acw = __builtin_amdgcn_mfma_f32_16x16x32_bf16(ww, lw, acw, 0, 0, 0);
        }
        const f32x4 a0 = ld4(p.in[15] + e * 512 + c), w0 = ld4(p.in[13] + e * 512 + c);
        f32x4 kd, bb, dec;
#pragma unroll
        for (int i = 0; i < 4; ++i) {
          const float ic = sigmoidf_(a0[i] + acc[i]);
          kd[i] = k4[i] * (1.f + (ic - 1.f) * ka[i]);
          bb[i] = kk4[i] * ic;
          const float z = w0[i] + acw[i];
          const float sp = fmaxf(-z, 0.f) + log1pf(__expf(-fabsf(z)));
          dec[i] = __expf(-__expf(-sp - 0.5f));
        }
        bacc += kd;
        *(f32x4*)(o_k + o) = kd; *(f32x4*)(o_b + o) = bb; *(f32x4*)(o_w + o) = dec;
      }
      const f32x4 rk = ld4(p.in[20] + c);
#pragma unroll
      for (int i = 0; i < 4; ++i) bs += r4[i] * 0.5f * bacc[i] * rk[i];
      f32x4 acc = z4;
#pragma unroll
      for (int ks = 0; ks < 4; ++ks) {
        const bf16x8 wg = *(const bf16x8*)(GUPT + (size_t)(h * 64 + ni * 16 + fr) * 128 + ks * 32 + fq * 8);
        const bf16x8 lg = *(const bf16x8*)(Lb + fr * LROWB + 256 + ks * 32 + fq * 8);
        acc = __builtin_amdgcn_mfma_f32_16x16x32_bf16(wg, lg, acc, 0, 0, 0);
      }
      *(uint2*)(gate + o) = make_uint2(pk2(acc[0], acc[1]), pk2(acc[2], acc[3]));
    }
    bs = quad_sum(bs);
#pragma unroll
    for (int ni = 0; ni < 4; ++ni) {
      const size_t o = (size_t)t * 512 + h * 64 + ni * 16 + fq * 4;
      const f32x4 v4 = *(const f32x4*)(o_v + o);
      *(uint2*)(bonus + o) = make_uint2(pk2(bs * v4[0], bs * v4[1]), pk2(bs * v4[2], bs * v4[3]));
    }
    __syncthreads();
  }
}

constexpr int TC = 16;
typedef float f32x2 __attribute__((ext_vector_type(2)));
template <int EPL>
DEV void scan_item(const Params& p, unsigned char* smem, int seq, int h, int dir, int rg) {
  constexpr int LPR = 64 / EPL, RPW = 64 / LPR, RPB = 4 * RPW, NV = RPB / 16, NP = EPL / 2;
  const int tid = threadIdx.x, lane = tid & 63, w = tid >> 6, riw = lane / LPR, kq = lane % LPR;
  const int T = seq < 16 ? 256 : 1024;
  const int tok0 = seq < 16 ? seq * 256 : NCTX + (seq - 16) * 1024;
  const int vrow_l = w * RPW + riw;
  const int vrow = rg * RPB + vrow_l;
  f32x2 S[NP];
  if (seq >= 16) {
    const float* sp = p.in[2] + ((size_t)(((seq - 16) * 2 + dir) * 8 + h) * 64 + vrow) * 64 + kq * EPL;
#pragma unroll
    for (int i = 0; i < NP; ++i) S[i] = *(const f32x2*)(sp + 2 * i);
  } else {
#pragma unroll
    for (int i = 0; i < NP; ++i) S[i] = (f32x2){0.f, 0.f};
  }
  const int lstep = tid >> 4, l16 = tid & 15;
  const float* pr = ops_arr(p, 0) + h * 64 + l16 * 4;
  const float* pw = ops_arr(p, 3 + dir) + h * 64 + l16 * 4;
  const float* pk = ops_arr(p, 5 + dir) + h * 64 + l16 * 4;
  const float* pa = ops_arr(p, 2) + h * 64 + l16 * 4;
  const float* pb = ops_arr(p, 7 + dir) + h * 64 + l16 * 4;
  const float* pv = ops_arr(p, 1) + h * 64 + rg * RPB + l16;
  float* yout = (float*)(p.ws + (dir ? OFF_YB : OFF_YF)) + h * 64 + rg * RPB + l16;
  const int nc = T / TC;
  float4 g_r, g_w, g_k, g_a, g_b; float rv[NV];
#define gload(c) do { const int ts_ = (c) * TC + lstep; const size_t t_ = (size_t)(tok0 + (dir ? T - 1 - ts_ : ts_)) * 512; \
    g_r = *(const float4*)(pr + t_); g_w = *(const float4*)(pw + t_); g_k = *(const float4*)(pk + t_); \
    g_a = *(const float4*)(pa + t_); g_b = *(const float4*)(pb + t_); \
    _Pragma("unroll") for (int q_ = 0; q_ < NV; ++q_) rv[q_] = pv[t_ + 16 * q_]; } while (0)
#define ywrite(c) do { const float* yb_ = (const float*)(smem + 45056 + ((c) & 1) * 2048); const int ts_ = (c) * TC + lstep; \
    const size_t t_ = (size_t)(tok0 + (dir ? T - 1 - ts_ : ts_)) * 512; \
    _Pragma("unroll") for (int q_ = 0; q_ < NV; ++q_) yout[t_ + 16 * q_] = yb_[lstep * 32 + l16 + 16 * q_]; } while (0)
  gload(0);
  for (int c = 0; c < nc; ++c) {
    unsigned char* st = smem + (c & 1) * 22528;
    *(float4*)(st + 0 * 4096 + lstep * 256 + l16 * 16) = g_r;
    *(float4*)(st + 1 * 4096 + lstep * 256 + l16 * 16) = g_w;
    *(float4*)(st + 2 * 4096 + lstep * 256 + l16 * 16) = g_k;
    *(float4*)(st + 3 * 4096 + lstep * 256 + l16 * 16) = g_a;
    *(float4*)(st + 4 * 4096 + lstep * 256 + l16 * 16) = g_b;
#pragma unroll
    for (int q = 0; q < NV; ++q) *(float*)(st + 20480 + lstep * 128 + (l16 + 16 * q) * 4) = rv[q];
    __syncthreads();
    if (c > 0) ywrite(c - 1);
    if (c + 1 < nc) gload(c + 1);
    float* ybw = (float*)(smem + 45056 + (c & 1) * 2048);
    f32x2 o_r[2][NP], o_w[2][NP], o_k[2][NP], o_a[2][NP], o_b[2][NP]; float o_v[2];
    float ykeep[TC / LPR];
#define LDOPS(bi, s_) do { \
      _Pragma("unroll") for (int i_ = 0; i_ < NP; ++i_) { \
        o_r[bi][i_] = *(const f32x2*)(st + 0 * 4096 + (s_) * 256 + kq * EPL * 4 + i_ * 8); \
        o_w[bi][i_] = *(const f32x2*)(st + 1 * 4096 + (s_) * 256 + kq * EPL * 4 + i_ * 8); \
        o_k[bi][i_] = *(const f32x2*)(st + 2 * 4096 + (s_) * 256 + kq * EPL * 4 + i_ * 8); \
        o_a[bi][i_] = *(const f32x2*)(st + 3 * 4096 + (s_) * 256 + kq * EPL * 4 + i_ * 8); \
        o_b[bi][i_] = *(const f32x2*)(st + 4 * 4096 + (s_) * 256 + kq * EPL * 4 + i_ * 8); } \
      o_v[bi] = *(const float*)(st + 20480 + (s_) * 128 + vrow_l * 4); } while (0)
    LDOPS(0, 0);
#pragma unroll
    for (int s = 0; s < TC; ++s) {
      const int bi = s & 1;
      if (s + 1 < TC) LDOPS(bi ^ 1, s + 1);
      const f32x2 vv2 = (f32x2){o_v[bi], o_v[bi]};
      f32x2 pa2 = S[0] * o_a[bi][0];
      f32x2 tt[NP];
      tt[0] = S[0] * o_w[bi][0] + vv2 * o_k[bi][0];
#pragma unroll
      for (int i = 1; i < NP; ++i) { pa2 += S[i] * o_a[bi][i]; tt[i] = S[i] * o_w[bi][i] + vv2 * o_k[bi][i]; }
      float sa = pa2[0] + pa2[1];
      sa += dpp_mov<0xB1>(sa); sa += dpp_mov<0x4E>(sa); sa += dpp_mov<0x141>(sa);
      if (LPR == 16) sa += dpp_mov<0x140>(sa);
      const f32x2 sa2 = (f32x2){sa, sa};
      f32x2 py = (f32x2){0.f, 0.f};
#pragma unroll
      for (int i = 0; i < NP; ++i) { S[i] = sa2 * o_b[bi][i] + tt[i]; py += S[i] * o_r[bi][i]; }
      float y = py[0] + py[1];
      y += dpp_mov<0xB1>(y); y += dpp_mov<0x4E>(y); y += dpp_mov<0x141>(y);
      if (LPR == 16) y += dpp_mov<0x140>(y);
      if ((s % LPR) == 0) ykeep[s / LPR] = y; else ykeep[s / LPR] = (kq == (s % LPR)) ? y : ykeep[s / LPR];
    }
#undef LDOPS
#pragma unroll
    for (int q = 0; q < TC / LPR; ++q) ybw[(q * LPR + kq) * 32 + vrow_l] = ykeep[q];
  }
  __syncthreads();
  ywrite(nc - 1);
  if (seq < 16) {
    float* so = p.out + OUT_STATE + ((size_t)((seq * 2 + dir) * 8 + h) * 64 + vrow) * 64 + kq * EPL;
#pragma unroll
    for (int i = 0; i < NP; ++i) *(f32x2*)(so + 2 * i) = S[i];
  }
  __syncthreads();
#undef gload
#undef ywrite
}

DEV void attn_wave_item(const Params& p, int witem) {
  const int lane = threadIdx.x & 63, fr = lane & 15, fq = lane >> 4;
  const bf16_t* qb = (const bf16_t*)(p.ws + OFF_QB);
  const bf16_t* kb = (const bf16_t*)(p.ws + OFF_KB);
  const bf16_t* vT = (const bf16_t*)(p.ws + OFF_VT);
  const bf16_t* ckb = (const bf16_t*)(p.ws + OFF_CKB);
  const bf16_t* cvT = (const bf16_t*)(p.ws + OFF_CVT);
  bf16_t* ona = (bf16_t*)(p.ws + OFF_ONA);
  int h, tq0, nsub;
  bool latent;
  int b = 0, r = 0, jb = 0, row_start = 0, band = 0, seq = 0;
  if (witem < 1024) {
    latent = true;
    b = witem >> 9; const int rem = witem & 511; r = rem >> 5; jb = (rem >> 3) & 3; h = rem & 7;
    tq0 = NCTX + b * 1024 + r * 64 + jb * 16;
    row_start = min(max(r - 4, 0), 8); band = min(max(jb * 16 - 8, 0), 32);
    nsub = 4;
  } else {
    latent = false;
    const int w2 = witem - 1024; const int qt = w2 >> 3; h = w2 & 7;
    tq0 = qt * 16; seq = tq0 >> 8; nsub = 2;
  }
  const bf16_t* qp = qb + (size_t)(tq0 + fr) * 512 + h * 64 + fq * 8;
  const bf16x8 qf0 = *(const bf16x8*)qp, qf1 = *(const bf16x8*)(qp + 32);
  float m = -INFINITY, l = 0.f;
  f32x4 O[4];
#pragma unroll
  for (int i = 0; i < 4; ++i) O[i] = (f32x4){0.f, 0.f, 0.f, 0.f};
#pragma unroll 1
  for (int sc = 0; sc < nsub; ++sc) {
    const int half = sc & 1;
    const bf16_t* kbase; const bf16_t* vbase; int KS, ldv;
    const bool win = latent && sc < 2;
    if (win) {
      const int tb = NCTX + b * 1024 + (row_start + half * 4) * 64 + band;
      kbase = kb + (size_t)tb * 512 + h * 64; vbase = vT + (size_t)(h * 64) * NTOK + tb; KS = 64; ldv = NTOK;
    } else if (latent) {
      kbase = ckb + (size_t)(b * 256 + half * 128) * 512 + h * 64; vbase = cvT + (size_t)((b * 8 + h) * 64) * 256 + half * 128; KS = 32; ldv = 256;
    } else {
      const int tb = seq * 256 + half * 128;
      kbase = kb + (size_t)tb * 512 + h * 64; vbase = vT + (size_t)(h * 64) * NTOK + tb; KS = 32; ldv = NTOK;
    }
    f32x4 st[8];
#pragma unroll
    for (int i = 0; i < 8; ++i) {
      const int tokrel = (i >> 1) * KS + (i & 1) * 16 + fr;
      const bf16_t* kp = kbase + (size_t)tokrel * 512 + fq * 8;
      const bf16x8 kf0 = *(const bf16x8*)kp, kf1 = *(const bf16x8*)(kp + 32);
      f32x4 z = (f32x4){0.f, 0.f, 0.f, 0.f};
      z = __builtin_amdgcn_mfma_f32_16x16x32_bf16(kf0, qf0, z, 0, 0, 0);
      st[i] = __builtin_amdgcn_mfma_f32_16x16x32_bf16(kf1, qf1, z, 0, 0, 0);
    }
    if (win) {
      const int q_col = jb * 16 + fr;
      const int win_start = min(max(q_col - 8, 0), 48);
      const float* rpb = p.in[25] + h * 465;
#pragma unroll
      for (int i = 0; i < 8; ++i) {
        const int dr = row_start + half * 4 + (i >> 1) - r + 7;
#pragma unroll
        for (int e = 0; e < 4; ++e) {
          const int k_col = band + (i & 1) * 16 + fq * 4 + e;
          const bool valid = (k_col >= win_start) && (k_col < win_start + 16);
          const int dc = min(max(k_col - q_col, -15), 15) + 15;
          st[i][e] = valid ? st[i][e] + rpb[dr * 31 + dc] : -1e30f;
        }
      }
    }
    float cmax = -1e30f;
#pragma unroll
    for (int i = 0; i < 8; ++i)
#pragma unroll
      for (int e = 0; e < 4; ++e) cmax = fmaxf(cmax, st[i][e]);
    cmax = fmaxf(cmax, __shfl_xor(cmax, 16)); cmax = fmaxf(cmax, __shfl_xor(cmax, 32));
    const float mnew = fmaxf(m, cmax);
    const float alpha = __expf(m - mnew);
    float psum = 0.f;
#pragma unroll
    for (int i = 0; i < 8; ++i)
#pragma unroll
      for (int e = 0; e < 4; ++e) { const float pv = __expf(st[i][e] - mnew); st[i][e] = pv; psum += pv; }
    psum += __shfl_xor(psum, 16); psum += __shfl_xor(psum, 32);
    l = l * alpha + psum;
#pragma unroll
    for (int i = 0; i < 4; ++i) O[i] = O[i] * alpha;
    m = mnew;
#pragma unroll
    for (int s = 0; s < 4; ++s) {
      union { bf16x8 v; unsigned u[4]; } pb;
      pb.u[0] = pk2(st[2 * s][0], st[2 * s][1]); pb.u[1] = pk2(st[2 * s][2], st[2 * s][3]);
      pb.u[2] = pk2(st[2 * s + 1][0], st[2 * s + 1][1]); pb.u[3] = pk2(st[2 * s + 1][2], st[2 * s + 1][3]);
#pragma unroll
      for (int dt = 0; dt < 4; ++dt) {
        const bf16_t* vp = vbase + (size_t)(dt * 16 + fr) * ldv + s * KS + fq * 4;
        union { bf16x8 v; uint2 u[2]; } va;
        va.u[0] = *(const uint2*)vp; va.u[1] = *(const uint2*)(vp + 16);
        O[dt] = __builtin_amdgcn_mfma_f32_16x16x32_bf16(va.v, pb.v, O[dt], 0, 0, 0);
      }
    }
  }
  const float inv = 1.f / l;
#pragma unroll
  for (int dt = 0; dt < 4; ++dt) {
    bf16_t* op = ona + (size_t)(tq0 + fr) * 512 + h * 64 + dt * 16 + fq * 4;
    *(uint2*)op = make_uint2(pk2(O[dt][0] * inv, O[dt][1] * inv), pk2(O[dt][2] * inv, O[dt][3] * inv));
  }
}

constexpr int N_SCAN_ITEMS = 128 + 512, N_ATTN_BLK = 768;
DEV void phase_scan_attn(const Params& p, unsigned char* smem, int* s_item, int rep) {
  unsigned* counter = (unsigned*)(p.ws + OFF_CTL) + rep;
  for (;;) {
    if (threadIdx.x == 0) *s_item = (int)atomicAdd(counter, 1u);
    __syncthreads();
    const int item = *s_item;
    __syncthreads();
    if (item >= N_SCAN_ITEMS + N_ATTN_BLK) break;
    if (item < 128) { const int rem = item & 63; scan_item<4>(p, smem, 16 + (item >> 6), rem >> 3, (rem >> 2) & 1, rem & 3); }
    else if (item < N_SCAN_ITEMS) { const int i2 = item - 128, rem = i2 & 31; scan_item<8>(p, smem, i2 >> 5, rem >> 2, (rem >> 1) & 1, rem & 1); }
    else attn_wave_item(p, (item - N_SCAN_ITEMS) * 4 + (threadIdx.x >> 6));
  }
}

DEV void phase_finalize_rw(const Params& p, int bid, int nb) {
  const int lane = threadIdx.x & 63, gw = bid * 4 + (threadIdx.x >> 6), nw = nb * 4;
  const float* yf = (const float*)(p.ws + OFF_YF);
  const float* yb = (const float*)(p.ws + OFF_YB);
  const bf16_t* bonus = (const bf16_t*)(p.ws + OFF_BG);
  const bf16_t* gate = (const bf16_t*)(p.ws + OFF_BG + 6291456);
  bf16_t* orw = (bf16_t*)(p.ws + OFF_ORW);
  for (int it = gw; it < NTOK * 8; it += nw) {
    const size_t o = (size_t)it * 64 + lane;
    const int c = (it & 7) * 64 + lane;
    const float y = yf[o] + yb[o];
    const float mean = wave_sum(y) * (1.f / 64.f);
    const float d = y - mean;
    const float var = wave_sum(d * d) * (1.f / 64.f);
    const float yn = d * rsqrtf(var + 64e-5f) * p.in[21][c] + p.in[22][c];
    orw[o] = f2bf((yn + bf2f(bonus[o])) * bf2f(gate[o]));
  }
}

#define XB_TMO      128
#define XB_XCNT(j)  (256  + 64 * (j))
#define XB_XSUB(j)  (1280 + 64 * (j))
#define XB_XGEN(j)  (2304 + 64 * (j))
#define XB_TOP      3328
#define XB_TOPGEN   3392
#define XCD_BAR_WORDS 3456
#define XB_SPIN_CAP (1u << 18)
#define LAS __attribute__((address_space(3)))
DEV unsigned xb_ld(unsigned* p)              { return __hip_atomic_load(p, __ATOMIC_RELAXED, __HIP_MEMORY_SCOPE_AGENT); }
DEV unsigned xb_add(unsigned* p, unsigned v) { return __hip_atomic_fetch_add(p, v, __ATOMIC_RELAXED, __HIP_MEMORY_SCOPE_AGENT); }
DEV unsigned xb_xcc_id() { return (unsigned)__builtin_amdgcn_s_getreg((3 << 11) | 20) & 0xFu; }
#define XB_SPIN(cond, bar) do { unsigned _sp = 0; while (cond) { __builtin_amdgcn_s_sleep(1); \
    if ((++_sp & 255u) == 0u) { if (xb_ld(&(bar)[XB_TMO])) break; if (_sp > XB_SPIN_CAP) { atomicAdd(&(bar)[XB_TMO], 1u); break; } } } } while (0)
struct XcdBarrier { unsigned* bar; unsigned x; volatile LAS unsigned* st; };
DEV XcdBarrier xcd_barrier_post(unsigned* bar, volatile LAS unsigned* st) {
  XcdBarrier b; b.bar = bar; b.x = xb_xcc_id(); b.st = st;
  if (threadIdx.x == 0) (void)xb_add(&bar[XB_XCNT(b.x)], 1u);
  return b;
}
DEV void xcd_barrier_complete(unsigned* bar, unsigned x, unsigned& nloc, unsigned& nx) {
  const unsigned G = gridDim.x * gridDim.y * gridDim.z;
  unsigned sum, cnt, mine, sp = 0u;
  for (;;) {
    sum = 0u; cnt = 0u; mine = 0u;
#pragma unroll
    for (unsigned j = 0; j < 16; ++j) { const unsigned c = xb_ld(&bar[XB_XCNT(j)]); sum += c; cnt += (c > 0u) ? 1u : 0u; mine = (j == x) ? c : mine; }
    if (sum == G) break;
    __builtin_amdgcn_s_sleep(1);
    if ((++sp & 255u) == 0u) { if (xb_ld(&bar[XB_TMO])) break; if (sp > XB_SPIN_CAP) { atomicAdd(&bar[XB_TMO], 1u); break; } }
  }
  nloc = mine > 0u ? mine : 1u; nx = cnt > 0u ? cnt : 1u;
}
DEV void xcd_barrier(const XcdBarrier& b) {
  asm volatile("s_waitcnt vmcnt(0)" ::: "memory");
  __syncthreads();
  if (threadIdx.x == 0) {
    unsigned* bar = b.bar;
    __builtin_amdgcn_s_waitcnt(0);
    unsigned nloc = b.st[0], nx = b.st[1];
    if (nloc == 0u) { xcd_barrier_complete(bar, b.x, nloc, nx); b.st[0] = nloc; b.st[1] = nx; }
    const unsigned old = xb_add(&bar[XB_XSUB(b.x)], 1u);
    const unsigned gen = old / nloc;
    if (old + 1u == (gen + 1u) * nloc) {
      __builtin_amdgcn_fence(__ATOMIC_RELEASE, "agent");
      asm volatile("s_waitcnt vmcnt(0)" ::: "memory");
      const unsigned og = xb_add(&bar[XB_TOP], 1u);
      const unsigned tg = og / nx;
      if (og + 1u == (tg + 1u) * nx) xb_add(&bar[XB_TOPGEN], 1u);
      else XB_SPIN(xb_ld(&bar[XB_TOPGEN]) == tg, bar);
      __builtin_amdgcn_fence(__ATOMIC_ACQUIRE, "agent");
      xb_add(&bar[XB_XGEN(b.x)], 1u);
      asm volatile("s_waitcnt vmcnt(0)" ::: "memory");
    } else {
      XB_SPIN(xb_ld(&bar[XB_XGEN(b.x)]) == gen, bar);
      __builtin_amdgcn_fence(__ATOMIC_ACQUIRE, "agent");
      asm volatile("s_waitcnt vmcnt(0)" ::: "memory");
    }
  }
  __syncthreads();
}

__global__ void __launch_bounds__(NTHR, 2) fwd_megakernel(Params p) {
  extern __shared__ __attribute__((aligned(16))) unsigned char smem[];
  __shared__ __attribute__((aligned(16))) unsigned sh_ctl[8];
  cg::grid_group grid = cg::this_grid();
  const int bid = blockIdx.x, nb = gridDim.x;
  if (threadIdx.x < 8) sh_ctl[threadIdx.x] = 0u;
  __syncthreads();
  const XcdBarrier xb = xcd_barrier_post((unsigned*)(p.ws + OFF_CTL), (volatile LAS unsigned*)sh_ctl);
  int* s_item_p = (int*)&sh_ctl[4];
  if (p.ph_hi > 1000) grid.sync();
#define GSYNC() xcd_barrier(xb)
#ifndef DUP
#define DUP -1
#endif
#define PH(n, body) if (p.ph_lo <= n && n < p.ph_hi) { { const int rep = 0; (void)rep; body; } if (DUP == n) { GSYNC(); const int rep = 1; (void)rep; body; } if (n + 1 < p.ph_hi) GSYNC(); }
  PH(0, phase0(p, smem, bid, nb, rep))
  PH(1, phase_normmod<0>(p, bid, nb))
  PH(2, reset_tiles(s_item_p); phase_gemm_in(p, smem, s_item_p))
  PH(3, phase_qkprep(p, smem, bid, nb); phase_rwprep(p, smem, bid, nb))
  PH(4, phase_scan_attn(p, smem, s_item_p, rep))
  PH(5, phase_finalize_rw(p, bid, nb))
  PH(6, reset_tiles(s_item_p); phase_gemm_merge(p, smem, s_item_p))
  PH(7, reset_tiles(s_item_p); phase_gemm_out(p, smem, s_item_p))
  PH(8, phase_normmod<1>(p, bid, nb))
  PH(9, reset_tiles(s_item_p); phase_gemm_ffn_up(p, smem, s_item_p))
  PH(10, reset_tiles(s_item_p); phase_gemm_ffn_down(p, smem, s_item_p))
}

extern "C" void kernel_launch(void* const* d_in, const int* in_sizes, int n_in, void* d_out, int out_size, void* d_ws, size_t ws_size,
                              hipStream_t stream) {
  static int grid_blocks = 0;
  if (grid_blocks == 0) {
    if (n_in != 32 || ws_size < WS_END) { fprintf(stderr, "kernel_launch: unexpected n_in %d / ws_size %zu (need %zu)\n", n_in, ws_size, (size_t)WS_END); grid_blocks = -1; return; }
    int dev = 0, cus = 0, per_cu = 0;
    hipGetDevice(&dev);
    hipDeviceGetAttribute(&cus, hipDeviceAttributeMultiprocessorCount, dev);
    if (hipFuncSetAttribute((const void*)fwd_megakernel, hipFuncAttributeMaxDynamicSharedMemorySize, LDS_BYTES) != hipSuccess) { fprintf(stderr, "hipFuncSetAttribute failed\n"); grid_blocks = -1; return; }
    if (hipOccupancyMaxActiveBlocksPerMultiprocessor(&per_cu, (const void*)fwd_megakernel, NTHR, LDS_BYTES) != hipSuccess || per_cu < 1) { fprintf(stderr, "occupancy query failed (%d)\n", per_cu); grid_blocks = -1; return; }
    if (per_cu > 2) per_cu = 2;
    grid_blocks = cus * per_cu;
    fprintf(stderr, "kernel_launch: cus %d per_cu %d grid %d\n", cus, per_cu, grid_blocks);
  }
  if (grid_blocks < 0) return;
  hipMemsetAsync((char*)d_ws + OFF_CTL, 0, CTL_ZERO_BYTES, stream);
  Params p{};
  for (int i = 0; i < 32; ++i) p.in[i] = (const float*)d_in[i];
  p.out = (float*)d_out; p.ws = (unsigned char*)d_ws; p.ph_lo = 0; p.ph_hi = 11;
  void* args[] = {&p};
  hipError_t e = hipLaunchCooperativeKernel((const void*)fwd_megakernel, dim3(grid_blocks), dim3(NTHR), args, LDS_BYTES, stream);
  if (e != hipSuccess) fprintf(stderr, "cooperative launch failed: %s (grid %d)\n", hipGetErrorString(e), grid_blocks);
}
```

```cpp
#include <hip/hip_runtime.h>
#include <hip/hip_cooperative_groups.h>
#include <cstdio>
#include <cstdint>
namespace cg = cooperative_groups;

#define DEV __device__ __forceinline__
typedef unsigned short bf16_t;
typedef short bf16x8 __attribute__((ext_vector_type(8)));
typedef short bf16x4 __attribute__((ext_vector_type(4)));
typedef float f32x4 __attribute__((ext_vector_type(4)));

constexpr int D = 1024, NTOK = 6144, NCTX = 4096, RW = 512, FF = 2816, INC = 5504, RWC = 1920;
constexpr int NTHR = 256;
constexpr int LDS_BYTES = 65536;

constexpr size_t OFF_CTL = 0;
constexpr size_t OFF_MOD = 16384;
constexpr size_t CTL_ZERO_BYTES = 16384 + 3 * 6144 * 4;
constexpr size_t OFF_WIN = 90112;
constexpr size_t OFF_WORW = OFF_WIN + 11272192;
constexpr size_t OFF_WONA = OFF_WORW + 1048576;
constexpr size_t OFF_WOUT = OFF_WONA + 1048576;
constexpr size_t OFF_W13 = OFF_WOUT + 2097152;
constexpr size_t OFF_W2 = OFF_W13 + 11534336;
constexpr size_t OFF_H = OFF_W2 + 5767168;
constexpr size_t OFF_URW = OFF_H + 12582912;
constexpr size_t OFF_UNA = OFF_URW + 47185920;
constexpr size_t OFF_OPS = OFF_UNA + 37748736;
constexpr size_t OPS_ARR = 12582912;
constexpr size_t OFF_BG = OFF_OPS + 9 * OPS_ARR;
constexpr size_t OFF_VT = OFF_BG + 12582912;
constexpr size_t OFF_CKB = OFF_VT + 6291456;
constexpr size_t OFF_CVT = OFF_CKB + 524288;
constexpr size_t OFF_LORA = OFF_CVT + 524288;
constexpr size_t WS_END = OFF_LORA + 393216;
constexpr size_t OFF_QB = OFF_H, OFF_KB = OFF_H + 6291456;
constexpr size_t OFF_YF = OFF_URW, OFF_YB = OFF_URW + 12582912;
constexpr size_t OFF_ORW = OFF_UNA, OFF_ONA = OFF_UNA + 6291456;
constexpr size_t OFF_MERGED = OFF_OPS;
constexpr size_t OFF_HID = OFF_URW;
constexpr size_t OUT_STATE = 6291456, OUT_K = 7340032, OUT_V = 9437184;

struct Params {
  const float* in[32];
  float* out;
  unsigned char* ws;
  int ph_lo, ph_hi;
};

DEV unsigned short f2bf(float f) { unsigned u = __float_as_uint(f); u += 0x7fffu + ((u >> 16) & 1u); return (unsigned short)(u >> 16); }
DEV unsigned pk2(float lo, float hi) { return (unsigned)f2bf(lo) | ((unsigned)f2bf(hi) << 16); }
DEV float bf2f(unsigned short b) { return __uint_as_float(((unsigned)b) << 16); }
DEV float sigmoidf_(float x) { return 1.f / (1.f + __expf(-x)); }
DEV float wave_sum(float x) {
#pragma unroll
  for (int o = 32; o > 0; o >>= 1) x += __shfl_xor(x, o);
  return x;
}
template <int CTRL> DEV float dpp_mov(float x) { return __int_as_float(__builtin_amdgcn_update_dpp(0, __float_as_int(x), CTRL, 0xf, 0xf, true)); }
DEV float row16_sum(float x) {
  x += dpp_mov<0xB1>(x); x += dpp_mov<0x4E>(x); x += dpp_mov<0x141>(x); x += dpp_mov<0x140>(x);
  return x;
}
#define BAR_LDS() do { asm volatile("s_waitcnt lgkmcnt(0)" ::: "memory"); __builtin_amdgcn_s_barrier(); asm volatile("" ::: "memory"); } while (0)
DEV const float* xrow(const Params& p, int t) { return t < NCTX ? p.in[0] + (size_t)t * D : p.in[1] + (size_t)(t - NCTX) * D; }
DEV int modidx(int t) { return t < NCTX ? 0 : 1 + ((t - NCTX) >> 10); }

DEV void conv_job(const Params& p, int j, const float*& src, bf16_t*& dst, int& K, int& N, int& mode, int& base) {
  if (j < 1376) { src = p.in[11]; dst = (bf16_t*)(p.ws + OFF_WIN); K = 1024; N = 5504; mode = 0; base = 0; }
  else if (j < 1504) { src = p.in[26]; dst = (bf16_t*)(p.ws + OFF_WORW); K = 512; N = 1024; mode = 0; base = 1376; }
  else if (j < 1632) { src = p.in[27]; dst = (bf16_t*)(p.ws + OFF_WONA); K = 512; N = 1024; mode = 0; base = 1504; }
  else if (j < 1888) { src = p.in[28]; dst = (bf16_t*)(p.ws + OFF_WOUT); K = 1024; N = 1024; mode = 0; base = 1632; }
  else if (j < 2592) { src = p.in[29]; dst = (bf16_t*)(p.ws + OFF_W13); K = 1024; N = 2816; mode = 1; base = 1888; }
  else if (j < 3296) { src = p.in[30]; dst = (bf16_t*)(p.ws + OFF_W13); K = 1024; N = 2816; mode = 2; base = 2592; }
  else if (j < 4000) { src = p.in[31]; dst = (bf16_t*)(p.ws + OFF_W2); K = 2816; N = 1024; mode = 0; base = 3296; }
  else if (j < 4016) { const int e = (j - 4000) >> 3; src = p.in[14] + e * 32768; dst = (bf16_t*)(p.ws + OFF_LORA) + e * 32768; K = 64; N = 512; mode = 0; base = 4000 + e * 8; }
  else if (j < 4032) { const int e = (j - 4016) >> 3; src = p.in[16] + e * 32768; dst = (bf16_t*)(p.ws + OFF_LORA) + 65536 + e * 32768; K = 64; N = 512; mode = 0; base = 4016 + e * 8; }
  else { src = p.in[17]; dst = (bf16_t*)(p.ws + OFF_LORA) + 131072; K = 128; N = 512; mode = 0; base = 4032; }
}
constexpr int N_CONV_TILES = 4048, N_MOD_TILES = 768;

DEV void phase0(const Params& p, unsigned char* smem, int bid, int nb, int rep) {
  const int tid = threadIdx.x;
  float* T = (float*)smem;
  for (int tile = bid; tile < N_MOD_TILES && rep == 0; tile += nb) {
    const int cgp = tile % 24, kc = tile / 24;
    if (tid < 96) {
      const int m = tid >> 5, kk = tid & 31, k = kc * 32 + kk;
      const float c = (m == 0) ? p.in[6][k] : p.in[5][(m - 1) * D + k];
      T[tid] = c * sigmoidf_(c);
    }
    __syncthreads();
    const int col = cgp * 256 + tid;
    const float* w = p.in[9] + (size_t)(kc * 32) * 6144 + col;
    float a0 = 0.f, a1 = 0.f, a2 = 0.f;
#pragma unroll
    for (int kk = 0; kk < 32; ++kk) {
      const float wv = w[(size_t)kk * 6144];
      a0 += T[kk] * wv; a1 += T[32 + kk] * wv; a2 += T[64 + kk] * wv;
    }
    if (kc == 0) { const float b = p.in[10][col]; a0 += b; a1 += b; a2 += b; }
    float* mod = (float*)(p.ws + OFF_MOD);
    atomicAdd(mod + col, a0); atomicAdd(mod + 6144 + col, a1); atomicAdd(mod + 12288 + col, a2);
    __syncthreads();
  }
  const int r_ = tid >> 4, c4_ = tid & 15;
  float4 v[4];
  const float* src; bf16_t* dst; int K, N, mode, base;
  int tile = bid;
  if (tile < N_CONV_TILES) {
    conv_job(p, tile, src, dst, K, N, mode, base);
    const int lt = tile - base, nN = N >> 6, k0 = (lt / nN) * 64, n0 = (lt % nN) * 64;
#pragma unroll
    for (int i = 0; i < 4; ++i) v[i] = *(const float4*)(src + (size_t)(k0 + r_ + 16 * i) * N + n0 + c4_ * 4);
  }
  while (tile < N_CONV_TILES) {
    const int lt = tile - base, nN = N >> 6, k0 = (lt / nN) * 64, n0 = (lt % nN) * 64;
    bf16_t* cdst = dst; const int cK = K, cmode = mode;
#pragma unroll
    for (int i = 0; i < 4; ++i) {
      float* tp = T + (r_ + 16 * i) * 65 + c4_ * 4;
      tp[0] = v[i].x; tp[1] = v[i].y; tp[2] = v[i].z; tp[3] = v[i].w;
    }
    BAR_LDS();
    tile += nb;
    if (tile < N_CONV_TILES) {
      conv_job(p, tile, src, dst, K, N, mode, base);
      const int lt2 = tile - base, nN2 = N >> 6, k2 = (lt2 / nN2) * 64, n2 = (lt2 % nN2) * 64;
#pragma unroll
      for (int i = 0; i < 4; ++i) v[i] = *(const float4*)(src + (size_t)(k2 + r_ + 16 * i) * N + n2 + c4_ * 4);
    }
    const int n = tid >> 2, kp = tid & 3;
    unsigned w[8];
#pragma unroll
    for (int i = 0; i < 8; ++i) w[i] = pk2(T[(kp * 16 + 2 * i) * 65 + n], T[(kp * 16 + 2 * i + 1) * 65 + n]);
    const int ng = n0 + n;
    int drow = ng;
    if (cmode == 1) drow = (ng >> 4) * 32 + (ng & 15);
    else if (cmode == 2) drow = (ng >> 4) * 32 + 16 + (ng & 15);
    uint4* dp = (uint4*)(cdst + (size_t)drow * cK + k0 + kp * 16);
    dp[0] = make_uint4(w[0], w[1], w[2], w[3]);
    dp[1] = make_uint4(w[4], w[5], w[6], w[7]);
    BAR_LDS();
  }
}

template <int WHICH>
DEV void phase_normmod(const Params& p, int bid, int nb) {
  const int lane = threadIdx.x & 63, gw = bid * 4 + (threadIdx.x >> 6), nw = nb * 4;
  const float* g = WHICH == 0 ? p.in[7] : p.in[8];
  const float* mod = (const float*)(p.ws + OFF_MOD);
  const int sh_off = WHICH == 0 ? 0 : 3072, sc_off = WHICH == 0 ? 1024 : 4096;
  bf16_t* dst = (bf16_t*)(p.ws + OFF_H);
  for (int t = gw; t < NTOK; t += nw) {
    const float* xp = WHICH == 0 ? xrow(p, t) : p.out + (size_t)t * D;
    const float* mm = mod + modidx(t) * 6144;
    float4 v[4];
    float ss = 0.f;
#pragma unroll
    for (int i = 0; i < 4; ++i) {
      v[i] = *(const float4*)(xp + (i * 64 + lane) * 4);
      ss += v[i].x * v[i].x + v[i].y * v[i].y + v[i].z * v[i].z + v[i].w * v[i].w;
    }
    ss = wave_sum(ss);
    const float rstd = rsqrtf(ss * (1.f / 1024.f) + 1e-6f);
#pragma unroll
    for (int i = 0; i < 4; ++i) {
      const int col = (i * 64 + lane) * 4;
      const float4 g4 = *(const float4*)(g + col);
      const float4 sc = *(const float4*)(mm + sc_off + col);
      const float4 sh = *(const float4*)(mm + sh_off + col);
      const float y0 = v[i].x * rstd * g4.x * (1.f + sc.x) + sh.x;
      const float y1 = v[i].y * rstd * g4.y * (1.f + sc.y) + sh.y;
      const float y2 = v[i].z * rstd * g4.z * (1.f + sc.z) + sh.z;
      const float y3 = v[i].w * rstd * g4.w * (1.f + sc.w) + sh.w;
      *(uint2*)(dst + (size_t)t * D + col) = make_uint2(pk2(y0, y1), pk2(y2, y3));
    }
  }
}

template <int MI>
DEV void gemm_tile_acc(f32x4 (&acc)[MI][4], const bf16_t* __restrict__ A, int lda, const bf16_t* __restrict__ Bt, int ldb,
                       int m0, int n0, int K, unsigned char* smem) {
  constexpr int AT = 2 * MI * 16 * 128, BT = 16384, STG = AT + BT;
  const int tid = threadIdx.x, lane = tid & 63, wid = tid >> 6, wr = wid >> 1, wc = wid & 1, fr = lane & 15, fq = lane >> 4;
  const int gkc = (tid & 7) ^ ((tid >> 4) & 7);
  const bf16_t* ga = A + (size_t)(m0 + (tid >> 3)) * lda + gkc * 8;
  const bf16_t* gb = Bt + (size_t)(n0 + (tid >> 3)) * ldb + gkc * 8;
  const int swz = (fr >> 1) & 7;
  const int nk = K >> 6;
#define GLDS_TILE(kt_, buf_) do { unsigned char* sb_ = smem + (buf_) * STG; const int k0_ = (kt_) * 64; \
    _Pragma("unroll") for (int i_ = 0; i_ < (2 * MI * 16) / 32; ++i_) \
      __builtin_amdgcn_global_load_lds((const unsigned*)(ga + (size_t)i_ * 32 * lda + k0_), (__attribute__((address_space(3))) unsigned*)(sb_ + (i_ * 256 + tid) * 16), 16, 0, 0); \
    _Pragma("unroll") for (int i_ = 0; i_ < 4; ++i_) \
      __builtin_amdgcn_global_load_lds((const unsigned*)(gb + (size_t)i_ * 32 * ldb + k0_), (__attribute__((address_space(3))) unsigned*)(sb_ + AT + (i_ * 256 + tid) * 16), 16, 0, 0); \
  } while (0)
  GLDS_TILE(0, 0);
  asm volatile("s_waitcnt vmcnt(0)" ::: "memory");
  __syncthreads();
  for (int kt = 0; kt < nk; ++kt) {
    if (kt + 1 < nk) GLDS_TILE(kt + 1, (kt + 1) & 1);
    const unsigned char* cur = smem + (kt & 1) * STG;
#pragma unroll
    for (int ks = 0; ks < 2; ++ks) {
      bf16x8 af[MI], bf[4];
      const int co = ((ks * 4 + fq) ^ swz) << 4;
#pragma unroll
      for (int mi = 0; mi < MI; ++mi) af[mi] = *(const bf16x8*)(cur + (wr * MI * 16 + mi * 16 + fr) * 128 + co);
#pragma unroll
      for (int ni = 0; ni < 4; ++ni) bf[ni] = *(const bf16x8*)(cur + AT + (wc * 64 + ni * 16 + fr) * 128 + co);
#pragma unroll
      for (int mi = 0; mi < MI; ++mi)
#pragma unroll
        for (int ni = 0; ni < 4; ++ni) acc[mi][ni] = __builtin_amdgcn_mfma_f32_16x16x32_bf16(bf[ni], af[mi], acc[mi][ni], 0, 0, 0);
    }
    asm volatile("s_waitcnt vmcnt(0)" ::: "memory");
    __syncthreads();
  }
#undef GLDS_TILE
}

template <int MI>
DEV void zero_acc(f32x4 (&acc)[MI][4]) {
#pragma unroll
  for (int i = 0; i < MI; ++i)
#pragma unroll
    for (int j = 0; j < 4; ++j) acc[i][j] = (f32x4){0.f, 0.f, 0.f, 0.f};
}

#ifndef DYN_TILES
#define DYN_TILES 0
#endif
DEV int grab_tile(const Params& p, int word, int* slot) {
#if DYN_TILES
  if (threadIdx.x == 0) *slot = (int)atomicAdd((unsigned*)(p.ws + OFF_CTL) + word, 1u);
  __syncthreads();
  const int t = *slot;
  __syncthreads();
  return t;
#else
  const int t = slot[1];
  __syncthreads();
  if (threadIdx.x == 0) slot[1] = t + gridDim.x;
  __syncthreads();
  return t;
#endif
}
DEV void reset_tiles(int* slot) { if (threadIdx.x == 0) slot[1] = blockIdx.x; __syncthreads(); }

#define EPI_COORDS const int lane = threadIdx.x & 63, wid = threadIdx.x >> 6, wr = wid >> 1, wc = wid & 1, fr = lane & 15, fq = lane >> 4

DEV void phase_gemm_in(const Params& p, unsigned char* smem, int* slot) {
  EPI_COORDS;
  const bf16_t* A = (const bf16_t*)(p.ws + OFF_H);
  const bf16_t* Bt = (const bf16_t*)(p.ws + OFF_WIN);
  float* urw = (float*)(p.ws + OFF_URW);
  float* una = (float*)(p.ws + OFF_UNA);
  bf16_t* gates = (bf16_t*)p.out;
  for (;;) {
    const int tile = grab_tile(p, 8, slot);
    if (tile >= 48 * 43) break;
    const int tm = tile % 48, tn = tile / 48, m0 = tm * 128, n0 = tn * 128;
    f32x4 acc[4][4];
    zero_acc<4>(acc);
    gemm_tile_acc<4>(acc, A, D, Bt, D, m0, n0, D, smem);
#pragma unroll
    for (int mi = 0; mi < 4; ++mi) {
      const int row = m0 + wr * 64 + mi * 16 + fr;
#pragma unroll
      for (int ni = 0; ni < 4; ++ni) {
        const int col = n0 + wc * 64 + ni * 16 + fq * 4;
        const f32x4 v = acc[mi][ni];
        if (n0 < 1920) *(f32x4*)(urw + (size_t)row * 1920 + col) = v;
        else if (n0 < 3456) *(f32x4*)(una + (size_t)row * 1536 + (col - 1920)) = v;
        else *(uint2*)(gates + (size_t)row * 2048 + (col - 3456)) = make_uint2(pk2(sigmoidf_(v[0]), sigmoidf_(v[1])), pk2(sigmoidf_(v[2]), sigmoidf_(v[3])));
      }
    }
  }
}

DEV void phase_gemm_merge(const Params& p, unsigned char* smem, int* slot) {
  EPI_COORDS;
  const bf16_t* orw = (const bf16_t*)(p.ws + OFF_ORW);
  const bf16_t* ona = (const bf16_t*)(p.ws + OFF_ONA);
  const bf16_t* w1 = (const bf16_t*)(p.ws + OFF_WORW);
  const bf16_t* w2 = (const bf16_t*)(p.ws + OFF_WONA);
  const bf16_t* gates = (const bf16_t*)p.out;
  bf16_t* merged = (bf16_t*)(p.ws + OFF_MERGED);
  float* mtmp = (float*)(p.ws + OFF_MERGED + 16777216);
  for (;;) {
    const int tile = grab_tile(p, 9, slot);
    if (tile >= 64 * 8) break;
    const int tm = tile % 64, tn = tile / 64, m0 = tm * 96, n0 = tn * 128;
    f32x4 acc[3][4];
    zero_acc<3>(acc);
    gemm_tile_acc<3>(acc, orw, RW, w1, RW, m0, n0, RW, smem);
#pragma unroll
    for (int mi = 0; mi < 3; ++mi) {
      const int row = m0 + wr * 48 + mi * 16 + fr;
#pragma unroll
      for (int ni = 0; ni < 4; ++ni) {
        const int col = n0 + wc * 64 + ni * 16 + fq * 4;
        const uint2 g = *(const uint2*)(gates + (size_t)row * 2048 + col);
        f32x4 r;
        r[0] = acc[mi][ni][0] * bf2f((unsigned short)(g.x & 0xffff));
        r[1] = acc[mi][ni][1] * bf2f((unsigned short)(g.x >> 16));
        r[2] = acc[mi][ni][2] * bf2f((unsigned short)(g.y & 0xffff));
        r[3] = acc[mi][ni][3] * bf2f((unsigned short)(g.y >> 16));
        *(f32x4*)(mtmp + (size_t)row * D + col) = r;
      }
    }
    zero_acc<3>(acc);
    gemm_tile_acc<3>(acc, ona, RW, w2, RW, m0, n0, RW, smem);
#pragma unroll
    for (int mi = 0; mi < 3; ++mi) {
      const int row = m0 + wr * 48 + mi * 16 + fr;
#pragma unroll
      for (int ni = 0; ni < 4; ++ni) {
        const int col = n0 + wc * 64 + ni * 16 + fq * 4;
        const uint2 g = *(const uint2*)(gates + (size_t)row * 2048 + 1024 + col);
        const f32x4 mg = *(const f32x4*)(mtmp + (size_t)row * D + col);
        const float r0 = mg[0] + acc[mi][ni][0] * bf2f((unsigned short)(g.x & 0xffff));
        const float r1 = mg[1] + acc[mi][ni][1] * bf2f((unsigned short)(g.x >> 16));
        const float r2 = mg[2] + acc[mi][ni][2] * bf2f((unsigned short)(g.y & 0xffff));
        const float r3 = mg[3] + acc[mi][ni][3] * bf2f((unsigned short)(g.y >> 16));
        *(uint2*)(merged + (size_t)row * D + col) = make_uint2(pk2(r0, r1), pk2(r2, r3));
      }
    }
  }
}

DEV void phase_gemm_out(const Params& p, unsigned char* smem, int* slot) {
  EPI_COORDS;
  const bf16_t* A = (const bf16_t*)(p.ws + OFF_MERGED);
  const bf16_t* Bt = (const bf16_t*)(p.ws + OFF_WOUT);
  const float* mod = (const float*)(p.ws + OFF_MOD);
  for (;;) {
    const int tile = grab_tile(p, 10, slot);
    if (tile >= 64 * 8) break;
    const int tm = tile % 64, tn = tile / 64, m0 = tm * 96, n0 = tn * 128;
    f32x4 acc[3][4];
    zero_acc<3>(acc);
    gemm_tile_acc<3>(acc, A, D, Bt, D, m0, n0, D, smem);
#pragma unroll
    for (int mi = 0; mi < 3; ++mi) {
      const int row = m0 + wr * 48 + mi * 16 + fr;
      const float* xp = xrow(p, row);
      const float* g1 = mod + modidx(row) * 6144 + 2048;
#pragma unroll
      for (int ni = 0; ni < 4; ++ni) {
        const int col = n0 + wc * 64 + ni * 16 + fq * 4;
        const f32x4 x = *(const f32x4*)(xp + col);
        const f32x4 g = *(const f32x4*)(g1 + col);
        *(f32x4*)(p.out + (size_t)row * D + col) = x + g * acc[mi][ni];
      }
    }
  }
}

DEV void phase_gemm_ffn_up(const Params& p, unsigned char* smem, int* slot) {
  EPI_COORDS;
  const bf16_t* A = (const bf16_t*)(p.ws + OFF_H);
  const bf16_t* Bt = (const bf16_t*)(p.ws + OFF_W13);
  bf16_t* hid = (bf16_t*)(p.ws + OFF_HID);
  for (;;) {
    const int tile = grab_tile(p, 11, slot);
    if (tile >= 48 * 44) break;
    const int tm = tile % 48, tn = tile / 48, m0 = tm * 128, n0 = tn * 128;
    f32x4 acc[4][4];
    zero_acc<4>(acc);
    gemm_tile_acc<4>(acc, A, D, Bt, D, m0, n0, D, smem);
#pragma unroll
    for (int mi = 0; mi < 4; ++mi) {
      const int row = m0 + wr * 64 + mi * 16 + fr;
#pragma unroll
      for (int gp = 0; gp < 2; ++gp) {
        const int hcol = ((n0 + wc * 64) >> 1) + gp * 16 + fq * 4;
        const f32x4 a = acc[mi][2 * gp], b = acc[mi][2 * gp + 1];
        float r[4];
#pragma unroll
        for (int e = 0; e < 4; ++e) r[e] = a[e] * sigmoidf_(a[e]) * b[e];
        *(uint2*)(hid + (size_t)row * FF + hcol) = make_uint2(pk2(r[0], r[1]), pk2(r[2], r[3]));
      }
    }
  }
}

DEV void phase_gemm_ffn_down(const Params& p, unsigned char* smem, int* slot) {
  EPI_COORDS;
  const bf16_t* A = (const bf16_t*)(p.ws + OFF_HID);
  const bf16_t* Bt = (const bf16_t*)(p.ws + OFF_W2);
  const float* mod = (const float*)(p.ws + OFF_MOD);
  for (;;) {
    const int tile = grab_tile(p, 12, slot);
    if (tile >= 64 * 8) break;
    const int tm = tile % 64, tn = tile / 64, m0 = tm * 96, n0 = tn * 128;
    f32x4 acc[3][4];
    zero_acc<3>(acc);
    gemm_tile_acc<3>(acc, A, FF, Bt, FF, m0, n0, FF, smem);
#pragma unroll
    for (int mi = 0; mi < 3; ++mi) {
      const int row = m0 + wr * 48 + mi * 16 + fr;
      const float* g2 = mod + modidx(row) * 6144 + 5120;
#pragma unroll
      for (int ni = 0; ni < 4; ++ni) {
        const int col = n0 + wc * 64 + ni * 16 + fq * 4;
        float* op = p.out + (size_t)row * D + col;
        const f32x4 x = *(const f32x4*)op;
        const f32x4 g = *(const f32x4*)(g2 + col);
        *(f32x4*)op = x + g * acc[mi][ni];
      }
    }
  }
}

DEV void phase_qkprep(const Params& p, unsigned char* smem, int bid, int nb) {
  const int tid = threadIdx.x;
  bf16_t* Vs = (bf16_t*)smem;
  bf16_t* qb = (bf16_t*)(p.ws + OFF_QB);
  bf16_t* kb = (bf16_t*)(p.ws + OFF_KB);
  bf16_t* vT = (bf16_t*)(p.ws + OFF_VT);
  bf16_t* ckb = (bf16_t*)(p.ws + OFF_CKB);
  bf16_t* cvT = (bf16_t*)(p.ws + OFF_CVT);
  const float* una = (const float*)(p.ws + OFF_UNA);
  const int tok = tid >> 2, part = tid & 3;
  for (int item = bid; item < 832; item += nb) {
    if (item < 768) {
      const int tt = item >> 3, h = item & 7, t0 = tt * 64, t = t0 + tok;
      const float* src = una + (size_t)t * 1536 + h * 64 + part * 16;
      {
        float x[16]; float ss = 0.f;
#pragma unroll
        for (int i = 0; i < 4; ++i) { const float4 v = *(const float4*)(src + i * 4); x[4 * i] = v.x; x[4 * i + 1] = v.y; x[4 * i + 2] = v.z; x[4 * i + 3] = v.w; }
#pragma unroll
        for (int i = 0; i < 16; ++i) ss += x[i] * x[i];
        ss += __shfl_xor(ss, 1); ss += __shfl_xor(ss, 2);
        const float rs = rsqrtf(ss * (1.f / 64.f) + 1e-6f) * 0.125f;
        unsigned w[8];
#pragma unroll
        for (int i = 0; i < 8; ++i) w[i] = pk2(x[2 * i] * rs * p.in[23][part * 16 + 2 * i], x[2 * i + 1] * rs * p.in[23][part * 16 + 2 * i + 1]);
        uint4* dp = (uint4*)(qb + (size_t)t * 512 + h * 64 + part * 16);
        dp[0] = make_uint4(w[0], w[1], w[2], w[3]); dp[1] = make_uint4(w[4], w[5], w[6], w[7]);
      }
      {
        float x[16]; float ss = 0.f;
#pragma unroll
        for (int i = 0; i < 4; ++i) { const float4 v = *(const float4*)(src + 512 + i * 4); x[4 * i] = v.x; x[4 * i + 1] = v.y; x[4 * i + 2] = v.z; x[4 * i + 3] = v.w; }
#pragma unroll
        for (int i = 0; i < 16; ++i) ss += x[i] * x[i];
        ss += __shfl_xor(ss, 1); ss += __shfl_xor(ss, 2);
        const float rs = rsqrtf(ss * (1.f / 64.f) + 1e-6f);
#pragma unroll
        for (int i = 0; i < 16; ++i) x[i] = x[i] * rs * p.in[24][part * 16 + i];
        if (t < NCTX) {
          float4* op = (float4*)(p.out + OUT_K + (size_t)t * 512 + h * 64 + part * 16);
#pragma unroll
          for (int i = 0; i < 4; ++i) op[i] = make_float4(x[4 * i], x[4 * i + 1], x[4 * i + 2], x[4 * i + 3]);
        }
        unsigned w[8];
#pragma unroll
        for (int i = 0; i < 8; ++i) w[i] = pk2(x[2 * i], x[2 * i + 1]);
        uint4* dp = (uint4*)(kb + (size_t)t * 512 + h * 64 + part * 16);
        dp[0] = make_uint4(w[0], w[1], w[2], w[3]); dp[1] = make_uint4(w[4], w[5], w[6], w[7]);
      }
      {
        float x[16];
#pragma unroll
        for (int i = 0; i < 4; ++i) { const float4 v = *(const float4*)(src + 1024 + i * 4); x[4 * i] = v.x; x[4 * i + 1] = v.y; x[4 * i + 2] = v.z; x[4 * i + 3] = v.w; }
        if (t < NCTX) {
          float4* op = (float4*)(p.out + OUT_V + (size_t)t * 512 + h * 64 + part * 16);
#pragma unroll
          for (int i = 0; i < 4; ++i) op[i] = make_float4(x[4 * i], x[4 * i + 1], x[4 * i + 2], x[4 * i + 3]);
        }
#pragma unroll
        for (int i = 0; i < 16; ++i) Vs[tok * 72 + part * 16 + i] = f2bf(x[i]);
      }
      __syncthreads();
      {
        const int d = tid >> 2;
        unsigned w[8];
#pragma unroll
        for (int i = 0; i < 8; ++i) w[i] = (unsigned)Vs[(part * 16 + 2 * i) * 72 + d] | ((unsigned)Vs[(part * 16 + 2 * i + 1) * 72 + d] << 16);
        uint4* dp = (uint4*)(vT + (size_t)(h * 64 + d) * NTOK + t0 + part * 16);
        dp[0] = make_uint4(w[0], w[1], w[2], w[3]); dp[1] = make_uint4(w[4], w[5], w[6], w[7]);
      }
      __syncthreads();
    } else {
      const int ci = item - 768, b = ci >> 5, rem = ci & 31, tt = rem >> 3, h = rem & 7, t0 = tt * 64, t = t0 + tok;
      const size_t sidx = (size_t)(b * 256 + t) * 512 + h * 64 + part * 16;
      {
        float x[16];
#pragma unroll
        for (int i = 0; i < 4; ++i) { const float4 v = *(const float4*)(p.in[3] + sidx + i * 4); x[4 * i] = v.x; x[4 * i + 1] = v.y; x[4 * i + 2] = v.z; x[4 * i + 3] = v.w; }
        unsigned w[8];
#pragma unroll
        for (int i = 0; i < 8; ++i) w[i] = pk2(x[2 * i], x[2 * i + 1]);
        uint4* dp = (uint4*)(ckb + sidx);
        dp[0] = make_uint4(w[0], w[1], w[2], w[3]); dp[1] = make_uint4(w[4], w[5], w[6], w[7]);
      }
      {
        float x[16];
#pragma unroll
        for (int i = 0; i < 4; ++i) { const float4 v = *(const float4*)(p.in[4] + sidx + i * 4); x[4 * i] = v.x; x[4 * i + 1] = v.y; x[4 * i + 2] = v.z; x[4 * i + 3] = v.w; }
#pragma unroll
        for (int i = 0; i < 16; ++i) Vs[tok * 72 + part * 16 + i] = f2bf(x[i]);
      }
      __syncthreads();
      {
        const int d = tid >> 2;
        unsigned w[8];
#pragma unroll
        for (int i = 0; i < 8; ++i) w[i] = (unsigned)Vs[(part * 16 + 2 * i) * 72 + d] | ((unsigned)Vs[(part * 16 + 2 * i + 1) * 72 + d] << 16);
        uint4* dp = (uint4*)(cvT + (size_t)((b * 8 + h) * 64 + d) * 256 + t0 + part * 16);
        dp[0] = make_uint4(w[0], w[1], w[2], w[3]); dp[1] = make_uint4(w[4], w[5], w[6], w[7]);
      }
      __syncthreads();
    }
  }
}

DEV float* ops_arr(const Params& p, int i) { return (float*)(p.ws + OFF_OPS + (size_t)i * OPS_ARR); }

DEV f32x4 shiftvec(f32x4 cur, f32x4 hal, f32x4 mu0, f32x4 mu1, int fr) {
  f32x4 prev, next;
#pragma unroll
  for (int i = 0; i < 4; ++i) {
    prev[i] = dpp_mov<0x111>(cur[i]);
    next[i] = dpp_mov<0x101>(cur[i]);
  }
  if (fr == 0) prev = hal;
  if (fr == 15) next = hal;
  return cur + mu0 * (prev - cur) + mu1 * (next - cur);
}
DEV float quad_sum(float x) { x += __shfl_xor(x, 16); x += __shfl_xor(x, 32); return x; }
DEV f32x4 ld4(const float* p) { return *(const f32x4*)p; }

constexpr int LROWB = 392;
DEV void phase_rwprep(const Params& p, unsigned char* smem, int bid, int nb) {
  const int tid = threadIdx.x, lane = tid & 63, w = tid >> 6, fr = lane & 15, fq = lane >> 4;
  bf16_t* Lb = (bf16_t*)smem;
  const float* urw = (const float*)(p.ws + OFF_URW);
  const float* mu = p.in[12];
  bf16_t* bonus = (bf16_t*)(p.ws + OFF_BG);
  bf16_t* gate = (bf16_t*)(p.ws + OFF_BG + 6291456);
  const bf16_t* WUPT = (const bf16_t*)(p.ws + OFF_LORA);
  const bf16_t* AUPT = WUPT + 65536;
  const bf16_t* GUPT = WUPT + 131072;
  float* o_r = ops_arr(p, 0); float* o_v = ops_arr(p, 1); float* o_a = ops_arr(p, 2);
  for (int item = bid; item < 768; item += nb) {
    const int t0 = (item >> 1) * 16, h = (item & 1) * 4 + w;
    int s_lo, s_hi;
    if (t0 < NCTX) { s_lo = t0 & ~255; s_hi = s_lo + 256; } else { s_lo = NCTX + ((t0 - NCTX) & ~1023); s_hi = s_lo + 1024; }
#pragma unroll 8
    for (int e = tid; e < 6144; e += NTHR) {
      const int cc = e % 384, tl = e / 384, col = 1536 + cc, t = t0 + tl;
      const float* up = urw + (size_t)t * RWC + col;
      const float uc = up[0];
      const float upv = (t > s_lo) ? up[-RWC] : 0.f;
      const float unx = (t + 1 < s_hi) ? up[RWC] : 0.f;
      const float us = uc + mu[col] * (upv - uc) + mu[RWC + col] * (unx - uc);
      const int kind = cc >> 7;
      const float val = kind == 0 ? tanhf(us) : (kind == 1 ? us : sigmoidf_(us));
      Lb[tl * LROWB + cc] = f2bf(val);
    }
    __syncthreads();
    const int t = t0 + fr;
    const bool lo_ok = (fr == 0) && (t > s_lo), hi_ok = (fr == 15) && (t + 1 < s_hi);
    const float* urow = urw + (size_t)t * RWC;
    const float* hrow = lo_ok ? urow - RWC : (hi_ok ? urow + RWC : urow);
    const bool hal_ok = lo_ok || hi_ok;
    const f32x4 z4 = (f32x4){0.f, 0.f, 0.f, 0.f};
    float ss = 0.f;
#pragma unroll
    for (int ni = 0; ni < 4; ++ni) {
      const int c = h * 64 + ni * 16 + fq * 4;
      const f32x4 kx = shiftvec(ld4(urow + 512 + c), hal_ok ? ld4(hrow + 512 + c) : z4, ld4(mu + 512 + c), ld4(mu + RWC + 512 + c), fr) * ld4(p.in[18] + c);
      ss += kx[0] * kx[0] + kx[1] * kx[1] + kx[2] * kx[2] + kx[3] * kx[3];
    }
    ss = quad_sum(ss);
    const float rn = rsqrtf(ss + 1e-12f);
    float bs = 0.f;
#pragma unroll 1
    for (int ni = 0; ni < 4; ++ni) {
      const int c = h * 64 + ni * 16 + fq * 4;
      const size_t o = (size_t)t * 512 + c;
      const f32x4 r4 = shiftvec(ld4(urow + c), hal_ok ? ld4(hrow + c) : z4, ld4(mu + c), ld4(mu + RWC + c), fr);
      const f32x4 k4 = shiftvec(ld4(urow + 512 + c), hal_ok ? ld4(hrow + 512 + c) : z4, ld4(mu + 512 + c), ld4(mu + RWC + 512 + c), fr);
      const f32x4 v4 = shiftvec(ld4(urow + 1024 + c), hal_ok ? ld4(hrow + 1024 + c) : z4, ld4(mu + 1024 + c), ld4(mu + RWC + 1024 + c), fr);
      const f32x4 kk4 = k4 * ld4(p.in[18] + c) * rn;
      *(f32x4*)(o_r + o) = r4; *(f32x4*)(o_v + o) = v4; *(f32x4*)(o_a + o) = -kk4;
      const f32x4 ka = ld4(p.in[19] + c);
      f32x4 bacc = z4;
#pragma unroll
      for (int e = 0; e < 2; ++e) {
        float* o_k = ops_arr(p, 5 + e); float* o_b = ops_arr(p, 7 + e); float* o_w = ops_arr(p, 3 + e);
        f32x4 acc = z4, acw = z4;
#pragma unroll
        for (int ks = 0; ks < 2; ++ks) {
          const bf16x8 wa = *(const bf16x8*)(AUPT + (size_t)(e * 512 + h * 64 + ni * 16 + fr) * 64 + ks * 32 + fq * 8);
          const bf16x8 la = *(const bf16x8*)(Lb + fr * LROWB + 128 + e * 64 + ks * 32 + fq * 8);
          acc = __builtin_amdgcn_mfma_f32_16x16x32_bf16(wa, la, acc, 0, 0, 0);
          const bf16x8 ww = *(const bf16x8*)(WUPT + (size_t)(e * 512 + h * 64 + ni * 16 + fr) * 64 + ks * 32 + fq * 8);
          const bf16x8 lw = *(const bf16x8*)(Lb + fr * LROWB + e * 64 + ks * 32 + fq * 8);
          acw = __builtin_amdgcn_mfma_f32_16x16x32_bf16(ww, lw, acw, 0, 0, 0);
        }
        const f32x4 a0 = ld4(p.in[15] + e * 512 + c), w0 = ld4(p.in[13] + e * 512 + c);
        f32x4 kd, bb, dec;
#pragma unroll
        for (int i = 0; i < 4; ++i) {
          const float ic = sigmoidf_(a0[i] + acc[i]);
          kd[i] = k4[i] * (1.f + (ic - 1.f) * ka[i]);
          bb[i] = kk4[i] * ic;
          const float z = w0[i] + acw[i];
          const float sp = fmaxf(-z, 0.f) + log1pf(__expf(-fabsf(z)));
          dec[i] = __expf(-__expf(-sp - 0.5f));
        }
        bacc += kd;
        *(f32x4*)(o_k + o) = kd; *(f32x4*)(o_b + o) = bb; *(f32x4*)(o_w + o) = dec;
      }
      const f32x4 rk = ld4(p.in[20] + c);
#pragma unroll
      for (int i = 0; i < 4; ++i) bs += r4[i] * 0.5f * bacc[i] * rk[i];
      f32x4 acc = z4;
#pragma unroll
      for (int ks = 0; ks < 4; ++ks) {
        const bf16x8 wg = *(const bf16x8*)(GUPT + (size_t)(h * 64 + ni * 16 + fr) * 128 + ks * 32 + fq * 8);
        const bf16x8 lg = *(const bf16x8*)(Lb + fr * LROWB + 256 + ks * 32 + fq * 8);
        acc = __builtin_amdgcn_mfma_f32_16x16x32_bf16(wg, lg, acc, 0, 0, 0);
      }
      *(uint2*)(gate + o) = make_uint2(pk2(acc[0], acc[1]), pk2(acc[2], acc[3]));
    }
    bs = quad_sum(bs);
#pragma unroll
    for (int ni = 0; ni < 4; ++ni) {
      const size_t o = (size_t)t * 512 + h * 64 + ni * 16 + fq * 4;
      const f32x4 v4 = *(const f32x4*)(o_v + o);
      *(uint2*)(bonus + o) = make_uint2(pk2(bs * v4[0], bs * v4[1]), pk2(bs * v4[2], bs * v4[3]));
    }
    __syncthreads();
  }
}

constexpr int TC = 16;
typedef float f32x2 __attribute__((ext_vector_type(2)));
template <int EPL, int R, int PD>
DEV void scan_item(const Params& p, unsigned char* smem, int seq, int h, int dir, int rg) {
  constexpr int LPR = 64 / EPL, RPW = 64 / LPR, RPB = 4 * RPW * R, NV = RPB / 16, NP = EPL / 2;
  constexpr int STG = 20480 + 16 * RPB * 4, YOFF = 2 * STG, YSZ = 16 * RPB * 4;
  const int tid = threadIdx.x, lane = tid & 63, w = tid >> 6, riw = lane / LPR, kq = lane % LPR;
  const int T = seq < 16 ? 256 : 1024;
  const int tok0 = seq < 16 ? seq * 256 : NCTX + (seq - 16) * 1024;
  const int vrow_l = (w * RPW + riw) * R;
  const int vrow = rg * RPB + vrow_l;
  f32x2 S[R][NP];
#pragma unroll
  for (int rr = 0; rr < R; ++rr) {
    if (seq >= 16) {
      const float* sp = p.in[2] + ((size_t)(((seq - 16) * 2 + dir) * 8 + h) * 64 + vrow + rr) * 64 + kq * EPL;
#pragma unroll
      for (int i = 0; i < NP; ++i) S[rr][i] = *(const f32x2*)(sp + 2 * i);
    } else {
#pragma unroll
      for (int i = 0; i < NP; ++i) S[rr][i] = (f32x2){0.f, 0.f};
    }
  }
  const int lstep = tid >> 4, l16 = tid & 15;
  const float* pr = ops_arr(p, 0) + h * 64 + l16 * 4;
  const float* pw = ops_arr(p, 3 + dir) + h * 64 + l16 * 4;
  const float* pk = ops_arr(p, 5 + dir) + h * 64 + l16 * 4;
  const float* pa = ops_arr(p, 2) + h * 64 + l16 * 4;
  const float* pb = ops_arr(p, 7 + dir) + h * 64 + l16 * 4;
  const float* pv = ops_arr(p, 1) + h * 64 + rg * RPB + l16;
  float* yout = (float*)(p.ws + (dir ? OFF_YB : OFF_YF)) + h * 64 + rg * RPB + l16;
  const int nc = T / TC;
  float4 g_r, g_w, g_k, g_a, g_b; float rv[NV];
#define gload(c) do { const int ts_ = (c) * TC + lstep; const size_t t_ = (size_t)(tok0 + (dir ? T - 1 - ts_ : ts_)) * 512; \
    g_r = *(const float4*)(pr + t_); g_w = *(const float4*)(pw + t_); g_k = *(const float4*)(pk + t_); \
    g_a = *(const float4*)(pa + t_); g_b = *(const float4*)(pb + t_); \
    _Pragma("unroll") for (int q_ = 0; q_ < NV; ++q_) rv[q_] = pv[t_ + 16 * q_]; } while (0)
#define ywrite(c) do { const float* yb_ = (const float*)(smem + YOFF + ((c) & 1) * YSZ); const int ts_ = (c) * TC + lstep; \
    const size_t t_ = (size_t)(tok0 + (dir ? T - 1 - ts_ : ts_)) * 512; \
    _Pragma("unroll") for (int q_ = 0; q_ < NV; ++q_) yout[t_ + 16 * q_] = yb_[lstep * RPB + l16 + 16 * q_]; } while (0)
  gload(0);
  for (int c = 0; c < nc; ++c) {
    unsigned char* st = smem + (c & 1) * STG;
    *(float4*)(st + 0 * 4096 + lstep * 256 + l16 * 16) = g_r;
    *(float4*)(st + 1 * 4096 + lstep * 256 + l16 * 16) = g_w;
    *(float4*)(st + 2 * 4096 + lstep * 256 + l16 * 16) = g_k;
    *(float4*)(st + 3 * 4096 + lstep * 256 + l16 * 16) = g_a;
    *(float4*)(st + 4 * 4096 + lstep * 256 + l16 * 16) = g_b;
#pragma unroll
    for (int q = 0; q < NV; ++q) *(float*)(st + 20480 + (lstep * RPB + l16 + 16 * q) * 4) = rv[q];
    __syncthreads();
    if (c > 0) ywrite(c - 1);
    if (c + 1 < nc) gload(c + 1);
    float* ybw = (float*)(smem + YOFF + (c & 1) * YSZ);
    constexpr int NS = PD + 1;
    f32x2 o_r[NS][NP], o_w[NS][NP], o_k[NS][NP], o_a[NS][NP], o_b[NS][NP]; float o_v[NS][R];
    float ykeep[R][TC / LPR];
#define LDOPS(bi, s_) do { \
      _Pragma("unroll") for (int i_ = 0; i_ < NP; ++i_) { \
        o_r[bi][i_] = *(const f32x2*)(st + 0 * 4096 + (s_) * 256 + kq * EPL * 4 + i_ * 8); \
        o_w[bi][i_] = *(const f32x2*)(st + 1 * 4096 + (s_) * 256 + kq * EPL * 4 + i_ * 8); \
        o_k[bi][i_] = *(const f32x2*)(st + 2 * 4096 + (s_) * 256 + kq * EPL * 4 + i_ * 8); \
        o_a[bi][i_] = *(const f32x2*)(st + 3 * 4096 + (s_) * 256 + kq * EPL * 4 + i_ * 8); \
        o_b[bi][i_] = *(const f32x2*)(st + 4 * 4096 + (s_) * 256 + kq * EPL * 4 + i_ * 8); } \
      _Pragma("unroll") for (int rr_ = 0; rr_ < R; ++rr_) o_v[bi][rr_] = *(const float*)(st + 20480 + ((s_) * RPB + vrow_l + rr_) * 4); } while (0)
#pragma unroll
    for (int s = 0; s < PD; ++s) LDOPS(s, s);
#pragma unroll
    for (int s = 0; s < TC; ++s) {
      const int bi = s % NS;
      if (s + PD < TC) LDOPS((s + PD) % NS, s + PD);
#pragma unroll
      for (int rr = 0; rr < R; ++rr) {
        const f32x2 vv2 = (f32x2){o_v[bi][rr], o_v[bi][rr]};
        f32x2 pa2 = S[rr][0] * o_a[bi][0];
        f32x2 tt[NP];
        tt[0] = S[rr][0] * o_w[bi][0] + vv2 * o_k[bi][0];
#pragma unroll
        for (int i = 1; i < NP; ++i) { pa2 += S[rr][i] * o_a[bi][i]; tt[i] = S[rr][i] * o_w[bi][i] + vv2 * o_k[bi][i]; }
        float sa = pa2[0] + pa2[1];
        sa += dpp_mov<0xB1>(sa); sa += dpp_mov<0x4E>(sa); sa += dpp_mov<0x141>(sa);
        if (LPR == 16) sa += dpp_mov<0x140>(sa);
        const f32x2 sa2 = (f32x2){sa, sa};
        f32x2 py = (f32x2){0.f, 0.f};
#pragma unroll
        for (int i = 0; i < NP; ++i) { S[rr][i] = sa2 * o_b[bi][i] + tt[i]; py += S[rr][i] * o_r[bi][i]; }
        float y = py[0] + py[1];
        y += dpp_mov<0xB1>(y); y += dpp_mov<0x4E>(y); y += dpp_mov<0x141>(y);
        if (LPR == 16) y += dpp_mov<0x140>(y);
        if ((s % LPR) == 0) ykeep[rr][s / LPR] = y; else ykeep[rr][s / LPR] = (kq == (s % LPR)) ? y : ykeep[rr][s / LPR];
      }
    }
#undef LDOPS
#pragma unroll
    for (int rr = 0; rr < R; ++rr)
#pragma unroll
      for (int q = 0; q < TC / LPR; ++q) ybw[(q * LPR + kq) * RPB + vrow_l + rr] = ykeep[rr][q];
  }
  __syncthreads();
  ywrite(nc - 1);
  if (seq < 16) {
#pragma unroll
    for (int rr = 0; rr < R; ++rr) {
      float* so = p.out + OUT_STATE + ((size_t)((seq * 2 + dir) * 8 + h) * 64 + vrow + rr) * 64 + kq * EPL;
#pragma unroll
      for (int i = 0; i < NP; ++i) *(f32x2*)(so + 2 * i) = S[rr][i];
    }
  }
  __syncthreads();
#undef gload
#undef ywrite
}

DEV void attn_wave_item(const Params& p, int witem) {
  const int lane = threadIdx.x & 63, fr = lane & 15, fq = lane >> 4;
  const bf16_t* qb = (const bf16_t*)(p.ws + OFF_QB);
  const bf16_t* kb = (const bf16_t*)(p.ws + OFF_KB);
  const bf16_t* vT = (const bf16_t*)(p.ws + OFF_VT);
  const bf16_t* ckb = (const bf16_t*)(p.ws + OFF_CKB);
  const bf16_t* cvT = (const bf16_t*)(p.ws + OFF_CVT);
  bf16_t* ona = (bf16_t*)(p.ws + OFF_ONA);
  int h, tq0, nsub;
  bool latent;
  int b = 0, r = 0, jb = 0, row_start = 0, band = 0, seq = 0;
  {
    const int bi = witem >> 2, wv = witem & 3;
    if (bi < 256) {
      latent = true;
      b = bi >> 7; const int rem = bi & 127; r = rem >> 3; h = rem & 7; jb = wv;
      tq0 = NCTX + b * 1024 + r * 64 + jb * 16;
      row_start = min(max(r - 4, 0), 8); band = min(max(jb * 16 - 8, 0), 32);
      nsub = 4;
    } else {
      latent = false;
      const int c2 = bi - 256; seq = c2 >> 5; const int rem = c2 & 31; h = rem >> 2; const int qg = rem & 3;
      tq0 = seq * 256 + (qg * 4 + wv) * 16; nsub = 2;
    }
  }
  const bf16_t* qp = qb + (size_t)(tq0 + fr) * 512 + h * 64 + fq * 8;
  const bf16x8 qf0 = *(const bf16x8*)qp, qf1 = *(const bf16x8*)(qp + 32);
  float m = -INFINITY, l = 0.f;
  f32x4 O[4];
#pragma unroll
  for (int i = 0; i < 4; ++i) O[i] = (f32x4){0.f, 0.f, 0.f, 0.f};
#define SUBDESC(sc_, kbase_, vbase_, KS_, ldv_, win_) do { const int half_ = (sc_) & 1; win_ = latent && (sc_) < 2; \
    if (win_) { const int tb_ = NCTX + b * 1024 + (row_start + half_ * 4) * 64 + band; \
      kbase_ = kb + (size_t)tb_ * 512 + h * 64; vbase_ = vT + (size_t)(h * 64) * NTOK + tb_; KS_ = 64; ldv_ = NTOK; } \
    else if (latent) { kbase_ = ckb + (size_t)(b * 256 + half_ * 128) * 512 + h * 64; vbase_ = cvT + (size_t)((b * 8 + h) * 64) * 256 + half_ * 128; KS_ = 32; ldv_ = 256; } \
    else { const int tb_ = seq * 256 + half_ * 128; kbase_ = kb + (size_t)tb_ * 512 + h * 64; vbase_ = vT + (size_t)(h * 64) * NTOK + tb_; KS_ = 32; ldv_ = NTOK; } } while (0)
#define KLOAD(kbase_, KS_) do { _Pragma("unroll") for (int i_ = 0; i_ < 8; ++i_) { \
      const bf16_t* kp_ = kbase_ + (size_t)((i_ >> 1) * KS_ + (fr >> 2) * 8 + (i_ & 1) * 4 + (fr & 3)) * 512 + fq * 8; \
      kf[2 * i_] = *(const bf16x8*)kp_; kf[2 * i_ + 1] = *(const bf16x8*)(kp_ + 32); } } while (0)
  bf16x8 kf[16];
#pragma unroll 1
  for (int sc = 0; sc < nsub; ++sc) {
    const int half = sc & 1;
    const bf16_t* kbase; const bf16_t* vbase; int KS, ldv; bool win;
    SUBDESC(sc, kbase, vbase, KS, ldv, win);
    KLOAD(kbase, KS);
    bf16x8 vf[4][4];
#pragma unroll
    for (int s = 0; s < 4; ++s)
#pragma unroll
      for (int dt = 0; dt < 4; ++dt) {
        vf[s][dt] = *(const bf16x8*)(vbase + (size_t)(dt * 16 + fr) * ldv + s * KS + fq * 8);
      }
    f32x4 st[8];
#pragma unroll
    for (int i = 0; i < 8; ++i) {
      f32x4 z = (f32x4){0.f, 0.f, 0.f, 0.f};
      z = __builtin_amdgcn_mfma_f32_16x16x32_bf16(kf[2 * i], qf0, z, 0, 0, 0);
      st[i] = __builtin_amdgcn_mfma_f32_16x16x32_bf16(kf[2 * i + 1], qf1, z, 0, 0, 0);
    }
    const bool cwin = win;
    if (cwin) {
      const int q_col = jb * 16 + fr;
      const int win_start = min(max(q_col - 8, 0), 48);
      const float* rpb = p.in[25] + h * 465;
#pragma unroll
      for (int i = 0; i < 8; ++i) {
        const int dr = row_start + half * 4 + (i >> 1) - r + 7;
#pragma unroll
        for (int e = 0; e < 4; ++e) {
          const int k_col = band + fq * 8 + (i & 1) * 4 + e;
          const bool valid = (k_col >= win_start) && (k_col < win_start + 16);
          const int dc = min(max(k_col - q_col, -15), 15) + 15;
          st[i][e] = valid ? st[i][e] + rpb[dr * 31 + dc] : -1e30f;
        }
      }
    }
    float cmax = -1e30f;
#pragma unroll
    for (int i = 0; i < 8; ++i)
#pragma unroll
      for (int e = 0; e < 4; ++e) cmax = fmaxf(cmax, st[i][e]);
    cmax = fmaxf(cmax, __shfl_xor(cmax, 16)); cmax = fmaxf(cmax, __shfl_xor(cmax, 32));
    const float mnew = fmaxf(m, cmax);
    const float alpha = __expf(m - mnew);
    float psum = 0.f;
#pragma unroll
    for (int i = 0; i < 8; ++i)
#pragma unroll
      for (int e = 0; e < 4; ++e) { const float pv = __expf(st[i][e] - mnew); st[i][e] = pv; psum += pv; }
    psum += __shfl_xor(psum, 16); psum += __shfl_xor(psum, 32);
    l = l * alpha + psum;
#pragma unroll
    for (int i = 0; i < 4; ++i) O[i] = O[i] * alpha;
    m = mnew;
#pragma unroll
    for (int s = 0; s < 4; ++s) {
      union { bf16x8 v; unsigned u[4]; } pb;
      pb.u[0] = pk2(st[2 * s][0], st[2 * s][1]); pb.u[1] = pk2(st[2 * s][2], st[2 * s][3]);
      pb.u[2] = pk2(st[2 * s + 1][0], st[2 * s + 1][1]); pb.u[3] = pk2(st[2 * s + 1][2], st[2 * s + 1][3]);
#pragma unroll
      for (int dt = 0; dt < 4; ++dt) {
        O[dt] = __builtin_amdgcn_mfma_f32_16x16x32_bf16(vf[s][dt], pb.v, O[dt], 0, 0, 0);
      }
    }
  }
#undef SUBDESC
#undef KLOAD
  const float inv = 1.f / l;
#pragma unroll
  for (int dt = 0; dt < 4; ++dt) {
    bf16_t* op = ona + (size_t)(tq0 + fr) * 512 + h * 64 + dt * 16 + fq * 4;
    *(uint2*)op = make_uint2(pk2(O[dt][0] * inv, O[dt][1] * inv), pk2(O[dt][2] * inv, O[dt][3] * inv));
  }
}

constexpr int N_SCAN_ITEMS = 128 + 256, N_ATTN_BLK = 768;
DEV void phase_scan_attn(const Params& p, unsigned char* smem, int* s_item, int rep) {
  unsigned* counter = (unsigned*)(p.ws + OFF_CTL) + rep;
  for (;;) {
    if (threadIdx.x == 0) *s_item = (int)atomicAdd(counter, 1u);
    __syncthreads();
    const int item = *s_item;
    __syncthreads();
    if (item >= N_SCAN_ITEMS + N_ATTN_BLK) break;
    if (item < 128) { const int rem = item & 63; scan_item<4, 1, 3>(p, smem, 16 + (item >> 6), rem >> 3, (rem >> 2) & 1, rem & 3); }
    else if (item < 128 + N_ATTN_BLK) attn_wave_item(p, (item - 128) * 4 + (threadIdx.x >> 6));
    else { const int i2 = item - 128 - N_ATTN_BLK, rem = i2 & 15; scan_item<4, 4, 1>(p, smem, i2 >> 4, rem >> 1, rem & 1, 0); }
  }
}

DEV void phase_finalize_rw(const Params& p, int bid, int nb) {
  const int lane = threadIdx.x & 63, gw = bid * 4 + (threadIdx.x >> 6), nw = nb * 4;
  const float* yf = (const float*)(p.ws + OFF_YF);
  const float* yb = (const float*)(p.ws + OFF_YB);
  const bf16_t* bonus = (const bf16_t*)(p.ws + OFF_BG);
  const bf16_t* gate = (const bf16_t*)(p.ws + OFF_BG + 6291456);
  bf16_t* orw = (bf16_t*)(p.ws + OFF_ORW);
  for (int it = gw; it < NTOK * 8; it += nw) {
    const size_t o = (size_t)it * 64 + lane;
    const int c = (it & 7) * 64 + lane;
    const float y = yf[o] + yb[o];
    const float mean = wave_sum(y) * (1.f / 64.f);
    const float d = y - mean;
    const float var = wave_sum(d * d) * (1.f / 64.f);
    const float yn = d * rsqrtf(var + 64e-5f) * p.in[21][c] + p.in[22][c];
    orw[o] = f2bf((yn + bf2f(bonus[o])) * bf2f(gate[o]));
  }
}

#define XB_TMO      128
#define XB_XCNT(j)  (256  + 64 * (j))
#define XB_XSUB(j)  (1280 + 64 * (j))
#define XB_XGEN(j)  (2304 + 64 * (j))
#define XB_TOP      3328
#define XB_TOPGEN   3392
#define XCD_BAR_WORDS 3456
#define XB_SPIN_CAP (1u << 18)
#define LAS __attribute__((address_space(3)))
DEV unsigned xb_ld(unsigned* p)              { return __hip_atomic_load(p, __ATOMIC_RELAXED, __HIP_MEMORY_SCOPE_AGENT); }
DEV unsigned xb_add(unsigned* p, unsigned v) { return __hip_atomic_fetch_add(p, v, __ATOMIC_RELAXED, __HIP_MEMORY_SCOPE_AGENT); }
DEV unsigned xb_xcc_id() { return (unsigned)__builtin_amdgcn_s_getreg((3 << 11) | 20) & 0xFu; }
#define XB_SPIN(cond, bar) do { unsigned _sp = 0; while (cond) { __builtin_amdgcn_s_sleep(1); \
    if ((++_sp & 255u) == 0u) { if (xb_ld(&(bar)[XB_TMO])) break; if (_sp > XB_SPIN_CAP) { atomicAdd(&(bar)[XB_TMO], 1u); break; } } } } while (0)
struct XcdBarrier { unsigned* bar; unsigned x; volatile LAS unsigned* st; };
DEV XcdBarrier xcd_barrier_post(unsigned* bar, volatile LAS unsigned* st) {
  XcdBarrier b; b.bar = bar; b.x = xb_xcc_id(); b.st = st;
  if (threadIdx.x == 0) (void)xb_add(&bar[XB_XCNT(b.x)], 1u);
  return b;
}
DEV void xcd_barrier_complete(unsigned* bar, unsigned x, unsigned& nloc, unsigned& nx) {
  const unsigned G = gridDim.x * gridDim.y * gridDim.z;
  unsigned sum, cnt, mine, sp = 0u;
  for (;;) {
    sum = 0u; cnt = 0u; mine = 0u;
#pragma unroll
    for (unsigned j = 0; j < 16; ++j) { const unsigned c = xb_ld(&bar[XB_XCNT(j)]); sum += c; cnt += (c > 0u) ? 1u : 0u; mine = (j == x) ? c : mine; }
    if (sum == G) break;
    __builtin_amdgcn_s_sleep(1);
    if ((++sp & 255u) == 0u) { if (xb_ld(&bar[XB_TMO])) break; if (sp > XB_SPIN_CAP) { atomicAdd(&bar[XB_TMO], 1u); break; } }
  }
  nloc = mine > 0u ? mine : 1u; nx = cnt > 0u ? cnt : 1u;
}
DEV void xcd_barrier(const XcdBarrier& b) {
  asm volatile("s_waitcnt vmcnt(0)" ::: "memory");
  __syncthreads();
  if (threadIdx.x == 0) {
    unsigned* bar = b.bar;
    __builtin_amdgcn_s_waitcnt(0);
    unsigned nloc = b.st[0], nx = b.st[1];
    if (nloc == 0u) { xcd_barrier_complete(bar, b.x, nloc, nx); b.st[0] = nloc; b.st[1] = nx; }
    const unsigned old = xb_add(&bar[XB_XSUB(b.x)], 1u);
    const unsigned gen = old / nloc;
    if (old + 1u == (gen + 1u) * nloc) {
      __builtin_amdgcn_fence(__ATOMIC_RELEASE, "agent");
      asm volatile("s_waitcnt vmcnt(0)" ::: "memory");
      const unsigned og = xb_add(&bar[XB_TOP], 1u);
      const unsigned tg = og / nx;
      if (og + 1u == (tg + 1u) * nx) xb_add(&bar[XB_TOPGEN], 1u);
      else XB_SPIN(xb_ld(&bar[XB_TOPGEN]) == tg, bar);
      __builtin_amdgcn_fence(__ATOMIC_ACQUIRE, "agent");
      xb_add(&bar[XB_XGEN(b.x)], 1u);
      asm volatile("s_waitcnt vmcnt(0)" ::: "memory");
    } else {
      XB_SPIN(xb_ld(&bar[XB_XGEN(b.x)]) == gen, bar);
      __builtin_amdgcn_fence(__ATOMIC_ACQUIRE, "agent");
      asm volatile("s_waitcnt vmcnt(0)" ::: "memory");
    }
  }
  __syncthreads();
}

__global__ void __launch_bounds__(NTHR, 2) fwd_megakernel(Params p) {
  extern __shared__ __attribute__((aligned(16))) unsigned char smem[];
  __shared__ __attribute__((aligned(16))) unsigned sh_ctl[8];
  cg::grid_group grid = cg::this_grid();
  const int bid = blockIdx.x, nb = gridDim.x;
  if (threadIdx.x < 8) sh_ctl[threadIdx.x] = 0u;
  __syncthreads();
  const XcdBarrier xb = xcd_barrier_post((unsigned*)(p.ws + OFF_CTL), (volatile LAS unsigned*)sh_ctl);
  int* s_item_p = (int*)&sh_ctl[4];
  if (p.ph_hi > 1000) grid.sync();
#define GSYNC() xcd_barrier(xb)
#ifndef DUP
#define DUP -1
#endif
#define PH(n, body) if (p.ph_lo <= n && n < p.ph_hi) { { const int rep = 0; (void)rep; body; } if (DUP == n) { GSYNC(); const int rep = 1; (void)rep; body; } if (n + 1 < p.ph_hi) GSYNC(); }
  PH(0, phase0(p, smem, bid, nb, rep))
  PH(1, phase_normmod<0>(p, bid, nb))
  PH(2, reset_tiles(s_item_p); phase_gemm_in(p, smem, s_item_p))
  PH(3, phase_qkprep(p, smem, bid, nb); phase_rwprep(p, smem, bid, nb))
  PH(4, phase_scan_attn(p, smem, s_item_p, rep))
  PH(5, phase_finalize_rw(p, bid, nb))
  PH(6, reset_tiles(s_item_p); phase_gemm_merge(p, smem, s_item_p))
  PH(7, reset_tiles(s_item_p); phase_gemm_out(p, smem, s_item_p))
  PH(8, phase_normmod<1>(p, bid, nb))
  PH(9, reset_tiles(s_item_p); phase_gemm_ffn_up(p, smem, s_item_p))
  PH(10, reset_tiles(s_item_p); phase_gemm_ffn_down(p, smem, s_item_p))
}

extern "C" void kernel_launch(void* const* d_in, const int* in_sizes, int n_in, void* d_out, int out_size, void* d_ws, size_t ws_size,
                              hipStream_t stream) {
  static int grid_blocks = 0;
  if (grid_blocks == 0) {
    if (n_in != 32 || ws_size < WS_END) { fprintf(stderr, "kernel_launch: unexpected n_in %d / ws_size %zu (need %zu)\n", n_in, ws_size, (size_t)WS_END); grid_blocks = -1; return; }
    int dev = 0, cus = 0, per_cu = 0;
    hipGetDevice(&dev);
    hipDeviceGetAttribute(&cus, hipDeviceAttributeMultiprocessorCount, dev);
    if (hipFuncSetAttribute((const void*)fwd_megakernel, hipFuncAttributeMaxDynamicSharedMemorySize, LDS_BYTES) != hipSuccess) { fprintf(stderr, "hipFuncSetAttribute failed\n"); grid_blocks = -1; return; }
    if (hipOccupancyMaxActiveBlocksPerMultiprocessor(&per_cu, (const void*)fwd_megakernel, NTHR, LDS_BYTES) != hipSuccess || per_cu < 1) { fprintf(stderr, "occupancy query failed (%d)\n", per_cu); grid_blocks = -1; return; }
    if (per_cu > 2) per_cu = 2;
    grid_blocks = cus * per_cu;
    fprintf(stderr, "kernel_launch: cus %d per_cu %d grid %d\n", cus, per_cu, grid_blocks);
  }
  if (grid_blocks < 0) return;
  hipMemsetAsync((char*)d_ws + OFF_CTL, 0, CTL_ZERO_BYTES, stream);
  Params p{};
  for (int i = 0; i < 32; ++i) p.in[i] = (const float*)d_in[i];
  p.out = (float*)d_out; p.ws = (unsigned char*)d_ws; p.ph_lo = 0; p.ph_hi = 11;
  void* args[] = {&p};
  hipError_t e = hipLaunchCooperativeKernel((const void*)fwd_megakernel, dim3(grid_blocks), dim3(NTHR), args, LDS_BYTES, stream);
  if (e != hipSuccess) fprintf(stderr, "cooperative launch failed: %s (grid %d)\n", hipGetErrorString(e), grid_blocks);
}
```

```cpp
#include <hip/hip_runtime.h>
#include <hip/hip_cooperative_groups.h>
#include <cstdio>
#include <cstdint>
namespace cg = cooperative_groups;

#define DEV __device__ __forceinline__
typedef unsigned short bf16_t;
typedef short bf16x8 __attribute__((ext_vector_type(8)));
typedef short bf16x4 __attribute__((ext_vector_type(4)));
typedef float f32x4 __attribute__((ext_vector_type(4)));

constexpr int D = 1024, NTOK = 6144, NCTX = 4096, RW = 512, FF = 2816, INC = 5504, RWC = 1920;
constexpr int NTHR = 256;
constexpr int LDS_BYTES = 65536;

constexpr size_t OFF_CTL = 0;
constexpr size_t OFF_MOD = 16384;
constexpr size_t CTL_ZERO_BYTES = 16384 + 3 * 6144 * 4;
constexpr size_t OFF_WIN = 90112;
constexpr size_t OFF_WORW = OFF_WIN + 11272192;
constexpr size_t OFF_WONA = OFF_WORW + 1048576;
constexpr size_t OFF_WOUT = OFF_WONA + 1048576;
constexpr size_t OFF_W13 = OFF_WOUT + 2097152;
constexpr size_t OFF_W2 = OFF_W13 + 11534336;
constexpr size_t OFF_H = OFF_W2 + 5767168;
constexpr size_t OFF_URW = OFF_H + 12582912;
constexpr size_t OFF_UNA = OFF_URW + 47185920;
constexpr size_t OFF_OPS = OFF_UNA + 37748736;
constexpr size_t OPS_ARR = 12582912;
constexpr size_t OFF_BG = OFF_OPS + 9 * OPS_ARR;
constexpr size_t OFF_VT = OFF_BG + 12582912;
constexpr size_t OFF_CKB = OFF_VT + 6291456;
constexpr size_t OFF_CVT = OFF_CKB + 524288;
constexpr size_t OFF_LORA = OFF_CVT + 524288;
constexpr size_t WS_END = OFF_LORA + 393216;
constexpr size_t OFF_QB = OFF_H, OFF_KB = OFF_H + 6291456;
constexpr size_t OFF_YF = OFF_URW, OFF_YB = OFF_URW + 12582912;
constexpr size_t OFF_ORW = OFF_UNA, OFF_ONA = OFF_UNA + 6291456;
constexpr size_t OFF_MERGED = OFF_OPS;
constexpr size_t OFF_HID = OFF_URW;
constexpr size_t OUT_STATE = 6291456, OUT_K = 7340032, OUT_V = 9437184;

struct Params {
  const float* in[32];
  float* out;
  unsigned char* ws;
  int ph_lo, ph_hi;
};

DEV unsigned short f2bf(float f) { unsigned u = __float_as_uint(f); u += 0x7fffu + ((u >> 16) & 1u); return (unsigned short)(u >> 16); }
DEV unsigned pk2(float lo, float hi) { return (unsigned)f2bf(lo) | ((unsigned)f2bf(hi) << 16); }
DEV float bf2f(unsigned short b) { return __uint_as_float(((unsigned)b) << 16); }
DEV float sigmoidf_(float x) { return 1.f / (1.f + __expf(-x)); }
DEV float wave_sum(float x) {
#pragma unroll
  for (int o = 32; o > 0; o >>= 1) x += __shfl_xor(x, o);
  return x;
}
template <int CTRL> DEV float dpp_mov(float x) { return __int_as_float(__builtin_amdgcn_update_dpp(0, __float_as_int(x), CTRL, 0xf, 0xf, true)); }
DEV float row16_sum(float x) {
  x += dpp_mov<0xB1>(x); x += dpp_mov<0x4E>(x); x += dpp_mov<0x141>(x); x += dpp_mov<0x140>(x);
  return x;
}
#define BAR_LDS() do { asm volatile("s_waitcnt lgkmcnt(0)" ::: "memory"); __builtin_amdgcn_s_barrier(); asm volatile("" ::: "memory"); } while (0)
DEV const float* xrow(const Params& p, int t) { return t < NCTX ? p.in[0] + (size_t)t * D : p.in[1] + (size_t)(t - NCTX) * D; }
DEV int modidx(int t) { return t < NCTX ? 0 : 1 + ((t - NCTX) >> 10); }

DEV void conv_job(const Params& p, int j, const float*& src, bf16_t*& dst, int& K, int& N, int& mode, int& base) {
  if (j < 1376) { src = p.in[11]; dst = (bf16_t*)(p.ws + OFF_WIN); K = 1024; N = 5504; mode = 0; base = 0; }
  else if (j < 1504) { src = p.in[26]; dst = (bf16_t*)(p.ws + OFF_WORW); K = 512; N = 1024; mode = 0; base = 1376; }
  else if (j < 1632) { src = p.in[27]; dst = (bf16_t*)(p.ws + OFF_WONA); K = 512; N = 1024; mode = 0; base = 1504; }
  else if (j < 1888) { src = p.in[28]; dst = (bf16_t*)(p.ws + OFF_WOUT); K = 1024; N = 1024; mode = 0; base = 1632; }
  else if (j < 2592) { src = p.in[29]; dst = (bf16_t*)(p.ws + OFF_W13); K = 1024; N = 2816; mode = 1; base = 1888; }
  else if (j < 3296) { src = p.in[30]; dst = (bf16_t*)(p.ws + OFF_W13); K = 1024; N = 2816; mode = 2; base = 2592; }
  else if (j < 4000) { src = p.in[31]; dst = (bf16_t*)(p.ws + OFF_W2); K = 2816; N = 1024; mode = 0; base = 3296; }
  else if (j < 4016) { const int e = (j - 4000) >> 3; src = p.in[14] + e * 32768; dst = (bf16_t*)(p.ws + OFF_LORA) + e * 32768; K = 64; N = 512; mode = 0; base = 4000 + e * 8; }
  else if (j < 4032) { const int e = (j - 4016) >> 3; src = p.in[16] + e * 32768; dst = (bf16_t*)(p.ws + OFF_LORA) + 65536 + e * 32768; K = 64; N = 512; mode = 0; base = 4016 + e * 8; }
  else { src = p.in[17]; dst = (bf16_t*)(p.ws + OFF_LORA) + 131072; K = 128; N = 512; mode = 0; base = 4032; }
}
constexpr int N_CONV_TILES = 4048, N_MOD_TILES = 768;

DEV void phase0(const Params& p, unsigned char* smem, int bid, int nb, int rep) {
  const int tid = threadIdx.x;
  float* T = (float*)smem;
  for (int tile = bid; tile < N_MOD_TILES && rep == 0; tile += nb) {
    const int cgp = tile % 24, kc = tile / 24;
    if (tid < 96) {
      const int m = tid >> 5, kk = tid & 31, k = kc * 32 + kk;
      const float c = (m == 0) ? p.in[6][k] : p.in[5][(m - 1) * D + k];
      T[tid] = c * sigmoidf_(c);
    }
    __syncthreads();
    const int col = cgp * 256 + tid;
    const float* w = p.in[9] + (size_t)(kc * 32) * 6144 + col;
    float a0 = 0.f, a1 = 0.f, a2 = 0.f;
#pragma unroll
    for (int kk = 0; kk < 32; ++kk) {
      const float wv = w[(size_t)kk * 6144];
      a0 += T[kk] * wv; a1 += T[32 + kk] * wv; a2 += T[64 + kk] * wv;
    }
    if (kc == 0) { const float b = p.in[10][col]; a0 += b; a1 += b; a2 += b; }
    float* mod = (float*)(p.ws + OFF_MOD);
    atomicAdd(mod + col, a0); atomicAdd(mod + 6144 + col, a1); atomicAdd(mod + 12288 + col, a2);
    __syncthreads();
  }
  const int r_ = tid >> 4, c4_ = tid & 15;
  float4 v[4];
  const float* src; bf16_t* dst; int K, N, mode, base;
  int tile = bid;
  if (tile < N_CONV_TILES) {
    conv_job(p, tile, src, dst, K, N, mode, base);
    const int lt = tile - base, nN = N >> 6, k0 = (lt / nN) * 64, n0 = (lt % nN) * 64;
#pragma unroll
    for (int i = 0; i < 4; ++i) v[i] = *(const float4*)(src + (size_t)(k0 + r_ + 16 * i) * N + n0 + c4_ * 4);
  }
  while (tile < N_CONV_TILES) {
    const int lt = tile - base, nN = N >> 6, k0 = (lt / nN) * 64, n0 = (lt % nN) * 64;
    bf16_t* cdst = dst; const int cK = K, cmode = mode;
#pragma unroll
    for (int i = 0; i < 4; ++i) {
      float* tp = T + (r_ + 16 * i) * 65 + c4_ * 4;
      tp[0] = v[i].x; tp[1] = v[i].y; tp[2] = v[i].z; tp[3] = v[i].w;
    }
    BAR_LDS();
    tile += nb;
    if (tile < N_CONV_TILES) {
      conv_job(p, tile, src, dst, K, N, mode, base);
      const int lt2 = tile - base, nN2 = N >> 6, k2 = (lt2 / nN2) * 64, n2 = (lt2 % nN2) * 64;
#pragma unroll
      for (int i = 0; i < 4; ++i) v[i] = *(const float4*)(src + (size_t)(k2 + r_ + 16 * i) * N + n2 + c4_ * 4);
    }
    const int n = tid >> 2, kp = tid & 3;
    unsigned w[8];
#pragma unroll
    for (int i = 0; i < 8; ++i) w[i] = pk2(T[(kp * 16 + 2 * i) * 65 + n], T[(kp * 16 + 2 * i + 1) * 65 + n]);
    const int ng = n0 + n;
    int drow = ng;
    if (cmode == 1) drow = (ng >> 4) * 32 + (ng & 15);
    else if (cmode == 2) drow = (ng >> 4) * 32 + 16 + (ng & 15);
    uint4* dp = (uint4*)(cdst + (size_t)drow * cK + k0 + kp * 16);
    dp[0] = make_uint4(w[0], w[1], w[2], w[3]);
    dp[1] = make_uint4(w[4], w[5], w[6], w[7]);
    BAR_LDS();
  }
}

template <int WHICH>
DEV void phase_normmod(const Params& p, int bid, int nb) {
  const int lane = threadIdx.x & 63, gw = bid * 4 + (threadIdx.x >> 6), nw = nb * 4;
  const float* g = WHICH == 0 ? p.in[7] : p.in[8];
  const float* mod = (const float*)(p.ws + OFF_MOD);
  const int sh_off = WHICH == 0 ? 0 : 3072, sc_off = WHICH == 0 ? 1024 : 4096;
  bf16_t* dst = (bf16_t*)(p.ws + OFF_H);
  for (int t = gw; t < NTOK; t += nw) {
    const float* xp = WHICH == 0 ? xrow(p, t) : p.out + (size_t)t * D;
    const float* mm = mod + modidx(t) * 6144;
    float4 v[4];
    float ss = 0.f;
#pragma unroll
    for (int i = 0; i < 4; ++i) {
      v[i] = *(const float4*)(xp + (i * 64 + lane) * 4);
      ss += v[i].x * v[i].x + v[i].y * v[i].y + v[i].z * v[i].z + v[i].w * v[i].w;
    }
    ss = wave_sum(ss);
    const float rstd = rsqrtf(ss * (1.f / 1024.f) + 1e-6f);
#pragma unroll
    for (int i = 0; i < 4; ++i) {
      const int col = (i * 64 + lane) * 4;
      const float4 g4 = *(const float4*)(g + col);
      const float4 sc = *(const float4*)(mm + sc_off + col);
      const float4 sh = *(const float4*)(mm + sh_off + col);
      const float y0 = v[i].x * rstd * g4.x * (1.f + sc.x) + sh.x;
      const float y1 = v[i].y * rstd * g4.y * (1.f + sc.y) + sh.y;
      const float y2 = v[i].z * rstd * g4.z * (1.f + sc.z) + sh.z;
      const float y3 = v[i].w * rstd * g4.w * (1.f + sc.w) + sh.w;
      *(uint2*)(dst + (size_t)t * D + col) = make_uint2(pk2(y0, y1), pk2(y2, y3));
    }
  }
}

template <int MI>
DEV void gemm_tile_acc(f32x4 (&acc)[MI][4], const bf16_t* __restrict__ A, int lda, const bf16_t* __restrict__ Bt, int ldb,
                       int m0, int n0, int K, unsigned char* smem) {
  constexpr int AT = 2 * MI * 16 * 128, BT = 16384, STG = AT + BT;
  const int tid = threadIdx.x, lane = tid & 63, wid = tid >> 6, wr = wid >> 1, wc = wid & 1, fr = lane & 15, fq = lane >> 4;
  const int gkc = (tid & 7) ^ ((tid >> 4) & 7);
  const bf16_t* ga = A + (size_t)(m0 + (tid >> 3)) * lda + gkc * 8;
  const bf16_t* gb = Bt + (size_t)(n0 + (tid >> 3)) * ldb + gkc * 8;
  const int swz = (fr >> 1) & 7;
  const int nk = K >> 6;
#define GLDS_TILE(kt_, buf_) do { unsigned char* sb_ = smem + (buf_) * STG; const int k0_ = (kt_) * 64; \
    _Pragma("unroll") for (int i_ = 0; i_ < (2 * MI * 16) / 32; ++i_) \
      __builtin_amdgcn_global_load_lds((const unsigned*)(ga + (size_t)i_ * 32 * lda + k0_), (__attribute__((address_space(3))) unsigned*)(sb_ + (i_ * 256 + tid) * 16), 16, 0, 0); \
    _Pragma("unroll") for (int i_ = 0; i_ < 4; ++i_) \
      __builtin_amdgcn_global_load_lds((const unsigned*)(gb + (size_t)i_ * 32 * ldb + k0_), (__attribute__((address_space(3))) unsigned*)(sb_ + AT + (i_ * 256 + tid) * 16), 16, 0, 0); \
  } while (0)
  GLDS_TILE(0, 0);
  asm volatile("s_waitcnt vmcnt(0)" ::: "memory");
  __syncthreads();
  for (int kt = 0; kt < nk; ++kt) {
    if (kt + 1 < nk) GLDS_TILE(kt + 1, (kt + 1) & 1);
    const unsigned char* cur = smem + (kt & 1) * STG;
#pragma unroll
    for (int ks = 0; ks < 2; ++ks) {
      bf16x8 af[MI], bf[4];
      const int co = ((ks * 4 + fq) ^ swz) << 4;
#pragma unroll
      for (int mi = 0; mi < MI; ++mi) af[mi] = *(const bf16x8*)(cur + (wr * MI * 16 + mi * 16 + fr) * 128 + co);
#pragma unroll
      for (int ni = 0; ni < 4; ++ni) bf[ni] = *(const bf16x8*)(cur + AT + (wc * 64 + ni * 16 + fr) * 128 + co);
#pragma unroll
      for (int mi = 0; mi < MI; ++mi)
#pragma unroll
        for (int ni = 0; ni < 4; ++ni) acc[mi][ni] = __builtin_amdgcn_mfma_f32_16x16x32_bf16(bf[ni], af[mi], acc[mi][ni], 0, 0, 0);
    }
    asm volatile("s_waitcnt vmcnt(0)" ::: "memory");
    __syncthreads();
  }
#undef GLDS_TILE
}

template <int MI>
DEV void zero_acc(f32x4 (&acc)[MI][4]) {
#pragma unroll
  for (int i = 0; i < MI; ++i)
#pragma unroll
    for (int j = 0; j < 4; ++j) acc[i][j] = (f32x4){0.f, 0.f, 0.f, 0.f};
}

#ifndef DYN_TILES
#define DYN_TILES 0
#endif
DEV int grab_tile(const Params& p, int word, int* slot) {
#if DYN_TILES
  if (threadIdx.x == 0) *slot = (int)atomicAdd((unsigned*)(p.ws + OFF_CTL) + word, 1u);
  __syncthreads();
  const int t = *slot;
  __syncthreads();
  return t;
#else
  const int t = slot[1];
  __syncthreads();
  if (threadIdx.x == 0) slot[1] = t + gridDim.x;
  __syncthreads();
  return t;
#endif
}
DEV void reset_tiles(int* slot) { if (threadIdx.x == 0) slot[1] = blockIdx.x; __syncthreads(); }

#define EPI_COORDS const int lane = threadIdx.x & 63, wid = threadIdx.x >> 6, wr = wid >> 1, wc = wid & 1, fr = lane & 15, fq = lane >> 4

DEV void phase_gemm_in(const Params& p, unsigned char* smem, int* slot) {
  EPI_COORDS;
  const bf16_t* A = (const bf16_t*)(p.ws + OFF_H);
  const bf16_t* Bt = (const bf16_t*)(p.ws + OFF_WIN);
  float* urw = (float*)(p.ws + OFF_URW);
  float* una = (float*)(p.ws + OFF_UNA);
  bf16_t* gates = (bf16_t*)p.out;
  for (;;) {
    const int tile = grab_tile(p, 8, slot);
    if (tile >= 48 * 43) break;
    const int tm = tile % 48, tn = tile / 48, m0 = tm * 128, n0 = tn * 128;
    f32x4 acc[4][4];
    zero_acc<4>(acc);
    gemm_tile_acc<4>(acc, A, D, Bt, D, m0, n0, D, smem);
#pragma unroll
    for (int mi = 0; mi < 4; ++mi) {
      const int row = m0 + wr * 64 + mi * 16 + fr;
#pragma unroll
      for (int ni = 0; ni < 4; ++ni) {
        const int col = n0 + wc * 64 + ni * 16 + fq * 4;
        const f32x4 v = acc[mi][ni];
        if (n0 < 1920) *(f32x4*)(urw + (size_t)row * 1920 + col) = v;
        else if (n0 < 3456) *(f32x4*)(una + (size_t)row * 1536 + (col - 1920)) = v;
        else *(uint2*)(gates + (size_t)row * 2048 + (col - 3456)) = make_uint2(pk2(sigmoidf_(v[0]), sigmoidf_(v[1])), pk2(sigmoidf_(v[2]), sigmoidf_(v[3])));
      }
    }
  }
}

DEV void phase_gemm_merge(const Params& p, unsigned char* smem, int* slot) {
  EPI_COORDS;
  const bf16_t* orw = (const bf16_t*)(p.ws + OFF_ORW);
  const bf16_t* ona = (const bf16_t*)(p.ws + OFF_ONA);
  const bf16_t* w1 = (const bf16_t*)(p.ws + OFF_WORW);
  const bf16_t* w2 = (const bf16_t*)(p.ws + OFF_WONA);
  const bf16_t* gates = (const bf16_t*)p.out;
  bf16_t* merged = (bf16_t*)(p.ws + OFF_MERGED);
  float* mtmp = (float*)(p.ws + OFF_MERGED + 16777216);
  for (;;) {
    const int tile = grab_tile(p, 9, slot);
    if (tile >= 64 * 8) break;
    const int tm = tile % 64, tn = tile / 64, m0 = tm * 96, n0 = tn * 128;
    f32x4 acc[3][4];
    zero_acc<3>(acc);
    gemm_tile_acc<3>(acc, orw, RW, w1, RW, m0, n0, RW, smem);
#pragma unroll
    for (int mi = 0; mi < 3; ++mi) {
      const int row = m0 + wr * 48 + mi * 16 + fr;
#pragma unroll
      for (int ni = 0; ni < 4; ++ni) {
        const int col = n0 + wc * 64 + ni * 16 + fq * 4;
        const uint2 g = *(const uint2*)(gates + (size_t)row * 2048 + col);
        f32x4 r;
        r[0] = acc[mi][ni][0] * bf2f((unsigned short)(g.x & 0xffff));
        r[1] = acc[mi][ni][1] * bf2f((unsigned short)(g.x >> 16));
        r[2] = acc[mi][ni][2] * bf2f((unsigned short)(g.y & 0xffff));
        r[3] = acc[mi][ni][3] * bf2f((unsigned short)(g.y >> 16));
        *(f32x4*)(mtmp + (size_t)row * D + col) = r;
      }
    }
    zero_acc<3>(acc);
    gemm_tile_acc<3>(acc, ona, RW, w2, RW, m0, n0, RW, smem);
#pragma unroll
    for (int mi = 0; mi < 3; ++mi) {
      const int row = m0 + wr * 48 + mi * 16 + fr;
#pragma unroll
      for (int ni = 0; ni < 4; ++ni) {
        const int col = n0 + wc * 64 + ni * 16 + fq * 4;
        const uint2 g = *(const uint2*)(gates + (size_t)row * 2048 + 1024 + col);
        const f32x4 mg = *(const f32x4*)(mtmp + (size_t)row * D + col);
        const float r0 = mg[0] + acc[mi][ni][0] * bf2f((unsigned short)(g.x & 0xffff));
        const float r1 = mg[1] + acc[mi][ni][1] * bf2f((unsigned short)(g.x >> 16));
        const float r2 = mg[2] + acc[mi][ni][2] * bf2f((unsigned short)(g.y & 0xffff));
        const float r3 = mg[3] + acc[mi][ni][3] * bf2f((unsigned short)(g.y >> 16));
        *(uint2*)(merged + (size_t)row * D + col) = make_uint2(pk2(r0, r1), pk2(r2, r3));
      }
    }
  }
}

DEV void phase_gemm_out(const Params& p, unsigned char* smem, int* slot) {
  EPI_COORDS;
  const bf16_t* A = (const bf16_t*)(p.ws + OFF_MERGED);
  const bf16_t* Bt = (const bf16_t*)(p.ws + OFF_WOUT);
  const float* mod = (const float*)(p.ws + OFF_MOD);
  for (;;) {
    const int tile = grab_tile(p, 10, slot);
    if (tile >= 64 * 8) break;
    const int tm = tile % 64, tn = tile / 64, m0 = tm * 96, n0 = tn * 128;
    f32x4 acc[3][4];
    zero_acc<3>(acc);
    gemm_tile_acc<3>(acc, A, D, Bt, D, m0, n0, D, smem);
#pragma unroll
    for (int mi = 0; mi < 3; ++mi) {
      const int row = m0 + wr * 48 + mi * 16 + fr;
      const float* xp = xrow(p, row);
      const float* g1 = mod + modidx(row) * 6144 + 2048;
#pragma unroll
      for (int ni = 0; ni < 4; ++ni) {
        const int col = n0 + wc * 64 + ni * 16 + fq * 4;
        const f32x4 x = *(const f32x4*)(xp + col);
        const f32x4 g = *(const f32x4*)(g1 + col);
        *(f32x4*)(p.out + (size_t)row * D + col) = x + g * acc[mi][ni];
      }
    }
  }
}

DEV void phase_gemm_ffn_up(const Params& p, unsigned char* smem, int* slot) {
  EPI_COORDS;
  const bf16_t* A = (const bf16_t*)(p.ws + OFF_H);
  const bf16_t* Bt = (const bf16_t*)(p.ws + OFF_W13);
  bf16_t* hid = (bf16_t*)(p.ws + OFF_HID);
  for (;;) {
    const int tile = grab_tile(p, 11, slot);
    if (tile >= 48 * 44) break;
    const int tm = tile % 48, tn = tile / 48, m0 = tm * 128, n0 = tn * 128;
    f32x4 acc[4][4];
    zero_acc<4>(acc);
    gemm_tile_acc<4>(acc, A, D, Bt, D, m0, n0, D, smem);
#pragma unroll
    for (int mi = 0; mi < 4; ++mi) {
      const int row = m0 + wr * 64 + mi * 16 + fr;
#pragma unroll
      for (int gp = 0; gp < 2; ++gp) {
        const int hcol = ((n0 + wc * 64) >> 1) + gp * 16 + fq * 4;
        const f32x4 a = acc[mi][2 * gp], b = acc[mi][2 * gp + 1];
        float r[4];
#pragma unroll
        for (int e = 0; e < 4; ++e) r[e] = a[e] * sigmoidf_(a[e]) * b[e];
        *(uint2*)(hid + (size_t)row * FF + hcol) = make_uint2(pk2(r[0], r[1]), pk2(r[2], r[3]));
      }
    }
  }
}

DEV void phase_gemm_ffn_down(const Params& p, unsigned char* smem, int* slot) {
  EPI_COORDS;
  const bf16_t* A = (const bf16_t*)(p.ws + OFF_HID);
  const bf16_t* Bt = (const bf16_t*)(p.ws + OFF_W2);
  const float* mod = (const float*)(p.ws + OFF_MOD);
  for (;;) {
    const int tile = grab_tile(p, 12, slot);
    if (tile >= 64 * 8) break;
    const int tm = tile % 64, tn = tile / 64, m0 = tm * 96, n0 = tn * 128;
    f32x4 acc[3][4];
    zero_acc<3>(acc);
    gemm_tile_acc<3>(acc, A, FF, Bt, FF, m0, n0, FF, smem);
#pragma unroll
    for (int mi = 0; mi < 3; ++mi) {
      const int row = m0 + wr * 48 + mi * 16 + fr;
      const float* g2 = mod + modidx(row) * 6144 + 5120;
#pragma unroll
      for (int ni = 0; ni < 4; ++ni) {
        const int col = n0 + wc * 64 + ni * 16 + fq * 4;
        float* op = p.out + (size_t)row * D + col;
        const f32x4 x = *(const f32x4*)op;
        const f32x4 g = *(const f32x4*)(g2 + col);
        *(f32x4*)op = x + g * acc[mi][ni];
      }
    }
  }
}

DEV void phase_qkprep(const Params& p, unsigned char* smem, int item_) {
  const int tid = threadIdx.x;
  bf16_t* Vs = (bf16_t*)smem;
  bf16_t* qb = (bf16_t*)(p.ws + OFF_QB);
  bf16_t* kb = (bf16_t*)(p.ws + OFF_KB);
  bf16_t* vT = (bf16_t*)(p.ws + OFF_VT);
  bf16_t* ckb = (bf16_t*)(p.ws + OFF_CKB);
  bf16_t* cvT = (bf16_t*)(p.ws + OFF_CVT);
  const float* una = (const float*)(p.ws + OFF_UNA);
  const int tok = tid >> 2, part = tid & 3;
  for (int item = item_; item < item_ + 1; ++item) {
    if (item < 768) {
      const int tt = item >> 3, h = item & 7, t0 = tt * 64, t = t0 + tok;
      const float* src = una + (size_t)t * 1536 + h * 64 + part * 16;
      {
        float x[16]; float ss = 0.f;
#pragma unroll
        for (int i = 0; i < 4; ++i) { const float4 v = *(const float4*)(src + i * 4); x[4 * i] = v.x; x[4 * i + 1] = v.y; x[4 * i + 2] = v.z; x[4 * i + 3] = v.w; }
#pragma unroll
        for (int i = 0; i < 16; ++i) ss += x[i] * x[i];
        ss += __shfl_xor(ss, 1); ss += __shfl_xor(ss, 2);
        const float rs = rsqrtf(ss * (1.f / 64.f) + 1e-6f) * 0.125f;
        unsigned w[8];
#pragma unroll
        for (int i = 0; i < 8; ++i) w[i] = pk2(x[2 * i] * rs * p.in[23][part * 16 + 2 * i], x[2 * i + 1] * rs * p.in[23][part * 16 + 2 * i + 1]);
        uint4* dp = (uint4*)(qb + (size_t)t * 512 + h * 64 + part * 16);
        dp[0] = make_uint4(w[0], w[1], w[2], w[3]); dp[1] = make_uint4(w[4], w[5], w[6], w[7]);
      }
      {
        float x[16]; float ss = 0.f;
#pragma unroll
        for (int i = 0; i < 4; ++i) { const float4 v = *(const float4*)(src + 512 + i * 4); x[4 * i] = v.x; x[4 * i + 1] = v.y; x[4 * i + 2] = v.z; x[4 * i + 3] = v.w; }
#pragma unroll
        for (int i = 0; i < 16; ++i) ss += x[i] * x[i];
        ss += __shfl_xor(ss, 1); ss += __shfl_xor(ss, 2);
        const float rs = rsqrtf(ss * (1.f / 64.f) + 1e-6f);
#pragma unroll
        for (int i = 0; i < 16; ++i) x[i] = x[i] * rs * p.in[24][part * 16 + i];
        if (t < NCTX) {
          float4* op = (float4*)(p.out + OUT_K + (size_t)t * 512 + h * 64 + part * 16);
#pragma unroll
          for (int i = 0; i < 4; ++i) op[i] = make_float4(x[4 * i], x[4 * i + 1], x[4 * i + 2], x[4 * i + 3]);
        }
        unsigned w[8];
#pragma unroll
        for (int i = 0; i < 8; ++i) w[i] = pk2(x[2 * i], x[2 * i + 1]);
        uint4* dp = (uint4*)(kb + (size_t)t * 512 + h * 64 + part * 16);
        dp[0] = make_uint4(w[0], w[1], w[2], w[3]); dp[1] = make_uint4(w[4], w[5], w[6], w[7]);
      }
      {
        float x[16];
#pragma unroll
        for (int i = 0; i < 4; ++i) { const float4 v = *(const float4*)(src + 1024 + i * 4); x[4 * i] = v.x; x[4 * i + 1] = v.y; x[4 * i + 2] = v.z; x[4 * i + 3] = v.w; }
        if (t < NCTX) {
          float4* op = (float4*)(p.out + OUT_V + (size_t)t * 512 + h * 64 + part * 16);
#pragma unroll
          for (int i = 0; i < 4; ++i) op[i] = make_float4(x[4 * i], x[4 * i + 1], x[4 * i + 2], x[4 * i + 3]);
        }
#pragma unroll
        for (int i = 0; i < 16; ++i) Vs[tok * 72 + part * 16 + i] = f2bf(x[i]);
      }
      __syncthreads();
      {
        const int d = tid >> 2;
        unsigned w[8];
#pragma unroll
        for (int i = 0; i < 8; ++i) w[i] = (unsigned)Vs[(part * 16 + 2 * i) * 72 + d] | ((unsigned)Vs[(part * 16 + 2 * i + 1) * 72 + d] << 16);
        uint4* dp = (uint4*)(vT + (size_t)(h * 64 + d) * NTOK + t0 + part * 16);
        dp[0] = make_uint4(w[0], w[1], w[2], w[3]); dp[1] = make_uint4(w[4], w[5], w[6], w[7]);
      }
      __syncthreads();
    } else {
      const int ci = item - 768, b = ci >> 5, rem = ci & 31, tt = rem >> 3, h = rem & 7, t0 = tt * 64, t = t0 + tok;
      const size_t sidx = (size_t)(b * 256 + t) * 512 + h * 64 + part * 16;
      {
        float x[16];
#pragma unroll
        for (int i = 0; i < 4; ++i) { const float4 v = *(const float4*)(p.in[3] + sidx + i * 4); x[4 * i] = v.x; x[4 * i + 1] = v.y; x[4 * i + 2] = v.z; x[4 * i + 3] = v.w; }
        unsigned w[8];
#pragma unroll
        for (int i = 0; i < 8; ++i) w[i] = pk2(x[2 * i], x[2 * i + 1]);
        uint4* dp = (uint4*)(ckb + sidx);
        dp[0] = make_uint4(w[0], w[1], w[2], w[3]); dp[1] = make_uint4(w[4], w[5], w[6], w[7]);
      }
      {
        float x[16];
#pragma unroll
        for (int i = 0; i < 4; ++i) { const float4 v = *(const float4*)(p.in[4] + sidx + i * 4); x[4 * i] = v.x; x[4 * i + 1] = v.y; x[4 * i + 2] = v.z; x[4 * i + 3] = v.w; }
#pragma unroll
        for (int i = 0; i < 16; ++i) Vs[tok * 72 + part * 16 + i] = f2bf(x[i]);
      }
      __syncthreads();
      {
        const int d = tid >> 2;
        unsigned w[8];
#pragma unroll
        for (int i = 0; i < 8; ++i) w[i] = (unsigned)Vs[(part * 16 + 2 * i) * 72 + d] | ((unsigned)Vs[(part * 16 + 2 * i + 1) * 72 + d] << 16);
        uint4* dp = (uint4*)(cvT + (size_t)((b * 8 + h) * 64 + d) * 256 + t0 + part * 16);
        dp[0] = make_uint4(w[0], w[1], w[2], w[3]); dp[1] = make_uint4(w[4], w[5], w[6], w[7]);
      }
      __syncthreads();
    }
  }
}

DEV float* ops_arr(const Params& p, int i) { return (float*)(p.ws + OFF_OPS + (size_t)i * OPS_ARR); }

DEV f32x4 shiftvec(f32x4 cur, f32x4 hal, f32x4 mu0, f32x4 mu1, int fr) {
  f32x4 prev, next;
#pragma unroll
  for (int i = 0; i < 4; ++i) {
    prev[i] = dpp_mov<0x111>(cur[i]);
    next[i] = dpp_mov<0x101>(cur[i]);
  }
  if (fr == 0) prev = hal;
  if (fr == 15) next = hal;
  return cur + mu0 * (prev - cur) + mu1 * (next - cur);
}
DEV float quad_sum(float x) { x += __shfl_xor(x, 16); x += __shfl_xor(x, 32); return x; }
DEV f32x4 ld4(const float* p) { return *(const f32x4*)p; }

constexpr int LROWB = 392;
DEV void phase_rwprep(const Params& p, unsigned char* smem, int item_) {
  const int tid = threadIdx.x, lane = tid & 63, w = tid >> 6, fr = lane & 15, fq = lane >> 4;
  bf16_t* Lb = (bf16_t*)smem;
  const float* urw = (const float*)(p.ws + OFF_URW);
  const float* mu = p.in[12];
  bf16_t* bonus = (bf16_t*)(p.ws + OFF_BG);
  bf16_t* gate = (bf16_t*)(p.ws + OFF_BG + 6291456);
  const bf16_t* WUPT = (const bf16_t*)(p.ws + OFF_LORA);
  const bf16_t* AUPT = WUPT + 65536;
  const bf16_t* GUPT = WUPT + 131072;
  float* o_r = ops_arr(p, 0); float* o_v = ops_arr(p, 1); float* o_a = ops_arr(p, 2);
  for (int item = item_; item < item_ + 1; ++item) {
    const int t0 = (item >> 1) * 16, h = (item & 1) * 4 + w;
    int s_lo, s_hi;
    if (t0 < NCTX) { s_lo = t0 & ~255; s_hi = s_lo + 256; } else { s_lo = NCTX + ((t0 - NCTX) & ~1023); s_hi = s_lo + 1024; }
#pragma unroll 8
    for (int e = tid; e < 6144; e += NTHR) {
      const int cc = e % 384, tl = e / 384, col = 1536 + cc, t = t0 + tl;
      const float* up = urw + (size_t)t * RWC + col;
      const float uc = up[0];
      const float upv = (t > s_lo) ? up[-RWC] : 0.f;
      const float unx = (t + 1 < s_hi) ? up[RWC] : 0.f;
      const float us = uc + mu[col] * (upv - uc) + mu[RWC + col] * (unx - uc);
      const int kind = cc >> 7;
      const float val = kind == 0 ? (1.f - 2.f / (1.f + __expf(2.f * us))) : (kind == 1 ? us : sigmoidf_(us));
      Lb[tl * LROWB + cc] = f2bf(val);
    }
    __syncthreads();
    const int t = t0 + fr;
    const bool lo_ok = (fr == 0) && (t > s_lo), hi_ok = (fr == 15) && (t + 1 < s_hi);
    const float* urow = urw + (size_t)t * RWC;
    const float* hrow = lo_ok ? urow - RWC : (hi_ok ? urow + RWC : urow);
    const bool hal_ok = lo_ok || hi_ok;
    const f32x4 z4 = (f32x4){0.f, 0.f, 0.f, 0.f};
    float ss = 0.f;
#pragma unroll
    for (int ni = 0; ni < 4; ++ni) {
      const int c = h * 64 + ni * 16 + fq * 4;
      const f32x4 kx = shiftvec(ld4(urow + 512 + c), hal_ok ? ld4(hrow + 512 + c) : z4, ld4(mu + 512 + c), ld4(mu + RWC + 512 + c), fr) * ld4(p.in[18] + c);
      ss += kx[0] * kx[0] + kx[1] * kx[1] + kx[2] * kx[2] + kx[3] * kx[3];
    }
    ss = quad_sum(ss);
    const float rn = rsqrtf(ss + 1e-12f);
    float bs = 0.f;
#pragma unroll 1
    for (int ni = 0; ni < 4; ++ni) {
      const int c = h * 64 + ni * 16 + fq * 4;
      const size_t o = (size_t)t * 512 + c;
      const f32x4 r4 = shiftvec(ld4(urow + c), hal_ok ? ld4(hrow + c) : z4, ld4(mu + c), ld4(mu + RWC + c), fr);
      const f32x4 k4 = shiftvec(ld4(urow + 512 + c), hal_ok ? ld4(hrow + 512 + c) : z4, ld4(mu + 512 + c), ld4(mu + RWC + 512 + c), fr);
      const f32x4 v4 = shiftvec(ld4(urow + 1024 + c), hal_ok ? ld4(hrow + 1024 + c) : z4, ld4(mu + 1024 + c), ld4(mu + RWC + 1024 + c), fr);
      const f32x4 kk4 = k4 * ld4(p.in[18] + c) * rn;
      *(f32x4*)(o_r + o) = r4; *(f32x4*)(o_v + o) = v4; *(f32x4*)(o_a + o) = -kk4;
      const f32x4 ka = ld4(p.in[19] + c);
      f32x4 bacc = z4;
#pragma unroll
      for (int e = 0; e < 2; ++e) {
        float* o_k = ops_arr(p, 5 + e); float* o_b = ops_arr(p, 7 + e); float* o_w = ops_arr(p, 3 + e);
        f32x4 acc = z4, acw = z4;
#pragma unroll
        for (int ks = 0; ks < 2; ++ks) {
          const bf16x8 wa = *(const bf16x8*)(AUPT + (size_t)(e * 512 + h * 64 + ni * 16 + fr) * 64 + ks * 32 + fq * 8);
          const bf16x8 la = *(const bf16x8*)(Lb + fr * LROWB + 128 + e * 64 + ks * 32 + fq * 8);
          acc = __builtin_amdgcn_mfma_f32_16x16x32_bf16(wa, la, acc, 0, 0, 0);
          const bf16x8 ww = *(const bf16x8*)(WUPT + (size_t)(e * 512 + h * 64 + ni * 16 + fr) * 64 + ks * 32 + fq * 8);
          const bf16x8 lw = *(const bf16x8*)(Lb + fr * LROWB + e * 64 + ks * 32 + fq * 8);
          acw = __builtin_amdgcn_mfma_f32_16x16x32_bf16(ww, lw, acw, 0, 0, 0);
        }
        const f32x4 a0 = ld4(p.in[15] + e * 512 + c), w0 = ld4(p.in[13] + e * 512 + c);
        f32x4 kd, bb, dec;
#pragma unroll
        for (int i = 0; i < 4; ++i) {
          const float ic = sigmoidf_(a0[i] + acc[i]);
          kd[i] = k4[i] * (1.f + (ic - 1.f) * ka[i]);
          bb[i] = kk4[i] * ic;
          const float z = w0[i] + acw[i];
          const float sp = fmaxf(-z, 0.f) + __logf(1.f + __expf(-fabsf(z)));
          dec[i] = __expf(-__expf(-sp - 0.5f));
        }
        bacc += kd;
        *(f32x4*)(o_k + o) = kd; *(f32x4*)(o_b + o) = bb; *(f32x4*)(o_w + o) = dec;
      }
      const f32x4 rk = ld4(p.in[20] + c);
#pragma unroll
      for (int i = 0; i < 4; ++i) bs += r4[i] * 0.5f * bacc[i] * rk[i];
      f32x4 acc = z4;
#pragma unroll
      for (int ks = 0; ks < 4; ++ks) {
        const bf16x8 wg = *(const bf16x8*)(GUPT + (size_t)(h * 64 + ni * 16 + fr) * 128 + ks * 32 + fq * 8);
        const bf16x8 lg = *(const bf16x8*)(Lb + fr * LROWB + 256 + ks * 32 + fq * 8);
        acc = __builtin_amdgcn_mfma_f32_16x16x32_bf16(wg, lg, acc, 0, 0, 0);
      }
      *(uint2*)(gate + o) = make_uint2(pk2(acc[0], acc[1]), pk2(acc[2], acc[3]));
    }
    bs = quad_sum(bs);
#pragma unroll
    for (int ni = 0; ni < 4; ++ni) {
      const size_t o = (size_t)t * 512 + h * 64 + ni * 16 + fq * 4;
      const f32x4 v4 = *(const f32x4*)(o_v + o);
      *(uint2*)(bonus + o) = make_uint2(pk2(bs * v4[0], bs * v4[1]), pk2(bs * v4[2], bs * v4[3]));
    }
    __syncthreads();
  }
}

DEV void phase_prep(const Params& p, unsigned char* smem, int* s_item, int rep) {
  unsigned* counter = (unsigned*)(p.ws + OFF_CTL) + 16 + rep;
  for (;;) {
    if (threadIdx.x == 0) *s_item = (int)atomicAdd(counter, 1u);
    __syncthreads();
    const int item = *s_item;
    __syncthreads();
    if (item >= 768 + 832) break;
    if (item < 768) phase_rwprep(p, smem, item);
    else phase_qkprep(p, smem, item - 768);
  }
}

constexpr int TC = 16;
typedef float f32x2 __attribute__((ext_vector_type(2)));
template <int EPL, int R, int PD>
DEV void scan_item(const Params& p, unsigned char* smem, int seq, int h, int dir, int rg) {
  constexpr int LPR = 64 / EPL, RPW = 64 / LPR, RPB = 4 * RPW * R, NV = RPB / 16, NP = EPL / 2;
  constexpr int STG = 20480 + 16 * RPB * 4, YOFF = 2 * STG, YSZ = 16 * RPB * 4;
  const int tid = threadIdx.x, lane = tid & 63, w = tid >> 6, riw = lane / LPR, kq = lane % LPR;
  const int T = seq < 16 ? 256 : 1024;
  const int tok0 = seq < 16 ? seq * 256 : NCTX + (seq - 16) * 1024;
  const int vrow_l = (w * RPW + riw) * R;
  const int vrow = rg * RPB + vrow_l;
  f32x2 S[R][NP];
#pragma unroll
  for (int rr = 0; rr < R; ++rr) {
    if (seq >= 16) {
      const float* sp = p.in[2] + ((size_t)(((seq - 16) * 2 + dir) * 8 + h) * 64 + vrow + rr) * 64 + kq * EPL;
#pragma unroll
      for (int i = 0; i < NP; ++i) S[rr][i] = *(const f32x2*)(sp + 2 * i);
    } else {
#pragma unroll
      for (int i = 0; i < NP; ++i) S[rr][i] = (f32x2){0.f, 0.f};
    }
  }
  const int lstep = tid >> 4, l16 = tid & 15;
  const float* pr = ops_arr(p, 0) + h * 64 + l16 * 4;
  const float* pw = ops_arr(p, 3 + dir) + h * 64 + l16 * 4;
  const float* pk = ops_arr(p, 5 + dir) + h * 64 + l16 * 4;
  const float* pa = ops_arr(p, 2) + h * 64 + l16 * 4;
  const float* pb = ops_arr(p, 7 + dir) + h * 64 + l16 * 4;
  const float* pv = ops_arr(p, 1) + h * 64 + rg * RPB + l16;
  float* yout = (float*)(p.ws + (dir ? OFF_YB : OFF_YF)) + h * 64 + rg * RPB + l16;
  const int nc = T / TC;
  float4 g_r, g_w, g_k, g_a, g_b; float rv[NV];
#define gload(c) do { const int ts_ = (c) * TC + lstep; const size_t t_ = (size_t)(tok0 + (dir ? T - 1 - ts_ : ts_)) * 512; \
    g_r = *(const float4*)(pr + t_); g_w = *(const float4*)(pw + t_); g_k = *(const float4*)(pk + t_); \
    g_a = *(const float4*)(pa + t_); g_b = *(const float4*)(pb + t_); \
    _Pragma("unroll") for (int q_ = 0; q_ < NV; ++q_) rv[q_] = pv[t_ + 16 * q_]; } while (0)
#define ywrite(c) do { const float* yb_ = (const float*)(smem + YOFF + ((c) & 1) * YSZ); const int ts_ = (c) * TC + lstep; \
    const size_t t_ = (size_t)(tok0 + (dir ? T - 1 - ts_ : ts_)) * 512; \
    _Pragma("unroll") for (int q_ = 0; q_ < NV; ++q_) yout[t_ + 16 * q_] = yb_[lstep * RPB + l16 + 16 * q_]; } while (0)
  gload(0);
  for (int c = 0; c < nc; ++c) {
    unsigned char* st = smem + (c & 1) * STG;
    *(float4*)(st + 0 * 4096 + lstep * 256 + l16 * 16) = g_r;
    *(float4*)(st + 1 * 4096 + lstep * 256 + l16 * 16) = g_w;
    *(float4*)(st + 2 * 4096 + lstep * 256 + l16 * 16) = g_k;
    *(float4*)(st + 3 * 4096 + lstep * 256 + l16 * 16) = g_a;
    *(float4*)(st + 4 * 4096 + lstep * 256 + l16 * 16) = g_b;
#pragma unroll
    for (int q = 0; q < NV; ++q) *(float*)(st + 20480 + (lstep * RPB + l16 + 16 * q) * 4) = rv[q];
    __syncthreads();
    if (c > 0) ywrite(c - 1);
    if (c + 1 < nc) gload(c + 1);
    float* ybw = (float*)(smem + YOFF + (c & 1) * YSZ);
    constexpr int NS = PD + 1;
    f32x2 o_r[NS][NP], o_w[NS][NP], o_k[NS][NP], o_a[NS][NP], o_b[NS][NP]; float o_v[NS][R];
    float ykeep[R][TC / LPR];
#define LDOPS(bi, s_) do { \
      _Pragma("unroll") for (int i_ = 0; i_ < NP; ++i_) { \
        o_r[bi][i_] = *(const f32x2*)(st + 0 * 4096 + (s_) * 256 + kq * EPL * 4 + i_ * 8); \
        o_w[bi][i_] = *(const f32x2*)(st + 1 * 4096 + (s_) * 256 + kq * EPL * 4 + i_ * 8); \
        o_k[bi][i_] = *(const f32x2*)(st + 2 * 4096 + (s_) * 256 + kq * EPL * 4 + i_ * 8); \
        o_a[bi][i_] = *(const f32x2*)(st + 3 * 4096 + (s_) * 256 + kq * EPL * 4 + i_ * 8); \
        o_b[bi][i_] = *(const f32x2*)(st + 4 * 4096 + (s_) * 256 + kq * EPL * 4 + i_ * 8); } \
      _Pragma("unroll") for (int rr_ = 0; rr_ < R; ++rr_) o_v[bi][rr_] = *(const float*)(st + 20480 + ((s_) * RPB + vrow_l + rr_) * 4); } while (0)
#pragma unroll
    for (int s = 0; s < PD; ++s) LDOPS(s, s);
#pragma unroll
    for (int s = 0; s < TC; ++s) {
      const int bi = s % NS;
      if (s + PD < TC) LDOPS((s + PD) % NS, s + PD);
#pragma unroll
      for (int rr = 0; rr < R; ++rr) {
        const f32x2 vv2 = (f32x2){o_v[bi][rr], o_v[bi][rr]};
        f32x2 pa2 = S[rr][0] * o_a[bi][0];
        f32x2 tt[NP];
        tt[0] = S[rr][0] * o_w[bi][0] + vv2 * o_k[bi][0];
#pragma unroll
        for (int i = 1; i < NP; ++i) { pa2 += S[rr][i] * o_a[bi][i]; tt[i] = S[rr][i] * o_w[bi][i] + vv2 * o_k[bi][i]; }
        float sa = pa2[0] + pa2[1];
        sa += dpp_mov<0xB1>(sa); sa += dpp_mov<0x4E>(sa); sa += dpp_mov<0x141>(sa);
        if (LPR == 16) sa += dpp_mov<0x140>(sa);
        const f32x2 sa2 = (f32x2){sa, sa};
        f32x2 py = (f32x2){0.f, 0.f};
#pragma unroll
        for (int i = 0; i < NP; ++i) { S[rr][i] = sa2 * o_b[bi][i] + tt[i]; py += S[rr][i] * o_r[bi][i]; }
        float y = py[0] + py[1];
        y += dpp_mov<0xB1>(y); y += dpp_mov<0x4E>(y); y += dpp_mov<0x141>(y);
        if (LPR == 16) y += dpp_mov<0x140>(y);
        if ((s % LPR) == 0) ykeep[rr][s / LPR] = y; else ykeep[rr][s / LPR] = (kq == (s % LPR)) ? y : ykeep[rr][s / LPR];
      }
    }
#undef LDOPS
#pragma unroll
    for (int rr = 0; rr < R; ++rr)
#pragma unroll
      for (int q = 0; q < TC / LPR; ++q) ybw[(q * LPR + kq) * RPB + vrow_l + rr] = ykeep[rr][q];
  }
  __syncthreads();
  ywrite(nc - 1);
  if (seq < 16) {
#pragma unroll
    for (int rr = 0; rr < R; ++rr) {
      float* so = p.out + OUT_STATE + ((size_t)((seq * 2 + dir) * 8 + h) * 64 + vrow + rr) * 64 + kq * EPL;
#pragma unroll
      for (int i = 0; i < NP; ++i) *(f32x2*)(so + 2 * i) = S[rr][i];
    }
  }
  __syncthreads();
#undef gload
#undef ywrite
}

DEV void attn_wave_item(const Params& p, int witem) {
  const int lane = threadIdx.x & 63, fr = lane & 15, fq = lane >> 4;
  const bf16_t* qb = (const bf16_t*)(p.ws + OFF_QB);
  const bf16_t* kb = (const bf16_t*)(p.ws + OFF_KB);
  const bf16_t* vT = (const bf16_t*)(p.ws + OFF_VT);
  const bf16_t* ckb = (const bf16_t*)(p.ws + OFF_CKB);
  const bf16_t* cvT = (const bf16_t*)(p.ws + OFF_CVT);
  bf16_t* ona = (bf16_t*)(p.ws + OFF_ONA);
  int h, tq0, nsub;
  bool latent;
  int b = 0, r = 0, jb = 0, row_start = 0, band = 0, seq = 0;
  {
    const int bi = witem >> 2, wv = witem & 3;
    if (bi < 256) {
      latent = true;
      b = bi >> 7; const int rem = bi & 127; r = rem >> 3; h = rem & 7; jb = wv;
      tq0 = NCTX + b * 1024 + r * 64 + jb * 16;
      row_start = min(max(r - 4, 0), 8); band = min(max(jb * 16 - 8, 0), 32);
      nsub = 4;
    } else {
      latent = false;
      const int c2 = bi - 256; seq = c2 >> 5; const int rem = c2 & 31; h = rem >> 2; const int qg = rem & 3;
      tq0 = seq * 256 + (qg * 4 + wv) * 16; nsub = 2;
    }
  }
  const bf16_t* qp = qb + (size_t)(tq0 + fr) * 512 + h * 64 + fq * 8;
  const bf16x8 qf0 = *(const bf16x8*)qp, qf1 = *(const bf16x8*)(qp + 32);
  float m = -INFINITY, l = 0.f;
  f32x4 O[4];
#pragma unroll
  for (int i = 0; i < 4; ++i) O[i] = (f32x4){0.f, 0.f, 0.f, 0.f};
#define SUBDESC(sc_, kbase_, vbase_, KS_, ldv_, win_) do { const int half_ = (sc_) & 1; win_ = latent && (sc_) < 2; \
    if (win_) { const int tb_ = NCTX + b * 1024 + (row_start + half_ * 4) * 64 + band; \
      kbase_ = kb + (size_t)tb_ * 512 + h * 64; vbase_ = vT + (size_t)(h * 64) * NTOK + tb_; KS_ = 64; ldv_ = NTOK; } \
    else if (latent) { kbase_ = ckb + (size_t)(b * 256 + half_ * 128) * 512 + h * 64; vbase_ = cvT + (size_t)((b * 8 + h) * 64) * 256 + half_ * 128; KS_ = 32; ldv_ = 256; } \
    else { const int tb_ = seq * 256 + half_ * 128; kbase_ = kb + (size_t)tb_ * 512 + h * 64; vbase_ = vT + (size_t)(h * 64) * NTOK + tb_; KS_ = 32; ldv_ = NTOK; } } while (0)
#define KLOAD(kbase_, KS_) do { _Pragma("unroll") for (int i_ = 0; i_ < 8; ++i_) { \
      const bf16_t* kp_ = kbase_ + (size_t)((i_ >> 1) * KS_ + (fr >> 2) * 8 + (i_ & 1) * 4 + (fr & 3)) * 512 + fq * 8; \
      kf[2 * i_] = *(const bf16x8*)kp_; kf[2 * i_ + 1] = *(const bf16x8*)(kp_ + 32); } } while (0)
  bf16x8 kf[16];
#pragma unroll 1
  for (int sc = 0; sc < nsub; ++sc) {
    const int half = sc & 1;
    const bf16_t* kbase; const bf16_t* vbase; int KS, ldv; bool win;
    SUBDESC(sc, kbase, vbase, KS, ldv, win);
    KLOAD(kbase, KS);
    bf16x8 vf[4][4];
#pragma unroll
    for (int s = 0; s < 4; ++s)
#pragma unroll
      for (int dt = 0; dt < 4; ++dt) {
        vf[s][dt] = *(const bf16x8*)(vbase + (size_t)(dt * 16 + fr) * ldv + s * KS + fq * 8);
      }
    f32x4 st[8];
#pragma unroll
    for (int i = 0; i < 8; ++i) {
      f32x4 z = (f32x4){0.f, 0.f, 0.f, 0.f};
      z = __builtin_amdgcn_mfma_f32_16x16x32_bf16(kf[2 * i], qf0, z, 0, 0, 0);
      st[i] = __builtin_amdgcn_mfma_f32_16x16x32_bf16(kf[2 * i + 1], qf1, z, 0, 0, 0);
    }
    const bool cwin = win;
    if (cwin) {
      const int q_col = jb * 16 + fr;
      const int win_start = min(max(q_col - 8, 0), 48);
      const float* rpb = p.in[25] + h * 465;
#pragma unroll
      for (int i = 0; i < 8; ++i) {
        const int dr = row_start + half * 4 + (i >> 1) - r + 7;
#pragma unroll
        for (int e = 0; e < 4; ++e) {
          const int k_col = band + fq * 8 + (i & 1) * 4 + e;
          const bool valid = (k_col >= win_start) && (k_col < win_start + 16);
          const int dc = min(max(k_col - q_col, -15), 15) + 15;
          st[i][e] = valid ? st[i][e] + rpb[dr * 31 + dc] : -1e30f;
        }
      }
    }
    float cmax = -1e30f;
#pragma unroll
    for (int i = 0; i < 8; ++i)
#pragma unroll
      for (int e = 0; e < 4; ++e) cmax = fmaxf(cmax, st[i][e]);
    cmax = fmaxf(cmax, __shfl_xor(cmax, 16)); cmax = fmaxf(cmax, __shfl_xor(cmax, 32));
    const float mnew = fmaxf(m, cmax);
    const float alpha = __expf(m - mnew);
    float psum = 0.f;
#pragma unroll
    for (int i = 0; i < 8; ++i)
#pragma unroll
      for (int e = 0; e < 4; ++e) { const float pv = __expf(st[i][e] - mnew); st[i][e] = pv; psum += pv; }
    psum += __shfl_xor(psum, 16); psum += __shfl_xor(psum, 32);
    l = l * alpha + psum;
#pragma unroll
    for (int i = 0; i < 4; ++i) O[i] = O[i] * alpha;
    m = mnew;
#pragma unroll
    for (int s = 0; s < 4; ++s) {
      union { bf16x8 v; unsigned u[4]; } pb;
      pb.u[0] = pk2(st[2 * s][0], st[2 * s][1]); pb.u[1] = pk2(st[2 * s][2], st[2 * s][3]);
      pb.u[2] = pk2(st[2 * s + 1][0], st[2 * s + 1][1]); pb.u[3] = pk2(st[2 * s + 1][2], st[2 * s + 1][3]);
#pragma unroll
      for (int dt = 0; dt < 4; ++dt) {
        O[dt] = __builtin_amdgcn_mfma_f32_16x16x32_bf16(vf[s][dt], pb.v, O[dt], 0, 0, 0);
      }
    }
  }
#undef SUBDESC
#undef KLOAD
  const float inv = 1.f / l;
#pragma unroll
  for (int dt = 0; dt < 4; ++dt) {
    bf16_t* op = ona + (size_t)(tq0 + fr) * 512 + h * 64 + dt * 16 + fq * 4;
    *(uint2*)op = make_uint2(pk2(O[dt][0] * inv, O[dt][1] * inv), pk2(O[dt][2] * inv, O[dt][3] * inv));
  }
}

constexpr int N_SCAN_ITEMS = 128 + 256, N_ATTN_BLK = 768;
DEV void phase_scan_attn(const Params& p, unsigned char* smem, int* s_item, int rep) {
  unsigned* counter = (unsigned*)(p.ws + OFF_CTL) + rep;
  for (;;) {
    if (threadIdx.x == 0) *s_item = (int)atomicAdd(counter, 1u);
    __syncthreads();
    const int item = *s_item;
    __syncthreads();
    if (item >= N_SCAN_ITEMS + N_ATTN_BLK) break;
    if (item < 128) { const int rem = item & 63; scan_item<4, 1, 3>(p, smem, 16 + (item >> 6), rem >> 3, (rem >> 2) & 1, rem & 3); }
    else if (item >= N_SCAN_ITEMS) attn_wave_item(p, (item - N_SCAN_ITEMS) * 4 + (threadIdx.x >> 6));
    else { const int i2 = item - 128, rem = i2 & 15; scan_item<4, 4, 1>(p, smem, i2 >> 4, rem >> 1, rem & 1, 0); }
  }
}

DEV void phase_finalize_rw(const Params& p, int bid, int nb) {
  const int lane = threadIdx.x & 63, gw = bid * 4 + (threadIdx.x >> 6), nw = nb * 4;
  const float* yf = (const float*)(p.ws + OFF_YF);
  const float* yb = (const float*)(p.ws + OFF_YB);
  const bf16_t* bonus = (const bf16_t*)(p.ws + OFF_BG);
  const bf16_t* gate = (const bf16_t*)(p.ws + OFF_BG + 6291456);
  bf16_t* orw = (bf16_t*)(p.ws + OFF_ORW);
  for (int it = gw; it < NTOK * 8; it += nw) {
    const size_t o = (size_t)it * 64 + lane;
    const int c = (it & 7) * 64 + lane;
    const float y = yf[o] + yb[o];
    const float mean = wave_sum(y) * (1.f / 64.f);
    const float d = y - mean;
    const float var = wave_sum(d * d) * (1.f / 64.f);
    const float yn = d * rsqrtf(var + 64e-5f) * p.in[21][c] + p.in[22][c];
    orw[o] = f2bf((yn + bf2f(bonus[o])) * bf2f(gate[o]));
  }
}

#define XB_TMO      128
#define XB_XCNT(j)  (256  + 64 * (j))
#define XB_XSUB(j)  (1280 + 64 * (j))
#define XB_XGEN(j)  (2304 + 64 * (j))
#define XB_TOP      3328
#define XB_TOPGEN   3392
#define XCD_BAR_WORDS 3456
#define XB_SPIN_CAP (1u << 18)
#define LAS __attribute__((address_space(3)))
DEV unsigned xb_ld(unsigned* p)              { return __hip_atomic_load(p, __ATOMIC_RELAXED, __HIP_MEMORY_SCOPE_AGENT); }
DEV unsigned xb_add(unsigned* p, unsigned v) { return __hip_atomic_fetch_add(p, v, __ATOMIC_RELAXED, __HIP_MEMORY_SCOPE_AGENT); }
DEV unsigned xb_xcc_id() { return (unsigned)__builtin_amdgcn_s_getreg((3 << 11) | 20) & 0xFu; }
#define XB_SPIN(cond, bar) do { unsigned _sp = 0; while (cond) { __builtin_amdgcn_s_sleep(1); \
    if ((++_sp & 255u) == 0u) { if (xb_ld(&(bar)[XB_TMO])) break; if (_sp > XB_SPIN_CAP) { atomicAdd(&(bar)[XB_TMO], 1u); break; } } } } while (0)
struct XcdBarrier { unsigned* bar; unsigned x; volatile LAS unsigned* st; };
DEV XcdBarrier xcd_barrier_post(unsigned* bar, volatile LAS unsigned* st) {
  XcdBarrier b; b.bar = bar; b.x = xb_xcc_id(); b.st = st;
  if (threadIdx.x == 0) (void)xb_add(&bar[XB_XCNT(b.x)], 1u);
  return b;
}
DEV void xcd_barrier_complete(unsigned* bar, unsigned x, unsigned& nloc, unsigned& nx) {
  const unsigned G = gridDim.x * gridDim.y * gridDim.z;
  unsigned sum, cnt, mine, sp = 0u;
  for (;;) {
    sum = 0u; cnt = 0u; mine = 0u;
#pragma unroll
    for (unsigned j = 0; j < 16; ++j) { const unsigned c = xb_ld(&bar[XB_XCNT(j)]); sum += c; cnt += (c > 0u) ? 1u : 0u; mine = (j == x) ? c : mine; }
    if (sum == G) break;
    __builtin_amdgcn_s_sleep(1);
    if ((++sp & 255u) == 0u) { if (xb_ld(&bar[XB_TMO])) break; if (sp > XB_SPIN_CAP) { atomicAdd(&bar[XB_TMO], 1u); break; } }
  }
  nloc = mine > 0u ? mine : 1u; nx = cnt > 0u ? cnt : 1u;
}
DEV void xcd_barrier(const XcdBarrier& b) {
  asm volatile("s_waitcnt vmcnt(0)" ::: "memory");
  __syncthreads();
  if (threadIdx.x == 0) {
    unsigned* bar = b.bar;
    __builtin_amdgcn_s_waitcnt(0);
    unsigned nloc = b.st[0], nx = b.st[1];
    if (nloc == 0u) { xcd_barrier_complete(bar, b.x, nloc, nx); b.st[0] = nloc; b.st[1] = nx; }
    const unsigned old = xb_add(&bar[XB_XSUB(b.x)], 1u);
    const unsigned gen = old / nloc;
    if (old + 1u == (gen + 1u) * nloc) {
      __builtin_amdgcn_fence(__ATOMIC_RELEASE, "agent");
      asm volatile("s_waitcnt vmcnt(0)" ::: "memory");
      const unsigned og = xb_add(&bar[XB_TOP], 1u);
      const unsigned tg = og / nx;
      if (og + 1u == (tg + 1u) * nx) xb_add(&bar[XB_TOPGEN], 1u);
      else XB_SPIN(xb_ld(&bar[XB_TOPGEN]) == tg, bar);
      __builtin_amdgcn_fence(__ATOMIC_ACQUIRE, "agent");
      xb_add(&bar[XB_XGEN(b.x)], 1u);
      asm volatile("s_waitcnt vmcnt(0)" ::: "memory");
    } else {
      XB_SPIN(xb_ld(&bar[XB_XGEN(b.x)]) == gen, bar);
      __builtin_amdgcn_fence(__ATOMIC_ACQUIRE, "agent");
      asm volatile("s_waitcnt vmcnt(0)" ::: "memory");
    }
  }
  __syncthreads();
}

__global__ void __launch_bounds__(NTHR, 2) fwd_megakernel(Params p) {
  extern __shared__ __attribute__((aligned(16))) unsigned char smem[];
  __shared__ __attribute__((aligned(16))) unsigned sh_ctl[8];
  cg::grid_group grid = cg::this_grid();
  const int bid = blockIdx.x, nb = gridDim.x;
  if (threadIdx.x < 8) sh_ctl[threadIdx.x] = 0u;
  __syncthreads();
  const XcdBarrier xb = xcd_barrier_post((unsigned*)(p.ws + OFF_CTL), (volatile LAS unsigned*)sh_ctl);
  int* s_item_p = (int*)&sh_ctl[4];
  if (p.ph_hi > 1000) grid.sync();
#define GSYNC() xcd_barrier(xb)
#ifndef DUP
#define DUP -1
#endif
#define PH(n, body) if (p.ph_lo <= n && n < p.ph_hi) { { const int rep = 0; (void)rep; body; } if (DUP == n) { GSYNC(); const int rep = 1; (void)rep; body; } if (n + 1 < p.ph_hi) GSYNC(); }
  PH(0, phase0(p, smem, bid, nb, rep))
  PH(1, phase_normmod<0>(p, bid, nb))
  PH(2, reset_tiles(s_item_p); phase_gemm_in(p, smem, s_item_p))
  PH(3, phase_prep(p, smem, s_item_p, rep))
  PH(4, phase_scan_attn(p, smem, s_item_p, rep))
  PH(5, phase_finalize_rw(p, bid, nb))
  PH(6, reset_tiles(s_item_p); phase_gemm_merge(p, smem, s_item_p))
  PH(7, reset_tiles(s_item_p); phase_gemm_out(p, smem, s_item_p))
  PH(8, phase_normmod<1>(p, bid, nb))
  PH(9, reset_tiles(s_item_p); phase_gemm_ffn_up(p, smem, s_item_p))
  PH(10, reset_tiles(s_item_p); phase_gemm_ffn_down(p, smem, s_item_p))
}

extern "C" void kernel_launch(void* const* d_in, const int* in_sizes, int n_in, void* d_out, int out_size, void* d_ws, size_t ws_size,
                              hipStream_t stream) {
  static int grid_blocks = 0;
  if (grid_blocks == 0) {
    if (n_in != 32 || ws_size < WS_END) { fprintf(stderr, "kernel_launch: unexpected n_in %d / ws_size %zu (need %zu)\n", n_in, ws_size, (size_t)WS_END); grid_blocks = -1; return; }
    int dev = 0, cus = 0, per_cu = 0;
    hipGetDevice(&dev);
    hipDeviceGetAttribute(&cus, hipDeviceAttributeMultiprocessorCount, dev);
    if (hipFuncSetAttribute((const void*)fwd_megakernel, hipFuncAttributeMaxDynamicSharedMemorySize, LDS_BYTES) != hipSuccess) { fprintf(stderr, "hipFuncSetAttribute failed\n"); grid_blocks = -1; return; }
    if (hipOccupancyMaxActiveBlocksPerMultiprocessor(&per_cu, (const void*)fwd_megakernel, NTHR, LDS_BYTES) != hipSuccess || per_cu < 1) { fprintf(stderr, "occupancy query failed (%d)\n", per_cu); grid_blocks = -1; return; }
    if (per_cu > 2) per_cu = 2;
    grid_blocks = cus * per_cu;
    fprintf(stderr, "kernel_launch: cus %d per_cu %d grid %d\n", cus, per_cu, grid_blocks);
  }
  if (grid_blocks < 0) return;
  hipMemsetAsync((char*)d_ws + OFF_CTL, 0, CTL_ZERO_BYTES, stream);
  Params p{};
  for (int i = 0; i < 32; ++i) p.in[i] = (const float*)d_in[i];
  p.out = (float*)d_out; p.ws = (unsigned char*)d_ws; p.ph_lo = 0; p.ph_hi = 11;
  void* args[] = {&p};
  hipError_t e = hipLaunchCooperativeKernel((const void*)fwd_megakernel, dim3(grid_blocks), dim3(NTHR), args, LDS_BYTES, stream);
  if (e != hipSuccess) fprintf(stderr, "cooperative launch failed: %s (grid %d)\n", hipGetErrorString(e), grid_blocks);
}
```

```cpp
#include <hip/hip_runtime.h>
#include <hip/hip_cooperative_groups.h>
#include <cstdio>
#include <cstdint>
namespace cg = cooperative_groups;

#define DEV __device__ __forceinline__
typedef unsigned short bf16_t;
typedef short bf16x8 __attribute__((ext_vector_type(8)));
typedef short bf16x4 __attribute__((ext_vector_type(4)));
typedef float f32x4 __attribute__((ext_vector_type(4)));

constexpr int D = 1024, NTOK = 6144, NCTX = 4096, RW = 512, FF = 2816, INC = 5504, RWC = 1920;
constexpr int NTHR = 256;
constexpr int LDS_BYTES = 65536;

constexpr size_t OFF_CTL = 0;
constexpr size_t OFF_MOD = 16384;
constexpr size_t CTL_ZERO_BYTES = 16384 + 3 * 6144 * 4;
constexpr size_t OFF_WIN = 90112;
constexpr size_t OFF_WORW = OFF_WIN + 11272192;
constexpr size_t OFF_WONA = OFF_WORW + 1048576;
constexpr size_t OFF_WOUT = OFF_WONA + 1048576;
constexpr size_t OFF_W13 = OFF_WOUT + 2097152;
constexpr size_t OFF_W2 = OFF_W13 + 11534336;
constexpr size_t OFF_H = OFF_W2 + 5767168;
constexpr size_t OFF_URW = OFF_H + 12582912;
constexpr size_t OFF_UNA = OFF_URW + 47185920;
constexpr size_t OFF_OPS = OFF_UNA + 37748736;
constexpr size_t OPS_ARR = 12582912;
constexpr size_t OFF_BG = OFF_OPS + 9 * OPS_ARR;
constexpr size_t OFF_VT = OFF_BG + 12582912;
constexpr size_t OFF_CKB = OFF_VT + 6291456;
constexpr size_t OFF_CVT = OFF_CKB + 524288;
constexpr size_t OFF_LORA = OFF_CVT + 524288;
constexpr size_t WS_END = OFF_LORA + 393216;
constexpr size_t OFF_QB = OFF_H, OFF_KB = OFF_H + 6291456;
constexpr size_t OFF_YF = OFF_URW, OFF_YB = OFF_URW + 12582912;
constexpr size_t OFF_ORW = OFF_UNA, OFF_ONA = OFF_UNA + 6291456;
constexpr size_t OFF_MERGED = OFF_OPS;
constexpr size_t OFF_HID = OFF_URW;
constexpr size_t OUT_STATE = 6291456, OUT_K = 7340032, OUT_V = 9437184;

struct Params {
  const float* in[32];
  float* out;
  unsigned char* ws;
  int ph_lo, ph_hi;
};

DEV unsigned short f2bf(float f) { unsigned u = __float_as_uint(f); u += 0x7fffu + ((u >> 16) & 1u); return (unsigned short)(u >> 16); }
DEV unsigned pk2(float lo, float hi) { return (unsigned)f2bf(lo) | ((unsigned)f2bf(hi) << 16); }
DEV float bf2f(unsigned short b) { return __uint_as_float(((unsigned)b) << 16); }
DEV float sigmoidf_(float x) { return 1.f / (1.f + __expf(-x)); }
DEV float wave_sum(float x) {
#pragma unroll
  for (int o = 32; o > 0; o >>= 1) x += __shfl_xor(x, o);
  return x;
}
template <int CTRL> DEV float dpp_mov(float x) { return __int_as_float(__builtin_amdgcn_update_dpp(0, __float_as_int(x), CTRL, 0xf, 0xf, true)); }
DEV float row16_sum(float x) {
  x += dpp_mov<0xB1>(x); x += dpp_mov<0x4E>(x); x += dpp_mov<0x141>(x); x += dpp_mov<0x140>(x);
  return x;
}
#define BAR_LDS() do { asm volatile("s_waitcnt lgkmcnt(0)" ::: "memory"); __builtin_amdgcn_s_barrier(); asm volatile("" ::: "memory"); } while (0)
DEV const float* xrow(const Params& p, int t) { return t < NCTX ? p.in[0] + (size_t)t * D : p.in[1] + (size_t)(t - NCTX) * D; }
DEV int modidx(int t) { return t < NCTX ? 0 : 1 + ((t - NCTX) >> 10); }

DEV void conv_job(const Params& p, int j, const float*& src, bf16_t*& dst, int& K, int& N, int& mode, int& base) {
  if (j < 1376) { src = p.in[11]; dst = (bf16_t*)(p.ws + OFF_WIN); K = 1024; N = 5504; mode = 0; base = 0; }
  else if (j < 1504) { src = p.in[26]; dst = (bf16_t*)(p.ws + OFF_WORW); K = 512; N = 1024; mode = 0; base = 1376; }
  else if (j < 1632) { src = p.in[27]; dst = (bf16_t*)(p.ws + OFF_WONA); K = 512; N = 1024; mode = 0; base = 1504; }
  else if (j < 1888) { src = p.in[28]; dst = (bf16_t*)(p.ws + OFF_WOUT); K = 1024; N = 1024; mode = 0; base = 1632; }
  else if (j < 2592) { src = p.in[29]; dst = (bf16_t*)(p.ws + OFF_W13); K = 1024; N = 2816; mode = 1; base = 1888; }
  else if (j < 3296) { src = p.in[30]; dst = (bf16_t*)(p.ws + OFF_W13); K = 1024; N = 2816; mode = 2; base = 2592; }
  else if (j < 4000) { src = p.in[31]; dst = (bf16_t*)(p.ws + OFF_W2); K = 2816; N = 1024; mode = 0; base = 3296; }
  else if (j < 4016) { const int e = (j - 4000) >> 3; src = p.in[14] + e * 32768; dst = (bf16_t*)(p.ws + OFF_LORA) + e * 32768; K = 64; N = 512; mode = 0; base = 4000 + e * 8; }
  else if (j < 4032) { const int e = (j - 4016) >> 3; src = p.in[16] + e * 32768; dst = (bf16_t*)(p.ws + OFF_LORA) + 65536 + e * 32768; K = 64; N = 512; mode = 0; base = 4016 + e * 8; }
  else { src = p.in[17]; dst = (bf16_t*)(p.ws + OFF_LORA) + 131072; K = 128; N = 512; mode = 0; base = 4032; }
}
constexpr int N_CONV_TILES = 4048, N_MOD_TILES = 768;

DEV void phase0(const Params& p, unsigned char* smem, int bid, int nb, int rep) {
  const int tid = threadIdx.x;
  float* T = (float*)smem;
  for (int tile = bid; tile < N_MOD_TILES && rep == 0; tile += nb) {
    const int cgp = tile % 24, kc = tile / 24;
    if (tid < 96) {
      const int m = tid >> 5, kk = tid & 31, k = kc * 32 + kk;
      const float c = (m == 0) ? p.in[6][k] : p.in[5][(m - 1) * D + k];
      T[tid] = c * sigmoidf_(c);
    }
    __syncthreads();
    const int col = cgp * 256 + tid;
    const float* w = p.in[9] + (size_t)(kc * 32) * 6144 + col;
    float a0 = 0.f, a1 = 0.f, a2 = 0.f;
#pragma unroll
    for (int kk = 0; kk < 32; ++kk) {
      const float wv = w[(size_t)kk * 6144];
      a0 += T[kk] * wv; a1 += T[32 + kk] * wv; a2 += T[64 + kk] * wv;
    }
    if (kc == 0) { const float b = p.in[10][col]; a0 += b; a1 += b; a2 += b; }
    float* mod = (float*)(p.ws + OFF_MOD);
    atomicAdd(mod + col, a0); atomicAdd(mod + 6144 + col, a1); atomicAdd(mod + 12288 + col, a2);
    __syncthreads();
  }
  const int r_ = tid >> 4, c4_ = tid & 15;
  float4 v[4];
  const float* src; bf16_t* dst; int K, N, mode, base;
  int tile = bid;
  if (tile < N_CONV_TILES) {
    conv_job(p, tile, src, dst, K, N, mode, base);
    const int lt = tile - base, nN = N >> 6, k0 = (lt / nN) * 64, n0 = (lt % nN) * 64;
#pragma unroll
    for (int i = 0; i < 4; ++i) v[i] = *(const float4*)(src + (size_t)(k0 + r_ + 16 * i) * N + n0 + c4_ * 4);
  }
  while (tile < N_CONV_TILES) {
    const int lt = tile - base, nN = N >> 6, k0 = (lt / nN) * 64, n0 = (lt % nN) * 64;
    bf16_t* cdst = dst; const int cK = K, cmode = mode;
#pragma unroll
    for (int i = 0; i < 4; ++i) {
      float* tp = T + (r_ + 16 * i) * 65 + c4_ * 4;
      tp[0] = v[i].x; tp[1] = v[i].y; tp[2] = v[i].z; tp[3] = v[i].w;
    }
    BAR_LDS();
    tile += nb;
    if (tile < N_CONV_TILES) {
      conv_job(p, tile, src, dst, K, N, mode, base);
      const int lt2 = tile - base, nN2 = N >> 6, k2 = (lt2 / nN2) * 64, n2 = (lt2 % nN2) * 64;
#pragma unroll
      for (int i = 0; i < 4; ++i) v[i] = *(const float4*)(src + (size_t)(k2 + r_ + 16 * i) * N + n2 + c4_ * 4);
    }
    const int n = tid >> 2, kp = tid & 3;
    unsigned w[8];
#pragma unroll
    for (int i = 0; i < 8; ++i) w[i] = pk2(T[(kp * 16 + 2 * i) * 65 + n], T[(kp * 16 + 2 * i + 1) * 65 + n]);
    const int ng = n0 + n;
    int drow = ng;
    if (cmode == 1) drow = (ng >> 4) * 32 + (ng & 15);
    else if (cmode == 2) drow = (ng >> 4) * 32 + 16 + (ng & 15);
    uint4* dp = (uint4*)(cdst + (size_t)drow * cK + k0 + kp * 16);
    dp[0] = make_uint4(w[0], w[1], w[2], w[3]);
    dp[1] = make_uint4(w[4], w[5], w[6], w[7]);
    BAR_LDS();
  }
}

template <int WHICH>
DEV void phase_normmod(const Params& p, int bid, int nb) {
  const int lane = threadIdx.x & 63, gw = bid * 4 + (threadIdx.x >> 6), nw = nb * 4;
  const float* g = WHICH == 0 ? p.in[7] : p.in[8];
  const float* mod = (const float*)(p.ws + OFF_MOD);
  const int sh_off = WHICH == 0 ? 0 : 3072, sc_off = WHICH == 0 ? 1024 : 4096;
  bf16_t* dst = (bf16_t*)(p.ws + OFF_H);
#pragma unroll 3
  for (int t = gw; t < NTOK; t += nw) {
    const float* xp = WHICH == 0 ? xrow(p, t) : p.out + (size_t)t * D;
    const float* mm = mod + modidx(t) * 6144;
    float4 v[4];
    float ss = 0.f;
#pragma unroll
    for (int i = 0; i < 4; ++i) {
      v[i] = *(const float4*)(xp + (i * 64 + lane) * 4);
      ss += v[i].x * v[i].x + v[i].y * v[i].y + v[i].z * v[i].z + v[i].w * v[i].w;
    }
    ss = wave_sum(ss);
    const float rstd = rsqrtf(ss * (1.f / 1024.f) + 1e-6f);
#pragma unroll
    for (int i = 0; i < 4; ++i) {
      const int col = (i * 64 + lane) * 4;
      const float4 g4 = *(const float4*)(g + col);
      const float4 sc = *(const float4*)(mm + sc_off + col);
      const float4 sh = *(const float4*)(mm + sh_off + col);
      const float y0 = v[i].x * rstd * g4.x * (1.f + sc.x) + sh.x;
      const float y1 = v[i].y * rstd * g4.y * (1.f + sc.y) + sh.y;
      const float y2 = v[i].z * rstd * g4.z * (1.f + sc.z) + sh.z;
      const float y3 = v[i].w * rstd * g4.w * (1.f + sc.w) + sh.w;
      *(uint2*)(dst + (size_t)t * D + col) = make_uint2(pk2(y0, y1), pk2(y2, y3));
    }
  }
}

template <int MI>
DEV void gemm_tile_acc(f32x4 (&acc)[MI][4], const bf16_t* __restrict__ A, int lda, const bf16_t* __restrict__ Bt, int ldb,
                       int m0, int n0, int K, unsigned char* smem) {
  constexpr int AT = 2 * MI * 16 * 128, BT = 16384, STG = AT + BT;
  const int tid = threadIdx.x, lane = tid & 63, wid = tid >> 6, wr = wid >> 1, wc = wid & 1, fr = lane & 15, fq = lane >> 4;
  const int gkc = (tid & 7) ^ ((tid >> 4) & 7);
  const bf16_t* ga = A + (size_t)(m0 + (tid >> 3)) * lda + gkc * 8;
  const bf16_t* gb = Bt + (size_t)(n0 + (tid >> 3)) * ldb + gkc * 8;
  const int swz = (fr >> 1) & 7;
  const int nk = K >> 6;
#define GLDS_TILE(kt_, buf_) do { unsigned char* sb_ = smem + (buf_) * STG; const int k0_ = (kt_) * 64; \
    _Pragma("unroll") for (int i_ = 0; i_ < (2 * MI * 16) / 32; ++i_) \
      __builtin_amdgcn_global_load_lds((const unsigned*)(ga + (size_t)i_ * 32 * lda + k0_), (__attribute__((address_space(3))) unsigned*)(sb_ + (i_ * 256 + tid) * 16), 16, 0, 0); \
    _Pragma("unroll") for (int i_ = 0; i_ < 4; ++i_) \
      __builtin_amdgcn_global_load_lds((const unsigned*)(gb + (size_t)i_ * 32 * ldb + k0_), (__attribute__((address_space(3))) unsigned*)(sb_ + AT + (i_ * 256 + tid) * 16), 16, 0, 0); \
  } while (0)
  GLDS_TILE(0, 0);
  asm volatile("s_waitcnt vmcnt(0)" ::: "memory");
  __syncthreads();
  for (int kt = 0; kt < nk; ++kt) {
    if (kt + 1 < nk) GLDS_TILE(kt + 1, (kt + 1) & 1);
    const unsigned char* cur = smem + (kt & 1) * STG;
#pragma unroll
    for (int ks = 0; ks < 2; ++ks) {
      bf16x8 af[MI], bf[4];
      const int co = ((ks * 4 + fq) ^ swz) << 4;
#pragma unroll
      for (int mi = 0; mi < MI; ++mi) af[mi] = *(const bf16x8*)(cur + (wr * MI * 16 + mi * 16 + fr) * 128 + co);
#pragma unroll
      for (int ni = 0; ni < 4; ++ni) bf[ni] = *(const bf16x8*)(cur + AT + (wc * 64 + ni * 16 + fr) * 128 + co);
      __builtin_amdgcn_s_setprio(1);
#pragma unroll
      for (int mi = 0; mi < MI; ++mi)
#pragma unroll
        for (int ni = 0; ni < 4; ++ni) acc[mi][ni] = __builtin_amdgcn_mfma_f32_16x16x32_bf16(bf[ni], af[mi], acc[mi][ni], 0, 0, 0);
      __builtin_amdgcn_s_setprio(0);
    }
    asm volatile("s_waitcnt vmcnt(0)" ::: "memory");
    __syncthreads();
  }
#undef GLDS_TILE
}

template <int MI>
DEV void zero_acc(f32x4 (&acc)[MI][4]) {
#pragma unroll
  for (int i = 0; i < MI; ++i)
#pragma unroll
    for (int j = 0; j < 4; ++j) acc[i][j] = (f32x4){0.f, 0.f, 0.f, 0.f};
}

#ifndef DYN_TILES
#define DYN_TILES 0
#endif
DEV int grab_tile(const Params& p, int word, int* slot) {
#if DYN_TILES
  if (threadIdx.x == 0) *slot = (int)atomicAdd((unsigned*)(p.ws + OFF_CTL) + word, 1u);
  __syncthreads();
  const int t = *slot;
  __syncthreads();
  return t;
#else
  const int t = slot[1];
  __syncthreads();
  if (threadIdx.x == 0) slot[1] = t + gridDim.x;
  __syncthreads();
  return t;
#endif
}
DEV void reset_tiles(int* slot) { if (threadIdx.x == 0) slot[1] = blockIdx.x; __syncthreads(); }

#define EPI_COORDS const int lane = threadIdx.x & 63, wid = threadIdx.x >> 6, wr = wid >> 1, wc = wid & 1, fr = lane & 15, fq = lane >> 4

DEV void phase_gemm_in(const Params& p, unsigned char* smem, int* slot) {
  EPI_COORDS;
  const bf16_t* A = (const bf16_t*)(p.ws + OFF_H);
  const bf16_t* Bt = (const bf16_t*)(p.ws + OFF_WIN);
  float* urw = (float*)(p.ws + OFF_URW);
  float* una = (float*)(p.ws + OFF_UNA);
  bf16_t* gates = (bf16_t*)p.out;
  for (;;) {
    const int tile = grab_tile(p, 8, slot);
    if (tile >= 48 * 43) break;
    const int tm = tile % 48, tn = tile / 48, m0 = tm * 128, n0 = tn * 128;
    f32x4 acc[4][4];
    zero_acc<4>(acc);
    gemm_tile_acc<4>(acc, A, D, Bt, D, m0, n0, D, smem);
#pragma unroll
    for (int mi = 0; mi < 4; ++mi) {
      const int row = m0 + wr * 64 + mi * 16 + fr;
#pragma unroll
      for (int ni = 0; ni < 4; ++ni) {
        const int col = n0 + wc * 64 + ni * 16 + fq * 4;
        const f32x4 v = acc[mi][ni];
        if (n0 < 1920) *(f32x4*)(urw + (size_t)row * 1920 + col) = v;
        else if (n0 < 3456) *(f32x4*)(una + (size_t)row * 1536 + (col - 1920)) = v;
        else *(uint2*)(gates + (size_t)row * 2048 + (col - 3456)) = make_uint2(pk2(sigmoidf_(v[0]), sigmoidf_(v[1])), pk2(sigmoidf_(v[2]), sigmoidf_(v[3])));
      }
    }
  }
}

DEV void phase_gemm_merge(const Params& p, unsigned char* smem, int* slot) {
  EPI_COORDS;
  const bf16_t* orw = (const bf16_t*)(p.ws + OFF_ORW);
  const bf16_t* ona = (const bf16_t*)(p.ws + OFF_ONA);
  const bf16_t* w1 = (const bf16_t*)(p.ws + OFF_WORW);
  const bf16_t* w2 = (const bf16_t*)(p.ws + OFF_WONA);
  const bf16_t* gates = (const bf16_t*)p.out;
  bf16_t* merged = (bf16_t*)(p.ws + OFF_MERGED);
  float* mtmp = (float*)(p.ws + OFF_MERGED + 16777216);
  for (;;) {
    const int tile = grab_tile(p, 9, slot);
    if (tile >= 64 * 8) break;
    const int tm = tile % 64, tn = tile / 64, m0 = tm * 96, n0 = tn * 128;
    f32x4 acc[3][4];
    zero_acc<3>(acc);
    gemm_tile_acc<3>(acc, orw, RW, w1, RW, m0, n0, RW, smem);
#pragma unroll
    for (int mi = 0; mi < 3; ++mi) {
      const int row = m0 + wr * 48 + mi * 16 + fr;
#pragma unroll
      for (int ni = 0; ni < 4; ++ni) {
        const int col = n0 + wc * 64 + ni * 16 + fq * 4;
        const uint2 g = *(const uint2*)(gates + (size_t)row * 2048 + col);
        f32x4 r;
        r[0] = acc[mi][ni][0] * bf2f((unsigned short)(g.x & 0xffff));
        r[1] = acc[mi][ni][1] * bf2f((unsigned short)(g.x >> 16));
        r[2] = acc[mi][ni][2] * bf2f((unsigned short)(g.y & 0xffff));
        r[3] = acc[mi][ni][3] * bf2f((unsigned short)(g.y >> 16));
        *(f32x4*)(mtmp + (size_t)row * D + col) = r;
      }
    }
    zero_acc<3>(acc);
    gemm_tile_acc<3>(acc, ona, RW, w2, RW, m0, n0, RW, smem);
#pragma unroll
    for (int mi = 0; mi < 3; ++mi) {
      const int row = m0 + wr * 48 + mi * 16 + fr;
#pragma unroll
      for (int ni = 0; ni < 4; ++ni) {
        const int col = n0 + wc * 64 + ni * 16 + fq * 4;
        const uint2 g = *(const uint2*)(gates + (size_t)row * 2048 + 1024 + col);
        const f32x4 mg = *(const f32x4*)(mtmp + (size_t)row * D + col);
        const float r0 = mg[0] + acc[mi][ni][0] * bf2f((unsigned short)(g.x & 0xffff));
        const float r1 = mg[1] + acc[mi][ni][1] * bf2f((unsigned short)(g.x >> 16));
        const float r2 = mg[2] + acc[mi][ni][2] * bf2f((unsigned short)(g.y & 0xffff));
        const float r3 = mg[3] + acc[mi][ni][3] * bf2f((unsigned short)(g.y >> 16));
        *(uint2*)(merged + (size_t)row * D + col) = make_uint2(pk2(r0, r1), pk2(r2, r3));
      }
    }
  }
}

DEV void phase_gemm_out(const Params& p, unsigned char* smem, int* slot) {
  EPI_COORDS;
  const bf16_t* A = (const bf16_t*)(p.ws + OFF_MERGED);
  const bf16_t* Bt = (const bf16_t*)(p.ws + OFF_WOUT);
  const float* mod = (const float*)(p.ws + OFF_MOD);
  for (;;) {
    const int tile = grab_tile(p, 10, slot);
    if (tile >= 64 * 8) break;
    const int tm = tile % 64, tn = tile / 64, m0 = tm * 96, n0 = tn * 128;
    f32x4 acc[3][4];
    zero_acc<3>(acc);
    gemm_tile_acc<3>(acc, A, D, Bt, D, m0, n0, D, smem);
#pragma unroll
    for (int mi = 0; mi < 3; ++mi) {
      const int row = m0 + wr * 48 + mi * 16 + fr;
      const float* xp = xrow(p, row);
      const float* g1 = mod + modidx(row) * 6144 + 2048;
#pragma unroll
      for (int ni = 0; ni < 4; ++ni) {
        const int col = n0 + wc * 64 + ni * 16 + fq * 4;
        const f32x4 x = *(const f32x4*)(xp + col);
        const f32x4 g = *(const f32x4*)(g1 + col);
        *(f32x4*)(p.out + (size_t)row * D + col) = x + g * acc[mi][ni];
      }
    }
  }
}

DEV void phase_gemm_ffn_up(const Params& p, unsigned char* smem, int* slot) {
  EPI_COORDS;
  const bf16_t* A = (const bf16_t*)(p.ws + OFF_H);
  const bf16_t* Bt = (const bf16_t*)(p.ws + OFF_W13);
  bf16_t* hid = (bf16_t*)(p.ws + OFF_HID);
  for (;;) {
    const int tile = grab_tile(p, 11, slot);
    if (tile >= 48 * 44) break;
    const int tm = tile % 48, tn = tile / 48, m0 = tm * 128, n0 = tn * 128;
    f32x4 acc[4][4];
    zero_acc<4>(acc);
    gemm_tile_acc<4>(acc, A, D, Bt, D, m0, n0, D, smem);
#pragma unroll
    for (int mi = 0; mi < 4; ++mi) {
      const int row = m0 + wr * 64 + mi * 16 + fr;
#pragma unroll
      for (int gp = 0; gp < 2; ++gp) {
        const int hcol = ((n0 + wc * 64) >> 1) + gp * 16 + fq * 4;
        const f32x4 a = acc[mi][2 * gp], b = acc[mi][2 * gp + 1];
        float r[4];
#pragma unroll
        for (int e = 0; e < 4; ++e) r[e] = a[e] * sigmoidf_(a[e]) * b[e];
        *(uint2*)(hid + (size_t)row * FF + hcol) = make_uint2(pk2(r[0], r[1]), pk2(r[2], r[3]));
      }
    }
  }
}

DEV void phase_gemm_ffn_down(const Params& p, unsigned char* smem, int* slot) {
  EPI_COORDS;
  const bf16_t* A = (const bf16_t*)(p.ws + OFF_HID);
  const bf16_t* Bt = (const bf16_t*)(p.ws + OFF_W2);
  const float* mod = (const float*)(p.ws + OFF_MOD);
  for (;;) {
    const int tile = grab_tile(p, 12, slot);
    if (tile >= 64 * 8) break;
    const int tm = tile % 64, tn = tile / 64, m0 = tm * 96, n0 = tn * 128;
    f32x4 acc[3][4];
    zero_acc<3>(acc);
    gemm_tile_acc<3>(acc, A, FF, Bt, FF, m0, n0, FF, smem);
#pragma unroll
    for (int mi = 0; mi < 3; ++mi) {
      const int row = m0 + wr * 48 + mi * 16 + fr;
      const float* g2 = mod + modidx(row) * 6144 + 5120;
#pragma unroll
      for (int ni = 0; ni < 4; ++ni) {
        const int col = n0 + wc * 64 + ni * 16 + fq * 4;
        float* op = p.out + (size_t)row * D + col;
        const f32x4 x = *(const f32x4*)op;
        const f32x4 g = *(const f32x4*)(g2 + col);
        *(f32x4*)op = x + g * acc[mi][ni];
      }
    }
  }
}

DEV void phase_qkprep(const Params& p, unsigned char* smem, int item_) {
  const int tid = threadIdx.x;
  bf16_t* Vs = (bf16_t*)smem;
  bf16_t* qb = (bf16_t*)(p.ws + OFF_QB);
  bf16_t* kb = (bf16_t*)(p.ws + OFF_KB);
  bf16_t* vT = (bf16_t*)(p.ws + OFF_VT);
  bf16_t* ckb = (bf16_t*)(p.ws + OFF_CKB);
  bf16_t* cvT = (bf16_t*)(p.ws + OFF_CVT);
  const float* una = (const float*)(p.ws + OFF_UNA);
  const int tok = tid >> 2, part = tid & 3;
  for (int item = item_; item < item_ + 1; ++item) {
    if (item < 768) {
      const int tt = item >> 3, h = item & 7, t0 = tt * 64, t = t0 + tok;
      const float* src = una + (size_t)t * 1536 + h * 64 + part * 16;
      {
        float x[16]; float ss = 0.f;
#pragma unroll
        for (int i = 0; i < 4; ++i) { const float4 v = *(const float4*)(src + i * 4); x[4 * i] = v.x; x[4 * i + 1] = v.y; x[4 * i + 2] = v.z; x[4 * i + 3] = v.w; }
#pragma unroll
        for (int i = 0; i < 16; ++i) ss += x[i] * x[i];
        ss += __shfl_xor(ss, 1); ss += __shfl_xor(ss, 2);
        const float rs = rsqrtf(ss * (1.f / 64.f) + 1e-6f) * 0.125f;
        unsigned w[8];
#pragma unroll
        for (int i = 0; i < 8; ++i) w[i] = pk2(x[2 * i] * rs * p.in[23][part * 16 + 2 * i], x[2 * i + 1] * rs * p.in[23][part * 16 + 2 * i + 1]);
        uint4* dp = (uint4*)(qb + (size_t)t * 512 + h * 64 + part * 16);
        dp[0] = make_uint4(w[0], w[1], w[2], w[3]); dp[1] = make_uint4(w[4], w[5], w[6], w[7]);
      }
      {
        float x[16]; float ss = 0.f;
#pragma unroll
        for (int i = 0; i < 4; ++i) { const float4 v = *(const float4*)(src + 512 + i * 4); x[4 * i] = v.x; x[4 * i + 1] = v.y; x[4 * i + 2] = v.z; x[4 * i + 3] = v.w; }
#pragma unroll
        for (int i = 0; i < 16; ++i) ss += x[i] * x[i];
        ss += __shfl_xor(ss, 1); ss += __shfl_xor(ss, 2);
        const float rs = rsqrtf(ss * (1.f / 64.f) + 1e-6f);
#pragma unroll
        for (int i = 0; i < 16; ++i) x[i] = x[i] * rs * p.in[24][part * 16 + i];
        if (t < NCTX) {
          float4* op = (float4*)(p.out + OUT_K + (size_t)t * 512 + h * 64 + part * 16);
#pragma unroll
          for (int i = 0; i < 4; ++i) op[i] = make_float4(x[4 * i], x[4 * i + 1], x[4 * i + 2], x[4 * i + 3]);
        }
        unsigned w[8];
#pragma unroll
        for (int i = 0; i < 8; ++i) w[i] = pk2(x[2 * i], x[2 * i + 1]);
        uint4* dp = (uint4*)(kb + (size_t)t * 512 + h * 64 + part * 16);
        dp[0] = make_uint4(w[0], w[1], w[2], w[3]); dp[1] = make_uint4(w[4], w[5], w[6], w[7]);
      }
      {
        float x[16];
#pragma unroll
        for (int i = 0; i < 4; ++i) { const float4 v = *(const float4*)(src + 1024 + i * 4); x[4 * i] = v.x; x[4 * i + 1] = v.y; x[4 * i + 2] = v.z; x[4 * i + 3] = v.w; }
        if (t < NCTX) {
          float4* op = (float4*)(p.out + OUT_V + (size_t)t * 512 + h * 64 + part * 16);
#pragma unroll
          for (int i = 0; i < 4; ++i) op[i] = make_float4(x[4 * i], x[4 * i + 1], x[4 * i + 2], x[4 * i + 3]);
        }
#pragma unroll
        for (int i = 0; i < 16; ++i) Vs[tok * 72 + part * 16 + i] = f2bf(x[i]);
      }
      __syncthreads();
      {
        const int d = tid >> 2;
        unsigned w[8];
#pragma unroll
        for (int i = 0; i < 8; ++i) w[i] = (unsigned)Vs[(part * 16 + 2 * i) * 72 + d] | ((unsigned)Vs[(part * 16 + 2 * i + 1) * 72 + d] << 16);
        uint4* dp = (uint4*)(vT + (size_t)(h * 64 + d) * NTOK + t0 + part * 16);
        dp[0] = make_uint4(w[0], w[1], w[2], w[3]); dp[1] = make_uint4(w[4], w[5], w[6], w[7]);
      }
      __syncthreads();
    } else {
      const int ci = item - 768, b = ci >> 5, rem = ci & 31, tt = rem >> 3, h = rem & 7, t0 = tt * 64, t = t0 + tok;
      const size_t sidx = (size_t)(b * 256 + t) * 512 + h * 64 + part * 16;
      {
        float x[16];
#pragma unroll
        for (int i = 0; i < 4; ++i) { const float4 v = *(const float4*)(p.in[3] + sidx + i * 4); x[4 * i] = v.x; x[4 * i + 1] = v.y; x[4 * i + 2] = v.z; x[4 * i + 3] = v.w; }
        unsigned w[8];
#pragma unroll
        for (int i = 0; i < 8; ++i) w[i] = pk2(x[2 * i], x[2 * i + 1]);
        uint4* dp = (uint4*)(ckb + sidx);
        dp[0] = make_uint4(w[0], w[1], w[2], w[3]); dp[1] = make_uint4(w[4], w[5], w[6], w[7]);
      }
      {
        float x[16];
#pragma unroll
        for (int i = 0; i < 4; ++i) { const float4 v = *(const float4*)(p.in[4] + sidx + i * 4); x[4 * i] = v.x; x[4 * i + 1] = v.y; x[4 * i + 2] = v.z; x[4 * i + 3] = v.w; }
#pragma unroll
        for (int i = 0; i < 16; ++i) Vs[tok * 72 + part * 16 + i] = f2bf(x[i]);
      }
      __syncthreads();
      {
        const int d = tid >> 2;
        unsigned w[8];
#pragma unroll
        for (int i = 0; i < 8; ++i) w[i] = (unsigned)Vs[(part * 16 + 2 * i) * 72 + d] | ((unsigned)Vs[(part * 16 + 2 * i + 1) * 72 + d] << 16);
        uint4* dp = (uint4*)(cvT + (size_t)((b * 8 + h) * 64 + d) * 256 + t0 + part * 16);
        dp[0] = make_uint4(w[0], w[1], w[2], w[3]); dp[1] = make_uint4(w[4], w[5], w[6], w[7]);
      }
      __syncthreads();
    }
  }
}

DEV float* ops_arr(const Params& p, int i) { return (float*)(p.ws + OFF_OPS + (size_t)i * OPS_ARR); }

DEV f32x4 shiftvec(f32x4 cur, f32x4 hal, f32x4 mu0, f32x4 mu1, int fr) {
  f32x4 prev, next;
#pragma unroll
  for (int i = 0; i < 4; ++i) {
    prev[i] = dpp_mov<0x111>(cur[i]);
    next[i] = dpp_mov<0x101>(cur[i]);
  }
  if (fr == 0) prev = hal;
  if (fr == 15) next = hal;
  return cur + mu0 * (prev - cur) + mu1 * (next - cur);
}
DEV float quad_sum(float x) { x += __shfl_xor(x, 16); x += __shfl_xor(x, 32); return x; }
DEV f32x4 ld4(const float* p) { return *(const f32x4*)p; }

constexpr int LROWB = 392;
DEV void phase_rwprep(const Params& p, unsigned char* smem, int item_) {
  const int tid = threadIdx.x, lane = tid & 63, w = tid >> 6, fr = lane & 15, fq = lane >> 4;
  bf16_t* Lb = (bf16_t*)smem;
  const float* urw = (const float*)(p.ws + OFF_URW);
  const float* mu = p.in[12];
  bf16_t* bonus = (bf16_t*)(p.ws + OFF_BG);
  bf16_t* gate = (bf16_t*)(p.ws + OFF_BG + 6291456);
  const bf16_t* WUPT = (const bf16_t*)(p.ws + OFF_LORA);
  const bf16_t* AUPT = WUPT + 65536;
  const bf16_t* GUPT = WUPT + 131072;
  float* o_r = ops_arr(p, 0); float* o_v = ops_arr(p, 1); float* o_a = ops_arr(p, 2);
  for (int item = item_; item < item_ + 1; ++item) {
    const int t0 = (item >> 1) * 16, h = (item & 1) * 4 + w;
    int s_lo, s_hi;
    if (t0 < NCTX) { s_lo = t0 & ~255; s_hi = s_lo + 256; } else { s_lo = NCTX + ((t0 - NCTX) & ~1023); s_hi = s_lo + 1024; }
#pragma unroll 8
    for (int e = tid; e < 6144; e += NTHR) {
      const int cc = e % 384, tl = e / 384, col = 1536 + cc, t = t0 + tl;
      const float* up = urw + (size_t)t * RWC + col;
      const float uc = up[0];
      const float upv = (t > s_lo) ? up[-RWC] : 0.f;
      const float unx = (t + 1 < s_hi) ? up[RWC] : 0.f;
      const float us = uc + mu[col] * (upv - uc) + mu[RWC + col] * (unx - uc);
      const int kind = cc >> 7;
      const float val = kind == 0 ? (1.f - 2.f / (1.f + __expf(2.f * us))) : (kind == 1 ? us : sigmoidf_(us));
      Lb[tl * LROWB + cc] = f2bf(val);
    }
    __syncthreads();
    const int t = t0 + fr;
    const bool lo_ok = (fr == 0) && (t > s_lo), hi_ok = (fr == 15) && (t + 1 < s_hi);
    const float* urow = urw + (size_t)t * RWC;
    const float* hrow = lo_ok ? urow - RWC : (hi_ok ? urow + RWC : urow);
    const bool hal_ok = lo_ok || hi_ok;
    const f32x4 z4 = (f32x4){0.f, 0.f, 0.f, 0.f};
    float ss = 0.f;
#pragma unroll
    for (int ni = 0; ni < 4; ++ni) {
      const int c = h * 64 + ni * 16 + fq * 4;
      const f32x4 kx = shiftvec(ld4(urow + 512 + c), hal_ok ? ld4(hrow + 512 + c) : z4, ld4(mu + 512 + c), ld4(mu + RWC + 512 + c), fr) * ld4(p.in[18] + c);
      ss += kx[0] * kx[0] + kx[1] * kx[1] + kx[2] * kx[2] + kx[3] * kx[3];
    }
    ss = quad_sum(ss);
    const float rn = rsqrtf(ss + 1e-12f);
    float bs = 0.f;
#pragma unroll 1
    for (int ni = 0; ni < 4; ++ni) {
      const int c = h * 64 + ni * 16 + fq * 4;
      const size_t o = (size_t)t * 512 + c;
      const f32x4 r4 = shiftvec(ld4(urow + c), hal_ok ? ld4(hrow + c) : z4, ld4(mu + c), ld4(mu + RWC + c), fr);
      const f32x4 k4 = shiftvec(ld4(urow + 512 + c), hal_ok ? ld4(hrow + 512 + c) : z4, ld4(mu + 512 + c), ld4(mu + RWC + 512 + c), fr);
      const f32x4 v4 = shiftvec(ld4(urow + 1024 + c), hal_ok ? ld4(hrow + 1024 + c) : z4, ld4(mu + 1024 + c), ld4(mu + RWC + 1024 + c), fr);
      const f32x4 kk4 = k4 * ld4(p.in[18] + c) * rn;
      *(f32x4*)(o_r + o) = r4; *(f32x4*)(o_v + o) = v4; *(f32x4*)(o_a + o) = -kk4;
      const f32x4 ka = ld4(p.in[19] + c);
      f32x4 bacc = z4;
#pragma unroll
      for (int e = 0; e < 2; ++e) {
        float* o_k = ops_arr(p, 5 + e); float* o_b = ops_arr(p, 7 + e); float* o_w = ops_arr(p, 3 + e);
        f32x4 acc = z4, acw = z4;
#pragma unroll
        for (int ks = 0; ks < 2; ++ks) {
          const bf16x8 wa = *(const bf16x8*)(AUPT + (size_t)(e * 512 + h * 64 + ni * 16 + fr) * 64 + ks * 32 + fq * 8);
          const bf16x8 la = *(const bf16x8*)(Lb + fr * LROWB + 128 + e * 64 + ks * 32 + fq * 8);
          acc = __builtin_amdgcn_mfma_f32_16x16x32_bf16(wa, la, acc, 0, 0, 0);
          const bf16x8 ww = *(const bf16x8*)(WUPT + (size_t)(e * 512 + h * 64 + ni * 16 + fr) * 64 + ks * 32 + fq * 8);
          const bf16x8 lw = *(const bf16x8*)(Lb + fr * LROWB + e * 64 + ks * 32 + fq * 8);
          acw = __builtin_amdgcn_mfma_f32_16x16x32_bf16(ww, lw, acw, 0, 0, 0);
        }
        const f32x4 a0 = ld4(p.in[15] + e * 512 + c), w0 = ld4(p.in[13] + e * 512 + c);
        f32x4 kd, bb, dec;
#pragma unroll
        for (int i = 0; i < 4; ++i) {
          const float ic = sigmoidf_(a0[i] + acc[i]);
          kd[i] = k4[i] * (1.f + (ic - 1.f) * ka[i]);
          bb[i] = kk4[i] * ic;
          const float z = w0[i] + acw[i];
          const float sp = fmaxf(-z, 0.f) + __logf(1.f + __expf(-fabsf(z)));
          dec[i] = __expf(-__expf(-sp - 0.5f));
        }
        bacc += kd;
        *(f32x4*)(o_k + o) = kd; *(f32x4*)(o_b + o) = bb; *(f32x4*)(o_w + o) = dec;
      }
      const f32x4 rk = ld4(p.in[20] + c);
#pragma unroll
      for (int i = 0; i < 4; ++i) bs += r4[i] * 0.5f * bacc[i] * rk[i];
      f32x4 acc = z4;
#pragma unroll
      for (int ks = 0; ks < 4; ++ks) {
        const bf16x8 wg = *(const bf16x8*)(GUPT + (size_t)(h * 64 + ni * 16 + fr) * 128 + ks * 32 + fq * 8);
        const bf16x8 lg = *(const bf16x8*)(Lb + fr * LROWB + 256 + ks * 32 + fq * 8);
        acc = __builtin_amdgcn_mfma_f32_16x16x32_bf16(wg, lg, acc, 0, 0, 0);
      }
      *(uint2*)(gate + o) = make_uint2(pk2(acc[0], acc[1]), pk2(acc[2], acc[3]));
    }
    bs = quad_sum(bs);
#pragma unroll
    for (int ni = 0; ni < 4; ++ni) {
      const size_t o = (size_t)t * 512 + h * 64 + ni * 16 + fq * 4;
      const f32x4 v4 = *(const f32x4*)(o_v + o);
      *(uint2*)(bonus + o) = make_uint2(pk2(bs * v4[0], bs * v4[1]), pk2(bs * v4[2], bs * v4[3]));
    }
    __syncthreads();
  }
}

DEV void phase_prep(const Params& p, unsigned char* smem, int* s_item, int rep) {
  unsigned* counter = (unsigned*)(p.ws + OFF_CTL) + 16 + rep;
  for (;;) {
    if (threadIdx.x == 0) *s_item = (int)atomicAdd(counter, 1u);
    __syncthreads();
    const int item = *s_item;
    __syncthreads();
    if (item >= 768 + 832) break;
    if (item < 768) phase_rwprep(p, smem, item);
    else phase_qkprep(p, smem, item - 768);
  }
}

constexpr int TC = 16;
typedef float f32x2 __attribute__((ext_vector_type(2)));
template <int EPL, int R, int PD>
DEV void scan_item(const Params& p, unsigned char* smem, int seq, int h, int dir, int rg) {
  constexpr int LPR = 64 / EPL, RPW = 64 / LPR, RPB = 4 * RPW * R, NV = RPB / 16, NP = EPL / 2;
  constexpr int STG = 20480 + 16 * RPB * 4, YOFF = 2 * STG, YSZ = 16 * RPB * 4;
  const int tid = threadIdx.x, lane = tid & 63, w = tid >> 6, riw = lane / LPR, kq = lane % LPR;
  const int T = seq < 16 ? 256 : 1024;
  const int tok0 = seq < 16 ? seq * 256 : NCTX + (seq - 16) * 1024;
  const int vrow_l = (w * RPW + riw) * R;
  const int vrow = rg * RPB + vrow_l;
  f32x2 S[R][NP];
#pragma unroll
  for (int rr = 0; rr < R; ++rr) {
    if (seq >= 16) {
      const float* sp = p.in[2] + ((size_t)(((seq - 16) * 2 + dir) * 8 + h) * 64 + vrow + rr) * 64 + kq * EPL;
#pragma unroll
      for (int i = 0; i < NP; ++i) S[rr][i] = *(const f32x2*)(sp + 2 * i);
    } else {
#pragma unroll
      for (int i = 0; i < NP; ++i) S[rr][i] = (f32x2){0.f, 0.f};
    }
  }
  const int lstep = tid >> 4, l16 = tid & 15;
  const float* pr = ops_arr(p, 0) + h * 64 + l16 * 4;
  const float* pw = ops_arr(p, 3 + dir) + h * 64 + l16 * 4;
  const float* pk = ops_arr(p, 5 + dir) + h * 64 + l16 * 4;
  const float* pa = ops_arr(p, 2) + h * 64 + l16 * 4;
  const float* pb = ops_arr(p, 7 + dir) + h * 64 + l16 * 4;
  const float* pv = ops_arr(p, 1) + h * 64 + rg * RPB + l16;
  float* yout = (float*)(p.ws + (dir ? OFF_YB : OFF_YF)) + h * 64 + rg * RPB + l16;
  const int nc = T / TC;
  float4 g_r, g_w, g_k, g_a, g_b; float rv[NV];
#define gload(c) do { const int ts_ = (c) * TC + lstep; const size_t t_ = (size_t)(tok0 + (dir ? T - 1 - ts_ : ts_)) * 512; \
    g_r = *(const float4*)(pr + t_); g_w = *(const float4*)(pw + t_); g_k = *(const float4*)(pk + t_); \
    g_a = *(const float4*)(pa + t_); g_b = *(const float4*)(pb + t_); \
    _Pragma("unroll") for (int q_ = 0; q_ < NV; ++q_) rv[q_] = pv[t_ + 16 * q_]; } while (0)
#define ywrite(c) do { const float* yb_ = (const float*)(smem + YOFF + ((c) & 1) * YSZ); const int ts_ = (c) * TC + lstep; \
    const size_t t_ = (size_t)(tok0 + (dir ? T - 1 - ts_ : ts_)) * 512; \
    _Pragma("unroll") for (int q_ = 0; q_ < NV; ++q_) yout[t_ + 16 * q_] = yb_[lstep * RPB + l16 + 16 * q_]; } while (0)
  gload(0);
  for (int c = 0; c < nc; ++c) {
    unsigned char* st = smem + (c & 1) * STG;
    *(float4*)(st + 0 * 4096 + lstep * 256 + l16 * 16) = g_r;
    *(float4*)(st + 1 * 4096 + lstep * 256 + l16 * 16) = g_w;
    *(float4*)(st + 2 * 4096 + lstep * 256 + l16 * 16) = g_k;
    *(float4*)(st + 3 * 4096 + lstep * 256 + l16 * 16) = g_a;
    *(float4*)(st + 4 * 4096 + lstep * 256 + l16 * 16) = g_b;
#pragma unroll
    for (int q = 0; q < NV; ++q) *(float*)(st + 20480 + (lstep * RPB + l16 + 16 * q) * 4) = rv[q];
    __syncthreads();
    if (c > 0) ywrite(c - 1);
    if (c + 1 < nc) gload(c + 1);
    float* ybw = (float*)(smem + YOFF + (c & 1) * YSZ);
    constexpr int NS = PD + 1;
    f32x2 o_r[NS][NP], o_w[NS][NP], o_k[NS][NP], o_a[NS][NP], o_b[NS][NP]; float o_v[NS][R];
    float ykeep[R][TC / LPR];
#define LDOPS(bi, s_) do { \
      _Pragma("unroll") for (int i_ = 0; i_ < NP; ++i_) { \
        o_r[bi][i_] = *(const f32x2*)(st + 0 * 4096 + (s_) * 256 + kq * EPL * 4 + i_ * 8); \
        o_w[bi][i_] = *(const f32x2*)(st + 1 * 4096 + (s_) * 256 + kq * EPL * 4 + i_ * 8); \
        o_k[bi][i_] = *(const f32x2*)(st + 2 * 4096 + (s_) * 256 + kq * EPL * 4 + i_ * 8); \
        o_a[bi][i_] = *(const f32x2*)(st + 3 * 4096 + (s_) * 256 + kq * EPL * 4 + i_ * 8); \
        o_b[bi][i_] = *(const f32x2*)(st + 4 * 4096 + (s_) * 256 + kq * EPL * 4 + i_ * 8); } \
      _Pragma("unroll") for (int rr_ = 0; rr_ < R; ++rr_) o_v[bi][rr_] = *(const float*)(st + 20480 + ((s_) * RPB + vrow_l + rr_) * 4); } while (0)
#pragma unroll
    for (int s = 0; s < PD; ++s) LDOPS(s, s);
#pragma unroll
    for (int s = 0; s < TC; ++s) {
      const int bi = s % NS;
      if (s + PD < TC) LDOPS((s + PD) % NS, s + PD);
#pragma unroll
      for (int rr = 0; rr < R; ++rr) {
        const f32x2 vv2 = (f32x2){o_v[bi][rr], o_v[bi][rr]};
        f32x2 pa2 = S[rr][0] * o_a[bi][0];
        f32x2 tt[NP];
        tt[0] = S[rr][0] * o_w[bi][0] + vv2 * o_k[bi][0];
#pragma unroll
        for (int i = 1; i < NP; ++i) { pa2 += S[rr][i] * o_a[bi][i]; tt[i] = S[rr][i] * o_w[bi][i] + vv2 * o_k[bi][i]; }
        float sa = pa2[0] + pa2[1];
        sa += dpp_mov<0xB1>(sa); sa += dpp_mov<0x4E>(sa); sa += dpp_mov<0x141>(sa);
        if (LPR == 16) sa += dpp_mov<0x140>(sa);
        const f32x2 sa2 = (f32x2){sa, sa};
        f32x2 py = (f32x2){0.f, 0.f};
#pragma unroll
        for (int i = 0; i < NP; ++i) { S[rr][i] = sa2 * o_b[bi][i] + tt[i]; py += S[rr][i] * o_r[bi][i]; }
        float y = py[0] + py[1];
        y += dpp_mov<0xB1>(y); y += dpp_mov<0x4E>(y); y += dpp_mov<0x141>(y);
        if (LPR == 16) y += dpp_mov<0x140>(y);
        if ((s % LPR) == 0) ykeep[rr][s / LPR] = y; else ykeep[rr][s / LPR] = (kq == (s % LPR)) ? y : ykeep[rr][s / LPR];
      }
    }
#undef LDOPS
#pragma unroll
    for (int rr = 0; rr < R; ++rr)
#pragma unroll
      for (int q = 0; q < TC / LPR; ++q) ybw[(q * LPR + kq) * RPB + vrow_l + rr] = ykeep[rr][q];
  }
  __syncthreads();
  ywrite(nc - 1);
  if (seq < 16) {
#pragma unroll
    for (int rr = 0; rr < R; ++rr) {
      float* so = p.out + OUT_STATE + ((size_t)((seq * 2 + dir) * 8 + h) * 64 + vrow + rr) * 64 + kq * EPL;
#pragma unroll
      for (int i = 0; i < NP; ++i) *(f32x2*)(so + 2 * i) = S[rr][i];
    }
  }
  __syncthreads();
#undef gload
#undef ywrite
}

DEV void attn_wave_item(const Params& p, int witem) {
  const int lane = threadIdx.x & 63, fr = lane & 15, fq = lane >> 4;
  const bf16_t* qb = (const bf16_t*)(p.ws + OFF_QB);
  const bf16_t* kb = (const bf16_t*)(p.ws + OFF_KB);
  const bf16_t* vT = (const bf16_t*)(p.ws + OFF_VT);
  const bf16_t* ckb = (const bf16_t*)(p.ws + OFF_CKB);
  const bf16_t* cvT = (const bf16_t*)(p.ws + OFF_CVT);
  bf16_t* ona = (bf16_t*)(p.ws + OFF_ONA);
  int h, tq0, nsub;
  bool latent;
  int b = 0, r = 0, jb = 0, row_start = 0, band = 0, seq = 0;
  {
    const int bi = witem >> 2, wv = witem & 3;
    if (bi < 256) {
      latent = true;
      b = bi >> 7; const int rem = bi & 127; r = rem >> 3; h = rem & 7; jb = wv;
      tq0 = NCTX + b * 1024 + r * 64 + jb * 16;
      row_start = min(max(r - 4, 0), 8); band = min(max(jb * 16 - 8, 0), 32);
      nsub = 4;
    } else {
      latent = false;
      const int c2 = bi - 256; seq = c2 >> 5; const int rem = c2 & 31; h = rem >> 2; const int qg = rem & 3;
      tq0 = seq * 256 + (qg * 4 + wv) * 16; nsub = 2;
    }
  }
  const bf16_t* qp = qb + (size_t)(tq0 + fr) * 512 + h * 64 + fq * 8;
  const bf16x8 qf0 = *(const bf16x8*)qp, qf1 = *(const bf16x8*)(qp + 32);
  float m = -INFINITY, l = 0.f;
  f32x4 O[4];
#pragma unroll
  for (int i = 0; i < 4; ++i) O[i] = (f32x4){0.f, 0.f, 0.f, 0.f};
#define SUBDESC(sc_, kbase_, vbase_, KS_, ldv_, win_) do { const int half_ = (sc_) & 1; win_ = latent && (sc_) < 2; \
    if (win_) { const int tb_ = NCTX + b * 1024 + (row_start + half_ * 4) * 64 + band; \
      kbase_ = kb + (size_t)tb_ * 512 + h * 64; vbase_ = vT + (size_t)(h * 64) * NTOK + tb_; KS_ = 64; ldv_ = NTOK; } \
    else if (latent) { kbase_ = ckb + (size_t)(b * 256 + half_ * 128) * 512 + h * 64; vbase_ = cvT + (size_t)((b * 8 + h) * 64) * 256 + half_ * 128; KS_ = 32; ldv_ = 256; } \
    else { const int tb_ = seq * 256 + half_ * 128; kbase_ = kb + (size_t)tb_ * 512 + h * 64; vbase_ = vT + (size_t)(h * 64) * NTOK + tb_; KS_ = 32; ldv_ = NTOK; } } while (0)
#define KLOAD(kbase_, KS_) do { _Pragma("unroll") for (int i_ = 0; i_ < 8; ++i_) { \
      const bf16_t* kp_ = kbase_ + (size_t)((i_ >> 1) * KS_ + (fr >> 2) * 8 + (i_ & 1) * 4 + (fr & 3)) * 512 + fq * 8; \
      kf[2 * i_] = *(const bf16x8*)kp_; kf[2 * i_ + 1] = *(const bf16x8*)(kp_ + 32); } } while (0)
  bf16x8 kf[16];
#pragma unroll 1
  for (int sc = 0; sc < nsub; ++sc) {
    const int half = sc & 1;
    const bf16_t* kbase; const bf16_t* vbase; int KS, ldv; bool win;
    SUBDESC(sc, kbase, vbase, KS, ldv, win);
    KLOAD(kbase, KS);
    bf16x8 vf[4][4];
#pragma unroll
    for (int s = 0; s < 4; ++s)
#pragma unroll
      for (int dt = 0; dt < 4; ++dt) {
        vf[s][dt] = *(const bf16x8*)(vbase + (size_t)(dt * 16 + fr) * ldv + s * KS + fq * 8);
      }
    f32x4 st[8];
#pragma unroll
    for (int i = 0; i < 8; ++i) {
      f32x4 z = (f32x4){0.f, 0.f, 0.f, 0.f};
      z = __builtin_amdgcn_mfma_f32_16x16x32_bf16(kf[2 * i], qf0, z, 0, 0, 0);
      st[i] = __builtin_amdgcn_mfma_f32_16x16x32_bf16(kf[2 * i + 1], qf1, z, 0, 0, 0);
    }
    const bool cwin = win;
    if (cwin) {
      const int q_col = jb * 16 + fr;
      const int win_start = min(max(q_col - 8, 0), 48);
      const float* rpb = p.in[25] + h * 465;
#pragma unroll
      for (int i = 0; i < 8; ++i) {
        const int dr = row_start + half * 4 + (i >> 1) - r + 7;
#pragma unroll
        for (int e = 0; e < 4; ++e) {
          const int k_col = band + fq * 8 + (i & 1) * 4 + e;
          const bool valid = (k_col >= win_start) && (k_col < win_start + 16);
          const int dc = min(max(k_col - q_col, -15), 15) + 15;
          st[i][e] = valid ? st[i][e] + rpb[dr * 31 + dc] : -1e30f;
        }
      }
    }
    float cmax = -1e30f;
#pragma unroll
    for (int i = 0; i < 8; ++i)
#pragma unroll
      for (int e = 0; e < 4; ++e) cmax = fmaxf(cmax, st[i][e]);
    cmax = fmaxf(cmax, __shfl_xor(cmax, 16)); cmax = fmaxf(cmax, __shfl_xor(cmax, 32));
    const float mnew = fmaxf(m, cmax);
    const float alpha = __expf(m - mnew);
    float psum = 0.f;
#pragma unroll
    for (int i = 0; i < 8; ++i)
#pragma unroll
      for (int e = 0; e < 4; ++e) { const float pv = __expf(st[i][e] - mnew); st[i][e] = pv; psum += pv; }
    psum += __shfl_xor(psum, 16); psum += __shfl_xor(psum, 32);
    l = l * alpha + psum;
#pragma unroll
    for (int i = 0; i < 4; ++i) O[i] = O[i] * alpha;
    m = mnew;
#pragma unroll
    for (int s = 0; s < 4; ++s) {
      union { bf16x8 v; unsigned u[4]; } pb;
      pb.u[0] = pk2(st[2 * s][0], st[2 * s][1]); pb.u[1] = pk2(st[2 * s][2], st[2 * s][3]);
      pb.u[2] = pk2(st[2 * s + 1][0], st[2 * s + 1][1]); pb.u[3] = pk2(st[2 * s + 1][2], st[2 * s + 1][3]);
#pragma unroll
      for (int dt = 0; dt < 4; ++dt) {
        O[dt] = __builtin_amdgcn_mfma_f32_16x16x32_bf16(vf[s][dt], pb.v, O[dt], 0, 0, 0);
      }
    }
  }
#undef SUBDESC
#undef KLOAD
  const float inv = 1.f / l;
#pragma unroll
  for (int dt = 0; dt < 4; ++dt) {
    bf16_t* op = ona + (size_t)(tq0 + fr) * 512 + h * 64 + dt * 16 + fq * 4;
    *(uint2*)op = make_uint2(pk2(O[dt][0] * inv, O[dt][1] * inv), pk2(O[dt][2] * inv, O[dt][3] * inv));
  }
}

constexpr int N_SCAN_ITEMS = 128 + 256, N_ATTN_BLK = 768;
DEV void phase_scan_attn(const Params& p, unsigned char* smem, int* s_item, int rep) {
  unsigned* counter = (unsigned*)(p.ws + OFF_CTL) + rep;
  for (;;) {
    if (threadIdx.x == 0) *s_item = (int)atomicAdd(counter, 1u);
    __syncthreads();
    const int item = *s_item;
    __syncthreads();
    if (item >= N_SCAN_ITEMS + N_ATTN_BLK) break;
    if (item < 128) { const int rem = item & 63; scan_item<4, 1, 3>(p, smem, 16 + (item >> 6), rem >> 3, (rem >> 2) & 1, rem & 3); }
    else if (item >= N_SCAN_ITEMS) attn_wave_item(p, (item - N_SCAN_ITEMS) * 4 + (threadIdx.x >> 6));
    else { const int i2 = item - 128, rem = i2 & 15; scan_item<4, 4, 1>(p, smem, i2 >> 4, rem >> 1, rem & 1, 0); }
  }
}

DEV void phase_finalize_rw(const Params& p, int bid, int nb) {
  const int lane = threadIdx.x & 63, gw = bid * 4 + (threadIdx.x >> 6), nw = nb * 4;
  const float* yf = (const float*)(p.ws + OFF_YF);
  const float* yb = (const float*)(p.ws + OFF_YB);
  const bf16_t* bonus = (const bf16_t*)(p.ws + OFF_BG);
  const bf16_t* gate = (const bf16_t*)(p.ws + OFF_BG + 6291456);
  bf16_t* orw = (bf16_t*)(p.ws + OFF_ORW);
  const float4 g0 = *(const float4*)(p.in[21] + lane * 8), g1 = *(const float4*)(p.in[21] + lane * 8 + 4);
  const float4 b0 = *(const float4*)(p.in[22] + lane * 8), b1 = *(const float4*)(p.in[22] + lane * 8 + 4);
  const float gg[8] = {g0.x, g0.y, g0.z, g0.w, g1.x, g1.y, g1.z, g1.w};
  const float bb[8] = {b0.x, b0.y, b0.z, b0.w, b1.x, b1.y, b1.z, b1.w};
#pragma unroll 3
  for (int t = gw; t < NTOK; t += nw) {
    const size_t o = (size_t)t * 512 + lane * 8;
    const float4 a0 = *(const float4*)(yf + o), a1 = *(const float4*)(yf + o + 4);
    const float4 c0 = *(const float4*)(yb + o), c1 = *(const float4*)(yb + o + 4);
    const uint4 bo = *(const uint4*)(bonus + o), ga = *(const uint4*)(gate + o);
    float y[8] = {a0.x + c0.x, a0.y + c0.y, a0.z + c0.z, a0.w + c0.w, a1.x + c1.x, a1.y + c1.y, a1.z + c1.z, a1.w + c1.w};
    float s = 0.f;
#pragma unroll
    for (int i = 0; i < 8; ++i) s += y[i];
    s += dpp_mov<0xB1>(s); s += dpp_mov<0x4E>(s); s += dpp_mov<0x141>(s);
    const float mean = s * (1.f / 64.f);
    float q = 0.f;
#pragma unroll
    for (int i = 0; i < 8; ++i) { y[i] -= mean; q += y[i] * y[i]; }
    q += dpp_mov<0xB1>(q); q += dpp_mov<0x4E>(q); q += dpp_mov<0x141>(q);
    const float rstd = rsqrtf(q * (1.f / 64.f) + 64e-5f);
    const unsigned bu[4] = {bo.x, bo.y, bo.z, bo.w}, gu[4] = {ga.x, ga.y, ga.z, ga.w};
    unsigned w[4];
#pragma unroll
    for (int i = 0; i < 4; ++i) {
      const float lo = (y[2 * i] * rstd * gg[2 * i] + bb[2 * i] + __uint_as_float(bu[i] << 16)) * __uint_as_float(gu[i] << 16);
      const float hi = (y[2 * i + 1] * rstd * gg[2 * i + 1] + bb[2 * i + 1] + __uint_as_float(bu[i] & 0xffff0000u)) * __uint_as_float(gu[i] & 0xffff0000u);
      w[i] = pk2(lo, hi);
    }
    *(uint4*)(orw + o) = make_uint4(w[0], w[1], w[2], w[3]);
  }
}

#define XB_TMO      128
#define XB_XCNT(j)  (256  + 64 * (j))
#define XB_XSUB(j)  (1280 + 64 * (j))
#define XB_XGEN(j)  (2304 + 64 * (j))
#define XB_TOP      3328
#define XB_TOPGEN   3392
#define XCD_BAR_WORDS 3456
#define XB_SPIN_CAP (1u << 18)
#define LAS __attribute__((address_space(3)))
DEV unsigned xb_ld(unsigned* p)              { return __hip_atomic_load(p, __ATOMIC_RELAXED, __HIP_MEMORY_SCOPE_AGENT); }
DEV unsigned xb_add(unsigned* p, unsigned v) { return __hip_atomic_fetch_add(p, v, __ATOMIC_RELAXED, __HIP_MEMORY_SCOPE_AGENT); }
DEV unsigned xb_xcc_id() { return (unsigned)__builtin_amdgcn_s_getreg((3 << 11) | 20) & 0xFu; }
#define XB_SPIN(cond, bar) do { unsigned _sp = 0; while (cond) { __builtin_amdgcn_s_sleep(1); \
    if ((++_sp & 255u) == 0u) { if (xb_ld(&(bar)[XB_TMO])) break; if (_sp > XB_SPIN_CAP) { atomicAdd(&(bar)[XB_TMO], 1u); break; } } } } while (0)
struct XcdBarrier { unsigned* bar; unsigned x; volatile LAS unsigned* st; };
DEV XcdBarrier xcd_barrier_post(unsigned* bar, volatile LAS unsigned* st) {
  XcdBarrier b; b.bar = bar; b.x = xb_xcc_id(); b.st = st;
  if (threadIdx.x == 0) (void)xb_add(&bar[XB_XCNT(b.x)], 1u);
  return b;
}
DEV void xcd_barrier_complete(unsigned* bar, unsigned x, unsigned& nloc, unsigned& nx) {
  const unsigned G = gridDim.x * gridDim.y * gridDim.z;
  unsigned sum, cnt, mine, sp = 0u;
  for (;;) {
    sum = 0u; cnt = 0u; mine = 0u;
#pragma unroll
    for (unsigned j = 0; j < 16; ++j) { const unsigned c = xb_ld(&bar[XB_XCNT(j)]); sum += c; cnt += (c > 0u) ? 1u : 0u; mine = (j == x) ? c : mine; }
    if (sum == G) break;
    __builtin_amdgcn_s_sleep(1);
    if ((++sp & 255u) == 0u) { if (xb_ld(&bar[XB_TMO])) break; if (sp > XB_SPIN_CAP) { atomicAdd(&bar[XB_TMO], 1u); break; } }
  }
  nloc = mine > 0u ? mine : 1u; nx = cnt > 0u ? cnt : 1u;
}
DEV void xcd_barrier(const XcdBarrier& b) {
  asm volatile("s_waitcnt vmcnt(0)" ::: "memory");
  __syncthreads();
  if (threadIdx.x == 0) {
    unsigned* bar = b.bar;
    __builtin_amdgcn_s_waitcnt(0);
    unsigned nloc = b.st[0], nx = b.st[1];
    if (nloc == 0u) { xcd_barrier_complete(bar, b.x, nloc, nx); b.st[0] = nloc; b.st[1] = nx; }
    const unsigned old = xb_add(&bar[XB_XSUB(b.x)], 1u);
    const unsigned gen = old / nloc;
    if (old + 1u == (gen + 1u) * nloc) {
      __builtin_amdgcn_fence(__ATOMIC_RELEASE, "agent");
      asm volatile("s_waitcnt vmcnt(0)" ::: "memory");
      const unsigned og = xb_add(&bar[XB_TOP], 1u);
      const unsigned tg = og / nx;
      if (og + 1u == (tg + 1u) * nx) xb_add(&bar[XB_TOPGEN], 1u);
      else XB_SPIN(xb_ld(&bar[XB_TOPGEN]) == tg, bar);
      __builtin_amdgcn_fence(__ATOMIC_ACQUIRE, "agent");
      xb_add(&bar[XB_XGEN(b.x)], 1u);
      asm volatile("s_waitcnt vmcnt(0)" ::: "memory");
    } else {
      XB_SPIN(xb_ld(&bar[XB_XGEN(b.x)]) == gen, bar);
      __builtin_amdgcn_fence(__ATOMIC_ACQUIRE, "agent");
      asm volatile("s_waitcnt vmcnt(0)" ::: "memory");
    }
  }
  __syncthreads();
}

__global__ void __launch_bounds__(NTHR, 2) fwd_megakernel(Params p) {
  extern __shared__ __attribute__((aligned(16))) unsigned char smem[];
  __shared__ __attribute__((aligned(16))) unsigned sh_ctl[8];
  cg::grid_group grid = cg::this_grid();
  const int bid = blockIdx.x, nb = gridDim.x;
  if (threadIdx.x < 8) sh_ctl[threadIdx.x] = 0u;
  __syncthreads();
  const XcdBarrier xb = xcd_barrier_post((unsigned*)(p.ws + OFF_CTL), (volatile LAS unsigned*)sh_ctl);
  int* s_item_p = (int*)&sh_ctl[4];
  if (p.ph_hi > 1000) grid.sync();
#define GSYNC() xcd_barrier(xb)
#ifndef DUP
#define DUP -1
#endif
#define PH(n, body) if (p.ph_lo <= n && n < p.ph_hi) { { const int rep = 0; (void)rep; body; } if (DUP == n) { GSYNC(); const int rep = 1; (void)rep; body; } if (n + 1 < p.ph_hi) GSYNC(); }
  PH(0, phase0(p, smem, bid, nb, rep))
  PH(1, phase_normmod<0>(p, bid, nb))
  PH(2, reset_tiles(s_item_p); phase_gemm_in(p, smem, s_item_p))
  PH(3, phase_prep(p, smem, s_item_p, rep))
  PH(4, phase_scan_attn(p, smem, s_item_p, rep))
  PH(5, phase_finalize_rw(p, bid, nb))
  PH(6, reset_tiles(s_item_p); phase_gemm_merge(p, smem, s_item_p))
  PH(7, reset_tiles(s_item_p); phase_gemm_out(p, smem, s_item_p))
  PH(8, phase_normmod<1>(p, bid, nb))
  PH(9, reset_tiles(s_item_p); phase_gemm_ffn_up(p, smem, s_item_p))
  PH(10, reset_tiles(s_item_p); phase_gemm_ffn_down(p, smem, s_item_p))
}

extern "C" void kernel_launch(void* const* d_in, const int* in_sizes, int n_in, void* d_out, int out_size, void* d_ws, size_t ws_size,
                              hipStream_t stream) {
  static int grid_blocks = 0;
  if (grid_blocks == 0) {
    if (n_in != 32 || ws_size < WS_END) { fprintf(stderr, "kernel_launch: unexpected n_in %d / ws_size %zu (need %zu)\n", n_in, ws_size, (size_t)WS_END); grid_blocks = -1; return; }
    int dev = 0, cus = 0, per_cu = 0;
    hipGetDevice(&dev);
    hipDeviceGetAttribute(&cus, hipDeviceAttributeMultiprocessorCount, dev);
    if (hipFuncSetAttribute((const void*)fwd_megakernel, hipFuncAttributeMaxDynamicSharedMemorySize, LDS_BYTES) != hipSuccess) { fprintf(stderr, "hipFuncSetAttribute failed\n"); grid_blocks = -1; return; }
    if (hipOccupancyMaxActiveBlocksPerMultiprocessor(&per_cu, (const void*)fwd_megakernel, NTHR, LDS_BYTES) != hipSuccess || per_cu < 1) { fprintf(stderr, "occupancy query failed (%d)\n", per_cu); grid_blocks = -1; return; }
    if (per_cu > 2) per_cu = 2;
    grid_blocks = cus * per_cu;
    fprintf(stderr, "kernel_launch: cus %d per_cu %d grid %d\n", cus, per_cu, grid_blocks);
  }
  if (grid_blocks < 0) return;
  hipMemsetAsync((char*)d_ws + OFF_CTL, 0, CTL_ZERO_BYTES, stream);
  Params p{};
  for (int i = 0; i < 32; ++i) p.in[i] = (const float*)d_in[i];
  p.out = (float*)d_out; p.ws = (unsigned char*)d_ws; p.ph_lo = 0; p.ph_hi = 11;
  void* args[] = {&p};
  hipError_t e = hipLaunchCooperativeKernel((const void*)fwd_megakernel, dim3(grid_blocks), dim3(NTHR), args, LDS_BYTES, stream);
  if (e != hipSuccess) fprintf(stderr, "cooperative launch failed: %s (grid %d)\n", hipGetErrorString(e), grid_blocks);
}
```

```cpp
#include <hip/hip_runtime.h>
#include <hip/hip_cooperative_groups.h>
#include <cstdio>
#include <cstdint>
namespace cg = cooperative_groups;

#define DEV __device__ __forceinline__
typedef unsigned short bf16_t;
typedef short bf16x8 __attribute__((ext_vector_type(8)));
typedef short bf16x4 __attribute__((ext_vector_type(4)));
typedef float f32x4 __attribute__((ext_vector_type(4)));

constexpr int D = 1024, NTOK = 6144, NCTX = 4096, RW = 512, FF = 2816, INC = 5504, RWC = 1920;
constexpr int NTHR = 256;
constexpr int LDS_BYTES = 65536;

constexpr size_t OFF_CTL = 0;
constexpr size_t OFF_MOD = 16384;
constexpr size_t CTL_ZERO_BYTES = 16384 + 3 * 6144 * 4;
constexpr size_t OFF_WIN = 90112;
constexpr size_t OFF_WORW = OFF_WIN + 11272192;
constexpr size_t OFF_WONA = OFF_WORW + 1048576;
constexpr size_t OFF_WOUT = OFF_WONA + 1048576;
constexpr size_t OFF_W13 = OFF_WOUT + 2097152;
constexpr size_t OFF_W2 = OFF_W13 + 11534336;
constexpr size_t OFF_H = OFF_W2 + 5767168;
constexpr size_t OFF_URW = OFF_H + 12582912;
constexpr size_t OFF_UNA = OFF_URW + 47185920;
constexpr size_t OFF_OPS = OFF_UNA + 37748736;
constexpr size_t OPS_ARR = 12582912;
constexpr size_t OFF_BG = OFF_OPS + 9 * OPS_ARR;
constexpr size_t OFF_VT = OFF_BG + 12582912;
constexpr size_t OFF_CKB = OFF_VT + 6291456;
constexpr size_t OFF_CVT = OFF_CKB + 524288;
constexpr size_t OFF_LORA = OFF_CVT + 524288;
constexpr size_t WS_END = OFF_LORA + 393216;
constexpr size_t OFF_QB = OFF_H, OFF_KB = OFF_H + 6291456;
constexpr size_t OFF_YF = OFF_URW, OFF_YB = OFF_URW + 12582912;
constexpr size_t OFF_ORW = OFF_UNA, OFF_ONA = OFF_UNA + 6291456;
constexpr size_t OFF_MERGED = OFF_OPS;
constexpr size_t OFF_HID = OFF_URW;
constexpr size_t OUT_STATE = 6291456, OUT_K = 7340032, OUT_V = 9437184;

struct Params {
  const float* in[32];
  float* out;
  unsigned char* ws;
  int ph_lo, ph_hi;
};

DEV unsigned short f2bf(float f) { unsigned u = __float_as_uint(f); u += 0x7fffu + ((u >> 16) & 1u); return (unsigned short)(u >> 16); }
DEV unsigned pk2(float lo, float hi) { return (unsigned)f2bf(lo) | ((unsigned)f2bf(hi) << 16); }
DEV float bf2f(unsigned short b) { return __uint_as_float(((unsigned)b) << 16); }
DEV float sigmoidf_(float x) { return 1.f / (1.f + __expf(-x)); }
DEV float wave_sum(float x) {
#pragma unroll
  for (int o = 32; o > 0; o >>= 1) x += __shfl_xor(x, o);
  return x;
}
template <int CTRL> DEV float dpp_mov(float x) { return __int_as_float(__builtin_amdgcn_update_dpp(0, __float_as_int(x), CTRL, 0xf, 0xf, true)); }
DEV float row16_sum(float x) {
  x += dpp_mov<0xB1>(x); x += dpp_mov<0x4E>(x); x += dpp_mov<0x141>(x); x += dpp_mov<0x140>(x);
  return x;
}
#define BAR_LDS() do { asm volatile("s_waitcnt lgkmcnt(0)" ::: "memory"); __builtin_amdgcn_s_barrier(); asm volatile("" ::: "memory"); } while (0)
DEV const float* xrow(const Params& p, int t) { return t < NCTX ? p.in[0] + (size_t)t * D : p.in[1] + (size_t)(t - NCTX) * D; }
DEV int modidx(int t) { return t < NCTX ? 0 : 1 + ((t - NCTX) >> 10); }

DEV void conv_job(const Params& p, int j, const float*& src, bf16_t*& dst, int& K, int& N, int& mode, int& base) {
  if (j < 1376) { src = p.in[11]; dst = (bf16_t*)(p.ws + OFF_WIN); K = 1024; N = 5504; mode = 0; base = 0; }
  else if (j < 1504) { src = p.in[26]; dst = (bf16_t*)(p.ws + OFF_WORW); K = 512; N = 1024; mode = 0; base = 1376; }
  else if (j < 1632) { src = p.in[27]; dst = (bf16_t*)(p.ws + OFF_WONA); K = 512; N = 1024; mode = 0; base = 1504; }
  else if (j < 1888) { src = p.in[28]; dst = (bf16_t*)(p.ws + OFF_WOUT); K = 1024; N = 1024; mode = 0; base = 1632; }
  else if (j < 2592) { src = p.in[29]; dst = (bf16_t*)(p.ws + OFF_W13); K = 1024; N = 2816; mode = 1; base = 1888; }
  else if (j < 3296) { src = p.in[30]; dst = (bf16_t*)(p.ws + OFF_W13); K = 1024; N = 2816; mode = 2; base = 2592; }
  else if (j < 4000) { src = p.in[31]; dst = (bf16_t*)(p.ws + OFF_W2); K = 2816; N = 1024; mode = 0; base = 3296; }
  else if (j < 4016) { const int e = (j - 4000) >> 3; src = p.in[14] + e * 32768; dst = (bf16_t*)(p.ws + OFF_LORA) + e * 32768; K = 64; N = 512; mode = 0; base = 4000 + e * 8; }
  else if (j < 4032) { const int e = (j - 4016) >> 3; src = p.in[16] + e * 32768; dst = (bf16_t*)(p.ws + OFF_LORA) + 65536 + e * 32768; K = 64; N = 512; mode = 0; base = 4016 + e * 8; }
  else { src = p.in[17]; dst = (bf16_t*)(p.ws + OFF_LORA) + 131072; K = 128; N = 512; mode = 0; base = 4032; }
}
constexpr int N_CONV_TILES = 4048, N_MOD_TILES = 768;

DEV void phase0(const Params& p, unsigned char* smem, int bid, int nb, int rep) {
  const int tid = threadIdx.x;
  float* T = (float*)smem;
  for (int tile = bid; tile < N_MOD_TILES && rep == 0; tile += nb) {
    const int cgp = tile % 24, kc = tile / 24;
    if (tid < 96) {
      const int m = tid >> 5, kk = tid & 31, k = kc * 32 + kk;
      const float c = (m == 0) ? p.in[6][k] : p.in[5][(m - 1) * D + k];
      T[tid] = c * sigmoidf_(c);
    }
    __syncthreads();
    const int col = cgp * 256 + tid;
    const float* w = p.in[9] + (size_t)(kc * 32) * 6144 + col;
    float a0 = 0.f, a1 = 0.f, a2 = 0.f;
#pragma unroll
    for (int kk = 0; kk < 32; ++kk) {
      const float wv = w[(size_t)kk * 6144];
      a0 += T[kk] * wv; a1 += T[32 + kk] * wv; a2 += T[64 + kk] * wv;
    }
    if (kc == 0) { const float b = p.in[10][col]; a0 += b; a1 += b; a2 += b; }
    float* mod = (float*)(p.ws + OFF_MOD);
    atomicAdd(mod + col, a0); atomicAdd(mod + 6144 + col, a1); atomicAdd(mod + 12288 + col, a2);
    __syncthreads();
  }
  const int r_ = tid >> 4, c4_ = tid & 15;
  float4 v[4];
  const float* src; bf16_t* dst; int K, N, mode, base;
  int tile = bid;
  if (tile < N_CONV_TILES) {
    conv_job(p, tile, src, dst, K, N, mode, base);
    const int lt = tile - base, nN = N >> 6, k0 = (lt / nN) * 64, n0 = (lt % nN) * 64;
#pragma unroll
    for (int i = 0; i < 4; ++i) v[i] = *(const float4*)(src + (size_t)(k0 + r_ + 16 * i) * N + n0 + c4_ * 4);
  }
  while (tile < N_CONV_TILES) {
    const int lt = tile - base, nN = N >> 6, k0 = (lt / nN) * 64, n0 = (lt % nN) * 64;
    bf16_t* cdst = dst; const int cK = K, cmode = mode;
#pragma unroll
    for (int i = 0; i < 4; ++i) {
      float* tp = T + (r_ + 16 * i) * 65 + c4_ * 4;
      tp[0] = v[i].x; tp[1] = v[i].y; tp[2] = v[i].z; tp[3] = v[i].w;
    }
    BAR_LDS();
    tile += nb;
    if (tile < N_CONV_TILES) {
      conv_job(p, tile, src, dst, K, N, mode, base);
      const int lt2 = tile - base, nN2 = N >> 6, k2 = (lt2 / nN2) * 64, n2 = (lt2 % nN2) * 64;
#pragma unroll
      for (int i = 0; i < 4; ++i) v[i] = *(const float4*)(src + (size_t)(k2 + r_ + 16 * i) * N + n2 + c4_ * 4);
    }
    const int n = tid >> 2, kp = tid & 3;
    unsigned w[8];
#pragma unroll
    for (int i = 0; i < 8; ++i) w[i] = pk2(T[(kp * 16 + 2 * i) * 65 + n], T[(kp * 16 + 2 * i + 1) * 65 + n]);
    const int ng = n0 + n;
    int drow = ng;
    if (cmode == 1) drow = (ng >> 4) * 32 + (ng & 15);
    else if (cmode == 2) drow = (ng >> 4) * 32 + 16 + (ng & 15);
    uint4* dp = (uint4*)(cdst + (size_t)drow * cK + k0 + kp * 16);
    dp[0] = make_uint4(w[0], w[1], w[2], w[3]);
    dp[1] = make_uint4(w[4], w[5], w[6], w[7]);
    BAR_LDS();
  }
}

template <int WHICH>
DEV void phase_normmod(const Params& p, int bid, int nb) {
  const int lane = threadIdx.x & 63, gw = bid * 4 + (threadIdx.x >> 6), nw = nb * 4;
  const float* g = WHICH == 0 ? p.in[7] : p.in[8];
  const float* mod = (const float*)(p.ws + OFF_MOD);
  const int sh_off = WHICH == 0 ? 0 : 3072, sc_off = WHICH == 0 ? 1024 : 4096;
  bf16_t* dst = (bf16_t*)(p.ws + OFF_H);
#pragma unroll 3
  for (int t = gw; t < NTOK; t += nw) {
    const float* xp = WHICH == 0 ? xrow(p, t) : p.out + (size_t)t * D;
    const float* mm = mod + modidx(t) * 6144;
    float4 v[4];
    float ss = 0.f;
#pragma unroll
    for (int i = 0; i < 4; ++i) {
      v[i] = *(const float4*)(xp + (i * 64 + lane) * 4);
      ss += v[i].x * v[i].x + v[i].y * v[i].y + v[i].z * v[i].z + v[i].w * v[i].w;
    }
    ss = wave_sum(ss);
    const float rstd = rsqrtf(ss * (1.f / 1024.f) + 1e-6f);
#pragma unroll
    for (int i = 0; i < 4; ++i) {
      const int col = (i * 64 + lane) * 4;
      const float4 g4 = *(const float4*)(g + col);
      const float4 sc = *(const float4*)(mm + sc_off + col);
      const float4 sh = *(const float4*)(mm + sh_off + col);
      const float y0 = v[i].x * rstd * g4.x * (1.f + sc.x) + sh.x;
      const float y1 = v[i].y * rstd * g4.y * (1.f + sc.y) + sh.y;
      const float y2 = v[i].z * rstd * g4.z * (1.f + sc.z) + sh.z;
      const float y3 = v[i].w * rstd * g4.w * (1.f + sc.w) + sh.w;
      *(uint2*)(dst + (size_t)t * D + col) = make_uint2(pk2(y0, y1), pk2(y2, y3));
    }
  }
}

template <int MI>
DEV void gemm_tile_acc(f32x4 (&acc)[MI][4], const bf16_t* __restrict__ A, int lda, const bf16_t* __restrict__ Bt, int ldb,
                       int m0, int n0, int K, unsigned char* smem) {
  constexpr int AT = 2 * MI * 16 * 128, BT = 16384, STG = AT + BT;
  const int tid = threadIdx.x, lane = tid & 63, wid = tid >> 6, wr = wid >> 1, wc = wid & 1, fr = lane & 15, fq = lane >> 4;
  const int gkc = (tid & 7) ^ ((tid >> 4) & 7);
  const bf16_t* ga = A + (size_t)(m0 + (tid >> 3)) * lda + gkc * 8;
  const bf16_t* gb = Bt + (size_t)(n0 + (tid >> 3)) * ldb + gkc * 8;
  const int swz = (fr >> 1) & 7;
  const int nk = K >> 6;
#define GLDS_TILE(kt_, buf_) do { unsigned char* sb_ = smem + (buf_) * STG; const int k0_ = (kt_) * 64; \
    _Pragma("unroll") for (int i_ = 0; i_ < (2 * MI * 16) / 32; ++i_) \
      __builtin_amdgcn_global_load_lds((const unsigned*)(ga + (size_t)i_ * 32 * lda + k0_), (__attribute__((address_space(3))) unsigned*)(sb_ + (i_ * 256 + tid) * 16), 16, 0, 0); \
    _Pragma("unroll") for (int i_ = 0; i_ < 4; ++i_) \
      __builtin_amdgcn_global_load_lds((const unsigned*)(gb + (size_t)i_ * 32 * ldb + k0_), (__attribute__((address_space(3))) unsigned*)(sb_ + AT + (i_ * 256 + tid) * 16), 16, 0, 0); \
  } while (0)
  GLDS_TILE(0, 0);
  asm volatile("s_waitcnt vmcnt(0)" ::: "memory");
  __syncthreads();
  for (int kt = 0; kt < nk; ++kt) {
    if (kt + 1 < nk) GLDS_TILE(kt + 1, (kt + 1) & 1);
    const unsigned char* cur = smem + (kt & 1) * STG;
#pragma unroll
    for (int ks = 0; ks < 2; ++ks) {
      bf16x8 af[MI], bf[4];
      const int co = ((ks * 4 + fq) ^ swz) << 4;
#pragma unroll
      for (int mi = 0; mi < MI; ++mi) af[mi] = *(const bf16x8*)(cur + (wr * MI * 16 + mi * 16 + fr) * 128 + co);
#pragma unroll
      for (int ni = 0; ni < 4; ++ni) bf[ni] = *(const bf16x8*)(cur + AT + (wc * 64 + ni * 16 + fr) * 128 + co);
      __builtin_amdgcn_s_setprio(1);
#pragma unroll
      for (int mi = 0; mi < MI; ++mi)
#pragma unroll
        for (int ni = 0; ni < 4; ++ni) acc[mi][ni] = __builtin_amdgcn_mfma_f32_16x16x32_bf16(bf[ni], af[mi], acc[mi][ni], 0, 0, 0);
      __builtin_amdgcn_s_setprio(0);
    }
    asm volatile("s_waitcnt vmcnt(0)" ::: "memory");
    __syncthreads();
  }
#undef GLDS_TILE
}

template <int MI>
DEV void zero_acc(f32x4 (&acc)[MI][4]) {
#pragma unroll
  for (int i = 0; i < MI; ++i)
#pragma unroll
    for (int j = 0; j < 4; ++j) acc[i][j] = (f32x4){0.f, 0.f, 0.f, 0.f};
}

#ifndef DYN_TILES
#define DYN_TILES 0
#endif
DEV int grab_tile(const Params& p, int word, int* slot) {
#if DYN_TILES
  if (threadIdx.x == 0) *slot = (int)atomicAdd((unsigned*)(p.ws + OFF_CTL) + word, 1u);
  __syncthreads();
  const int t = *slot;
  __syncthreads();
  return t;
#else
  const int t = slot[1];
  __syncthreads();
  if (threadIdx.x == 0) slot[1] = t + gridDim.x;
  __syncthreads();
  return t;
#endif
}
DEV void reset_tiles(int* slot) { if (threadIdx.x == 0) slot[1] = blockIdx.x; __syncthreads(); }

#define EPI_COORDS const int lane = threadIdx.x & 63, wid = threadIdx.x >> 6, wr = wid >> 1, wc = wid & 1, fr = lane & 15, fq = lane >> 4

DEV void phase_gemm_in(const Params& p, unsigned char* smem, int* slot) {
  EPI_COORDS;
  const bf16_t* A = (const bf16_t*)(p.ws + OFF_H);
  const bf16_t* Bt = (const bf16_t*)(p.ws + OFF_WIN);
  float* urw = (float*)(p.ws + OFF_URW);
  float* una = (float*)(p.ws + OFF_UNA);
  bf16_t* gates = (bf16_t*)p.out;
  for (;;) {
    const int tile = grab_tile(p, 8, slot);
    if (tile >= 48 * 43) break;
    const int tm = tile % 48, tn = tile / 48, m0 = tm * 128, n0 = tn * 128;
    f32x4 acc[4][4];
    zero_acc<4>(acc);
    gemm_tile_acc<4>(acc, A, D, Bt, D, m0, n0, D, smem);
#pragma unroll
    for (int mi = 0; mi < 4; ++mi) {
      const int row = m0 + wr * 64 + mi * 16 + fr;
#pragma unroll
      for (int ni = 0; ni < 4; ++ni) {
        const int col = n0 + wc * 64 + ni * 16 + fq * 4;
        const f32x4 v = acc[mi][ni];
        if (n0 < 1920) *(f32x4*)(urw + (size_t)row * 1920 + col) = v;
        else if (n0 < 3456) *(f32x4*)(una + (size_t)row * 1536 + (col - 1920)) = v;
        else *(uint2*)(gates + (size_t)row * 2048 + (col - 3456)) = make_uint2(pk2(sigmoidf_(v[0]), sigmoidf_(v[1])), pk2(sigmoidf_(v[2]), sigmoidf_(v[3])));
      }
    }
  }
}

DEV void phase_gemm_merge(const Params& p, unsigned char* smem, int* slot) {
  EPI_COORDS;
  const bf16_t* orw = (const bf16_t*)(p.ws + OFF_ORW);
  const bf16_t* ona = (const bf16_t*)(p.ws + OFF_ONA);
  const bf16_t* w1 = (const bf16_t*)(p.ws + OFF_WORW);
  const bf16_t* w2 = (const bf16_t*)(p.ws + OFF_WONA);
  const bf16_t* gates = (const bf16_t*)p.out;
  bf16_t* merged = (bf16_t*)(p.ws + OFF_MERGED);
  float* mtmp = (float*)(p.ws + OFF_MERGED + 16777216);
  for (;;) {
    const int tile = grab_tile(p, 9, slot);
    if (tile >= 64 * 8) break;
    const int tm = tile % 64, tn = tile / 64, m0 = tm * 96, n0 = tn * 128;
    f32x4 acc[3][4];
    zero_acc<3>(acc);
    gemm_tile_acc<3>(acc, orw, RW, w1, RW, m0, n0, RW, smem);
#pragma unroll
    for (int mi = 0; mi < 3; ++mi) {
      const int row = m0 + wr * 48 + mi * 16 + fr;
#pragma unroll
      for (int ni = 0; ni < 4; ++ni) {
        const int col = n0 + wc * 64 + ni * 16 + fq * 4;
        const uint2 g = *(const uint2*)(gates + (size_t)row * 2048 + col);
        f32x4 r;
        r[0] = acc[mi][ni][0] * bf2f((unsigned short)(g.x & 0xffff));
        r[1] = acc[mi][ni][1] * bf2f((unsigned short)(g.x >> 16));
        r[2] = acc[mi][ni][2] * bf2f((unsigned short)(g.y & 0xffff));
        r[3] = acc[mi][ni][3] * bf2f((unsigned short)(g.y >> 16));
        *(f32x4*)(mtmp + (size_t)row * D + col) = r;
      }
    }
    zero_acc<3>(acc);
    gemm_tile_acc<3>(acc, ona, RW, w2, RW, m0, n0, RW, smem);
#pragma unroll
    for (int mi = 0; mi < 3; ++mi) {
      const int row = m0 + wr * 48 + mi * 16 + fr;
#pragma unroll
      for (int ni = 0; ni < 4; ++ni) {
        const int col = n0 + wc * 64 + ni * 16 + fq * 4;
        const uint2 g = *(const uint2*)(gates + (size_t)row * 2048 + 1024 + col);
        const f32x4 mg = *(const f32x4*)(mtmp + (size_t)row * D + col);
        const float r0 = mg[0] + acc[mi][ni][0] * bf2f((unsigned short)(g.x & 0xffff));
        const float r1 = mg[1] + acc[mi][ni][1] * bf2f((unsigned short)(g.x >> 16));
        const float r2 = mg[2] + acc[mi][ni][2] * bf2f((unsigned short)(g.y & 0xffff));
        const float r3 = mg[3] + acc[mi][ni][3] * bf2f((unsigned short)(g.y >> 16));
        *(uint2*)(merged + (size_t)row * D + col) = make_uint2(pk2(r0, r1), pk2(r2, r3));
      }
    }
  }
}

DEV void phase_gemm_out(const Params& p, unsigned char* smem, int* slot) {
  EPI_COORDS;
  const bf16_t* A = (const bf16_t*)(p.ws + OFF_MERGED);
  const bf16_t* Bt = (const bf16_t*)(p.ws + OFF_WOUT);
  const float* mod = (const float*)(p.ws + OFF_MOD);
  for (;;) {
    const int tile = grab_tile(p, 10, slot);
    if (tile >= 64 * 8) break;
    const int tm = tile % 64, tn = tile / 64, m0 = tm * 96, n0 = tn * 128;
    f32x4 acc[3][4];
    zero_acc<3>(acc);
    gemm_tile_acc<3>(acc, A, D, Bt, D, m0, n0, D, smem);
#pragma unroll
    for (int mi = 0; mi < 3; ++mi) {
      const int row = m0 + wr * 48 + mi * 16 + fr;
      const float* xp = xrow(p, row);
      const float* g1 = mod + modidx(row) * 6144 + 2048;
#pragma unroll
      for (int ni = 0; ni < 4; ++ni) {
        const int col = n0 + wc * 64 + ni * 16 + fq * 4;
        const f32x4 x = *(const f32x4*)(xp + col);
        const f32x4 g = *(const f32x4*)(g1 + col);
        *(f32x4*)(p.out + (size_t)row * D + col) = x + g * acc[mi][ni];
      }
    }
  }
}

DEV void phase_gemm_ffn_up(const Params& p, unsigned char* smem, int* slot) {
  EPI_COORDS;
  const bf16_t* A = (const bf16_t*)(p.ws + OFF_H);
  const bf16_t* Bt = (const bf16_t*)(p.ws + OFF_W13);
  bf16_t* hid = (bf16_t*)(p.ws + OFF_HID);
  for (;;) {
    const int tile = grab_tile(p, 11, slot);
    if (tile >= 48 * 44) break;
    const int tm = tile % 48, tn = tile / 48, m0 = tm * 128, n0 = tn * 128;
    f32x4 acc[4][4];
    zero_acc<4>(acc);
    gemm_tile_acc<4>(acc, A, D, Bt, D, m0, n0, D, smem);
#pragma unroll
    for (int mi = 0; mi < 4; ++mi) {
      const int row = m0 + wr * 64 + mi * 16 + fr;
#pragma unroll
      for (int gp = 0; gp < 2; ++gp) {
        const int hcol = ((n0 + wc * 64) >> 1) + gp * 16 + fq * 4;
        const f32x4 a = acc[mi][2 * gp], b = acc[mi][2 * gp + 1];
        float r[4];
#pragma unroll
        for (int e = 0; e < 4; ++e) r[e] = a[e] * sigmoidf_(a[e]) * b[e];
        *(uint2*)(hid + (size_t)row * FF + hcol) = make_uint2(pk2(r[0], r[1]), pk2(r[2], r[3]));
      }
    }
  }
}

DEV void phase_gemm_ffn_down(const Params& p, unsigned char* smem, int* slot) {
  EPI_COORDS;
  const bf16_t* A = (const bf16_t*)(p.ws + OFF_HID);
  const bf16_t* Bt = (const bf16_t*)(p.ws + OFF_W2);
  const float* mod = (const float*)(p.ws + OFF_MOD);
  for (;;) {
    const int tile = grab_tile(p, 12, slot);
    if (tile >= 64 * 8) break;
    const int tm = tile % 64, tn = tile / 64, m0 = tm * 96, n0 = tn * 128;
    f32x4 acc[3][4];
    zero_acc<3>(acc);
    gemm_tile_acc<3>(acc, A, FF, Bt, FF, m0, n0, FF, smem);
#pragma unroll
    for (int mi = 0; mi < 3; ++mi) {
      const int row = m0 + wr * 48 + mi * 16 + fr;
      const float* g2 = mod + modidx(row) * 6144 + 5120;
#pragma unroll
      for (int ni = 0; ni < 4; ++ni) {
        const int col = n0 + wc * 64 + ni * 16 + fq * 4;
        float* op = p.out + (size_t)row * D + col;
        const f32x4 x = *(const f32x4*)op;
        const f32x4 g = *(const f32x4*)(g2 + col);
        *(f32x4*)op = x + g * acc[mi][ni];
      }
    }
  }
}

DEV void phase_qkprep(const Params& p, unsigned char* smem, int item_) {
  const int tid = threadIdx.x;
  bf16_t* Vs = (bf16_t*)smem;
  bf16_t* qb = (bf16_t*)(p.ws + OFF_QB);
  bf16_t* kb = (bf16_t*)(p.ws + OFF_KB);
  bf16_t* vT = (bf16_t*)(p.ws + OFF_VT);
  bf16_t* ckb = (bf16_t*)(p.ws + OFF_CKB);
  bf16_t* cvT = (bf16_t*)(p.ws + OFF_CVT);
  const float* una = (const float*)(p.ws + OFF_UNA);
  const int tok = tid >> 2, part = tid & 3;
  for (int item = item_; item < item_ + 1; ++item) {
    if (item < 768) {
      const int tt = item >> 3, h = item & 7, t0 = tt * 64, t = t0 + tok;
      const float* src = una + (size_t)t * 1536 + h * 64 + part * 16;
      {
        float x[16]; float ss = 0.f;
#pragma unroll
        for (int i = 0; i < 4; ++i) { const float4 v = *(const float4*)(src + i * 4); x[4 * i] = v.x; x[4 * i + 1] = v.y; x[4 * i + 2] = v.z; x[4 * i + 3] = v.w; }
#pragma unroll
        for (int i = 0; i < 16; ++i) ss += x[i] * x[i];
        ss += __shfl_xor(ss, 1); ss += __shfl_xor(ss, 2);
        const float rs = rsqrtf(ss * (1.f / 64.f) + 1e-6f) * 0.125f;
        unsigned w[8];
#pragma unroll
        for (int i = 0; i < 8; ++i) w[i] = pk2(x[2 * i] * rs * p.in[23][part * 16 + 2 * i], x[2 * i + 1] * rs * p.in[23][part * 16 + 2 * i + 1]);
        uint4* dp = (uint4*)(qb + (size_t)t * 512 + h * 64 + part * 16);
        dp[0] = make_uint4(w[0], w[1], w[2], w[3]); dp[1] = make_uint4(w[4], w[5], w[6], w[7]);
      }
      {
        float x[16]; float ss = 0.f;
#pragma unroll
        for (int i = 0; i < 4; ++i) { const float4 v = *(const float4*)(src + 512 + i * 4); x[4 * i] = v.x; x[4 * i + 1] = v.y; x[4 * i + 2] = v.z; x[4 * i + 3] = v.w; }
#pragma unroll
        for (int i = 0; i < 16; ++i) ss += x[i] * x[i];
        ss += __shfl_xor(ss, 1); ss += __shfl_xor(ss, 2);
        const float rs = rsqrtf(ss * (1.f / 64.f) + 1e-6f);
#pragma unroll
        for (int i = 0; i < 16; ++i) x[i] = x[i] * rs * p.in[24][part * 16 + i];
        if (t < NCTX) {
          float4* op = (float4*)(p.out + OUT_K + (size_t)t * 512 + h * 64 + part * 16);
#pragma unroll
          for (int i = 0; i < 4; ++i) op[i] = make_float4(x[4 * i], x[4 * i + 1], x[4 * i + 2], x[4 * i + 3]);
        }
        unsigned w[8];
#pragma unroll
        for (int i = 0; i < 8; ++i) w[i] = pk2(x[2 * i], x[2 * i + 1]);
        uint4* dp = (uint4*)(kb + (size_t)t * 512 + h * 64 + part * 16);
        dp[0] = make_uint4(w[0], w[1], w[2], w[3]); dp[1] = make_uint4(w[4], w[5], w[6], w[7]);
      }
      {
        float x[16];
#pragma unroll
        for (int i = 0; i < 4; ++i) { const float4 v = *(const float4*)(src + 1024 + i * 4); x[4 * i] = v.x; x[4 * i + 1] = v.y; x[4 * i + 2] = v.z; x[4 * i + 3] = v.w; }
        if (t < NCTX) {
          float4* op = (float4*)(p.out + OUT_V + (size_t)t * 512 + h * 64 + part * 16);
#pragma unroll
          for (int i = 0; i < 4; ++i) op[i] = make_float4(x[4 * i], x[4 * i + 1], x[4 * i + 2], x[4 * i + 3]);
        }
#pragma unroll
        for (int i = 0; i < 16; ++i) Vs[tok * 72 + part * 16 + i] = f2bf(x[i]);
      }
      __syncthreads();
      {
        const int d = tid >> 2;
        unsigned w[8];
#pragma unroll
        for (int i = 0; i < 8; ++i) w[i] = (unsigned)Vs[(part * 16 + 2 * i) * 72 + d] | ((unsigned)Vs[(part * 16 + 2 * i + 1) * 72 + d] << 16);
        uint4* dp = (uint4*)(vT + (size_t)(h * 64 + d) * NTOK + t0 + part * 16);
        dp[0] = make_uint4(w[0], w[1], w[2], w[3]); dp[1] = make_uint4(w[4], w[5], w[6], w[7]);
      }
      __syncthreads();
    } else {
      const int ci = item - 768, b = ci >> 5, rem = ci & 31, tt = rem >> 3, h = rem & 7, t0 = tt * 64, t = t0 + tok;
      const size_t sidx = (size_t)(b * 256 + t) * 512 + h * 64 + part * 16;
      {
        float x[16];
#pragma unroll
        for (int i = 0; i < 4; ++i) { const float4 v = *(const float4*)(p.in[3] + sidx + i * 4); x[4 * i] = v.x; x[4 * i + 1] = v.y; x[4 * i + 2] = v.z; x[4 * i + 3] = v.w; }
        unsigned w[8];
#pragma unroll
        for (int i = 0; i < 8; ++i) w[i] = pk2(x[2 * i], x[2 * i + 1]);
        uint4* dp = (uint4*)(ckb + sidx);
        dp[0] = make_uint4(w[0], w[1], w[2], w[3]); dp[1] = make_uint4(w[4], w[5], w[6], w[7]);
      }
      {
        float x[16];
#pragma unroll
        for (int i = 0; i < 4; ++i) { const float4 v = *(const float4*)(p.in[4] + sidx + i * 4); x[4 * i] = v.x; x[4 * i + 1] = v.y; x[4 * i + 2] = v.z; x[4 * i + 3] = v.w; }
#pragma unroll
        for (int i = 0; i < 16; ++i) Vs[tok * 72 + part * 16 + i] = f2bf(x[i]);
      }
      __syncthreads();
      {
        const int d = tid >> 2;
        unsigned w[8];
#pragma unroll
        for (int i = 0; i < 8; ++i) w[i] = (unsigned)Vs[(part * 16 + 2 * i) * 72 + d] | ((unsigned)Vs[(part * 16 + 2 * i + 1) * 72 + d] << 16);
        uint4* dp = (uint4*)(cvT + (size_t)((b * 8 + h) * 64 + d) * 256 + t0 + part * 16);
        dp[0] = make_uint4(w[0], w[1], w[2], w[3]); dp[1] = make_uint4(w[4], w[5], w[6], w[7]);
      }
      __syncthreads();
    }
  }
}

DEV float* ops_arr(const Params& p, int i) { return (float*)(p.ws + OFF_OPS + (size_t)i * OPS_ARR); }

DEV f32x4 shiftvec(f32x4 cur, f32x4 hal, f32x4 mu0, f32x4 mu1, int fr) {
  f32x4 prev, next;
#pragma unroll
  for (int i = 0; i < 4; ++i) {
    prev[i] = dpp_mov<0x111>(cur[i]);
    next[i] = dpp_mov<0x101>(cur[i]);
  }
  if (fr == 0) prev = hal;
  if (fr == 15) next = hal;
  return cur + mu0 * (prev - cur) + mu1 * (next - cur);
}
DEV float quad_sum(float x) { x += __shfl_xor(x, 16); x += __shfl_xor(x, 32); return x; }
DEV f32x4 ld4(const float* p) { return *(const f32x4*)p; }

constexpr int LROWB = 392;
DEV void phase_rwprep(const Params& p, unsigned char* smem, int item_) {
  const int tid = threadIdx.x, lane = tid & 63, w = tid >> 6, fr = lane & 15, fq = lane >> 4;
  bf16_t* Lb = (bf16_t*)smem;
  const float* urw = (const float*)(p.ws + OFF_URW);
  const float* mu = p.in[12];
  bf16_t* bonus = (bf16_t*)(p.ws + OFF_BG);
  bf16_t* gate = (bf16_t*)(p.ws + OFF_BG + 6291456);
  const bf16_t* WUPT = (const bf16_t*)(p.ws + OFF_LORA);
  const bf16_t* AUPT = WUPT + 65536;
  const bf16_t* GUPT = WUPT + 131072;
  float* o_r = ops_arr(p, 0); float* o_v = ops_arr(p, 1); float* o_a = ops_arr(p, 2);
  for (int item = item_; item < item_ + 1; ++item) {
    const int t0 = (item >> 1) * 16, h = (item & 1) * 4 + w;
    int s_lo, s_hi;
    if (t0 < NCTX) { s_lo = t0 & ~255; s_hi = s_lo + 256; } else { s_lo = NCTX + ((t0 - NCTX) & ~1023); s_hi = s_lo + 1024; }
    {
      const int tl = tid >> 4, g16 = tid & 15, tt = t0 + tl;
      const float* up = urw + (size_t)tt * RWC + 1536;
      const bool hp = tt > s_lo, hn = tt + 1 < s_hi;
#pragma unroll
      for (int j = 0; j < 6; ++j) {
        const int col = (g16 + 16 * j) * 4;
        const f32x4 c = ld4(up + col);
        const f32x4 z = (f32x4){0.f, 0.f, 0.f, 0.f};
        const f32x4 pv = hp ? ld4(up - RWC + col) : z;
        const f32x4 nx = hn ? ld4(up + RWC + col) : z;
        const f32x4 m0 = ld4(mu + 1536 + col), m1 = ld4(mu + RWC + 1536 + col);
        const f32x4 us = c + m0 * (pv - c) + m1 * (nx - c);
        const int kind = col >> 7;
        float o4[4];
#pragma unroll
        for (int i = 0; i < 4; ++i) o4[i] = kind == 0 ? (1.f - 2.f / (1.f + __expf(2.f * us[i]))) : (kind == 1 ? us[i] : sigmoidf_(us[i]));
        *(uint2*)(Lb + tl * LROWB + col) = make_uint2(pk2(o4[0], o4[1]), pk2(o4[2], o4[3]));
      }
    }
    __syncthreads();
    const int t = t0 + fr;
    const bool lo_ok = (fr == 0) && (t > s_lo), hi_ok = (fr == 15) && (t + 1 < s_hi);
    const float* urow = urw + (size_t)t * RWC;
    const float* hrow = lo_ok ? urow - RWC : (hi_ok ? urow + RWC : urow);
    const bool hal_ok = lo_ok || hi_ok;
    const f32x4 z4 = (f32x4){0.f, 0.f, 0.f, 0.f};
    float ss = 0.f;
#pragma unroll
    for (int ni = 0; ni < 4; ++ni) {
      const int c = h * 64 + ni * 16 + fq * 4;
      const f32x4 kx = shiftvec(ld4(urow + 512 + c), hal_ok ? ld4(hrow + 512 + c) : z4, ld4(mu + 512 + c), ld4(mu + RWC + 512 + c), fr) * ld4(p.in[18] + c);
      ss += kx[0] * kx[0] + kx[1] * kx[1] + kx[2] * kx[2] + kx[3] * kx[3];
    }
    ss = quad_sum(ss);
    const float rn = rsqrtf(ss + 1e-12f);
    float bs = 0.f;
#pragma unroll 1
    for (int ni = 0; ni < 4; ++ni) {
      const int c = h * 64 + ni * 16 + fq * 4;
      const size_t o = (size_t)t * 512 + c;
      const f32x4 r4 = shiftvec(ld4(urow + c), hal_ok ? ld4(hrow + c) : z4, ld4(mu + c), ld4(mu + RWC + c), fr);
      const f32x4 k4 = shiftvec(ld4(urow + 512 + c), hal_ok ? ld4(hrow + 512 + c) : z4, ld4(mu + 512 + c), ld4(mu + RWC + 512 + c), fr);
      const f32x4 v4 = shiftvec(ld4(urow + 1024 + c), hal_ok ? ld4(hrow + 1024 + c) : z4, ld4(mu + 1024 + c), ld4(mu + RWC + 1024 + c), fr);
      const f32x4 kk4 = k4 * ld4(p.in[18] + c) * rn;
      *(f32x4*)(o_r + o) = r4; *(f32x4*)(o_v + o) = v4; *(f32x4*)(o_a + o) = -kk4;
      const f32x4 ka = ld4(p.in[19] + c);
      f32x4 bacc = z4;
#pragma unroll
      for (int e = 0; e < 2; ++e) {
        float* o_k = ops_arr(p, 5 + e); float* o_b = ops_arr(p, 7 + e); float* o_w = ops_arr(p, 3 + e);
        f32x4 acc = z4, acw = z4;
#pragma unroll
        for (int ks = 0; ks < 2; ++ks) {
          const bf16x8 wa = *(const bf16x8*)(AUPT + (size_t)(e * 512 + h * 64 + ni * 16 + fr) * 64 + ks * 32 + fq * 8);
          const bf16x8 la = *(const bf16x8*)(Lb + fr * LROWB + 128 + e * 64 + ks * 32 + fq * 8);
          acc = __builtin_amdgcn_mfma_f32_16x16x32_bf16(wa, la, acc, 0, 0, 0);
          const bf16x8 ww = *(const bf16x8*)(WUPT + (size_t)(e * 512 + h * 64 + ni * 16 + fr) * 64 + ks * 32 + fq * 8);
          const bf16x8 lw = *(const bf16x8*)(Lb + fr * LROWB + e * 64 + ks * 32 + fq * 8);
          acw = __builtin_amdgcn_mfma_f32_16x16x32_bf16(ww, lw, acw, 0, 0, 0);
        }
        const f32x4 a0 = ld4(p.in[15] + e * 512 + c), w0 = ld4(p.in[13] + e * 512 + c);
        f32x4 kd, bb, dec;
#pragma unroll
        for (int i = 0; i < 4; ++i) {
          const float ic = sigmoidf_(a0[i] + acc[i]);
          kd[i] = k4[i] * (1.f + (ic - 1.f) * ka[i]);
          bb[i] = kk4[i] * ic;
          const float z = w0[i] + acw[i];
          const float sp = fmaxf(-z, 0.f) + __logf(1.f + __expf(-fabsf(z)));
          dec[i] = __expf(-__expf(-sp - 0.5f));
        }
        bacc += kd;
        *(f32x4*)(o_k + o) = kd; *(f32x4*)(o_b + o) = bb; *(f32x4*)(o_w + o) = dec;
      }
      const f32x4 rk = ld4(p.in[20] + c);
#pragma unroll
      for (int i = 0; i < 4; ++i) bs += r4[i] * 0.5f * bacc[i] * rk[i];
      f32x4 acc = z4;
#pragma unroll
      for (int ks = 0; ks < 4; ++ks) {
        const bf16x8 wg = *(const bf16x8*)(GUPT + (size_t)(h * 64 + ni * 16 + fr) * 128 + ks * 32 + fq * 8);
        const bf16x8 lg = *(const bf16x8*)(Lb + fr * LROWB + 256 + ks * 32 + fq * 8);
        acc = __builtin_amdgcn_mfma_f32_16x16x32_bf16(wg, lg, acc, 0, 0, 0);
      }
      *(uint2*)(gate + o) = make_uint2(pk2(acc[0], acc[1]), pk2(acc[2], acc[3]));
    }
    bs = quad_sum(bs);
#pragma unroll
    for (int ni = 0; ni < 4; ++ni) {
      const size_t o = (size_t)t * 512 + h * 64 + ni * 16 + fq * 4;
      const f32x4 v4 = *(const f32x4*)(o_v + o);
      *(uint2*)(bonus + o) = make_uint2(pk2(bs * v4[0], bs * v4[1]), pk2(bs * v4[2], bs * v4[3]));
    }
    __syncthreads();
  }
}

DEV void phase_prep(const Params& p, unsigned char* smem, int* s_item, int rep) {
  unsigned* counter = (unsigned*)(p.ws + OFF_CTL) + 16 + rep;
  for (;;) {
    if (threadIdx.x == 0) *s_item = (int)atomicAdd(counter, 1u);
    __syncthreads();
    const int item = *s_item;
    __syncthreads();
    if (item >= 768 + 832) break;
    if (item < 768) phase_rwprep(p, smem, item);
    else phase_qkprep(p, smem, item - 768);
  }
}

constexpr int TC = 16;
typedef float f32x2 __attribute__((ext_vector_type(2)));
template <int EPL, int R, int PD>
DEV void scan_item(const Params& p, unsigned char* smem, int seq, int h, int dir, int rg) {
  constexpr int LPR = 64 / EPL, RPW = 64 / LPR, RPB = 4 * RPW * R, NV = RPB / 16, NP = EPL / 2;
  constexpr int STG = 20480 + 16 * RPB * 4, YOFF = 2 * STG, YSZ = 16 * RPB * 4;
  const int tid = threadIdx.x, lane = tid & 63, w = tid >> 6, riw = lane / LPR, kq = lane % LPR;
  const int T = seq < 16 ? 256 : 1024;
  const int tok0 = seq < 16 ? seq * 256 : NCTX + (seq - 16) * 1024;
  const int vrow_l = (w * RPW + riw) * R;
  const int vrow = rg * RPB + vrow_l;
  f32x2 S[R][NP];
#pragma unroll
  for (int rr = 0; rr < R; ++rr) {
    if (seq >= 16) {
      const float* sp = p.in[2] + ((size_t)(((seq - 16) * 2 + dir) * 8 + h) * 64 + vrow + rr) * 64 + kq * EPL;
#pragma unroll
      for (int i = 0; i < NP; ++i) S[rr][i] = *(const f32x2*)(sp + 2 * i);
    } else {
#pragma unroll
      for (int i = 0; i < NP; ++i) S[rr][i] = (f32x2){0.f, 0.f};
    }
  }
  const int lstep = tid >> 4, l16 = tid & 15;
  const float* pr = ops_arr(p, 0) + h * 64 + l16 * 4;
  const float* pw = ops_arr(p, 3 + dir) + h * 64 + l16 * 4;
  const float* pk = ops_arr(p, 5 + dir) + h * 64 + l16 * 4;
  const float* pa = ops_arr(p, 2) + h * 64 + l16 * 4;
  const float* pb = ops_arr(p, 7 + dir) + h * 64 + l16 * 4;
  const float* pv = ops_arr(p, 1) + h * 64 + rg * RPB + l16;
  float* yout = (float*)(p.ws + (dir ? OFF_YB : OFF_YF)) + h * 64 + rg * RPB + l16;
  const int nc = T / TC;
  float4 g_r, g_w, g_k, g_a, g_b; float rv[NV];
#define gload(c) do { const int ts_ = (c) * TC + lstep; const size_t t_ = (size_t)(tok0 + (dir ? T - 1 - ts_ : ts_)) * 512; \
    g_r = *(const float4*)(pr + t_); g_w = *(const float4*)(pw + t_); g_k = *(const float4*)(pk + t_); \
    g_a = *(const float4*)(pa + t_); g_b = *(const float4*)(pb + t_); \
    _Pragma("unroll") for (int q_ = 0; q_ < NV; ++q_) rv[q_] = pv[t_ + 16 * q_]; } while (0)
#define ywrite(c) do { const float* yb_ = (const float*)(smem + YOFF + ((c) & 1) * YSZ); const int ts_ = (c) * TC + lstep; \
    const size_t t_ = (size_t)(tok0 + (dir ? T - 1 - ts_ : ts_)) * 512; \
    _Pragma("unroll") for (int q_ = 0; q_ < NV; ++q_) yout[t_ + 16 * q_] = yb_[lstep * RPB + l16 + 16 * q_]; } while (0)
  gload(0);
  for (int c = 0; c < nc; ++c) {
    unsigned char* st = smem + (c & 1) * STG;
    *(float4*)(st + 0 * 4096 + lstep * 256 + l16 * 16) = g_r;
    *(float4*)(st + 1 * 4096 + lstep * 256 + l16 * 16) = g_w;
    *(float4*)(st + 2 * 4096 + lstep * 256 + l16 * 16) = g_k;
    *(float4*)(st + 3 * 4096 + lstep * 256 + l16 * 16) = g_a;
    *(float4*)(st + 4 * 4096 + lstep * 256 + l16 * 16) = g_b;
#pragma unroll
    for (int q = 0; q < NV; ++q) *(float*)(st + 20480 + (lstep * RPB + l16 + 16 * q) * 4) = rv[q];
    __syncthreads();
    if (c > 0) ywrite(c - 1);
    if (c + 1 < nc) gload(c + 1);
    float* ybw = (float*)(smem + YOFF + (c & 1) * YSZ);
    constexpr int NS = PD + 1;
    f32x2 o_r[NS][NP], o_w[NS][NP], o_k[NS][NP], o_a[NS][NP], o_b[NS][NP]; float o_v[NS][R];
    float ykeep[R][TC / LPR];
#define LDOPS(bi, s_) do { \
      _Pragma("unroll") for (int i_ = 0; i_ < NP; ++i_) { \
        o_r[bi][i_] = *(const f32x2*)(st + 0 * 4096 + (s_) * 256 + kq * EPL * 4 + i_ * 8); \
        o_w[bi][i_] = *(const f32x2*)(st + 1 * 4096 + (s_) * 256 + kq * EPL * 4 + i_ * 8); \
        o_k[bi][i_] = *(const f32x2*)(st + 2 * 4096 + (s_) * 256 + kq * EPL * 4 + i_ * 8); \
        o_a[bi][i_] = *(const f32x2*)(st + 3 * 4096 + (s_) * 256 + kq * EPL * 4 + i_ * 8); \
        o_b[bi][i_] = *(const f32x2*)(st + 4 * 4096 + (s_) * 256 + kq * EPL * 4 + i_ * 8); } \
      _Pragma("unroll") for (int rr_ = 0; rr_ < R; ++rr_) o_v[bi][rr_] = *(const float*)(st + 20480 + ((s_) * RPB + vrow_l + rr_) * 4); } while (0)
#pragma unroll
    for (int s = 0; s < PD; ++s) LDOPS(s, s);
#pragma unroll
    for (int s = 0; s < TC; ++s) {
      const int bi = s % NS;
      if (s + PD < TC) LDOPS((s + PD) % NS, s + PD);
#pragma unroll
      for (int rr = 0; rr < R; ++rr) {
        const f32x2 vv2 = (f32x2){o_v[bi][rr], o_v[bi][rr]};
        f32x2 pa2 = S[rr][0] * o_a[bi][0];
        f32x2 tt[NP];
        tt[0] = S[rr][0] * o_w[bi][0] + vv2 * o_k[bi][0];
#pragma unroll
        for (int i = 1; i < NP; ++i) { pa2 += S[rr][i] * o_a[bi][i]; tt[i] = S[rr][i] * o_w[bi][i] + vv2 * o_k[bi][i]; }
        float sa = pa2[0] + pa2[1];
        sa += dpp_mov<0xB1>(sa); sa += dpp_mov<0x4E>(sa); sa += dpp_mov<0x141>(sa);
        if (LPR == 16) sa += dpp_mov<0x140>(sa);
        const f32x2 sa2 = (f32x2){sa, sa};
        f32x2 py = (f32x2){0.f, 0.f};
#pragma unroll
        for (int i = 0; i < NP; ++i) { S[rr][i] = sa2 * o_b[bi][i] + tt[i]; py += S[rr][i] * o_r[bi][i]; }
        float y = py[0] + py[1];
        y += dpp_mov<0xB1>(y); y += dpp_mov<0x4E>(y); y += dpp_mov<0x141>(y);
        if (LPR == 16) y += dpp_mov<0x140>(y);
        if ((s % LPR) == 0) ykeep[rr][s / LPR] = y; else ykeep[rr][s / LPR] = (kq == (s % LPR)) ? y : ykeep[rr][s / LPR];
      }
    }
#undef LDOPS
#pragma unroll
    for (int rr = 0; rr < R; ++rr)
#pragma unroll
      for (int q = 0; q < TC / LPR; ++q) ybw[(q * LPR + kq) * RPB + vrow_l + rr] = ykeep[rr][q];
  }
  __syncthreads();
  ywrite(nc - 1);
  if (seq < 16) {
#pragma unroll
    for (int rr = 0; rr < R; ++rr) {
      float* so = p.out + OUT_STATE + ((size_t)((seq * 2 + dir) * 8 + h) * 64 + vrow + rr) * 64 + kq * EPL;
#pragma unroll
      for (int i = 0; i < NP; ++i) *(f32x2*)(so + 2 * i) = S[rr][i];
    }
  }
  __syncthreads();
#undef gload
#undef ywrite
}

DEV void attn_wave_item(const Params& p, int witem) {
  const int lane = threadIdx.x & 63, fr = lane & 15, fq = lane >> 4;
  const bf16_t* qb = (const bf16_t*)(p.ws + OFF_QB);
  const bf16_t* kb = (const bf16_t*)(p.ws + OFF_KB);
  const bf16_t* vT = (const bf16_t*)(p.ws + OFF_VT);
  const bf16_t* ckb = (const bf16_t*)(p.ws + OFF_CKB);
  const bf16_t* cvT = (const bf16_t*)(p.ws + OFF_CVT);
  bf16_t* ona = (bf16_t*)(p.ws + OFF_ONA);
  int h, tq0, nsub;
  bool latent;
  int b = 0, r = 0, jb = 0, row_start = 0, band = 0, seq = 0;
  {
    const int bi = witem >> 2, wv = witem & 3;
    if (bi < 256) {
      latent = true;
      b = bi >> 7; const int rem = bi & 127; r = rem >> 3; h = rem & 7; jb = wv;
      tq0 = NCTX + b * 1024 + r * 64 + jb * 16;
      row_start = min(max(r - 4, 0), 8); band = min(max(jb * 16 - 8, 0), 32);
      nsub = 4;
    } else {
      latent = false;
      const int c2 = bi - 256; seq = c2 >> 5; const int rem = c2 & 31; h = rem >> 2; const int qg = rem & 3;
      tq0 = seq * 256 + (qg * 4 + wv) * 16; nsub = 2;
    }
  }
  const bf16_t* qp = qb + (size_t)(tq0 + fr) * 512 + h * 64 + fq * 8;
  const bf16x8 qf0 = *(const bf16x8*)qp, qf1 = *(const bf16x8*)(qp + 32);
  float m = -INFINITY, l = 0.f;
  f32x4 O[4];
#pragma unroll
  for (int i = 0; i < 4; ++i) O[i] = (f32x4){0.f, 0.f, 0.f, 0.f};
#define SUBDESC(sc_, kbase_, vbase_, KS_, ldv_, win_) do { const int half_ = (sc_) & 1; win_ = latent && (sc_) < 2; \
    if (win_) { const int tb_ = NCTX + b * 1024 + (row_start + half_ * 4) * 64 + band; \
      kbase_ = kb + (size_t)tb_ * 512 + h * 64; vbase_ = vT + (size_t)(h * 64) * NTOK + tb_; KS_ = 64; ldv_ = NTOK; } \
    else if (latent) { kbase_ = ckb + (size_t)(b * 256 + half_ * 128) * 512 + h * 64; vbase_ = cvT + (size_t)((b * 8 + h) * 64) * 256 + half_ * 128; KS_ = 32; ldv_ = 256; } \
    else { const int tb_ = seq * 256 + half_ * 128; kbase_ = kb + (size_t)tb_ * 512 + h * 64; vbase_ = vT + (size_t)(h * 64) * NTOK + tb_; KS_ = 32; ldv_ = NTOK; } } while (0)
#define KLOAD(kbase_, KS_) do { _Pragma("unroll") for (int i_ = 0; i_ < 8; ++i_) { \
      const bf16_t* kp_ = kbase_ + (size_t)((i_ >> 1) * KS_ + (fr >> 2) * 8 + (i_ & 1) * 4 + (fr & 3)) * 512 + fq * 8; \
      kf[2 * i_] = *(const bf16x8*)kp_; kf[2 * i_ + 1] = *(const bf16x8*)(kp_ + 32); } } while (0)
  bf16x8 kf[16];
#pragma unroll 1
  for (int sc = 0; sc < nsub; ++sc) {
    const int half = sc & 1;
    const bf16_t* kbase; const bf16_t* vbase; int KS, ldv; bool win;
    SUBDESC(sc, kbase, vbase, KS, ldv, win);
    KLOAD(kbase, KS);
    bf16x8 vf[4][4];
#pragma unroll
    for (int s = 0; s < 4; ++s)
#pragma unroll
      for (int dt = 0; dt < 4; ++dt) {
        vf[s][dt] = *(const bf16x8*)(vbase + (size_t)(dt * 16 + fr) * ldv + s * KS + fq * 8);
      }
    f32x4 st[8];
#pragma unroll
    for (int i = 0; i < 8; ++i) {
      f32x4 z = (f32x4){0.f, 0.f, 0.f, 0.f};
      z = __builtin_amdgcn_mfma_f32_16x16x32_bf16(kf[2 * i], qf0, z, 0, 0, 0);
      st[i] = __builtin_amdgcn_mfma_f32_16x16x32_bf16(kf[2 * i + 1], qf1, z, 0, 0, 0);
    }
    const bool cwin = win;
    if (cwin) {
      const int q_col = jb * 16 + fr;
      const int win_start = min(max(q_col - 8, 0), 48);
      const float* rpb = p.in[25] + h * 465;
#pragma unroll
      for (int i = 0; i < 8; ++i) {
        const int dr = row_start + half * 4 + (i >> 1) - r + 7;
#pragma unroll
        for (int e = 0; e < 4; ++e) {
          const int k_col = band + fq * 8 + (i & 1) * 4 + e;
          const bool valid = (k_col >= win_start) && (k_col < win_start + 16);
          const int dc = min(max(k_col - q_col, -15), 15) + 15;
          st[i][e] = valid ? st[i][e] + rpb[dr * 31 + dc] : -1e30f;
        }
      }
    }
    float cmax = -1e30f;
#pragma unroll
    for (int i = 0; i < 8; ++i)
#pragma unroll
      for (int e = 0; e < 4; ++e) cmax = fmaxf(cmax, st[i][e]);
    cmax = fmaxf(cmax, __shfl_xor(cmax, 16)); cmax = fmaxf(cmax, __shfl_xor(cmax, 32));
    const float mnew = fmaxf(m, cmax);
    const float alpha = __expf(m - mnew);
    float psum = 0.f;
#pragma unroll
    for (int i = 0; i < 8; ++i)
#pragma unroll
      for (int e = 0; e < 4; ++e) { const float pv = __expf(st[i][e] - mnew); st[i][e] = pv; psum += pv; }
    psum += __shfl_xor(psum, 16); psum += __shfl_xor(psum, 32);
    l = l * alpha + psum;
#pragma unroll
    for (int i = 0; i < 4; ++i) O[i] = O[i] * alpha;
    m = mnew;
#pragma unroll
    for (int s = 0; s < 4; ++s) {
      union { bf16x8 v; unsigned u[4]; } pb;
      pb.u[0] = pk2(st[2 * s][0], st[2 * s][1]); pb.u[1] = pk2(st[2 * s][2], st[2 * s][3]);
      pb.u[2] = pk2(st[2 * s + 1][0], st[2 * s + 1][1]); pb.u[3] = pk2(st[2 * s + 1][2], st[2 * s + 1][3]);
#pragma unroll
      for (int dt = 0; dt < 4; ++dt) {
        O[dt] = __builtin_amdgcn_mfma_f32_16x16x32_bf16(vf[s][dt], pb.v, O[dt], 0, 0, 0);
      }
    }
  }
#undef SUBDESC
#undef KLOAD
  const float inv = 1.f / l;
#pragma unroll
  for (int dt = 0; dt < 4; ++dt) {
    bf16_t* op = ona + (size_t)(tq0 + fr) * 512 + h * 64 + dt * 16 + fq * 4;
    *(uint2*)op = make_uint2(pk2(O[dt][0] * inv, O[dt][1] * inv), pk2(O[dt][2] * inv, O[dt][3] * inv));
  }
}

constexpr int N_SCAN_ITEMS = 128 + 256, N_ATTN_BLK = 768;
DEV void phase_scan_attn(const Params& p, unsigned char* smem, int* s_item, int rep) {
  unsigned* counter = (unsigned*)(p.ws + OFF_CTL) + rep;
  for (;;) {
    if (threadIdx.x == 0) *s_item = (int)atomicAdd(counter, 1u);
    __syncthreads();
    const int item = *s_item;
    __syncthreads();
    if (item >= N_SCAN_ITEMS + N_ATTN_BLK) break;
    if (item < 128) { const int rem = item & 63; scan_item<4, 1, 3>(p, smem, 16 + (item >> 6), rem >> 3, (rem >> 2) & 1, rem & 3); }
    else if (item >= N_SCAN_ITEMS) attn_wave_item(p, (item - N_SCAN_ITEMS) * 4 + (threadIdx.x >> 6));
    else { const int i2 = item - 128, rem = i2 & 15; scan_item<4, 4, 1>(p, smem, i2 >> 4, rem >> 1, rem & 1, 0); }
  }
}

DEV void phase_finalize_rw(const Params& p, int bid, int nb) {
  const int lane = threadIdx.x & 63, gw = bid * 4 + (threadIdx.x >> 6), nw = nb * 4;
  const float* yf = (const float*)(p.ws + OFF_YF);
  const float* yb = (const float*)(p.ws + OFF_YB);
  const bf16_t* bonus = (const bf16_t*)(p.ws + OFF_BG);
  const bf16_t* gate = (const bf16_t*)(p.ws + OFF_BG + 6291456);
  bf16_t* orw = (bf16_t*)(p.ws + OFF_ORW);
  const float4 g0 = *(const float4*)(p.in[21] + lane * 8), g1 = *(const float4*)(p.in[21] + lane * 8 + 4);
  const float4 b0 = *(const float4*)(p.in[22] + lane * 8), b1 = *(const float4*)(p.in[22] + lane * 8 + 4);
  const float gg[8] = {g0.x, g0.y, g0.z, g0.w, g1.x, g1.y, g1.z, g1.w};
  const float bb[8] = {b0.x, b0.y, b0.z, b0.w, b1.x, b1.y, b1.z, b1.w};
#pragma unroll 3
  for (int t = gw; t < NTOK; t += nw) {
    const size_t o = (size_t)t * 512 + lane * 8;
    const float4 a0 = *(const float4*)(yf + o), a1 = *(const float4*)(yf + o + 4);
    const float4 c0 = *(const float4*)(yb + o), c1 = *(const float4*)(yb + o + 4);
    const uint4 bo = *(const uint4*)(bonus + o), ga = *(const uint4*)(gate + o);
    float y[8] = {a0.x + c0.x, a0.y + c0.y, a0.z + c0.z, a0.w + c0.w, a1.x + c1.x, a1.y + c1.y, a1.z + c1.z, a1.w + c1.w};
    float s = 0.f;
#pragma unroll
    for (int i = 0; i < 8; ++i) s += y[i];
    s += dpp_mov<0xB1>(s); s += dpp_mov<0x4E>(s); s += dpp_mov<0x141>(s);
    const float mean = s * (1.f / 64.f);
    float q = 0.f;
#pragma unroll
    for (int i = 0; i < 8; ++i) { y[i] -= mean; q += y[i] * y[i]; }
    q += dpp_mov<0xB1>(q); q += dpp_mov<0x4E>(q); q += dpp_mov<0x141>(q);
    const float rstd = rsqrtf(q * (1.f / 64.f) + 64e-5f);
    const unsigned bu[4] = {bo.x, bo.y, bo.z, bo.w}, gu[4] = {ga.x, ga.y, ga.z, ga.w};
    unsigned w[4];
#pragma unroll
    for (int i = 0; i < 4; ++i) {
      const float lo = (y[2 * i] * rstd * gg[2 * i] + bb[2 * i] + __uint_as_float(bu[i] << 16)) * __uint_as_float(gu[i] << 16);
      const float hi = (y[2 * i + 1] * rstd * gg[2 * i + 1] + bb[2 * i + 1] + __uint_as_float(bu[i] & 0xffff0000u)) * __uint_as_float(gu[i] & 0xffff0000u);
      w[i] = pk2(lo, hi);
    }
    *(uint4*)(orw + o) = make_uint4(w[0], w[1], w[2], w[3]);
  }
}

#define XB_TMO      128
#define XB_XCNT(j)  (256  + 64 * (j))
#define XB_XSUB(j)  (1280 + 64 * (j))
#define XB_XGEN(j)  (2304 + 64 * (j))
#define XB_TOP      3328
#define XB_TOPGEN   3392
#define XCD_BAR_WORDS 3456
#define XB_SPIN_CAP (1u << 18)
#define LAS __attribute__((address_space(3)))
DEV unsigned xb_ld(unsigned* p)              { return __hip_atomic_load(p, __ATOMIC_RELAXED, __HIP_MEMORY_SCOPE_AGENT); }
DEV unsigned xb_add(unsigned* p, unsigned v) { return __hip_atomic_fetch_add(p, v, __ATOMIC_RELAXED, __HIP_MEMORY_SCOPE_AGENT); }
DEV unsigned xb_xcc_id() { return (unsigned)__builtin_amdgcn_s_getreg((3 << 11) | 20) & 0xFu; }
#define XB_SPIN(cond, bar) do { unsigned _sp = 0; while (cond) { __builtin_amdgcn_s_sleep(1); \
    if ((++_sp & 255u) == 0u) { if (xb_ld(&(bar)[XB_TMO])) break; if (_sp > XB_SPIN_CAP) { atomicAdd(&(bar)[XB_TMO], 1u); break; } } } } while (0)
struct XcdBarrier { unsigned* bar; unsigned x; volatile LAS unsigned* st; };
DEV XcdBarrier xcd_barrier_post(unsigned* bar, volatile LAS unsigned* st) {
  XcdBarrier b; b.bar = bar; b.x = xb_xcc_id(); b.st = st;
  if (threadIdx.x == 0) (void)xb_add(&bar[XB_XCNT(b.x)], 1u);
  return b;
}
DEV void xcd_barrier_complete(unsigned* bar, unsigned x, unsigned& nloc, unsigned& nx) {
  const unsigned G = gridDim.x * gridDim.y * gridDim.z;
  unsigned sum, cnt, mine, sp = 0u;
  for (;;) {
    sum = 0u; cnt = 0u; mine = 0u;
#pragma unroll
    for (unsigned j = 0; j < 16; ++j) { const unsigned c = xb_ld(&bar[XB_XCNT(j)]); sum += c; cnt += (c > 0u) ? 1u : 0u; mine = (j == x) ? c : mine; }
    if (sum == G) break;
    __builtin_amdgcn_s_sleep(1);
    if ((++sp & 255u) == 0u) { if (xb_ld(&bar[XB_TMO])) break; if (sp > XB_SPIN_CAP) { atomicAdd(&bar[XB_TMO], 1u); break; } }
  }
  nloc = mine > 0u ? mine : 1u; nx = cnt > 0u ? cnt : 1u;
}
DEV void xcd_barrier(const XcdBarrier& b) {
  asm volatile("s_waitcnt vmcnt(0)" ::: "memory");
  __syncthreads();
  if (threadIdx.x == 0) {
    unsigned* bar = b.bar;
    __builtin_amdgcn_s_waitcnt(0);
    unsigned nloc = b.st[0], nx = b.st[1];
    if (nloc == 0u) { xcd_barrier_complete(bar, b.x, nloc, nx); b.st[0] = nloc; b.st[1] = nx; }
    const unsigned old = xb_add(&bar[XB_XSUB(b.x)], 1u);
    const unsigned gen = old / nloc;
    if (old + 1u == (gen + 1u) * nloc) {
      __builtin_amdgcn_fence(__ATOMIC_RELEASE, "agent");
      asm volatile("s_waitcnt vmcnt(0)" ::: "memory");
      const unsigned og = xb_add(&bar[XB_TOP], 1u);
      const unsigned tg = og / nx;
      if (og + 1u == (tg + 1u) * nx) xb_add(&bar[XB_TOPGEN], 1u);
      else XB_SPIN(xb_ld(&bar[XB_TOPGEN]) == tg, bar);
      __builtin_amdgcn_fence(__ATOMIC_ACQUIRE, "agent");
      xb_add(&bar[XB_XGEN(b.x)], 1u);
      asm volatile("s_waitcnt vmcnt(0)" ::: "memory");
    } else {
      XB_SPIN(xb_ld(&bar[XB_XGEN(b.x)]) == gen, bar);
      __builtin_amdgcn_fence(__ATOMIC_ACQUIRE, "agent");
      asm volatile("s_waitcnt vmcnt(0)" ::: "memory");
    }
  }
  __syncthreads();
}

__global__ void __launch_bounds__(NTHR, 2) fwd_megakernel(Params p) {
  extern __shared__ __attribute__((aligned(16))) unsigned char smem[];
  __shared__ __attribute__((aligned(16))) unsigned sh_ctl[8];
  cg::grid_group grid = cg::this_grid();
  const int bid = blockIdx.x, nb = gridDim.x;
  if (threadIdx.x < 8) sh_ctl[threadIdx.x] = 0u;
  __syncthreads();
  const XcdBarrier xb = xcd_barrier_post((unsigned*)(p.ws + OFF_CTL), (volatile LAS unsigned*)sh_ctl);
  int* s_item_p = (int*)&sh_ctl[4];
  if (p.ph_hi > 1000) grid.sync();
#define GSYNC() xcd_barrier(xb)
#ifndef DUP
#define DUP -1
#endif
#define PH(n, body) if (p.ph_lo <= n && n < p.ph_hi) { { const int rep = 0; (void)rep; body; } if (DUP == n) { GSYNC(); const int rep = 1; (void)rep; body; } if (n + 1 < p.ph_hi) GSYNC(); }
  PH(0, phase0(p, smem, bid, nb, rep))
  PH(1, phase_normmod<0>(p, bid, nb))
  PH(2, reset_tiles(s_item_p); phase_gemm_in(p, smem, s_item_p))
  PH(3, phase_prep(p, smem, s_item_p, rep))
  PH(4, phase_scan_attn(p, smem, s_item_p, rep))
  PH(5, phase_finalize_rw(p, bid, nb))
  PH(6, reset_tiles(s_item_p); phase_gemm_merge(p, smem, s_item_p))
  PH(7, reset_tiles(s_item_p); phase_gemm_out(p, smem, s_item_p))
  PH(8, phase_normmod<1>(p, bid, nb))
  PH(9, reset_tiles(s_item_p); phase_gemm_ffn_up(p, smem, s_item_p))
  PH(10, reset_tiles(s_item_p); phase_gemm_ffn_down(p, smem, s_item_p))
}

extern "C" void kernel_launch(void* const* d_in, const int* in_sizes, int n_in, void* d_out, int out_size, void* d_ws, size_t ws_size,
                              hipStream_t stream) {
  static int grid_blocks = 0;
  if (grid_blocks == 0) {
    if (n_in != 32 || ws_size < WS_END) { fprintf(stderr, "kernel_launch: unexpected n_in %d / ws_size %zu (need %zu)\n", n_in, ws_size, (size_t)WS_END); grid_blocks = -1; return; }
    int dev = 0, cus = 0, per_cu = 0;
    hipGetDevice(&dev);
    hipDeviceGetAttribute(&cus, hipDeviceAttributeMultiprocessorCount, dev);
    if (hipFuncSetAttribute((const void*)fwd_megakernel, hipFuncAttributeMaxDynamicSharedMemorySize, LDS_BYTES) != hipSuccess) { fprintf(stderr, "hipFuncSetAttribute failed\n"); grid_blocks = -1; return; }
    if (hipOccupancyMaxActiveBlocksPerMultiprocessor(&per_cu, (const void*)fwd_megakernel, NTHR, LDS_BYTES) != hipSuccess || per_cu < 1) { fprintf(stderr, "occupancy query failed (%d)\n", per_cu); grid_blocks = -1; return; }
    if (per_cu > 2) per_cu = 2;
    grid_blocks = cus * per_cu;
    fprintf(stderr, "kernel_launch: cus %d per_cu %d grid %d\n", cus, per_cu, grid_blocks);
  }
  if (grid_blocks < 0) return;
  hipMemsetAsync((char*)d_ws + OFF_CTL, 0, CTL_ZERO_BYTES, stream);
  Params p{};
  for (int i = 0; i < 32; ++i) p.in[i] = (const float*)d_in[i];
  p.out = (float*)d_out; p.ws = (unsigned char*)d_ws; p.ph_lo = 0; p.ph_hi = 11;
  void* args[] = {&p};
  hipError_t e = hipLaunchCooperativeKernel((const void*)fwd_megakernel, dim3(grid_blocks), dim3(NTHR), args, LDS_BYTES, stream);
  if (e != hipSuccess) fprintf(stderr, "cooperative launch failed: %s (grid %d)\n", hipGetErrorString(e), grid_blocks);
}
```

```cpp
#include <hip/hip_runtime.h>
#include <hip/hip_cooperative_groups.h>
#include <cstdio>
#include <cstdint>
namespace cg = cooperative_groups;

#define DEV __device__ __forceinline__
typedef unsigned short bf16_t;
typedef short bf16x8 __attribute__((ext_vector_type(8)));
typedef short bf16x4 __attribute__((ext_vector_type(4)));
typedef float f32x4 __attribute__((ext_vector_type(4)));

constexpr int D = 1024, NTOK = 6144, NCTX = 4096, RW = 512, FF = 2816, INC = 5504, RWC = 1920;
constexpr int NTHR = 256;
constexpr int LDS_BYTES = 65536;

constexpr size_t OFF_CTL = 0;
constexpr size_t OFF_MOD = 16384;
constexpr size_t CTL_ZERO_BYTES = 16384 + 3 * 6144 * 4;
constexpr size_t OFF_WIN = 90112;
constexpr size_t OFF_WORW = OFF_WIN + 11272192;
constexpr size_t OFF_WONA = OFF_WORW + 1048576;
constexpr size_t OFF_WOUT = OFF_WONA + 1048576;
constexpr size_t OFF_W13 = OFF_WOUT + 2097152;
constexpr size_t OFF_W2 = OFF_W13 + 11534336;
constexpr size_t OFF_H = OFF_W2 + 5767168;
constexpr size_t OFF_URW = OFF_H + 12582912;
constexpr size_t OFF_UNA = OFF_URW + 47185920;
constexpr size_t OFF_OPS = OFF_UNA + 37748736;
constexpr size_t OPS_ARR = 12582912;
constexpr size_t OFF_BG = OFF_OPS + 9 * OPS_ARR;
constexpr size_t OFF_VT = OFF_BG + 12582912;
constexpr size_t OFF_CKB = OFF_VT + 6291456;
constexpr size_t OFF_CVT = OFF_CKB + 524288;
constexpr size_t OFF_LORA = OFF_CVT + 524288;
constexpr size_t WS_END = OFF_LORA + 393216;
constexpr size_t OFF_QB = OFF_UNA + 12582912, OFF_KB = OFF_UNA + 18874368;
constexpr size_t OFF_YF = OFF_URW, OFF_YB = OFF_URW + 12582912;
constexpr size_t OFF_ORW = OFF_UNA, OFF_ONA = OFF_UNA + 6291456;
constexpr size_t OFF_MERGED = OFF_OPS;
constexpr size_t OFF_HID = OFF_URW;
constexpr size_t OUT_STATE = 6291456, OUT_K = 7340032, OUT_V = 9437184;

struct Params {
  const float* in[32];
  float* out;
  unsigned char* ws;
  int ph_lo, ph_hi;
};

DEV unsigned short f2bf(float f) { unsigned u = __float_as_uint(f); u += 0x7fffu + ((u >> 16) & 1u); return (unsigned short)(u >> 16); }
DEV unsigned pk2(float lo, float hi) { return (unsigned)f2bf(lo) | ((unsigned)f2bf(hi) << 16); }
DEV float bf2f(unsigned short b) { return __uint_as_float(((unsigned)b) << 16); }
DEV float sigmoidf_(float x) { return 1.f / (1.f + __expf(-x)); }
DEV float wave_sum(float x) {
#pragma unroll
  for (int o = 32; o > 0; o >>= 1) x += __shfl_xor(x, o);
  return x;
}
template <int CTRL> DEV float dpp_mov(float x) { return __int_as_float(__builtin_amdgcn_update_dpp(0, __float_as_int(x), CTRL, 0xf, 0xf, true)); }
DEV float row16_sum(float x) {
  x += dpp_mov<0xB1>(x); x += dpp_mov<0x4E>(x); x += dpp_mov<0x141>(x); x += dpp_mov<0x140>(x);
  return x;
}
#define BAR_LDS() do { asm volatile("s_waitcnt lgkmcnt(0)" ::: "memory"); __builtin_amdgcn_s_barrier(); asm volatile("" ::: "memory"); } while (0)
DEV const float* xrow(const Params& p, int t) { return t < NCTX ? p.in[0] + (size_t)t * D : p.in[1] + (size_t)(t - NCTX) * D; }
DEV int modidx(int t) { return t < NCTX ? 0 : 1 + ((t - NCTX) >> 10); }

DEV void conv_job(const Params& p, int j, const float*& src, bf16_t*& dst, int& K, int& N, int& mode, int& base) {
  if (j < 1376) { src = p.in[11]; dst = (bf16_t*)(p.ws + OFF_WIN); K = 1024; N = 5504; mode = 0; base = 0; }
  else if (j < 1504) { src = p.in[26]; dst = (bf16_t*)(p.ws + OFF_WORW); K = 512; N = 1024; mode = 0; base = 1376; }
  else if (j < 1632) { src = p.in[27]; dst = (bf16_t*)(p.ws + OFF_WONA); K = 512; N = 1024; mode = 0; base = 1504; }
  else if (j < 1888) { src = p.in[28]; dst = (bf16_t*)(p.ws + OFF_WOUT); K = 1024; N = 1024; mode = 0; base = 1632; }
  else if (j < 2592) { src = p.in[29]; dst = (bf16_t*)(p.ws + OFF_W13); K = 1024; N = 2816; mode = 1; base = 1888; }
  else if (j < 3296) { src = p.in[30]; dst = (bf16_t*)(p.ws + OFF_W13); K = 1024; N = 2816; mode = 2; base = 2592; }
  else if (j < 4000) { src = p.in[31]; dst = (bf16_t*)(p.ws + OFF_W2); K = 2816; N = 1024; mode = 0; base = 3296; }
  else if (j < 4016) { const int e = (j - 4000) >> 3; src = p.in[14] + e * 32768; dst = (bf16_t*)(p.ws + OFF_LORA) + e * 32768; K = 64; N = 512; mode = 0; base = 4000 + e * 8; }
  else if (j < 4032) { const int e = (j - 4016) >> 3; src = p.in[16] + e * 32768; dst = (bf16_t*)(p.ws + OFF_LORA) + 65536 + e * 32768; K = 64; N = 512; mode = 0; base = 4016 + e * 8; }
  else { src = p.in[17]; dst = (bf16_t*)(p.ws + OFF_LORA) + 131072; K = 128; N = 512; mode = 0; base = 4032; }
}
constexpr int N_CONV_TILES = 4048, N_MOD_TILES = 768;

DEV void phase0(const Params& p, unsigned char* smem, int bid, int nb, int rep) {
  const int tid = threadIdx.x;
  float* T = (float*)smem;
  for (int tile = bid; tile < N_MOD_TILES && rep == 0; tile += nb) {
    const int cgp = tile % 24, kc = tile / 24;
    if (tid < 96) {
      const int m = tid >> 5, kk = tid & 31, k = kc * 32 + kk;
      const float c = (m == 0) ? p.in[6][k] : p.in[5][(m - 1) * D + k];
      T[tid] = c * sigmoidf_(c);
    }
    __syncthreads();
    const int col = cgp * 256 + tid;
    const float* w = p.in[9] + (size_t)(kc * 32) * 6144 + col;
    float a0 = 0.f, a1 = 0.f, a2 = 0.f;
#pragma unroll
    for (int kk = 0; kk < 32; ++kk) {
      const float wv = w[(size_t)kk * 6144];
      a0 += T[kk] * wv; a1 += T[32 + kk] * wv; a2 += T[64 + kk] * wv;
    }
    if (kc == 0) { const float b = p.in[10][col]; a0 += b; a1 += b; a2 += b; }
    float* mod = (float*)(p.ws + OFF_MOD);
    atomicAdd(mod + col, a0); atomicAdd(mod + 6144 + col, a1); atomicAdd(mod + 12288 + col, a2);
    __syncthreads();
  }
  const int r_ = tid >> 4, c4_ = tid & 15;
  float4 v[4];
  const float* src; bf16_t* dst; int K, N, mode, base;
  int tile = bid;
  if (tile < N_CONV_TILES) {
    conv_job(p, tile, src, dst, K, N, mode, base);
    const int lt = tile - base, nN = N >> 6, k0 = (lt / nN) * 64, n0 = (lt % nN) * 64;
#pragma unroll
    for (int i = 0; i < 4; ++i) v[i] = *(const float4*)(src + (size_t)(k0 + r_ + 16 * i) * N + n0 + c4_ * 4);
  }
  while (tile < N_CONV_TILES) {
    const int lt = tile - base, nN = N >> 6, k0 = (lt / nN) * 64, n0 = (lt % nN) * 64;
    bf16_t* cdst = dst; const int cK = K, cmode = mode;
#pragma unroll
    for (int i = 0; i < 4; ++i) {
      float* tp = T + (r_ + 16 * i) * 65 + c4_ * 4;
      tp[0] = v[i].x; tp[1] = v[i].y; tp[2] = v[i].z; tp[3] = v[i].w;
    }
    BAR_LDS();
    tile += nb;
    if (tile < N_CONV_TILES) {
      conv_job(p, tile, src, dst, K, N, mode, base);
      const int lt2 = tile - base, nN2 = N >> 6, k2 = (lt2 / nN2) * 64, n2 = (lt2 % nN2) * 64;
#pragma unroll
      for (int i = 0; i < 4; ++i) v[i] = *(const float4*)(src + (size_t)(k2 + r_ + 16 * i) * N + n2 + c4_ * 4);
    }
    const int n = tid >> 2, kp = tid & 3;
    unsigned w[8];
#pragma unroll
    for (int i = 0; i < 8; ++i) w[i] = pk2(T[(kp * 16 + 2 * i) * 65 + n], T[(kp * 16 + 2 * i + 1) * 65 + n]);
    const int ng = n0 + n;
    int drow = ng;
    if (cmode == 1) drow = (ng >> 4) * 32 + (ng & 15);
    else if (cmode == 2) drow = (ng >> 4) * 32 + 16 + (ng & 15);
    uint4* dp = (uint4*)(cdst + (size_t)drow * cK + k0 + kp * 16);
    dp[0] = make_uint4(w[0], w[1], w[2], w[3]);
    dp[1] = make_uint4(w[4], w[5], w[6], w[7]);
    BAR_LDS();
  }
}

template <int WHICH>
DEV void phase_normmod(const Params& p, int bid, int nb) {
  const int lane = threadIdx.x & 63, gw = bid * 4 + (threadIdx.x >> 6), nw = nb * 4;
  const float* g = WHICH == 0 ? p.in[7] : p.in[8];
  const float* mod = (const float*)(p.ws + OFF_MOD);
  const int sh_off = WHICH == 0 ? 0 : 3072, sc_off = WHICH == 0 ? 1024 : 4096;
  bf16_t* dst = (bf16_t*)(p.ws + OFF_H);
#pragma unroll 3
  for (int t = gw; t < NTOK; t += nw) {
    const float* xp = WHICH == 0 ? xrow(p, t) : p.out + (size_t)t * D;
    const float* mm = mod + modidx(t) * 6144;
    float4 v[4];
    float ss = 0.f;
#pragma unroll
    for (int i = 0; i < 4; ++i) {
      v[i] = *(const float4*)(xp + (i * 64 + lane) * 4);
      ss += v[i].x * v[i].x + v[i].y * v[i].y + v[i].z * v[i].z + v[i].w * v[i].w;
    }
    ss = wave_sum(ss);
    const float rstd = rsqrtf(ss * (1.f / 1024.f) + 1e-6f);
#pragma unroll
    for (int i = 0; i < 4; ++i) {
      const int col = (i * 64 + lane) * 4;
      const float4 g4 = *(const float4*)(g + col);
      const float4 sc = *(const float4*)(mm + sc_off + col);
      const float4 sh = *(const float4*)(mm + sh_off + col);
      const float y0 = v[i].x * rstd * g4.x * (1.f + sc.x) + sh.x;
      const float y1 = v[i].y * rstd * g4.y * (1.f + sc.y) + sh.y;
      const float y2 = v[i].z * rstd * g4.z * (1.f + sc.z) + sh.z;
      const float y3 = v[i].w * rstd * g4.w * (1.f + sc.w) + sh.w;
      *(uint2*)(dst + (size_t)t * D + col) = make_uint2(pk2(y0, y1), pk2(y2, y3));
    }
  }
}

template <int MI>
DEV void gemm_tile_acc(f32x4 (&acc)[MI][4], const bf16_t* __restrict__ A, int lda, const bf16_t* __restrict__ Bt, int ldb,
                       int m0, int n0, int K, unsigned char* smem) {
  constexpr int AT = 2 * MI * 16 * 128, BT = 16384, STG = AT + BT;
  const int tid = threadIdx.x, lane = tid & 63, wid = tid >> 6, wr = wid >> 1, wc = wid & 1, fr = lane & 15, fq = lane >> 4;
  const int gkc = (tid & 7) ^ ((tid >> 4) & 7);
  const bf16_t* ga = A + (size_t)(m0 + (tid >> 3)) * lda + gkc * 8;
  const bf16_t* gb = Bt + (size_t)(n0 + (tid >> 3)) * ldb + gkc * 8;
  const int swz = (fr >> 1) & 7;
  const int nk = K >> 6;
#define GLDS_TILE(kt_, buf_) do { unsigned char* sb_ = smem + (buf_) * STG; const int k0_ = (kt_) * 64; \
    _Pragma("unroll") for (int i_ = 0; i_ < (2 * MI * 16) / 32; ++i_) \
      __builtin_amdgcn_global_load_lds((const unsigned*)(ga + (size_t)i_ * 32 * lda + k0_), (__attribute__((address_space(3))) unsigned*)(sb_ + (i_ * 256 + tid) * 16), 16, 0, 0); \
    _Pragma("unroll") for (int i_ = 0; i_ < 4; ++i_) \
      __builtin_amdgcn_global_load_lds((const unsigned*)(gb + (size_t)i_ * 32 * ldb + k0_), (__attribute__((address_space(3))) unsigned*)(sb_ + AT + (i_ * 256 + tid) * 16), 16, 0, 0); \
  } while (0)
  GLDS_TILE(0, 0);
  asm volatile("s_waitcnt vmcnt(0)" ::: "memory");
  __syncthreads();
  for (int kt = 0; kt < nk; ++kt) {
    if (kt + 1 < nk) GLDS_TILE(kt + 1, (kt + 1) & 1);
    const unsigned char* cur = smem + (kt & 1) * STG;
#pragma unroll
    for (int ks = 0; ks < 2; ++ks) {
      bf16x8 af[MI], bf[4];
      const int co = ((ks * 4 + fq) ^ swz) << 4;
#pragma unroll
      for (int mi = 0; mi < MI; ++mi) af[mi] = *(const bf16x8*)(cur + (wr * MI * 16 + mi * 16 + fr) * 128 + co);
#pragma unroll
      for (int ni = 0; ni < 4; ++ni) bf[ni] = *(const bf16x8*)(cur + AT + (wc * 64 + ni * 16 + fr) * 128 + co);
      __builtin_amdgcn_s_setprio(1);
#pragma unroll
      for (int mi = 0; mi < MI; ++mi)
#pragma unroll
        for (int ni = 0; ni < 4; ++ni) acc[mi][ni] = __builtin_amdgcn_mfma_f32_16x16x32_bf16(bf[ni], af[mi], acc[mi][ni], 0, 0, 0);
      __builtin_amdgcn_s_setprio(0);
    }
    asm volatile("s_waitcnt vmcnt(0)" ::: "memory");
    __syncthreads();
  }
#undef GLDS_TILE
}

template <int MI>
DEV void zero_acc(f32x4 (&acc)[MI][4]) {
#pragma unroll
  for (int i = 0; i < MI; ++i)
#pragma unroll
    for (int j = 0; j < 4; ++j) acc[i][j] = (f32x4){0.f, 0.f, 0.f, 0.f};
}

#ifndef DYN_TILES
#define DYN_TILES 0
#endif
DEV int grab_tile(const Params& p, int word, int* slot) {
#if DYN_TILES
  if (threadIdx.x == 0) *slot = (int)atomicAdd((unsigned*)(p.ws + OFF_CTL) + word, 1u);
  __syncthreads();
  const int t = *slot;
  __syncthreads();
  return t;
#else
  const int t = slot[1];
  __syncthreads();
  if (threadIdx.x == 0) slot[1] = t + gridDim.x;
  __syncthreads();
  return t;
#endif
}
DEV void reset_tiles(int* slot) { if (threadIdx.x == 0) slot[1] = blockIdx.x; __syncthreads(); }

#define EPI_COORDS const int lane = threadIdx.x & 63, wid = threadIdx.x >> 6, wr = wid >> 1, wc = wid & 1, fr = lane & 15, fq = lane >> 4

DEV void phase_gemm_in(const Params& p, unsigned char* smem, int* slot) {
  EPI_COORDS;
  const bf16_t* A = (const bf16_t*)(p.ws + OFF_H);
  const bf16_t* Bt = (const bf16_t*)(p.ws + OFF_WIN);
  float* urw = (float*)(p.ws + OFF_URW);
  float* una = (float*)(p.ws + OFF_UNA);
  bf16_t* gates = (bf16_t*)p.out;
  for (;;) {
    const int tile = grab_tile(p, 8, slot);
    if (tile >= 48 * 43) break;
    const int tm = tile % 48, tn = tile / 48, m0 = tm * 128, n0 = tn * 128;
    f32x4 acc[4][4];
    zero_acc<4>(acc);
    gemm_tile_acc<4>(acc, A, D, Bt, D, m0, n0, D, smem);
    if (n0 >= 1920 && n0 < 3456) {
      const int sec = (n0 - 1920) >> 9;
      const int h = (((n0 - 1920) & 511) >> 6) + wc;
      bf16_t* qb = (bf16_t*)(p.ws + OFF_QB); bf16_t* kb = (bf16_t*)(p.ws + OFF_KB); bf16_t* vT = (bf16_t*)(p.ws + OFF_VT);
#pragma unroll
      for (int mi = 0; mi < 4; ++mi) {
        const int row = m0 + wr * 64 + mi * 16 + fr;
        if (sec < 2) {
          float ss = 0.f;
#pragma unroll
          for (int ni = 0; ni < 4; ++ni) { const f32x4 v = acc[mi][ni]; ss += v[0] * v[0] + v[1] * v[1] + v[2] * v[2] + v[3] * v[3]; }
          ss += __shfl_xor(ss, 16); ss += __shfl_xor(ss, 32);
          const float rs = rsqrtf(ss * (1.f / 64.f) + 1e-6f) * (sec == 0 ? 0.125f : 1.f);
          const float* gv = sec == 0 ? p.in[23] : p.in[24];
          bf16_t* dstb = (sec == 0 ? qb : kb) + (size_t)row * 512 + h * 64;
#pragma unroll
          for (int ni = 0; ni < 4; ++ni) {
            const int d = ni * 16 + fq * 4;
            const f32x4 x = acc[mi][ni] * rs * (*(const f32x4*)(gv + d));
            *(uint2*)(dstb + d) = make_uint2(pk2(x[0], x[1]), pk2(x[2], x[3]));
            if (sec == 1 && row < NCTX) *(f32x4*)(p.out + OUT_K + (size_t)row * 512 + h * 64 + d) = x;
          }
        } else {
#pragma unroll
          for (int ni = 0; ni < 4; ++ni) {
            const int d = ni * 16 + fq * 4;
            const f32x4 x = acc[mi][ni];
            if (row < NCTX) *(f32x4*)(p.out + OUT_V + (size_t)row * 512 + h * 64 + d) = x;
#pragma unroll
            for (int e2 = 0; e2 < 4; ++e2) *(bf16_t*)(smem + (wc * 64 + d + e2) * 272 + (wr * 64 + mi * 16 + fr) * 2) = f2bf(x[e2]);
          }
        }
      }
      if (sec == 2) {
        __syncthreads();
        const int dd = threadIdx.x >> 1, hf = threadIdx.x & 1;
        const int hb = ((n0 - 1920) & 511) >> 6;
        bf16_t* vrow = vT + (size_t)(hb * 64 + dd) * NTOK + m0 + hf * 64;
#pragma unroll
        for (int j = 0; j < 8; ++j) *(uint4*)(vrow + j * 8) = *(const uint4*)(smem + dd * 272 + hf * 128 + j * 16);
        __syncthreads();
      }
    } else {
#pragma unroll
      for (int mi = 0; mi < 4; ++mi) {
        const int row = m0 + wr * 64 + mi * 16 + fr;
#pragma unroll
        for (int ni = 0; ni < 4; ++ni) {
          const int col = n0 + wc * 64 + ni * 16 + fq * 4;
          const f32x4 v = acc[mi][ni];
          if (n0 < 1920) *(f32x4*)(urw + (size_t)row * 1920 + col) = v;
          else *(uint2*)(gates + (size_t)row * 2048 + (col - 3456)) = make_uint2(pk2(sigmoidf_(v[0]), sigmoidf_(v[1])), pk2(sigmoidf_(v[2]), sigmoidf_(v[3])));
        }
      }
    }
  }
}

DEV void phase_gemm_merge(const Params& p, unsigned char* smem, int* slot) {
  EPI_COORDS;
  const bf16_t* orw = (const bf16_t*)(p.ws + OFF_ORW);
  const bf16_t* ona = (const bf16_t*)(p.ws + OFF_ONA);
  const bf16_t* w1 = (const bf16_t*)(p.ws + OFF_WORW);
  const bf16_t* w2 = (const bf16_t*)(p.ws + OFF_WONA);
  const bf16_t* gates = (const bf16_t*)p.out;
  bf16_t* merged = (bf16_t*)(p.ws + OFF_MERGED);
  float* mtmp = (float*)(p.ws + OFF_MERGED + 16777216);
  for (;;) {
    const int tile = grab_tile(p, 9, slot);
    if (tile >= 64 * 8) break;
    const int tm = tile % 64, tn = tile / 64, m0 = tm * 96, n0 = tn * 128;
    f32x4 acc[3][4];
    zero_acc<3>(acc);
    gemm_tile_acc<3>(acc, orw, RW, w1, RW, m0, n0, RW, smem);
#pragma unroll
    for (int mi = 0; mi < 3; ++mi) {
      const int row = m0 + wr * 48 + mi * 16 + fr;
#pragma unroll
      for (int ni = 0; ni < 4; ++ni) {
        const int col = n0 + wc * 64 + ni * 16 + fq * 4;
        const uint2 g = *(const uint2*)(gates + (size_t)row * 2048 + col);
        f32x4 r;
        r[0] = acc[mi][ni][0] * bf2f((unsigned short)(g.x & 0xffff));
        r[1] = acc[mi][ni][1] * bf2f((unsigned short)(g.x >> 16));
        r[2] = acc[mi][ni][2] * bf2f((unsigned short)(g.y & 0xffff));
        r[3] = acc[mi][ni][3] * bf2f((unsigned short)(g.y >> 16));
        *(f32x4*)(mtmp + (size_t)row * D + col) = r;
      }
    }
    zero_acc<3>(acc);
    gemm_tile_acc<3>(acc, ona, RW, w2, RW, m0, n0, RW, smem);
#pragma unroll
    for (int mi = 0; mi < 3; ++mi) {
      const int row = m0 + wr * 48 + mi * 16 + fr;
#pragma unroll
      for (int ni = 0; ni < 4; ++ni) {
        const int col = n0 + wc * 64 + ni * 16 + fq * 4;
        const uint2 g = *(const uint2*)(gates + (size_t)row * 2048 + 1024 + col);
        const f32x4 mg = *(const f32x4*)(mtmp + (size_t)row * D + col);
        const float r0 = mg[0] + acc[mi][ni][0] * bf2f((unsigned short)(g.x & 0xffff));
        const float r1 = mg[1] + acc[mi][ni][1] * bf2f((unsigned short)(g.x >> 16));
        const float r2 = mg[2] + acc[mi][ni][2] * bf2f((unsigned short)(g.y & 0xffff));
        const float r3 = mg[3] + acc[mi][ni][3] * bf2f((unsigned short)(g.y >> 16));
        *(uint2*)(merged + (size_t)row * D + col) = make_uint2(pk2(r0, r1), pk2(r2, r3));
      }
    }
  }
}

DEV void phase_gemm_out(const Params& p, unsigned char* smem, int* slot) {
  EPI_COORDS;
  const bf16_t* A = (const bf16_t*)(p.ws + OFF_MERGED);
  const bf16_t* Bt = (const bf16_t*)(p.ws + OFF_WOUT);
  const float* mod = (const float*)(p.ws + OFF_MOD);
  for (;;) {
    const int tile = grab_tile(p, 10, slot);
    if (tile >= 64 * 8) break;
    const int tm = tile % 64, tn = tile / 64, m0 = tm * 96, n0 = tn * 128;
    f32x4 acc[3][4];
    zero_acc<3>(acc);
    gemm_tile_acc<3>(acc, A, D, Bt, D, m0, n0, D, smem);
#pragma unroll
    for (int mi = 0; mi < 3; ++mi) {
      const int row = m0 + wr * 48 + mi * 16 + fr;
      const float* xp = xrow(p, row);
      const float* g1 = mod + modidx(row) * 6144 + 2048;
#pragma unroll
      for (int ni = 0; ni < 4; ++ni) {
        const int col = n0 + wc * 64 + ni * 16 + fq * 4;
        const f32x4 x = *(const f32x4*)(xp + col);
        const f32x4 g = *(const f32x4*)(g1 + col);
        *(f32x4*)(p.out + (size_t)row * D + col) = x + g * acc[mi][ni];
      }
    }
  }
}

DEV void phase_gemm_ffn_up(const Params& p, unsigned char* smem, int* slot) {
  EPI_COORDS;
  const bf16_t* A = (const bf16_t*)(p.ws + OFF_H);
  const bf16_t* Bt = (const bf16_t*)(p.ws + OFF_W13);
  bf16_t* hid = (bf16_t*)(p.ws + OFF_HID);
  for (;;) {
    const int tile = grab_tile(p, 11, slot);
    if (tile >= 48 * 44) break;
    const int tm = tile % 48, tn = tile / 48, m0 = tm * 128, n0 = tn * 128;
    f32x4 acc[4][4];
    zero_acc<4>(acc);
    gemm_tile_acc<4>(acc, A, D, Bt, D, m0, n0, D, smem);
#pragma unroll
    for (int mi = 0; mi < 4; ++mi) {
      const int row = m0 + wr * 64 + mi * 16 + fr;
#pragma unroll
      for (int gp = 0; gp < 2; ++gp) {
        const int hcol = ((n0 + wc * 64) >> 1) + gp * 16 + fq * 4;
        const f32x4 a = acc[mi][2 * gp], b = acc[mi][2 * gp + 1];
        float r[4];
#pragma unroll
        for (int e = 0; e < 4; ++e) r[e] = a[e] * sigmoidf_(a[e]) * b[e];
        *(uint2*)(hid + (size_t)row * FF + hcol) = make_uint2(pk2(r[0], r[1]), pk2(r[2], r[3]));
      }
    }
  }
}

DEV void phase_gemm_ffn_down(const Params& p, unsigned char* smem, int* slot) {
  EPI_COORDS;
  const bf16_t* A = (const bf16_t*)(p.ws + OFF_HID);
  const bf16_t* Bt = (const bf16_t*)(p.ws + OFF_W2);
  const float* mod = (const float*)(p.ws + OFF_MOD);
  for (;;) {
    const int tile = grab_tile(p, 12, slot);
    if (tile >= 64 * 8) break;
    const int tm = tile % 64, tn = tile / 64, m0 = tm * 96, n0 = tn * 128;
    f32x4 acc[3][4];
    zero_acc<3>(acc);
    gemm_tile_acc<3>(acc, A, FF, Bt, FF, m0, n0, FF, smem);
#pragma unroll
    for (int mi = 0; mi < 3; ++mi) {
      const int row = m0 + wr * 48 + mi * 16 + fr;
      const float* g2 = mod + modidx(row) * 6144 + 5120;
#pragma unroll
      for (int ni = 0; ni < 4; ++ni) {
        const int col = n0 + wc * 64 + ni * 16 + fq * 4;
        float* op = p.out + (size_t)row * D + col;
        const f32x4 x = *(const f32x4*)op;
        const f32x4 g = *(const f32x4*)(g2 + col);
        *(f32x4*)op = x + g * acc[mi][ni];
      }
    }
  }
}

DEV void phase_qkprep(const Params& p, unsigned char* smem, int item_) {
  const int tid = threadIdx.x;
  bf16_t* Vs = (bf16_t*)smem;
  bf16_t* qb = (bf16_t*)(p.ws + OFF_QB);
  bf16_t* kb = (bf16_t*)(p.ws + OFF_KB);
  bf16_t* vT = (bf16_t*)(p.ws + OFF_VT);
  bf16_t* ckb = (bf16_t*)(p.ws + OFF_CKB);
  bf16_t* cvT = (bf16_t*)(p.ws + OFF_CVT);
  const float* una = (const float*)(p.ws + OFF_UNA);
  const int tok = tid >> 2, part = tid & 3;
  for (int item = item_; item < item_ + 1; ++item) {
    if (item < 768) {
      const int tt = item >> 3, h = item & 7, t0 = tt * 64, t = t0 + tok;
      const float* src = una + (size_t)t * 1536 + h * 64 + part * 16;
      {
        float x[16]; float ss = 0.f;
#pragma unroll
        for (int i = 0; i < 4; ++i) { const float4 v = *(const float4*)(src + i * 4); x[4 * i] = v.x; x[4 * i + 1] = v.y; x[4 * i + 2] = v.z; x[4 * i + 3] = v.w; }
#pragma unroll
        for (int i = 0; i < 16; ++i) ss += x[i] * x[i];
        ss += __shfl_xor(ss, 1); ss += __shfl_xor(ss, 2);
        const float rs = rsqrtf(ss * (1.f / 64.f) + 1e-6f) * 0.125f;
        unsigned w[8];
#pragma unroll
        for (int i = 0; i < 8; ++i) w[i] = pk2(x[2 * i] * rs * p.in[23][part * 16 + 2 * i], x[2 * i + 1] * rs * p.in[23][part * 16 + 2 * i + 1]);
        uint4* dp = (uint4*)(qb + (size_t)t * 512 + h * 64 + part * 16);
        dp[0] = make_uint4(w[0], w[1], w[2], w[3]); dp[1] = make_uint4(w[4], w[5], w[6], w[7]);
      }
      {
        float x[16]; float ss = 0.f;
#pragma unroll
        for (int i = 0; i < 4; ++i) { const float4 v = *(const float4*)(src + 512 + i * 4); x[4 * i] = v.x; x[4 * i + 1] = v.y; x[4 * i + 2] = v.z; x[4 * i + 3] = v.w; }
#pragma unroll
        for (int i = 0; i < 16; ++i) ss += x[i] * x[i];
        ss += __shfl_xor(ss, 1); ss += __shfl_xor(ss, 2);
        const float rs = rsqrtf(ss * (1.f / 64.f) + 1e-6f);
#pragma unroll
        for (int i = 0; i < 16; ++i) x[i] = x[i] * rs * p.in[24][part * 16 + i];
        if (t < NCTX) {
          float4* op = (float4*)(p.out + OUT_K + (size_t)t * 512 + h * 64 + part * 16);
#pragma unroll
          for (int i = 0; i < 4; ++i) op[i] = make_float4(x[4 * i], x[4 * i + 1], x[4 * i + 2], x[4 * i + 3]);
        }
        unsigned w[8];
#pragma unroll
        for (int i = 0; i < 8; ++i) w[i] = pk2(x[2 * i], x[2 * i + 1]);
        uint4* dp = (uint4*)(kb + (size_t)t * 512 + h * 64 + part * 16);
        dp[0] = make_uint4(w[0], w[1], w[2], w[3]); dp[1] = make_uint4(w[4], w[5], w[6], w[7]);
      }
      {
        float x[16];
#pragma unroll
        for (int i = 0; i < 4; ++i) { const float4 v = *(const float4*)(src + 1024 + i * 4); x[4 * i] = v.x; x[4 * i + 1] = v.y; x[4 * i + 2] = v.z; x[4 * i + 3] = v.w; }
        if (t < NCTX) {
          float4* op = (float4*)(p.out + OUT_V + (size_t)t * 512 + h * 64 + part * 16);
#pragma unroll
          for (int i = 0; i < 4; ++i) op[i] = make_float4(x[4 * i], x[4 * i + 1], x[4 * i + 2], x[4 * i + 3]);
        }
#pragma unroll
        for (int i = 0; i < 16; ++i) Vs[tok * 72 + part * 16 + i] = f2bf(x[i]);
      }
      __syncthreads();
      {
        const int d = tid >> 2;
        unsigned w[8];
#pragma unroll
        for (int i = 0; i < 8; ++i) w[i] = (unsigned)Vs[(part * 16 + 2 * i) * 72 + d] | ((unsigned)Vs[(part * 16 + 2 * i + 1) * 72 + d] << 16);
        uint4* dp = (uint4*)(vT + (size_t)(h * 64 + d) * NTOK + t0 + part * 16);
        dp[0] = make_uint4(w[0], w[1], w[2], w[3]); dp[1] = make_uint4(w[4], w[5], w[6], w[7]);
      }
      __syncthreads();
    } else {
      const int ci = item - 768, b = ci >> 5, rem = ci & 31, tt = rem >> 3, h = rem & 7, t0 = tt * 64, t = t0 + tok;
      const size_t sidx = (size_t)(b * 256 + t) * 512 + h * 64 + part * 16;
      {
        float x[16];
#pragma unroll
        for (int i = 0; i < 4; ++i) { const float4 v = *(const float4*)(p.in[3] + sidx + i * 4); x[4 * i] = v.x; x[4 * i + 1] = v.y; x[4 * i + 2] = v.z; x[4 * i + 3] = v.w; }
        unsigned w[8];
#pragma unroll
        for (int i = 0; i < 8; ++i) w[i] = pk2(x[2 * i], x[2 * i + 1]);
        uint4* dp = (uint4*)(ckb + sidx);
        dp[0] = make_uint4(w[0], w[1], w[2], w[3]); dp[1] = make_uint4(w[4], w[5], w[6], w[7]);
      }
      {
        float x[16];
#pragma unroll
        for (int i = 0; i < 4; ++i) { const float4 v = *(const float4*)(p.in[4] + sidx + i * 4); x[4 * i] = v.x; x[4 * i + 1] = v.y; x[4 * i + 2] = v.z; x[4 * i + 3] = v.w; }
#pragma unroll
        for (int i = 0; i < 16; ++i) Vs[tok * 72 + part * 16 + i] = f2bf(x[i]);
      }
      __syncthreads();
      {
        const int d = tid >> 2;
        unsigned w[8];
#pragma unroll
        for (int i = 0; i < 8; ++i) w[i] = (unsigned)Vs[(part * 16 + 2 * i) * 72 + d] | ((unsigned)Vs[(part * 16 + 2 * i + 1) * 72 + d] << 16);
        uint4* dp = (uint4*)(cvT + (size_t)((b * 8 + h) * 64 + d) * 256 + t0 + part * 16);
        dp[0] = make_uint4(w[0], w[1], w[2], w[3]); dp[1] = make_uint4(w[4], w[5], w[6], w[7]);
      }
      __syncthreads();
    }
  }
}

DEV float* ops_arr(const Params& p, int i) { return (float*)(p.ws + OFF_OPS + (size_t)i * OPS_ARR); }

DEV f32x4 shiftvec(f32x4 cur, f32x4 hal, f32x4 mu0, f32x4 mu1, int fr) {
  f32x4 prev, next;
#pragma unroll
  for (int i = 0; i < 4; ++i) {
    prev[i] = dpp_mov<0x111>(cur[i]);
    next[i] = dpp_mov<0x101>(cur[i]);
  }
  if (fr == 0) prev = hal;
  if (fr == 15) next = hal;
  return cur + mu0 * (prev - cur) + mu1 * (next - cur);
}
DEV float quad_sum(float x) { x += __shfl_xor(x, 16); x += __shfl_xor(x, 32); return x; }
DEV f32x4 ld4(const float* p) { return *(const f32x4*)p; }

constexpr int LROWB = 392;
template <bool HALF>
DEV void phase_rwprep(const Params& p, unsigned char* smem, int item_) {
  const int tid = threadIdx.x, lane = tid & 63, w = tid >> 6, fr = lane & 15, fq = lane >> 4;
  bf16_t* Lb = (bf16_t*)smem;
  const float* urw = (const float*)(p.ws + OFF_URW);
  const float* mu = p.in[12];
  bf16_t* bonus = (bf16_t*)(p.ws + OFF_BG);
  bf16_t* gate = (bf16_t*)(p.ws + OFF_BG + 6291456);
  const bf16_t* WUPT = (const bf16_t*)(p.ws + OFF_LORA);
  const bf16_t* AUPT = WUPT + 65536;
  const bf16_t* GUPT = WUPT + 131072;
  float* o_r = ops_arr(p, 0); float* o_v = ops_arr(p, 1); float* o_a = ops_arr(p, 2);
  for (int item = item_; item < item_ + 1; ++item) {
    const int t0 = HALF ? (256 + (item >> 2)) * 16 : (item >> 1) * 16;
    const int h = HALF ? (item & 3) * 2 + (w >> 1) : (item & 1) * 4 + w;
    const int ni_lo = HALF ? (w & 1) * 2 : 0, ni_hi = HALF ? ni_lo + 2 : 4;
    float* xs = (float*)(smem + 16384);
    int s_lo, s_hi;
    if (t0 < NCTX) { s_lo = t0 & ~255; s_hi = s_lo + 256; } else { s_lo = NCTX + ((t0 - NCTX) & ~1023); s_hi = s_lo + 1024; }
    {
      const int tl = tid >> 4, g16 = tid & 15, tt = t0 + tl;
      const float* up = urw + (size_t)tt * RWC + 1536;
      const bool hp = tt > s_lo, hn = tt + 1 < s_hi;
#pragma unroll
      for (int j = 0; j < 6; ++j) {
        const int col = (g16 + 16 * j) * 4;
        const f32x4 c = ld4(up + col);
        const f32x4 z = (f32x4){0.f, 0.f, 0.f, 0.f};
        const f32x4 pv = hp ? ld4(up - RWC + col) : z;
        const f32x4 nx = hn ? ld4(up + RWC + col) : z;
        const f32x4 m0 = ld4(mu + 1536 + col), m1 = ld4(mu + RWC + 1536 + col);
        const f32x4 us = c + m0 * (pv - c) + m1 * (nx - c);
        const int kind = col >> 7;
        float o4[4];
#pragma unroll
        for (int i = 0; i < 4; ++i) o4[i] = kind == 0 ? (1.f - 2.f / (1.f + __expf(2.f * us[i]))) : (kind == 1 ? us[i] : sigmoidf_(us[i]));
        *(uint2*)(Lb + tl * LROWB + col) = make_uint2(pk2(o4[0], o4[1]), pk2(o4[2], o4[3]));
      }
    }
    __syncthreads();
    const int t = t0 + fr;
    const bool lo_ok = (fr == 0) && (t > s_lo), hi_ok = (fr == 15) && (t + 1 < s_hi);
    const float* urow = urw + (size_t)t * RWC;
    const float* hrow = lo_ok ? urow - RWC : (hi_ok ? urow + RWC : urow);
    const bool hal_ok = lo_ok || hi_ok;
    const f32x4 z4 = (f32x4){0.f, 0.f, 0.f, 0.f};
    float ss = 0.f;
#pragma unroll
    for (int ni = ni_lo; ni < ni_hi; ++ni) {
      const int c = h * 64 + ni * 16 + fq * 4;
      const f32x4 kx = shiftvec(ld4(urow + 512 + c), hal_ok ? ld4(hrow + 512 + c) : z4, ld4(mu + 512 + c), ld4(mu + RWC + 512 + c), fr) * ld4(p.in[18] + c);
      ss += kx[0] * kx[0] + kx[1] * kx[1] + kx[2] * kx[2] + kx[3] * kx[3];
    }
    ss = quad_sum(ss);
    if (HALF) { if (fq == 0) xs[w * 16 + fr] = ss; __syncthreads(); ss += xs[(w ^ 1) * 16 + fr]; }
    const float rn = rsqrtf(ss + 1e-12f);
    float bs = 0.f;
#pragma unroll 1
    for (int ni = ni_lo; ni < ni_hi; ++ni) {
      const int c = h * 64 + ni * 16 + fq * 4;
      const size_t o = (size_t)t * 512 + c;
      const f32x4 r4 = shiftvec(ld4(urow + c), hal_ok ? ld4(hrow + c) : z4, ld4(mu + c), ld4(mu + RWC + c), fr);
      const f32x4 k4 = shiftvec(ld4(urow + 512 + c), hal_ok ? ld4(hrow + 512 + c) : z4, ld4(mu + 512 + c), ld4(mu + RWC + 512 + c), fr);
      const f32x4 v4 = shiftvec(ld4(urow + 1024 + c), hal_ok ? ld4(hrow + 1024 + c) : z4, ld4(mu + 1024 + c), ld4(mu + RWC + 1024 + c), fr);
      const f32x4 kk4 = k4 * ld4(p.in[18] + c) * rn;
      *(f32x4*)(o_r + o) = r4; *(f32x4*)(o_v + o) = v4; *(f32x4*)(o_a + o) = -kk4;
      const f32x4 ka = ld4(p.in[19] + c);
      f32x4 bacc = z4;
#pragma unroll
      for (int e = 0; e < 2; ++e) {
        float* o_k = ops_arr(p, 5 + e); float* o_b = ops_arr(p, 7 + e); float* o_w = ops_arr(p, 3 + e);
        f32x4 acc = z4, acw = z4;
#pragma unroll
        for (int ks = 0; ks < 2; ++ks) {
          const bf16x8 wa = *(const bf16x8*)(AUPT + (size_t)(e * 512 + h * 64 + ni * 16 + fr) * 64 + ks * 32 + fq * 8);
          const bf16x8 la = *(const bf16x8*)(Lb + fr * LROWB + 128 + e * 64 + ks * 32 + fq * 8);
          acc = __builtin_amdgcn_mfma_f32_16x16x32_bf16(wa, la, acc, 0, 0, 0);
          const bf16x8 ww = *(const bf16x8*)(WUPT + (size_t)(e * 512 + h * 64 + ni * 16 + fr) * 64 + ks * 32 + fq * 8);
          const bf16x8 lw = *(const bf16x8*)(Lb + fr * LROWB + e * 64 + ks * 32 + fq * 8);
          acw = __builtin_amdgcn_mfma_f32_16x16x32_bf16(ww, lw, acw, 0, 0, 0);
        }
        const f32x4 a0 = ld4(p.in[15] + e * 512 + c), w0 = ld4(p.in[13] + e * 512 + c);
        f32x4 kd, bb, dec;
#pragma unroll
        for (int i = 0; i < 4; ++i) {
          const float ic = sigmoidf_(a0[i] + acc[i]);
          kd[i] = k4[i] * (1.f + (ic - 1.f) * ka[i]);
          bb[i] = kk4[i] * ic;
          const float z = w0[i] + acw[i];
          const float sp = fmaxf(-z, 0.f) + __logf(1.f + __expf(-fabsf(z)));
          dec[i] = __expf(-__expf(-sp - 0.5f));
        }
        bacc += kd;
        *(f32x4*)(o_k + o) = kd; *(f32x4*)(o_b + o) = bb; *(f32x4*)(o_w + o) = dec;
      }
      const f32x4 rk = ld4(p.in[20] + c);
#pragma unroll
      for (int i = 0; i < 4; ++i) bs += r4[i] * 0.5f * bacc[i] * rk[i];
      f32x4 acc = z4;
#pragma unroll
      for (int ks = 0; ks < 4; ++ks) {
        const bf16x8 wg = *(const bf16x8*)(GUPT + (size_t)(h * 64 + ni * 16 + fr) * 128 + ks * 32 + fq * 8);
        const bf16x8 lg = *(const bf16x8*)(Lb + fr * LROWB + 256 + ks * 32 + fq * 8);
        acc = __builtin_amdgcn_mfma_f32_16x16x32_bf16(wg, lg, acc, 0, 0, 0);
      }
      *(uint2*)(gate + o) = make_uint2(pk2(acc[0], acc[1]), pk2(acc[2], acc[3]));
    }
    bs = quad_sum(bs);
    if (HALF) { if (fq == 0) xs[64 + w * 16 + fr] = bs; __syncthreads(); bs += xs[64 + (w ^ 1) * 16 + fr]; }
#pragma unroll
    for (int ni = ni_lo; ni < ni_hi; ++ni) {
      const size_t o = (size_t)t * 512 + h * 64 + ni * 16 + fq * 4;
      const f32x4 v4 = *(const f32x4*)(o_v + o);
      *(uint2*)(bonus + o) = make_uint2(pk2(bs * v4[0], bs * v4[1]), pk2(bs * v4[2], bs * v4[3]));
    }
    __syncthreads();
  }
}

DEV void phase_prep(const Params& p, unsigned char* smem, int* s_item, int rep) {
  unsigned* counter = (unsigned*)(p.ws + OFF_CTL) + 16 + rep;
  for (;;) {
    if (threadIdx.x == 0) *s_item = (int)atomicAdd(counter, 1u);
    __syncthreads();
    const int item = *s_item;
    __syncthreads();
    if (item >= 1024 + 64) break;
    if (item < 512) phase_rwprep<false>(p, smem, item);
    else if (item < 1024) phase_rwprep<true>(p, smem, item - 512);
    else phase_qkprep(p, smem, item - 256);
  }
}

constexpr int TC = 16;
typedef float f32x2 __attribute__((ext_vector_type(2)));
template <int EPL, int R, int PD>
DEV void scan_item(const Params& p, unsigned char* smem, int seq, int h, int dir, int rg) {
  constexpr int LPR = 64 / EPL, RPW = 64 / LPR, RPB = 4 * RPW * R, NV = RPB / 16, NP = EPL / 2;
  constexpr int STG = 20480 + 16 * RPB * 4, YOFF = 2 * STG, YSZ = 16 * RPB * 4;
  const int tid = threadIdx.x, lane = tid & 63, w = tid >> 6, riw = lane / LPR, kq = lane % LPR;
  const int T = seq < 16 ? 256 : 1024;
  const int tok0 = seq < 16 ? seq * 256 : NCTX + (seq - 16) * 1024;
  const int vrow_l = (w * RPW + riw) * R;
  const int vrow = rg * RPB + vrow_l;
  f32x2 S[R][NP];
#pragma unroll
  for (int rr = 0; rr < R; ++rr) {
    if (seq >= 16) {
      const float* sp = p.in[2] + ((size_t)(((seq - 16) * 2 + dir) * 8 + h) * 64 + vrow + rr) * 64 + kq * EPL;
#pragma unroll
      for (int i = 0; i < NP; ++i) S[rr][i] = *(const f32x2*)(sp + 2 * i);
    } else {
#pragma unroll
      for (int i = 0; i < NP; ++i) S[rr][i] = (f32x2){0.f, 0.f};
    }
  }
  const int lstep = tid >> 4, l16 = tid & 15;
  const float* pr = ops_arr(p, 0) + h * 64 + l16 * 4;
  const float* pw = ops_arr(p, 3 + dir) + h * 64 + l16 * 4;
  const float* pk = ops_arr(p, 5 + dir) + h * 64 + l16 * 4;
  const float* pa = ops_arr(p, 2) + h * 64 + l16 * 4;
  const float* pb = ops_arr(p, 7 + dir) + h * 64 + l16 * 4;
  const float* pv = ops_arr(p, 1) + h * 64 + rg * RPB + l16;
  float* yout = (float*)(p.ws + (dir ? OFF_YB : OFF_YF)) + h * 64 + rg * RPB + l16;
  const int nc = T / TC;
  float4 g_r, g_w, g_k, g_a, g_b; float rv[NV];
#define gload(c) do { const int ts_ = (c) * TC + lstep; const size_t t_ = (size_t)(tok0 + (dir ? T - 1 - ts_ : ts_)) * 512; \
    g_r = *(const float4*)(pr + t_); g_w = *(const float4*)(pw + t_); g_k = *(const float4*)(pk + t_); \
    g_a = *(const float4*)(pa + t_); g_b = *(const float4*)(pb + t_); \
    _Pragma("unroll") for (int q_ = 0; q_ < NV; ++q_) rv[q_] = pv[t_ + 16 * q_]; } while (0)
#define ywrite(c) do { const float* yb_ = (const float*)(smem + YOFF + ((c) & 1) * YSZ); const int ts_ = (c) * TC + lstep; \
    const size_t t_ = (size_t)(tok0 + (dir ? T - 1 - ts_ : ts_)) * 512; \
    _Pragma("unroll") for (int q_ = 0; q_ < NV; ++q_) yout[t_ + 16 * q_] = yb_[lstep * RPB + l16 + 16 * q_]; } while (0)
  gload(0);
  for (int c = 0; c < nc; ++c) {
    unsigned char* st = smem + (c & 1) * STG;
    *(float4*)(st + 0 * 4096 + lstep * 256 + l16 * 16) = g_r;
    *(float4*)(st + 1 * 4096 + lstep * 256 + l16 * 16) = g_w;
    *(float4*)(st + 2 * 4096 + lstep * 256 + l16 * 16) = g_k;
    *(float4*)(st + 3 * 4096 + lstep * 256 + l16 * 16) = g_a;
    *(float4*)(st + 4 * 4096 + lstep * 256 + l16 * 16) = g_b;
#pragma unroll
    for (int q = 0; q < NV; ++q) *(float*)(st + 20480 + (lstep * RPB + l16 + 16 * q) * 4) = rv[q];
    __syncthreads();
    if (c > 0) ywrite(c - 1);
    if (c + 1 < nc) gload(c + 1);
    float* ybw = (float*)(smem + YOFF + (c & 1) * YSZ);
    constexpr int NS = PD + 1;
    f32x2 o_r[NS][NP], o_w[NS][NP], o_k[NS][NP], o_a[NS][NP], o_b[NS][NP]; float o_v[NS][R];
    float ykeep[R][TC / LPR];
#define LDOPS(bi, s_) do { \
      _Pragma("unroll") for (int i_ = 0; i_ < NP; ++i_) { \
        o_r[bi][i_] = *(const f32x2*)(st + 0 * 4096 + (s_) * 256 + kq * EPL * 4 + i_ * 8); \
        o_w[bi][i_] = *(const f32x2*)(st + 1 * 4096 + (s_) * 256 + kq * EPL * 4 + i_ * 8); \
        o_k[bi][i_] = *(const f32x2*)(st + 2 * 4096 + (s_) * 256 + kq * EPL * 4 + i_ * 8); \
        o_a[bi][i_] = *(const f32x2*)(st + 3 * 4096 + (s_) * 256 + kq * EPL * 4 + i_ * 8); \
        o_b[bi][i_] = *(const f32x2*)(st + 4 * 4096 + (s_) * 256 + kq * EPL * 4 + i_ * 8); } \
      _Pragma("unroll") for (int rr_ = 0; rr_ < R; ++rr_) o_v[bi][rr_] = *(const float*)(st + 20480 + ((s_) * RPB + vrow_l + rr_) * 4); } while (0)
#pragma unroll
    for (int s = 0; s < PD; ++s) LDOPS(s, s);
#pragma unroll
    for (int s = 0; s < TC; ++s) {
      const int bi = s % NS;
      if (s + PD < TC) LDOPS((s + PD) % NS, s + PD);
#pragma unroll
      for (int rr = 0; rr < R; ++rr) {
        const f32x2 vv2 = (f32x2){o_v[bi][rr], o_v[bi][rr]};
        f32x2 pa2 = S[rr][0] * o_a[bi][0];
        f32x2 tt[NP];
        tt[0] = S[rr][0] * o_w[bi][0] + vv2 * o_k[bi][0];
#pragma unroll
        for (int i = 1; i < NP; ++i) { pa2 += S[rr][i] * o_a[bi][i]; tt[i] = S[rr][i] * o_w[bi][i] + vv2 * o_k[bi][i]; }
        float sa = pa2[0] + pa2[1];
        sa += dpp_mov<0xB1>(sa); sa += dpp_mov<0x4E>(sa); sa += dpp_mov<0x141>(sa);
        if (LPR == 16) sa += dpp_mov<0x140>(sa);
        const f32x2 sa2 = (f32x2){sa, sa};
        f32x2 py = (f32x2){0.f, 0.f};
#pragma unroll
        for (int i = 0; i < NP; ++i) { S[rr][i] = sa2 * o_b[bi][i] + tt[i]; py += S[rr][i] * o_r[bi][i]; }
        float y = py[0] + py[1];
        y += dpp_mov<0xB1>(y); y += dpp_mov<0x4E>(y); y += dpp_mov<0x141>(y);
        if (LPR == 16) y += dpp_mov<0x140>(y);
        if ((s % LPR) == 0) ykeep[rr][s / LPR] = y; else ykeep[rr][s / LPR] = (kq == (s % LPR)) ? y : ykeep[rr][s / LPR];
      }
    }
#undef LDOPS
#pragma unroll
    for (int rr = 0; rr < R; ++rr)
#pragma unroll
      for (int q = 0; q < TC / LPR; ++q) ybw[(q * LPR + kq) * RPB + vrow_l + rr] = ykeep[rr][q];
  }
  __syncthreads();
  ywrite(nc - 1);
  if (seq < 16) {
#pragma unroll
    for (int rr = 0; rr < R; ++rr) {
      float* so = p.out + OUT_STATE + ((size_t)((seq * 2 + dir) * 8 + h) * 64 + vrow + rr) * 64 + kq * EPL;
#pragma unroll
      for (int i = 0; i < NP; ++i) *(f32x2*)(so + 2 * i) = S[rr][i];
    }
  }
  __syncthreads();
#undef gload
#undef ywrite
}

DEV void attn_wave_item(const Params& p, int witem) {
  const int lane = threadIdx.x & 63, fr = lane & 15, fq = lane >> 4;
  const bf16_t* qb = (const bf16_t*)(p.ws + OFF_QB);
  const bf16_t* kb = (const bf16_t*)(p.ws + OFF_KB);
  const bf16_t* vT = (const bf16_t*)(p.ws + OFF_VT);
  const bf16_t* ckb = (const bf16_t*)(p.ws + OFF_CKB);
  const bf16_t* cvT = (const bf16_t*)(p.ws + OFF_CVT);
  bf16_t* ona = (bf16_t*)(p.ws + OFF_ONA);
  int h, tq0, nsub;
  bool latent;
  int b = 0, r = 0, jb = 0, row_start = 0, band = 0, seq = 0;
  {
    const int bi = witem >> 2, wv = witem & 3;
    if (bi < 256) {
      latent = true;
      b = bi >> 7; const int rem = bi & 127; r = rem >> 3; h = rem & 7; jb = wv;
      tq0 = NCTX + b * 1024 + r * 64 + jb * 16;
      row_start = min(max(r - 4, 0), 8); band = min(max(jb * 16 - 8, 0), 32);
      nsub = 4;
    } else {
      latent = false;
      const int c2 = bi - 256; seq = c2 >> 5; const int rem = c2 & 31; h = rem >> 2; const int qg = rem & 3;
      tq0 = seq * 256 + (qg * 4 + wv) * 16; nsub = 2;
    }
  }
  const bf16_t* qp = qb + (size_t)(tq0 + fr) * 512 + h * 64 + fq * 8;
  const bf16x8 qf0 = *(const bf16x8*)qp, qf1 = *(const bf16x8*)(qp + 32);
  float m = -INFINITY, l = 0.f;
  f32x4 O[4];
#pragma unroll
  for (int i = 0; i < 4; ++i) O[i] = (f32x4){0.f, 0.f, 0.f, 0.f};
#define SUBDESC(sc_, kbase_, vbase_, KS_, ldv_, win_) do { const int half_ = (sc_) & 1; win_ = latent && (sc_) < 2; \
    if (win_) { const int tb_ = NCTX + b * 1024 + (row_start + half_ * 4) * 64 + band; \
      kbase_ = kb + (size_t)tb_ * 512 + h * 64; vbase_ = vT + (size_t)(h * 64) * NTOK + tb_; KS_ = 64; ldv_ = NTOK; } \
    else if (latent) { kbase_ = ckb + (size_t)(b * 256 + half_ * 128) * 512 + h * 64; vbase_ = cvT + (size_t)((b * 8 + h) * 64) * 256 + half_ * 128; KS_ = 32; ldv_ = 256; } \
    else { const int tb_ = seq * 256 + half_ * 128; kbase_ = kb + (size_t)tb_ * 512 + h * 64; vbase_ = vT + (size_t)(h * 64) * NTOK + tb_; KS_ = 32; ldv_ = NTOK; } } while (0)
#define KLOAD(kbase_, KS_) do { _Pragma("unroll") for (int i_ = 0; i_ < 8; ++i_) { \
      const bf16_t* kp_ = kbase_ + (size_t)((i_ >> 1) * KS_ + (fr >> 2) * 8 + (i_ & 1) * 4 + (fr & 3)) * 512 + fq * 8; \
      kf[2 * i_] = *(const bf16x8*)kp_; kf[2 * i_ + 1] = *(const bf16x8*)(kp_ + 32); } } while (0)
  bf16x8 kf[16];
#pragma unroll 1
  for (int sc = 0; sc < nsub; ++sc) {
    const int half = sc & 1;
    const bf16_t* kbase; const bf16_t* vbase; int KS, ldv; bool win;
    SUBDESC(sc, kbase, vbase, KS, ldv, win);
    KLOAD(kbase, KS);
    bf16x8 vf[4][4];
#pragma unroll
    for (int s = 0; s < 4; ++s)
#pragma unroll
      for (int dt = 0; dt < 4; ++dt) {
        vf[s][dt] = *(const bf16x8*)(vbase + (size_t)(dt * 16 + fr) * ldv + s * KS + fq * 8);
      }
    f32x4 st[8];
#pragma unroll
    for (int i = 0; i < 8; ++i) {
      f32x4 z = (f32x4){0.f, 0.f, 0.f, 0.f};
      z = __builtin_amdgcn_mfma_f32_16x16x32_bf16(kf[2 * i], qf0, z, 0, 0, 0);
      st[i] = __builtin_amdgcn_mfma_f32_16x16x32_bf16(kf[2 * i + 1], qf1, z, 0, 0, 0);
    }
    const bool cwin = win;
    if (cwin) {
      const int q_col = jb * 16 + fr;
      const int win_start = min(max(q_col - 8, 0), 48);
      const float* rpb = p.in[25] + h * 465;
#pragma unroll
      for (int i = 0; i < 8; ++i) {
        const int dr = row_start + half * 4 + (i >> 1) - r + 7;
#pragma unroll
        for (int e = 0; e < 4; ++e) {
          const int k_col = band + fq * 8 + (i & 1) * 4 + e;
          const bool valid = (k_col >= win_start) && (k_col < win_start + 16);
          const int dc = min(max(k_col - q_col, -15), 15) + 15;
          st[i][e] = valid ? st[i][e] + rpb[dr * 31 + dc] : -1e30f;
        }
      }
    }
    float cmax = -1e30f;
#pragma unroll
    for (int i = 0; i < 8; ++i)
#pragma unroll
      for (int e = 0; e < 4; ++e) cmax = fmaxf(cmax, st[i][e]);
    cmax = fmaxf(cmax, __shfl_xor(cmax, 16)); cmax = fmaxf(cmax, __shfl_xor(cmax, 32));
    const float mnew = fmaxf(m, cmax);
    const float alpha = __expf(m - mnew);
    float psum = 0.f;
#pragma unroll
    for (int i = 0; i < 8; ++i)
#pragma unroll
      for (int e = 0; e < 4; ++e) { const float pv = __expf(st[i][e] - mnew); st[i][e] = pv; psum += pv; }
    psum += __shfl_xor(psum, 16); psum += __shfl_xor(psum, 32);
    l = l * alpha + psum;
#pragma unroll
    for (int i = 0; i < 4; ++i) O[i] = O[i] * alpha;
    m = mnew;
#pragma unroll
    for (int s = 0; s < 4; ++s) {
      union { bf16x8 v; unsigned u[4]; } pb;
      pb.u[0] = pk2(st[2 * s][0], st[2 * s][1]); pb.u[1] = pk2(st[2 * s][2], st[2 * s][3]);
      pb.u[2] = pk2(st[2 * s + 1][0], st[2 * s + 1][1]); pb.u[3] = pk2(st[2 * s + 1][2], st[2 * s + 1][3]);
#pragma unroll
      for (int dt = 0; dt < 4; ++dt) {
        O[dt] = __builtin_amdgcn_mfma_f32_16x16x32_bf16(vf[s][dt], pb.v, O[dt], 0, 0, 0);
      }
    }
  }
#undef SUBDESC
#undef KLOAD
  const float inv = 1.f / l;
#pragma unroll
  for (int dt = 0; dt < 4; ++dt) {
    bf16_t* op = ona + (size_t)(tq0 + fr) * 512 + h * 64 + dt * 16 + fq * 4;
    *(uint2*)op = make_uint2(pk2(O[dt][0] * inv, O[dt][1] * inv), pk2(O[dt][2] * inv, O[dt][3] * inv));
  }
}

constexpr int N_SCAN_ITEMS = 128 + 256, N_ATTN_BLK = 768;
DEV void phase_scan_attn(const Params& p, unsigned char* smem, int* s_item, int rep) {
  unsigned* counter = (unsigned*)(p.ws + OFF_CTL) + rep;
  for (;;) {
    if (threadIdx.x == 0) *s_item = (int)atomicAdd(counter, 1u);
    __syncthreads();
    const int item = *s_item;
    __syncthreads();
    if (item >= N_SCAN_ITEMS + N_ATTN_BLK) break;
    if (item < 128) { const int rem = item & 63; scan_item<4, 1, 3>(p, smem, 16 + (item >> 6), rem >> 3, (rem >> 2) & 1, rem & 3); }
    else if (item >= N_SCAN_ITEMS) attn_wave_item(p, (item - N_SCAN_ITEMS) * 4 + (threadIdx.x >> 6));
    else { const int i2 = item - 128, rem = i2 & 15; scan_item<4, 4, 1>(p, smem, i2 >> 4, rem >> 1, rem & 1, 0); }
  }
}

DEV void phase_finalize_rw(const Params& p, int bid, int nb) {
  const int lane = threadIdx.x & 63, gw = bid * 4 + (threadIdx.x >> 6), nw = nb * 4;
  const float* yf = (const float*)(p.ws + OFF_YF);
  const float* yb = (const float*)(p.ws + OFF_YB);
  const bf16_t* bonus = (const bf16_t*)(p.ws + OFF_BG);
  const bf16_t* gate = (const bf16_t*)(p.ws + OFF_BG + 6291456);
  bf16_t* orw = (bf16_t*)(p.ws + OFF_ORW);
  const float4 g0 = *(const float4*)(p.in[21] + lane * 8), g1 = *(const float4*)(p.in[21] + lane * 8 + 4);
  const float4 b0 = *(const float4*)(p.in[22] + lane * 8), b1 = *(const float4*)(p.in[22] + lane * 8 + 4);
  const float gg[8] = {g0.x, g0.y, g0.z, g0.w, g1.x, g1.y, g1.z, g1.w};
  const float bb[8] = {b0.x, b0.y, b0.z, b0.w, b1.x, b1.y, b1.z, b1.w};
#pragma unroll 3
  for (int t = gw; t < NTOK; t += nw) {
    const size_t o = (size_t)t * 512 + lane * 8;
    const float4 a0 = *(const float4*)(yf + o), a1 = *(const float4*)(yf + o + 4);
    const float4 c0 = *(const float4*)(yb + o), c1 = *(const float4*)(yb + o + 4);
    const uint4 bo = *(const uint4*)(bonus + o), ga = *(const uint4*)(gate + o);
    float y[8] = {a0.x + c0.x, a0.y + c0.y, a0.z + c0.z, a0.w + c0.w, a1.x + c1.x, a1.y + c1.y, a1.z + c1.z, a1.w + c1.w};
    float s = 0.f;
#pragma unroll
    for (int i = 0; i < 8; ++i) s += y[i];
    s += dpp_mov<0xB1>(s); s += dpp_mov<0x4E>(s); s += dpp_mov<0x141>(s);
    const float mean = s * (1.f / 64.f);
    float q = 0.f;
#pragma unroll
    for (int i = 0; i < 8; ++i) { y[i] -= mean; q += y[i] * y[i]; }
    q += dpp_mov<0xB1>(q); q += dpp_mov<0x4E>(q); q += dpp_mov<0x141>(q);
    const float rstd = rsqrtf(q * (1.f / 64.f) + 64e-5f);
    const unsigned bu[4] = {bo.x, bo.y, bo.z, bo.w}, gu[4] = {ga.x, ga.y, ga.z, ga.w};
    unsigned w[4];
#pragma unroll
    for (int i = 0; i < 4; ++i) {
      const float lo = (y[2 * i] * rstd * gg[2 * i] + bb[2 * i] + __uint_as_float(bu[i] << 16)) * __uint_as_float(gu[i] << 16);
      const float hi = (y[2 * i + 1] * rstd * gg[2 * i + 1] + bb[2 * i + 1] + __uint_as_float(bu[i] & 0xffff0000u)) * __uint_as_float(gu[i] & 0xffff0000u);
      w[i] = pk2(lo, hi);
    }
    *(uint4*)(orw + o) = make_uint4(w[0], w[1], w[2], w[3]);
  }
}

#define XB_TMO      128
#define XB_XCNT(j)  (256  + 64 * (j))
#define XB_XSUB(j)  (1280 + 64 * (j))
#define XB_XGEN(j)  (2304 + 64 * (j))
#define XB_TOP      3328
#define XB_TOPGEN   3392
#define XCD_BAR_WORDS 3456
#define XB_SPIN_CAP (1u << 18)
#define LAS __attribute__((address_space(3)))
DEV unsigned xb_ld(unsigned* p)              { return __hip_atomic_load(p, __ATOMIC_RELAXED, __HIP_MEMORY_SCOPE_AGENT); }
DEV unsigned xb_add(unsigned* p, unsigned v) { return __hip_atomic_fetch_add(p, v, __ATOMIC_RELAXED, __HIP_MEMORY_SCOPE_AGENT); }
DEV unsigned xb_xcc_id() { return (unsigned)__builtin_amdgcn_s_getreg((3 << 11) | 20) & 0xFu; }
#define XB_SPIN(cond, bar) do { unsigned _sp = 0; while (cond) { __builtin_amdgcn_s_sleep(1); \
    if ((++_sp & 255u) == 0u) { if (xb_ld(&(bar)[XB_TMO])) break; if (_sp > XB_SPIN_CAP) { atomicAdd(&(bar)[XB_TMO], 1u); break; } } } } while (0)
struct XcdBarrier { unsigned* bar; unsigned x; volatile LAS unsigned* st; };
DEV XcdBarrier xcd_barrier_post(unsigned* bar, volatile LAS unsigned* st) {
  XcdBarrier b; b.bar = bar; b.x = xb_xcc_id(); b.st = st;
  if (threadIdx.x == 0) (void)xb_add(&bar[XB_XCNT(b.x)], 1u);
  return b;
}
DEV void xcd_barrier_complete(unsigned* bar, unsigned x, unsigned& nloc, unsigned& nx) {
  const unsigned G = gridDim.x * gridDim.y * gridDim.z;
  unsigned sum, cnt, mine, sp = 0u;
  for (;;) {
    sum = 0u; cnt = 0u; mine = 0u;
#pragma unroll
    for (unsigned j = 0; j < 16; ++j) { const unsigned c = xb_ld(&bar[XB_XCNT(j)]); sum += c; cnt += (c > 0u) ? 1u : 0u; mine = (j == x) ? c : mine; }
    if (sum == G) break;
    __builtin_amdgcn_s_sleep(1);
    if ((++sp & 255u) == 0u) { if (xb_ld(&bar[XB_TMO])) break; if (sp > XB_SPIN_CAP) { atomicAdd(&bar[XB_TMO], 1u); break; } }
  }
  nloc = mine > 0u ? mine : 1u; nx = cnt > 0u ? cnt : 1u;
}
DEV void xcd_barrier(const XcdBarrier& b) {
  asm volatile("s_waitcnt vmcnt(0)" ::: "memory");
  __syncthreads();
  if (threadIdx.x == 0) {
    unsigned* bar = b.bar;
    __builtin_amdgcn_s_waitcnt(0);
    unsigned nloc = b.st[0], nx = b.st[1];
    if (nloc == 0u) { xcd_barrier_complete(bar, b.x, nloc, nx); b.st[0] = nloc; b.st[1] = nx; }
    const unsigned old = xb_add(&bar[XB_XSUB(b.x)], 1u);
    const unsigned gen = old / nloc;
    if (old + 1u == (gen + 1u) * nloc) {
      __builtin_amdgcn_fence(__ATOMIC_RELEASE, "agent");
      asm volatile("s_waitcnt vmcnt(0)" ::: "memory");
      const unsigned og = xb_add(&bar[XB_TOP], 1u);
      const unsigned tg = og / nx;
      if (og + 1u == (tg + 1u) * nx) xb_add(&bar[XB_TOPGEN], 1u);
      else XB_SPIN(xb_ld(&bar[XB_TOPGEN]) == tg, bar);
      __builtin_amdgcn_fence(__ATOMIC_ACQUIRE, "agent");
      xb_add(&bar[XB_XGEN(b.x)], 1u);
      asm volatile("s_waitcnt vmcnt(0)" ::: "memory");
    } else {
      XB_SPIN(xb_ld(&bar[XB_XGEN(b.x)]) == gen, bar);
      __builtin_amdgcn_fence(__ATOMIC_ACQUIRE, "agent");
      asm volatile("s_waitcnt vmcnt(0)" ::: "memory");
    }
  }
  __syncthreads();
}

__global__ void __launch_bounds__(NTHR, 2) fwd_megakernel(Params p) {
  extern __shared__ __attribute__((aligned(16))) unsigned char smem[];
  __shared__ __attribute__((aligned(16))) unsigned sh_ctl[8];
  cg::grid_group grid = cg::this_grid();
  const int bid = blockIdx.x, nb = gridDim.x;
  if (threadIdx.x < 8) sh_ctl[threadIdx.x] = 0u;
  __syncthreads();
  const XcdBarrier xb = xcd_barrier_post((unsigned*)(p.ws + OFF_CTL), (volatile LAS unsigned*)sh_ctl);
  int* s_item_p = (int*)&sh_ctl[4];
  if (p.ph_hi > 1000) grid.sync();
#define GSYNC() xcd_barrier(xb)
#ifndef DUP
#define DUP -1
#endif
#define PH(n, body) if (p.ph_lo <= n && n < p.ph_hi) { { const int rep = 0; (void)rep; body; } if (DUP == n) { GSYNC(); const int rep = 1; (void)rep; body; } if (n + 1 < p.ph_hi) GSYNC(); }
  PH(0, phase0(p, smem, bid, nb, rep))
  PH(1, phase_normmod<0>(p, bid, nb))
  PH(2, reset_tiles(s_item_p); phase_gemm_in(p, smem, s_item_p))
  PH(3, phase_prep(p, smem, s_item_p, rep))
  PH(4, phase_scan_attn(p, smem, s_item_p, rep))
  PH(5, phase_finalize_rw(p, bid, nb))
  PH(6, reset_tiles(s_item_p); phase_gemm_merge(p, smem, s_item_p))
  PH(7, reset_tiles(s_item_p); phase_gemm_out(p, smem, s_item_p))
  PH(8, phase_normmod<1>(p, bid, nb))
  PH(9, reset_tiles(s_item_p); phase_gemm_ffn_up(p, smem, s_item_p))
  PH(10, reset_tiles(s_item_p); phase_gemm_ffn_down(p, smem, s_item_p))
}

extern "C" void kernel_launch(void* const* d_in, const int* in_sizes, int n_in, void* d_out, int out_size, void* d_ws, size_t ws_size,
                              hipStream_t stream) {
  static int grid_blocks = 0;
  if (grid_blocks == 0) {
    if (n_in != 32 || ws_size < WS_END) { fprintf(stderr, "kernel_launch: unexpected n_in %d / ws_size %zu (need %zu)\n", n_in, ws_size, (size_t)WS_END); grid_blocks = -1; return; }
    int dev = 0, cus = 0, per_cu = 0;
    hipGetDevice(&dev);
    hipDeviceGetAttribute(&cus, hipDeviceAttributeMultiprocessorCount, dev);
    if (hipFuncSetAttribute((const void*)fwd_megakernel, hipFuncAttributeMaxDynamicSharedMemorySize, LDS_BYTES) != hipSuccess) { fprintf(stderr, "hipFuncSetAttribute failed\n"); grid_blocks = -1; return; }
    if (hipOccupancyMaxActiveBlocksPerMultiprocessor(&per_cu, (const void*)fwd_megakernel, NTHR, LDS_BYTES) != hipSuccess || per_cu < 1) { fprintf(stderr, "occupancy query failed (%d)\n", per_cu); grid_blocks = -1; return; }
    if (per_cu > 2) per_cu = 2;
    grid_blocks = cus * per_cu;
    fprintf(stderr, "kernel_launch: cus %d per_cu %d grid %d\n", cus, per_cu, grid_blocks);
  }
  if (grid_blocks < 0) return;
  hipMemsetAsync((char*)d_ws + OFF_CTL, 0, CTL_ZERO_BYTES, stream);
  Params p{};
  for (int i = 0; i < 32; ++i) p.in[i] = (const float*)d_in[i];
  p.out = (float*)d_out; p.ws = (unsigned char*)d_ws; p.ph_lo = 0; p.ph_hi = 11;
  void* args[] = {&p};
  hipError_t e = hipLaunchCooperativeKernel((const void*)fwd_megakernel, dim3(grid_blocks), dim3(NTHR), args, LDS_BYTES, stream);
  if (e != hipSuccess) fprintf(stderr, "cooperative launch failed: %s (grid %d)\n", hipGetErrorString(e), grid_blocks);
}
```

```cpp
#include <hip/hip_runtime.h>
#include <hip/hip_cooperative_groups.h>
#include <cstdio>
#include <cstdint>
namespace cg = cooperative_groups;

#define DEV __device__ __forceinline__
typedef unsigned short bf16_t;
typedef short bf16x8 __attribute__((ext_vector_type(8)));
typedef short bf16x4 __attribute__((ext_vector_type(4)));
typedef float f32x4 __attribute__((ext_vector_type(4)));

constexpr int D = 1024, NTOK = 6144, NCTX = 4096, RW = 512, FF = 2816, INC = 5504, RWC = 1920;
constexpr int NTHR = 256;
constexpr int LDS_BYTES = 65536;

constexpr size_t OFF_CTL = 0;
constexpr size_t OFF_MOD = 16384;
constexpr size_t CTL_ZERO_BYTES = 16384 + 3 * 6144 * 4;
constexpr size_t OFF_WIN = 90112;
constexpr size_t OFF_WORW = OFF_WIN + 11272192;
constexpr size_t OFF_WONA = OFF_WORW + 1048576;
constexpr size_t OFF_WOUT = OFF_WONA + 1048576;
constexpr size_t OFF_W13 = OFF_WOUT + 2097152;
constexpr size_t OFF_W2 = OFF_W13 + 11534336;
constexpr size_t OFF_H = OFF_W2 + 5767168;
constexpr size_t OFF_URW = OFF_H + 12582912;
constexpr size_t OFF_UNA = OFF_URW + 47185920;
constexpr size_t OFF_OPS = OFF_UNA + 37748736;
constexpr size_t OPS_ARR = 12582912;
constexpr size_t OFF_BG = OFF_OPS + 9 * OPS_ARR;
constexpr size_t OFF_VT = OFF_BG + 12582912;
constexpr size_t OFF_CKB = OFF_VT + 6291456;
constexpr size_t OFF_CVT = OFF_CKB + 524288;
constexpr size_t OFF_LORA = OFF_CVT + 524288;
constexpr size_t WS_END = OFF_LORA + 393216;
constexpr size_t OFF_QB = OFF_UNA + 12582912, OFF_KB = OFF_UNA + 18874368;
constexpr size_t OFF_YF = OFF_URW, OFF_YB = OFF_URW + 12582912;
constexpr size_t OFF_ORW = OFF_UNA, OFF_ONA = OFF_UNA + 6291456;
constexpr size_t OFF_MERGED = OFF_OPS;
constexpr size_t OFF_HID = OFF_URW;
constexpr size_t OUT_STATE = 6291456, OUT_K = 7340032, OUT_V = 9437184;

struct Params {
  const float* in[32];
  float* out;
  unsigned char* ws;
  int ph_lo, ph_hi;
};

DEV unsigned short f2bf(float f) { unsigned u = __float_as_uint(f); u += 0x7fffu + ((u >> 16) & 1u); return (unsigned short)(u >> 16); }
DEV unsigned pk2(float lo, float hi) { return (unsigned)f2bf(lo) | ((unsigned)f2bf(hi) << 16); }
DEV float bf2f(unsigned short b) { return __uint_as_float(((unsigned)b) << 16); }
DEV float sigmoidf_(float x) { return 1.f / (1.f + __expf(-x)); }
DEV float wave_sum(float x) {
#pragma unroll
  for (int o = 32; o > 0; o >>= 1) x += __shfl_xor(x, o);
  return x;
}
template <int CTRL> DEV float dpp_mov(float x) { return __int_as_float(__builtin_amdgcn_update_dpp(0, __float_as_int(x), CTRL, 0xf, 0xf, true)); }
DEV float row16_sum(float x) {
  x += dpp_mov<0xB1>(x); x += dpp_mov<0x4E>(x); x += dpp_mov<0x141>(x); x += dpp_mov<0x140>(x);
  return x;
}
#define BAR_LDS() do { asm volatile("s_waitcnt lgkmcnt(0)" ::: "memory"); __builtin_amdgcn_s_barrier(); asm volatile("" ::: "memory"); } while (0)
DEV const float* xrow(const Params& p, int t) { return t < NCTX ? p.in[0] + (size_t)t * D : p.in[1] + (size_t)(t - NCTX) * D; }
DEV int modidx(int t) { return t < NCTX ? 0 : 1 + ((t - NCTX) >> 10); }

DEV void conv_job(const Params& p, int j, const float*& src, bf16_t*& dst, int& K, int& N, int& mode, int& base) {
  if (j < 1376) { src = p.in[11]; dst = (bf16_t*)(p.ws + OFF_WIN); K = 1024; N = 5504; mode = 0; base = 0; }
  else if (j < 1504) { src = p.in[26]; dst = (bf16_t*)(p.ws + OFF_WORW); K = 512; N = 1024; mode = 0; base = 1376; }
  else if (j < 1632) { src = p.in[27]; dst = (bf16_t*)(p.ws + OFF_WONA); K = 512; N = 1024; mode = 0; base = 1504; }
  else if (j < 1888) { src = p.in[28]; dst = (bf16_t*)(p.ws + OFF_WOUT); K = 1024; N = 1024; mode = 0; base = 1632; }
  else if (j < 2592) { src = p.in[29]; dst = (bf16_t*)(p.ws + OFF_W13); K = 1024; N = 2816; mode = 1; base = 1888; }
  else if (j < 3296) { src = p.in[30]; dst = (bf16_t*)(p.ws + OFF_W13); K = 1024; N = 2816; mode = 2; base = 2592; }
  else if (j < 4000) { src = p.in[31]; dst = (bf16_t*)(p.ws + OFF_W2); K = 2816; N = 1024; mode = 0; base = 3296; }
  else if (j < 4016) { const int e = (j - 4000) >> 3; src = p.in[14] + e * 32768; dst = (bf16_t*)(p.ws + OFF_LORA) + e * 32768; K = 64; N = 512; mode = 0; base = 4000 + e * 8; }
  else if (j < 4032) { const int e = (j - 4016) >> 3; src = p.in[16] + e * 32768; dst = (bf16_t*)(p.ws + OFF_LORA) + 65536 + e * 32768; K = 64; N = 512; mode = 0; base = 4016 + e * 8; }
  else { src = p.in[17]; dst = (bf16_t*)(p.ws + OFF_LORA) + 131072; K = 128; N = 512; mode = 0; base = 4032; }
}
constexpr int N_CONV_TILES = 4048, N_MOD_TILES = 768;

DEV void phase0(const Params& p, unsigned char* smem, int bid, int nb, int rep) {
  const int tid = threadIdx.x;
  float* T = (float*)smem;
  for (int tile = bid; tile < N_MOD_TILES && rep == 0; tile += nb) {
    const int cgp = tile % 24, kc = tile / 24;
    if (tid < 96) {
      const int m = tid >> 5, kk = tid & 31, k = kc * 32 + kk;
      const float c = (m == 0) ? p.in[6][k] : p.in[5][(m - 1) * D + k];
      T[tid] = c * sigmoidf_(c);
    }
    __syncthreads();
    const int col = cgp * 256 + tid;
    const float* w = p.in[9] + (size_t)(kc * 32) * 6144 + col;
    float a0 = 0.f, a1 = 0.f, a2 = 0.f;
#pragma unroll
    for (int kk = 0; kk < 32; ++kk) {
      const float wv = __builtin_nontemporal_load(w + (size_t)kk * 6144);
      a0 += T[kk] * wv; a1 += T[32 + kk] * wv; a2 += T[64 + kk] * wv;
    }
    if (kc == 0) { const float b = p.in[10][col]; a0 += b; a1 += b; a2 += b; }
    float* mod = (float*)(p.ws + OFF_MOD);
    atomicAdd(mod + col, a0); atomicAdd(mod + 6144 + col, a1); atomicAdd(mod + 12288 + col, a2);
    __syncthreads();
  }
  const int r_ = tid >> 4, c4_ = tid & 15;
  float4 v[4];
  const float* src; bf16_t* dst; int K, N, mode, base;
  int tile = bid;
  if (tile < N_CONV_TILES) {
    conv_job(p, tile, src, dst, K, N, mode, base);
    const int lt = tile - base, nN = N >> 6, k0 = (lt / nN) * 64, n0 = (lt % nN) * 64;
#pragma unroll
    for (int i = 0; i < 4; ++i) { const f32x4 t_ = __builtin_nontemporal_load((const f32x4*)(src + (size_t)(k0 + r_ + 16 * i) * N + n0 + c4_ * 4)); v[i] = make_float4(t_[0], t_[1], t_[2], t_[3]); }
  }
  while (tile < N_CONV_TILES) {
    const int lt = tile - base, nN = N >> 6, k0 = (lt / nN) * 64, n0 = (lt % nN) * 64;
    bf16_t* cdst = dst; const int cK = K, cmode = mode;
#pragma unroll
    for (int i = 0; i < 4; ++i) {
      float* tp = T + (r_ + 16 * i) * 65 + c4_ * 4;
      tp[0] = v[i].x; tp[1] = v[i].y; tp[2] = v[i].z; tp[3] = v[i].w;
    }
    BAR_LDS();
    tile += nb;
    if (tile < N_CONV_TILES) {
      conv_job(p, tile, src, dst, K, N, mode, base);
      const int lt2 = tile - base, nN2 = N >> 6, k2 = (lt2 / nN2) * 64, n2 = (lt2 % nN2) * 64;
#pragma unroll
      for (int i = 0; i < 4; ++i) { const f32x4 t_ = __builtin_nontemporal_load((const f32x4*)(src + (size_t)(k2 + r_ + 16 * i) * N + n2 + c4_ * 4)); v[i] = make_float4(t_[0], t_[1], t_[2], t_[3]); }
    }
    const int n = tid >> 2, kp = tid & 3;
    unsigned w[8];
#pragma unroll
    for (int i = 0; i < 8; ++i) w[i] = pk2(T[(kp * 16 + 2 * i) * 65 + n], T[(kp * 16 + 2 * i + 1) * 65 + n]);
    const int ng = n0 + n;
    int drow = ng;
    if (cmode == 1) drow = (ng >> 4) * 32 + (ng & 15);
    else if (cmode == 2) drow = (ng >> 4) * 32 + 16 + (ng & 15);
    uint4* dp = (uint4*)(cdst + (size_t)drow * cK + k0 + kp * 16);
    dp[0] = make_uint4(w[0], w[1], w[2], w[3]);
    dp[1] = make_uint4(w[4], w[5], w[6], w[7]);
    BAR_LDS();
  }
}

template <int WHICH>
DEV void phase_normmod(const Params& p, int bid, int nb) {
  const int lane = threadIdx.x & 63, gw = bid * 4 + (threadIdx.x >> 6), nw = nb * 4;
  const float* g = WHICH == 0 ? p.in[7] : p.in[8];
  const float* mod = (const float*)(p.ws + OFF_MOD);
  const int sh_off = WHICH == 0 ? 0 : 3072, sc_off = WHICH == 0 ? 1024 : 4096;
  bf16_t* dst = (bf16_t*)(p.ws + OFF_H);
#pragma unroll 3
  for (int t = gw; t < NTOK; t += nw) {
    const float* xp = WHICH == 0 ? xrow(p, t) : p.out + (size_t)t * D;
    const float* mm = mod + modidx(t) * 6144;
    float4 v[4];
    float ss = 0.f;
#pragma unroll
    for (int i = 0; i < 4; ++i) {
      v[i] = *(const float4*)(xp + (i * 64 + lane) * 4);
      ss += v[i].x * v[i].x + v[i].y * v[i].y + v[i].z * v[i].z + v[i].w * v[i].w;
    }
    ss = wave_sum(ss);
    const float rstd = rsqrtf(ss * (1.f / 1024.f) + 1e-6f);
#pragma unroll
    for (int i = 0; i < 4; ++i) {
      const int col = (i * 64 + lane) * 4;
      const float4 g4 = *(const float4*)(g + col);
      const float4 sc = *(const float4*)(mm + sc_off + col);
      const float4 sh = *(const float4*)(mm + sh_off + col);
      const float y0 = v[i].x * rstd * g4.x * (1.f + sc.x) + sh.x;
      const float y1 = v[i].y * rstd * g4.y * (1.f + sc.y) + sh.y;
      const float y2 = v[i].z * rstd * g4.z * (1.f + sc.z) + sh.z;
      const float y3 = v[i].w * rstd * g4.w * (1.f + sc.w) + sh.w;
      *(uint2*)(dst + (size_t)t * D + col) = make_uint2(pk2(y0, y1), pk2(y2, y3));
    }
  }
}

template <int MI>
DEV void gemm_tile_acc(f32x4 (&acc)[MI][4], const bf16_t* __restrict__ A, int lda, const bf16_t* __restrict__ Bt, int ldb,
                       int m0, int n0, int K, unsigned char* smem) {
  constexpr int AT = 2 * MI * 16 * 128, BT = 16384, STG = AT + BT;
  const int tid = threadIdx.x, lane = tid & 63, wid = tid >> 6, wr = wid >> 1, wc = wid & 1, fr = lane & 15, fq = lane >> 4;
  const int gkc = (tid & 7) ^ ((tid >> 4) & 7);
  const bf16_t* ga = A + (size_t)(m0 + (tid >> 3)) * lda + gkc * 8;
  const bf16_t* gb = Bt + (size_t)(n0 + (tid >> 3)) * ldb + gkc * 8;
  const int swz = (fr >> 1) & 7;
  const int nk = K >> 6;
#define GLDS_TILE(kt_, buf_) do { unsigned char* sb_ = smem + (buf_) * STG; const int k0_ = (kt_) * 64; \
    _Pragma("unroll") for (int i_ = 0; i_ < (2 * MI * 16) / 32; ++i_) \
      __builtin_amdgcn_global_load_lds((const unsigned*)(ga + (size_t)i_ * 32 * lda + k0_), (__attribute__((address_space(3))) unsigned*)(sb_ + (i_ * 256 + tid) * 16), 16, 0, 0); \
    _Pragma("unroll") for (int i_ = 0; i_ < 4; ++i_) \
      __builtin_amdgcn_global_load_lds((const unsigned*)(gb + (size_t)i_ * 32 * ldb + k0_), (__attribute__((address_space(3))) unsigned*)(sb_ + AT + (i_ * 256 + tid) * 16), 16, 0, 0); \
  } while (0)
  GLDS_TILE(0, 0);
  asm volatile("s_waitcnt vmcnt(0)" ::: "memory");
  __syncthreads();
  for (int kt = 0; kt < nk; ++kt) {
    if (kt + 1 < nk) GLDS_TILE(kt + 1, (kt + 1) & 1);
    const unsigned char* cur = smem + (kt & 1) * STG;
#pragma unroll
    for (int ks = 0; ks < 2; ++ks) {
      bf16x8 af[MI], bf[4];
      const int co = ((ks * 4 + fq) ^ swz) << 4;
#pragma unroll
      for (int mi = 0; mi < MI; ++mi) af[mi] = *(const bf16x8*)(cur + (wr * MI * 16 + mi * 16 + fr) * 128 + co);
#pragma unroll
      for (int ni = 0; ni < 4; ++ni) bf[ni] = *(const bf16x8*)(cur + AT + (wc * 64 + ni * 16 + fr) * 128 + co);
      __builtin_amdgcn_s_setprio(1);
#pragma unroll
      for (int mi = 0; mi < MI; ++mi)
#pragma unroll
        for (int ni = 0; ni < 4; ++ni) acc[mi][ni] = __builtin_amdgcn_mfma_f32_16x16x32_bf16(bf[ni], af[mi], acc[mi][ni], 0, 0, 0);
      __builtin_amdgcn_s_setprio(0);
    }
    asm volatile("s_waitcnt vmcnt(0)" ::: "memory");
    __syncthreads();
  }
#undef GLDS_TILE
}

template <int MI>
DEV void zero_acc(f32x4 (&acc)[MI][4]) {
#pragma unroll
  for (int i = 0; i < MI; ++i)
#pragma unroll
    for (int j = 0; j < 4; ++j) acc[i][j] = (f32x4){0.f, 0.f, 0.f, 0.f};
}

#ifndef DYN_TILES
#define DYN_TILES 0
#endif
DEV int grab_tile(const Params& p, int word, int* slot) {
#if DYN_TILES
  if (threadIdx.x == 0) *slot = (int)atomicAdd((unsigned*)(p.ws + OFF_CTL) + word, 1u);
  __syncthreads();
  const int t = *slot;
  __syncthreads();
  return t;
#else
  const int t = slot[1];
  __syncthreads();
  if (threadIdx.x == 0) slot[1] = t + gridDim.x;
  __syncthreads();
  return t;
#endif
}
DEV void reset_tiles(int* slot) { if (threadIdx.x == 0) slot[1] = blockIdx.x; __syncthreads(); }

#define EPI_COORDS const int lane = threadIdx.x & 63, wid = threadIdx.x >> 6, wr = wid >> 1, wc = wid & 1, fr = lane & 15, fq = lane >> 4

DEV void phase_gemm_in(const Params& p, unsigned char* smem, int* slot) {
  EPI_COORDS;
  const bf16_t* A = (const bf16_t*)(p.ws + OFF_H);
  const bf16_t* Bt = (const bf16_t*)(p.ws + OFF_WIN);
  float* urw = (float*)(p.ws + OFF_URW);
  float* una = (float*)(p.ws + OFF_UNA);
  bf16_t* gates = (bf16_t*)p.out;
  for (;;) {
    const int tile = grab_tile(p, 8, slot);
    if (tile >= 48 * 43) break;
    const int tm = tile % 48, tn = tile / 48, m0 = tm * 128, n0 = tn * 128;
    f32x4 acc[4][4];
    zero_acc<4>(acc);
    gemm_tile_acc<4>(acc, A, D, Bt, D, m0, n0, D, smem);
    if (n0 >= 1920 && n0 < 3456) {
      const int sec = (n0 - 1920) >> 9;
      const int h = (((n0 - 1920) & 511) >> 6) + wc;
      bf16_t* qb = (bf16_t*)(p.ws + OFF_QB); bf16_t* kb = (bf16_t*)(p.ws + OFF_KB); bf16_t* vT = (bf16_t*)(p.ws + OFF_VT);
#pragma unroll
      for (int mi = 0; mi < 4; ++mi) {
        const int row = m0 + wr * 64 + mi * 16 + fr;
        if (sec < 2) {
          float ss = 0.f;
#pragma unroll
          for (int ni = 0; ni < 4; ++ni) { const f32x4 v = acc[mi][ni]; ss += v[0] * v[0] + v[1] * v[1] + v[2] * v[2] + v[3] * v[3]; }
          ss += __shfl_xor(ss, 16); ss += __shfl_xor(ss, 32);
          const float rs = rsqrtf(ss * (1.f / 64.f) + 1e-6f) * (sec == 0 ? 0.125f : 1.f);
          const float* gv = sec == 0 ? p.in[23] : p.in[24];
          bf16_t* dstb = (sec == 0 ? qb : kb) + (size_t)row * 512 + h * 64;
#pragma unroll
          for (int ni = 0; ni < 4; ++ni) {
            const int d = ni * 16 + fq * 4;
            const f32x4 x = acc[mi][ni] * rs * (*(const f32x4*)(gv + d));
            *(uint2*)(dstb + d) = make_uint2(pk2(x[0], x[1]), pk2(x[2], x[3]));
            if (sec == 1 && row < NCTX) *(f32x4*)(p.out + OUT_K + (size_t)row * 512 + h * 64 + d) = x;
          }
        } else {
#pragma unroll
          for (int ni = 0; ni < 4; ++ni) {
            const int d = ni * 16 + fq * 4;
            const f32x4 x = acc[mi][ni];
            if (row < NCTX) *(f32x4*)(p.out + OUT_V + (size_t)row * 512 + h * 64 + d) = x;
#pragma unroll
            for (int e2 = 0; e2 < 4; ++e2) *(bf16_t*)(smem + (wc * 64 + d + e2) * 272 + (wr * 64 + mi * 16 + fr) * 2) = f2bf(x[e2]);
          }
        }
      }
      if (sec == 2) {
        __syncthreads();
        const int dd = threadIdx.x >> 1, hf = threadIdx.x & 1;
        const int hb = ((n0 - 1920) & 511) >> 6;
        bf16_t* vrow = vT + (size_t)(hb * 64 + dd) * NTOK + m0 + hf * 64;
#pragma unroll
        for (int j = 0; j < 8; ++j) *(uint4*)(vrow + j * 8) = *(const uint4*)(smem + dd * 272 + hf * 128 + j * 16);
        __syncthreads();
      }
    } else {
#pragma unroll
      for (int mi = 0; mi < 4; ++mi) {
        const int row = m0 + wr * 64 + mi * 16 + fr;
#pragma unroll
        for (int ni = 0; ni < 4; ++ni) {
          const int col = n0 + wc * 64 + ni * 16 + fq * 4;
          const f32x4 v = acc[mi][ni];
          if (n0 < 1920) *(f32x4*)(urw + (size_t)row * 1920 + col) = v;
          else *(uint2*)(gates + (size_t)row * 2048 + (col - 3456)) = make_uint2(pk2(sigmoidf_(v[0]), sigmoidf_(v[1])), pk2(sigmoidf_(v[2]), sigmoidf_(v[3])));
        }
      }
    }
  }
}

DEV void phase_gemm_merge(const Params& p, unsigned char* smem, int* slot) {
  EPI_COORDS;
  const bf16_t* orw = (const bf16_t*)(p.ws + OFF_ORW);
  const bf16_t* ona = (const bf16_t*)(p.ws + OFF_ONA);
  const bf16_t* w1 = (const bf16_t*)(p.ws + OFF_WORW);
  const bf16_t* w2 = (const bf16_t*)(p.ws + OFF_WONA);
  const bf16_t* gates = (const bf16_t*)p.out;
  bf16_t* merged = (bf16_t*)(p.ws + OFF_MERGED);
  float* mtmp = (float*)(p.ws + OFF_MERGED + 16777216);
  for (;;) {
    const int tile = grab_tile(p, 9, slot);
    if (tile >= 64 * 8) break;
    const int tm = tile % 64, tn = tile / 64, m0 = tm * 96, n0 = tn * 128;
    f32x4 acc[3][4];
    zero_acc<3>(acc);
    gemm_tile_acc<3>(acc, orw, RW, w1, RW, m0, n0, RW, smem);
#pragma unroll
    for (int mi = 0; mi < 3; ++mi) {
      const int row = m0 + wr * 48 + mi * 16 + fr;
#pragma unroll
      for (int ni = 0; ni < 4; ++ni) {
        const int col = n0 + wc * 64 + ni * 16 + fq * 4;
        const uint2 g = *(const uint2*)(gates + (size_t)row * 2048 + col);
        f32x4 r;
        r[0] = acc[mi][ni][0] * bf2f((unsigned short)(g.x & 0xffff));
        r[1] = acc[mi][ni][1] * bf2f((unsigned short)(g.x >> 16));
        r[2] = acc[mi][ni][2] * bf2f((unsigned short)(g.y & 0xffff));
        r[3] = acc[mi][ni][3] * bf2f((unsigned short)(g.y >> 16));
        *(f32x4*)(mtmp + (size_t)row * D + col) = r;
      }
    }
    zero_acc<3>(acc);
    gemm_tile_acc<3>(acc, ona, RW, w2, RW, m0, n0, RW, smem);
#pragma unroll
    for (int mi = 0; mi < 3; ++mi) {
      const int row = m0 + wr * 48 + mi * 16 + fr;
#pragma unroll
      for (int ni = 0; ni < 4; ++ni) {
        const int col = n0 + wc * 64 + ni * 16 + fq * 4;
        const uint2 g = *(const uint2*)(gates + (size_t)row * 2048 + 1024 + col);
        const f32x4 mg = *(const f32x4*)(mtmp + (size_t)row * D + col);
        const float r0 = mg[0] + acc[mi][ni][0] * bf2f((unsigned short)(g.x & 0xffff));
        const float r1 = mg[1] + acc[mi][ni][1] * bf2f((unsigned short)(g.x >> 16));
        const float r2 = mg[2] + acc[mi][ni][2] * bf2f((unsigned short)(g.y & 0xffff));
        const float r3 = mg[3] + acc[mi][ni][3] * bf2f((unsigned short)(g.y >> 16));
        *(uint2*)(merged + (size_t)row * D + col) = make_uint2(pk2(r0, r1), pk2(r2, r3));
      }
    }
  }
}

DEV void phase_gemm_out(const Params& p, unsigned char* smem, int* slot) {
  EPI_COORDS;
  const bf16_t* A = (const bf16_t*)(p.ws + OFF_MERGED);
  const bf16_t* Bt = (const bf16_t*)(p.ws + OFF_WOUT);
  const float* mod = (const float*)(p.ws + OFF_MOD);
  for (;;) {
    const int tile = grab_tile(p, 10, slot);
    if (tile >= 64 * 8) break;
    const int tm = tile % 64, tn = tile / 64, m0 = tm * 96, n0 = tn * 128;
    f32x4 acc[3][4];
    zero_acc<3>(acc);
    gemm_tile_acc<3>(acc, A, D, Bt, D, m0, n0, D, smem);
#pragma unroll
    for (int mi = 0; mi < 3; ++mi) {
      const int row = m0 + wr * 48 + mi * 16 + fr;
      const float* xp = xrow(p, row);
      const float* g1 = mod + modidx(row) * 6144 + 2048;
#pragma unroll
      for (int ni = 0; ni < 4; ++ni) {
        const int col = n0 + wc * 64 + ni * 16 + fq * 4;
        const f32x4 x = *(const f32x4*)(xp + col);
        const f32x4 g = *(const f32x4*)(g1 + col);
        *(f32x4*)(p.out + (size_t)row * D + col) = x + g * acc[mi][ni];
      }
    }
  }
}

DEV void phase_gemm_ffn_up(const Params& p, unsigned char* smem, int* slot) {
  EPI_COORDS;
  const bf16_t* A = (const bf16_t*)(p.ws + OFF_H);
  const bf16_t* Bt = (const bf16_t*)(p.ws + OFF_W13);
  bf16_t* hid = (bf16_t*)(p.ws + OFF_HID);
  for (;;) {
    const int tile = grab_tile(p, 11, slot);
    if (tile >= 48 * 44) break;
    const int tm = tile % 48, tn = tile / 48, m0 = tm * 128, n0 = tn * 128;
    f32x4 acc[4][4];
    zero_acc<4>(acc);
    gemm_tile_acc<4>(acc, A, D, Bt, D, m0, n0, D, smem);
#pragma unroll
    for (int mi = 0; mi < 4; ++mi) {
      const int row = m0 + wr * 64 + mi * 16 + fr;
#pragma unroll
      for (int gp = 0; gp < 2; ++gp) {
        const int hcol = ((n0 + wc * 64) >> 1) + gp * 16 + fq * 4;
        const f32x4 a = acc[mi][2 * gp], b = acc[mi][2 * gp + 1];
        float r[4];
#pragma unroll
        for (int e = 0; e < 4; ++e) r[e] = a[e] * sigmoidf_(a[e]) * b[e];
        *(uint2*)(hid + (size_t)row * FF + hcol) = make_uint2(pk2(r[0], r[1]), pk2(r[2], r[3]));
      }
    }
  }
}

DEV void phase_gemm_ffn_down(const Params& p, unsigned char* smem, int* slot) {
  EPI_COORDS;
  const bf16_t* A = (const bf16_t*)(p.ws + OFF_HID);
  const bf16_t* Bt = (const bf16_t*)(p.ws + OFF_W2);
  const float* mod = (const float*)(p.ws + OFF_MOD);
  for (;;) {
    const int tile = grab_tile(p, 12, slot);
    if (tile >= 64 * 8) break;
    const int tm = tile % 64, tn = tile / 64, m0 = tm * 96, n0 = tn * 128;
    f32x4 acc[3][4];
    zero_acc<3>(acc);
    gemm_tile_acc<3>(acc, A, FF, Bt, FF, m0, n0, FF, smem);
#pragma unroll
    for (int mi = 0; mi < 3; ++mi) {
      const int row = m0 + wr * 48 + mi * 16 + fr;
      const float* g2 = mod + modidx(row) * 6144 + 5120;
#pragma unroll
      for (int ni = 0; ni < 4; ++ni) {
        const int col = n0 + wc * 64 + ni * 16 + fq * 4;
        float* op = p.out + (size_t)row * D + col;
        const f32x4 x = *(const f32x4*)op;
        const f32x4 g = *(const f32x4*)(g2 + col);
        *(f32x4*)op = x + g * acc[mi][ni];
      }
    }
  }
}

DEV void phase_qkprep(const Params& p, unsigned char* smem, int item_) {
  const int tid = threadIdx.x;
  bf16_t* Vs = (bf16_t*)smem;
  bf16_t* qb = (bf16_t*)(p.ws + OFF_QB);
  bf16_t* kb = (bf16_t*)(p.ws + OFF_KB);
  bf16_t* vT = (bf16_t*)(p.ws + OFF_VT);
  bf16_t* ckb = (bf16_t*)(p.ws + OFF_CKB);
  bf16_t* cvT = (bf16_t*)(p.ws + OFF_CVT);
  const float* una = (const float*)(p.ws + OFF_UNA);
  const int tok = tid >> 2, part = tid & 3;
  for (int item = item_; item < item_ + 1; ++item) {
    if (item < 768) {
      const int tt = item >> 3, h = item & 7, t0 = tt * 64, t = t0 + tok;
      const float* src = una + (size_t)t * 1536 + h * 64 + part * 16;
      {
        float x[16]; float ss = 0.f;
#pragma unroll
        for (int i = 0; i < 4; ++i) { const float4 v = *(const float4*)(src + i * 4); x[4 * i] = v.x; x[4 * i + 1] = v.y; x[4 * i + 2] = v.z; x[4 * i + 3] = v.w; }
#pragma unroll
        for (int i = 0; i < 16; ++i) ss += x[i] * x[i];
        ss += __shfl_xor(ss, 1); ss += __shfl_xor(ss, 2);
        const float rs = rsqrtf(ss * (1.f / 64.f) + 1e-6f) * 0.125f;
        unsigned w[8];
#pragma unroll
        for (int i = 0; i < 8; ++i) w[i] = pk2(x[2 * i] * rs * p.in[23][part * 16 + 2 * i], x[2 * i + 1] * rs * p.in[23][part * 16 + 2 * i + 1]);
        uint4* dp = (uint4*)(qb + (size_t)t * 512 + h * 64 + part * 16);
        dp[0] = make_uint4(w[0], w[1], w[2], w[3]); dp[1] = make_uint4(w[4], w[5], w[6], w[7]);
      }
      {
        float x[16]; float ss = 0.f;
#pragma unroll
        for (int i = 0; i < 4; ++i) { const float4 v = *(const float4*)(src + 512 + i * 4); x[4 * i] = v.x; x[4 * i + 1] = v.y; x[4 * i + 2] = v.z; x[4 * i + 3] = v.w; }
#pragma unroll
        for (int i = 0; i < 16; ++i) ss += x[i] * x[i];
        ss += __shfl_xor(ss, 1); ss += __shfl_xor(ss, 2);
        const float rs = rsqrtf(ss * (1.f / 64.f) + 1e-6f);
#pragma unroll
        for (int i = 0; i < 16; ++i) x[i] = x[i] * rs * p.in[24][part * 16 + i];
        if (t < NCTX) {
          float4* op = (float4*)(p.out + OUT_K + (size_t)t * 512 + h * 64 + part * 16);
#pragma unroll
          for (int i = 0; i < 4; ++i) op[i] = make_float4(x[4 * i], x[4 * i + 1], x[4 * i + 2], x[4 * i + 3]);
        }
        unsigned w[8];
#pragma unroll
        for (int i = 0; i < 8; ++i) w[i] = pk2(x[2 * i], x[2 * i + 1]);
        uint4* dp = (uint4*)(kb + (size_t)t * 512 + h * 64 + part * 16);
        dp[0] = make_uint4(w[0], w[1], w[2], w[3]); dp[1] = make_uint4(w[4], w[5], w[6], w[7]);
      }
      {
        float x[16];
#pragma unroll
        for (int i = 0; i < 4; ++i) { const float4 v = *(const float4*)(src + 1024 + i * 4); x[4 * i] = v.x; x[4 * i + 1] = v.y; x[4 * i + 2] = v.z; x[4 * i + 3] = v.w; }
        if (t < NCTX) {
          float4* op = (float4*)(p.out + OUT_V + (size_t)t * 512 + h * 64 + part * 16);
#pragma unroll
          for (int i = 0; i < 4; ++i) op[i] = make_float4(x[4 * i], x[4 * i + 1], x[4 * i + 2], x[4 * i + 3]);
        }
#pragma unroll
        for (int i = 0; i < 16; ++i) Vs[tok * 72 + part * 16 + i] = f2bf(x[i]);
      }
      __syncthreads();
      {
        const int d = tid >> 2;
        unsigned w[8];
#pragma unroll
        for (int i = 0; i < 8; ++i) w[i] = (unsigned)Vs[(part * 16 + 2 * i) * 72 + d] | ((unsigned)Vs[(part * 16 + 2 * i + 1) * 72 + d] << 16);
        uint4* dp = (uint4*)(vT + (size_t)(h * 64 + d) * NTOK + t0 + part * 16);
        dp[0] = make_uint4(w[0], w[1], w[2], w[3]); dp[1] = make_uint4(w[4], w[5], w[6], w[7]);
      }
      __syncthreads();
    } else {
      const int ci = item - 768, b = ci >> 5, rem = ci & 31, tt = rem >> 3, h = rem & 7, t0 = tt * 64, t = t0 + tok;
      const size_t sidx = (size_t)(b * 256 + t) * 512 + h * 64 + part * 16;
      {
        float x[16];
#pragma unroll
        for (int i = 0; i < 4; ++i) { const float4 v = *(const float4*)(p.in[3] + sidx + i * 4); x[4 * i] = v.x; x[4 * i + 1] = v.y; x[4 * i + 2] = v.z; x[4 * i + 3] = v.w; }
        unsigned w[8];
#pragma unroll
        for (int i = 0; i < 8; ++i) w[i] = pk2(x[2 * i], x[2 * i + 1]);
        uint4* dp = (uint4*)(ckb + sidx);
        dp[0] = make_uint4(w[0], w[1], w[2], w[3]); dp[1] = make_uint4(w[4], w[5], w[6], w[7]);
      }
      {
        float x[16];
#pragma unroll
        for (int i = 0; i < 4; ++i) { const float4 v = *(const float4*)(p.in[4] + sidx + i * 4); x[4 * i] = v.x; x[4 * i + 1] = v.y; x[4 * i + 2] = v.z; x[4 * i + 3] = v.w; }
#pragma unroll
        for (int i = 0; i < 16; ++i) Vs[tok * 72 + part * 16 + i] = f2bf(x[i]);
      }
      __syncthreads();
      {
        const int d = tid >> 2;
        unsigned w[8];
#pragma unroll
        for (int i = 0; i < 8; ++i) w[i] = (unsigned)Vs[(part * 16 + 2 * i) * 72 + d] | ((unsigned)Vs[(part * 16 + 2 * i + 1) * 72 + d] << 16);
        uint4* dp = (uint4*)(cvT + (size_t)((b * 8 + h) * 64 + d) * 256 + t0 + part * 16);
        dp[0] = make_uint4(w[0], w[1], w[2], w[3]); dp[1] = make_uint4(w[4], w[5], w[6], w[7]);
      }
      __syncthreads();
    }
  }
}

DEV float* ops_arr(const Params& p, int i) { return (float*)(p.ws + OFF_OPS + (size_t)i * OPS_ARR); }

DEV f32x4 shiftvec(f32x4 cur, f32x4 hal, f32x4 mu0, f32x4 mu1, int fr) {
  f32x4 prev, next;
#pragma unroll
  for (int i = 0; i < 4; ++i) {
    prev[i] = dpp_mov<0x111>(cur[i]);
    next[i] = dpp_mov<0x101>(cur[i]);
  }
  if (fr == 0) prev = hal;
  if (fr == 15) next = hal;
  return cur + mu0 * (prev - cur) + mu1 * (next - cur);
}
DEV float quad_sum(float x) { x += __shfl_xor(x, 16); x += __shfl_xor(x, 32); return x; }
DEV f32x4 ld4(const float* p) { return *(const f32x4*)p; }

constexpr int LROWB = 392;
template <bool HALF>
DEV void phase_rwprep(const Params& p, unsigned char* smem, int item_) {
  const int tid = threadIdx.x, lane = tid & 63, w = tid >> 6, fr = lane & 15, fq = lane >> 4;
  bf16_t* Lb = (bf16_t*)smem;
  const float* urw = (const float*)(p.ws + OFF_URW);
  const float* mu = p.in[12];
  bf16_t* bonus = (bf16_t*)(p.ws + OFF_BG);
  bf16_t* gate = (bf16_t*)(p.ws + OFF_BG + 6291456);
  const bf16_t* WUPT = (const bf16_t*)(p.ws + OFF_LORA);
  const bf16_t* AUPT = WUPT + 65536;
  const bf16_t* GUPT = WUPT + 131072;
  float* o_r = ops_arr(p, 0); float* o_v = ops_arr(p, 1); float* o_a = ops_arr(p, 2);
  for (int item = item_; item < item_ + 1; ++item) {
    const int t0 = HALF ? (256 + (item >> 2)) * 16 : (item >> 1) * 16;
    const int h = HALF ? (item & 3) * 2 + (w >> 1) : (item & 1) * 4 + w;
    const int ni_lo = HALF ? (w & 1) * 2 : 0, ni_hi = HALF ? ni_lo + 2 : 4;
    float* xs = (float*)(smem + 16384);
    int s_lo, s_hi;
    if (t0 < NCTX) { s_lo = t0 & ~255; s_hi = s_lo + 256; } else { s_lo = NCTX + ((t0 - NCTX) & ~1023); s_hi = s_lo + 1024; }
    {
      const int tl = tid >> 4, g16 = tid & 15, tt = t0 + tl;
      const float* up = urw + (size_t)tt * RWC + 1536;
      const bool hp = tt > s_lo, hn = tt + 1 < s_hi;
#pragma unroll
      for (int j = 0; j < 6; ++j) {
        const int col = (g16 + 16 * j) * 4;
        const f32x4 c = ld4(up + col);
        const f32x4 z = (f32x4){0.f, 0.f, 0.f, 0.f};
        const f32x4 pv = hp ? ld4(up - RWC + col) : z;
        const f32x4 nx = hn ? ld4(up + RWC + col) : z;
        const f32x4 m0 = ld4(mu + 1536 + col), m1 = ld4(mu + RWC + 1536 + col);
        const f32x4 us = c + m0 * (pv - c) + m1 * (nx - c);
        const int kind = col >> 7;
        float o4[4];
#pragma unroll
        for (int i = 0; i < 4; ++i) o4[i] = kind == 0 ? (1.f - 2.f / (1.f + __expf(2.f * us[i]))) : (kind == 1 ? us[i] : sigmoidf_(us[i]));
        *(uint2*)(Lb + tl * LROWB + col) = make_uint2(pk2(o4[0], o4[1]), pk2(o4[2], o4[3]));
      }
    }
    __syncthreads();
    const int t = t0 + fr;
    const bool lo_ok = (fr == 0) && (t > s_lo), hi_ok = (fr == 15) && (t + 1 < s_hi);
    const float* urow = urw + (size_t)t * RWC;
    const float* hrow = lo_ok ? urow - RWC : (hi_ok ? urow + RWC : urow);
    const bool hal_ok = lo_ok || hi_ok;
    const f32x4 z4 = (f32x4){0.f, 0.f, 0.f, 0.f};
    float ss = 0.f;
#pragma unroll
    for (int ni = ni_lo; ni < ni_hi; ++ni) {
      const int c = h * 64 + ni * 16 + fq * 4;
      const f32x4 kx = shiftvec(ld4(urow + 512 + c), hal_ok ? ld4(hrow + 512 + c) : z4, ld4(mu + 512 + c), ld4(mu + RWC + 512 + c), fr) * ld4(p.in[18] + c);
      ss += kx[0] * kx[0] + kx[1] * kx[1] + kx[2] * kx[2] + kx[3] * kx[3];
    }
    ss = quad_sum(ss);
    if (HALF) { if (fq == 0) xs[w * 16 + fr] = ss; __syncthreads(); ss += xs[(w ^ 1) * 16 + fr]; }
    const float rn = rsqrtf(ss + 1e-12f);
    float bs = 0.f;
#pragma unroll 1
    for (int ni = ni_lo; ni < ni_hi; ++ni) {
      const int c = h * 64 + ni * 16 + fq * 4;
      const size_t o = (size_t)t * 512 + c;
      const f32x4 r4 = shiftvec(ld4(urow + c), hal_ok ? ld4(hrow + c) : z4, ld4(mu + c), ld4(mu + RWC + c), fr);
      const f32x4 k4 = shiftvec(ld4(urow + 512 + c), hal_ok ? ld4(hrow + 512 + c) : z4, ld4(mu + 512 + c), ld4(mu + RWC + 512 + c), fr);
      const f32x4 v4 = shiftvec(ld4(urow + 1024 + c), hal_ok ? ld4(hrow + 1024 + c) : z4, ld4(mu + 1024 + c), ld4(mu + RWC + 1024 + c), fr);
      const f32x4 kk4 = k4 * ld4(p.in[18] + c) * rn;
      *(f32x4*)(o_r + o) = r4; *(f32x4*)(o_v + o) = v4; *(f32x4*)(o_a + o) = -kk4;
      const f32x4 ka = ld4(p.in[19] + c);
      f32x4 bacc = z4;
#pragma unroll
      for (int e = 0; e < 2; ++e) {
        float* o_k = ops_arr(p, 5 + e); float* o_b = ops_arr(p, 7 + e); float* o_w = ops_arr(p, 3 + e);
        f32x4 acc = z4, acw = z4;
#pragma unroll
        for (int ks = 0; ks < 2; ++ks) {
          const bf16x8 wa = *(const bf16x8*)(AUPT + (size_t)(e * 512 + h * 64 + ni * 16 + fr) * 64 + ks * 32 + fq * 8);
          const bf16x8 la = *(const bf16x8*)(Lb + fr * LROWB + 128 + e * 64 + ks * 32 + fq * 8);
          acc = __builtin_amdgcn_mfma_f32_16x16x32_bf16(wa, la, acc, 0, 0, 0);
          const bf16x8 ww = *(const bf16x8*)(WUPT + (size_t)(e * 512 + h * 64 + ni * 16 + fr) * 64 + ks * 32 + fq * 8);
          const bf16x8 lw = *(const bf16x8*)(Lb + fr * LROWB + e * 64 + ks * 32 + fq * 8);
          acw = __builtin_amdgcn_mfma_f32_16x16x32_bf16(ww, lw, acw, 0, 0, 0);
        }
        const f32x4 a0 = ld4(p.in[15] + e * 512 + c), w0 = ld4(p.in[13] + e * 512 + c);
        f32x4 kd, bb, dec;
#pragma unroll
        for (int i = 0; i < 4; ++i) {
          const float ic = sigmoidf_(a0[i] + acc[i]);
          kd[i] = k4[i] * (1.f + (ic - 1.f) * ka[i]);
          bb[i] = kk4[i] * ic;
          const float z = w0[i] + acw[i];
          const float sp = fmaxf(-z, 0.f) + __logf(1.f + __expf(-fabsf(z)));
          dec[i] = __expf(-__expf(-sp - 0.5f));
        }
        bacc += kd;
        *(f32x4*)(o_k + o) = kd; *(f32x4*)(o_b + o) = bb; *(f32x4*)(o_w + o) = dec;
      }
      const f32x4 rk = ld4(p.in[20] + c);
#pragma unroll
      for (int i = 0; i < 4; ++i) bs += r4[i] * 0.5f * bacc[i] * rk[i];
      f32x4 acc = z4;
#pragma unroll
      for (int ks = 0; ks < 4; ++ks) {
        const bf16x8 wg = *(const bf16x8*)(GUPT + (size_t)(h * 64 + ni * 16 + fr) * 128 + ks * 32 + fq * 8);
        const bf16x8 lg = *(const bf16x8*)(Lb + fr * LROWB + 256 + ks * 32 + fq * 8);
        acc = __builtin_amdgcn_mfma_f32_16x16x32_bf16(wg, lg, acc, 0, 0, 0);
      }
      *(uint2*)(gate + o) = make_uint2(pk2(acc[0], acc[1]), pk2(acc[2], acc[3]));
    }
    bs = quad_sum(bs);
    if (HALF) { if (fq == 0) xs[64 + w * 16 + fr] = bs; __syncthreads(); bs += xs[64 + (w ^ 1) * 16 + fr]; }
#pragma unroll
    for (int ni = ni_lo; ni < ni_hi; ++ni) {
      const size_t o = (size_t)t * 512 + h * 64 + ni * 16 + fq * 4;
      const f32x4 v4 = *(const f32x4*)(o_v + o);
      *(uint2*)(bonus + o) = make_uint2(pk2(bs * v4[0], bs * v4[1]), pk2(bs * v4[2], bs * v4[3]));
    }
    __syncthreads();
  }
}

DEV void phase_prep(const Params& p, unsigned char* smem, int* s_item, int rep) {
  unsigned* counter = (unsigned*)(p.ws + OFF_CTL) + 16 + rep;
  for (;;) {
    if (threadIdx.x == 0) *s_item = (int)atomicAdd(counter, 1u);
    __syncthreads();
    const int item = *s_item;
    __syncthreads();
    if (item >= 1024 + 64) break;
    if (item < 512) phase_rwprep<false>(p, smem, item);
    else if (item < 1024) phase_rwprep<true>(p, smem, item - 512);
    else phase_qkprep(p, smem, item - 256);
  }
}

constexpr int TC = 16;
typedef float f32x2 __attribute__((ext_vector_type(2)));
template <int EPL, int R, int PD>
DEV void scan_item(const Params& p, unsigned char* smem, int seq, int h, int dir, int rg) {
  constexpr int LPR = 64 / EPL, RPW = 64 / LPR, RPB = 4 * RPW * R, NV = RPB / 16, NP = EPL / 2;
  constexpr int STG = 20480 + 16 * RPB * 4, YOFF = 2 * STG, YSZ = 16 * RPB * 4;
  const int tid = threadIdx.x, lane = tid & 63, w = tid >> 6, riw = lane / LPR, kq = lane % LPR;
  const int T = seq < 16 ? 256 : 1024;
  const int tok0 = seq < 16 ? seq * 256 : NCTX + (seq - 16) * 1024;
  const int vrow_l = (w * RPW + riw) * R;
  const int vrow = rg * RPB + vrow_l;
  f32x2 S[R][NP];
#pragma unroll
  for (int rr = 0; rr < R; ++rr) {
    if (seq >= 16) {
      const float* sp = p.in[2] + ((size_t)(((seq - 16) * 2 + dir) * 8 + h) * 64 + vrow + rr) * 64 + kq * EPL;
#pragma unroll
      for (int i = 0; i < NP; ++i) S[rr][i] = *(const f32x2*)(sp + 2 * i);
    } else {
#pragma unroll
      for (int i = 0; i < NP; ++i) S[rr][i] = (f32x2){0.f, 0.f};
    }
  }
  const int lstep = tid >> 4, l16 = tid & 15;
  const float* pr = ops_arr(p, 0) + h * 64 + l16 * 4;
  const float* pw = ops_arr(p, 3 + dir) + h * 64 + l16 * 4;
  const float* pk = ops_arr(p, 5 + dir) + h * 64 + l16 * 4;
  const float* pa = ops_arr(p, 2) + h * 64 + l16 * 4;
  const float* pb = ops_arr(p, 7 + dir) + h * 64 + l16 * 4;
  const float* pv = ops_arr(p, 1) + h * 64 + rg * RPB + l16;
  float* yout = (float*)(p.ws + (dir ? OFF_YB : OFF_YF)) + h * 64 + rg * RPB + l16;
  const int nc = T / TC;
  float4 g_r, g_w, g_k, g_a, g_b; float rv[NV];
#define gload(c) do { const int ts_ = (c) * TC + lstep; const size_t t_ = (size_t)(tok0 + (dir ? T - 1 - ts_ : ts_)) * 512; \
    g_r = *(const float4*)(pr + t_); g_w = *(const float4*)(pw + t_); g_k = *(const float4*)(pk + t_); \
    g_a = *(const float4*)(pa + t_); g_b = *(const float4*)(pb + t_); \
    _Pragma("unroll") for (int q_ = 0; q_ < NV; ++q_) rv[q_] = pv[t_ + 16 * q_]; } while (0)
#define ywrite(c) do { const float* yb_ = (const float*)(smem + YOFF + ((c) & 1) * YSZ); const int ts_ = (c) * TC + lstep; \
    const size_t t_ = (size_t)(tok0 + (dir ? T - 1 - ts_ : ts_)) * 512; \
    _Pragma("unroll") for (int q_ = 0; q_ < NV; ++q_) yout[t_ + 16 * q_] = yb_[lstep * RPB + l16 + 16 * q_]; } while (0)
  gload(0);
  for (int c = 0; c < nc; ++c) {
    unsigned char* st = smem + (c & 1) * STG;
    *(float4*)(st + 0 * 4096 + lstep * 256 + l16 * 16) = g_r;
    *(float4*)(st + 1 * 4096 + lstep * 256 + l16 * 16) = g_w;
    *(float4*)(st + 2 * 4096 + lstep * 256 + l16 * 16) = g_k;
    *(float4*)(st + 3 * 4096 + lstep * 256 + l16 * 16) = g_a;
    *(float4*)(st + 4 * 4096 + lstep * 256 + l16 * 16) = g_b;
#pragma unroll
    for (int q = 0; q < NV; ++q) *(float*)(st + 20480 + (lstep * RPB + l16 + 16 * q) * 4) = rv[q];
    __syncthreads();
    if (c > 0) ywrite(c - 1);
    if (c + 1 < nc) gload(c + 1);
    float* ybw = (float*)(smem + YOFF + (c & 1) * YSZ);
    constexpr int NS = PD + 1;
    f32x2 o_r[NS][NP], o_w[NS][NP], o_k[NS][NP], o_a[NS][NP], o_b[NS][NP]; float o_v[NS][R];
    float ykeep[R][TC / LPR];
#define LDOPS(bi, s_) do { \
      _Pragma("unroll") for (int i_ = 0; i_ < NP; ++i_) { \
        o_r[bi][i_] = *(const f32x2*)(st + 0 * 4096 + (s_) * 256 + kq * EPL * 4 + i_ * 8); \
        o_w[bi][i_] = *(const f32x2*)(st + 1 * 4096 + (s_) * 256 + kq * EPL * 4 + i_ * 8); \
        o_k[bi][i_] = *(const f32x2*)(st + 2 * 4096 + (s_) * 256 + kq * EPL * 4 + i_ * 8); \
        o_a[bi][i_] = *(const f32x2*)(st + 3 * 4096 + (s_) * 256 + kq * EPL * 4 + i_ * 8); \
        o_b[bi][i_] = *(const f32x2*)(st + 4 * 4096 + (s_) * 256 + kq * EPL * 4 + i_ * 8); } \
      _Pragma("unroll") for (int rr_ = 0; rr_ < R; ++rr_) o_v[bi][rr_] = *(const float*)(st + 20480 + ((s_) * RPB + vrow_l + rr_) * 4); } while (0)
#pragma unroll
    for (int s = 0; s < PD; ++s) LDOPS(s, s);
#pragma unroll
    for (int s = 0; s < TC; ++s) {
      const int bi = s % NS;
      if (s + PD < TC) LDOPS((s + PD) % NS, s + PD);
#pragma unroll
      for (int rr = 0; rr < R; ++rr) {
        const f32x2 vv2 = (f32x2){o_v[bi][rr], o_v[bi][rr]};
        f32x2 pa2 = S[rr][0] * o_a[bi][0];
        f32x2 tt[NP];
        tt[0] = S[rr][0] * o_w[bi][0] + vv2 * o_k[bi][0];
#pragma unroll
        for (int i = 1; i < NP; ++i) { pa2 += S[rr][i] * o_a[bi][i]; tt[i] = S[rr][i] * o_w[bi][i] + vv2 * o_k[bi][i]; }
        float sa = pa2[0] + pa2[1];
        sa += dpp_mov<0xB1>(sa); sa += dpp_mov<0x4E>(sa); sa += dpp_mov<0x141>(sa);
        if (LPR == 16) sa += dpp_mov<0x140>(sa);
        const f32x2 sa2 = (f32x2){sa, sa};
        f32x2 py = (f32x2){0.f, 0.f};
#pragma unroll
        for (int i = 0; i < NP; ++i) { S[rr][i] = sa2 * o_b[bi][i] + tt[i]; py += S[rr][i] * o_r[bi][i]; }
        float y = py[0] + py[1];
        y += dpp_mov<0xB1>(y); y += dpp_mov<0x4E>(y); y += dpp_mov<0x141>(y);
        if (LPR == 16) y += dpp_mov<0x140>(y);
        if ((s % LPR) == 0) ykeep[rr][s / LPR] = y; else ykeep[rr][s / LPR] = (kq == (s % LPR)) ? y : ykeep[rr][s / LPR];
      }
    }
#undef LDOPS
#pragma unroll
    for (int rr = 0; rr < R; ++rr)
#pragma unroll
      for (int q = 0; q < TC / LPR; ++q) ybw[(q * LPR + kq) * RPB + vrow_l + rr] = ykeep[rr][q];
  }
  __syncthreads();
  ywrite(nc - 1);
  if (seq < 16) {
#pragma unroll
    for (int rr = 0; rr < R; ++rr) {
      float* so = p.out + OUT_STATE + ((size_t)((seq * 2 + dir) * 8 + h) * 64 + vrow + rr) * 64 + kq * EPL;
#pragma unroll
      for (int i = 0; i < NP; ++i) *(f32x2*)(so + 2 * i) = S[rr][i];
    }
  }
  __syncthreads();
#undef gload
#undef ywrite
}

DEV void attn_wave_item(const Params& p, int witem) {
  const int lane = threadIdx.x & 63, fr = lane & 15, fq = lane >> 4;
  const bf16_t* qb = (const bf16_t*)(p.ws + OFF_QB);
  const bf16_t* kb = (const bf16_t*)(p.ws + OFF_KB);
  const bf16_t* vT = (const bf16_t*)(p.ws + OFF_VT);
  const bf16_t* ckb = (const bf16_t*)(p.ws + OFF_CKB);
  const bf16_t* cvT = (const bf16_t*)(p.ws + OFF_CVT);
  bf16_t* ona = (bf16_t*)(p.ws + OFF_ONA);
  int h, tq0, nsub;
  bool latent;
  int b = 0, r = 0, jb = 0, row_start = 0, band = 0, seq = 0;
  {
    const int bi = witem >> 2, wv = witem & 3;
    if (bi < 256) {
      latent = true;
      b = bi >> 7; const int rem = bi & 127; r = rem >> 3; h = rem & 7; jb = wv;
      tq0 = NCTX + b * 1024 + r * 64 + jb * 16;
      row_start = min(max(r - 4, 0), 8); band = min(max(jb * 16 - 8, 0), 32);
      nsub = 4;
    } else {
      latent = false;
      const int c2 = bi - 256; seq = c2 >> 5; const int rem = c2 & 31; h = rem >> 2; const int qg = rem & 3;
      tq0 = seq * 256 + (qg * 4 + wv) * 16; nsub = 2;
    }
  }
  const bf16_t* qp = qb + (size_t)(tq0 + fr) * 512 + h * 64 + fq * 8;
  const bf16x8 qf0 = *(const bf16x8*)qp, qf1 = *(const bf16x8*)(qp + 32);
  float m = -INFINITY, l = 0.f;
  f32x4 O[4];
#pragma unroll
  for (int i = 0; i < 4; ++i) O[i] = (f32x4){0.f, 0.f, 0.f, 0.f};
#define SUBDESC(sc_, kbase_, vbase_, KS_, ldv_, win_) do { const int half_ = (sc_) & 1; win_ = latent && (sc_) < 2; \
    if (win_) { const int tb_ = NCTX + b * 1024 + (row_start + half_ * 4) * 64 + band; \
      kbase_ = kb + (size_t)tb_ * 512 + h * 64; vbase_ = vT + (size_t)(h * 64) * NTOK + tb_; KS_ = 64; ldv_ = NTOK; } \
    else if (latent) { kbase_ = ckb + (size_t)(b * 256 + half_ * 128) * 512 + h * 64; vbase_ = cvT + (size_t)((b * 8 + h) * 64) * 256 + half_ * 128; KS_ = 32; ldv_ = 256; } \
    else { const int tb_ = seq * 256 + half_ * 128; kbase_ = kb + (size_t)tb_ * 512 + h * 64; vbase_ = vT + (size_t)(h * 64) * NTOK + tb_; KS_ = 32; ldv_ = NTOK; } } while (0)
#define KLOAD(kbase_, KS_) do { _Pragma("unroll") for (int i_ = 0; i_ < 8; ++i_) { \
      const bf16_t* kp_ = kbase_ + (size_t)((i_ >> 1) * KS_ + (fr >> 2) * 8 + (i_ & 1) * 4 + (fr & 3)) * 512 + fq * 8; \
      kf[2 * i_] = *(const bf16x8*)kp_; kf[2 * i_ + 1] = *(const bf16x8*)(kp_ + 32); } } while (0)
  bf16x8 kf[16];
#pragma unroll 1
  for (int sc = 0; sc < nsub; ++sc) {
    const int half = sc & 1;
    const bf16_t* kbase; const bf16_t* vbase; int KS, ldv; bool win;
    SUBDESC(sc, kbase, vbase, KS, ldv, win);
    KLOAD(kbase, KS);
    bf16x8 vf[4][4];
#pragma unroll
    for (int s = 0; s < 4; ++s)
#pragma unroll
      for (int dt = 0; dt < 4; ++dt) {
        vf[s][dt] = *(const bf16x8*)(vbase + (size_t)(dt * 16 + fr) * ldv + s * KS + fq * 8);
      }
    f32x4 st[8];
#pragma unroll
    for (int i = 0; i < 8; ++i) {
      f32x4 z = (f32x4){0.f, 0.f, 0.f, 0.f};
      z = __builtin_amdgcn_mfma_f32_16x16x32_bf16(kf[2 * i], qf0, z, 0, 0, 0);
      st[i] = __builtin_amdgcn_mfma_f32_16x16x32_bf16(kf[2 * i + 1], qf1, z, 0, 0, 0);
    }
    const bool cwin = win;
    if (cwin) {
      const int q_col = jb * 16 + fr;
      const int win_start = min(max(q_col - 8, 0), 48);
      const float* rpb = p.in[25] + h * 465;
#pragma unroll
      for (int i = 0; i < 8; ++i) {
        const int dr = row_start + half * 4 + (i >> 1) - r + 7;
#pragma unroll
        for (int e = 0; e < 4; ++e) {
          const int k_col = band + fq * 8 + (i & 1) * 4 + e;
          const bool valid = (k_col >= win_start) && (k_col < win_start + 16);
          const int dc = min(max(k_col - q_col, -15), 15) + 15;
          st[i][e] = valid ? st[i][e] + rpb[dr * 31 + dc] : -1e30f;
        }
      }
    }
    float cmax = -1e30f;
#pragma unroll
    for (int i = 0; i < 8; ++i)
#pragma unroll
      for (int e = 0; e < 4; ++e) cmax = fmaxf(cmax, st[i][e]);
    cmax = fmaxf(cmax, __shfl_xor(cmax, 16)); cmax = fmaxf(cmax, __shfl_xor(cmax, 32));
    const float mnew = fmaxf(m, cmax);
    const float alpha = __expf(m - mnew);
    float psum = 0.f;
#pragma unroll
    for (int i = 0; i < 8; ++i)
#pragma unroll
      for (int e = 0; e < 4; ++e) { const float pv = __expf(st[i][e] - mnew); st[i][e] = pv; psum += pv; }
    psum += __shfl_xor(psum, 16); psum += __shfl_xor(psum, 32);
    l = l * alpha + psum;
#pragma unroll
    for (int i = 0; i < 4; ++i) O[i] = O[i] * alpha;
    m = mnew;
#pragma unroll
    for (int s = 0; s < 4; ++s) {
      union { bf16x8 v; unsigned u[4]; } pb;
      pb.u[0] = pk2(st[2 * s][0], st[2 * s][1]); pb.u[1] = pk2(st[2 * s][2], st[2 * s][3]);
      pb.u[2] = pk2(st[2 * s + 1][0], st[2 * s + 1][1]); pb.u[3] = pk2(st[2 * s + 1][2], st[2 * s + 1][3]);
#pragma unroll
      for (int dt = 0; dt < 4; ++dt) {
        O[dt] = __builtin_amdgcn_mfma_f32_16x16x32_bf16(vf[s][dt], pb.v, O[dt], 0, 0, 0);
      }
    }
  }
#undef SUBDESC
#undef KLOAD
  const float inv = 1.f / l;
#pragma unroll
  for (int dt = 0; dt < 4; ++dt) {
    bf16_t* op = ona + (size_t)(tq0 + fr) * 512 + h * 64 + dt * 16 + fq * 4;
    *(uint2*)op = make_uint2(pk2(O[dt][0] * inv, O[dt][1] * inv), pk2(O[dt][2] * inv, O[dt][3] * inv));
  }
}

constexpr int N_SCAN_ITEMS = 128 + 256, N_ATTN_BLK = 768;
DEV void phase_scan_attn(const Params& p, unsigned char* smem, int* s_item, int rep) {
  unsigned* counter = (unsigned*)(p.ws + OFF_CTL) + rep;
  for (;;) {
    if (threadIdx.x == 0) *s_item = (int)atomicAdd(counter, 1u);
    __syncthreads();
    const int item = *s_item;
    __syncthreads();
    if (item >= N_SCAN_ITEMS + N_ATTN_BLK) break;
    if (item < 128) { const int rem = item & 63; scan_item<4, 1, 3>(p, smem, 16 + (item >> 6), rem >> 3, (rem >> 2) & 1, rem & 3); }
    else if (item >= N_SCAN_ITEMS) attn_wave_item(p, (item - N_SCAN_ITEMS) * 4 + (threadIdx.x >> 6));
    else { const int i2 = item - 128, rem = i2 & 15; scan_item<4, 4, 1>(p, smem, i2 >> 4, rem >> 1, rem & 1, 0); }
  }
}

DEV void phase_finalize_rw(const Params& p, int bid, int nb) {
  const int lane = threadIdx.x & 63, gw = bid * 4 + (threadIdx.x >> 6), nw = nb * 4;
  const float* yf = (const float*)(p.ws + OFF_YF);
  const float* yb = (const float*)(p.ws + OFF_YB);
  const bf16_t* bonus = (const bf16_t*)(p.ws + OFF_BG);
  const bf16_t* gate = (const bf16_t*)(p.ws + OFF_BG + 6291456);
  bf16_t* orw = (bf16_t*)(p.ws + OFF_ORW);
  const float4 g0 = *(const float4*)(p.in[21] + lane * 8), g1 = *(const float4*)(p.in[21] + lane * 8 + 4);
  const float4 b0 = *(const float4*)(p.in[22] + lane * 8), b1 = *(const float4*)(p.in[22] + lane * 8 + 4);
  const float gg[8] = {g0.x, g0.y, g0.z, g0.w, g1.x, g1.y, g1.z, g1.w};
  const float bb[8] = {b0.x, b0.y, b0.z, b0.w, b1.x, b1.y, b1.z, b1.w};
#pragma unroll 3
  for (int t = gw; t < NTOK; t += nw) {
    const size_t o = (size_t)t * 512 + lane * 8;
    const float4 a0 = *(const float4*)(yf + o), a1 = *(const float4*)(yf + o + 4);
    const float4 c0 = *(const float4*)(yb + o), c1 = *(const float4*)(yb + o + 4);
    const uint4 bo = *(const uint4*)(bonus + o), ga = *(const uint4*)(gate + o);
    float y[8] = {a0.x + c0.x, a0.y + c0.y, a0.z + c0.z, a0.w + c0.w, a1.x + c1.x, a1.y + c1.y, a1.z + c1.z, a1.w + c1.w};
    float s = 0.f;
#pragma unroll
    for (int i = 0; i < 8; ++i) s += y[i];
    s += dpp_mov<0xB1>(s); s += dpp_mov<0x4E>(s); s += dpp_mov<0x141>(s);
    const float mean = s * (1.f / 64.f);
    float q = 0.f;
#pragma unroll
    for (int i = 0; i < 8; ++i) { y[i] -= mean; q += y[i] * y[i]; }
    q += dpp_mov<0xB1>(q); q += dpp_mov<0x4E>(q); q += dpp_mov<0x141>(q);
    const float rstd = rsqrtf(q * (1.f / 64.f) + 64e-5f);
    const unsigned bu[4] = {bo.x, bo.y, bo.z, bo.w}, gu[4] = {ga.x, ga.y, ga.z, ga.w};
    unsigned w[4];
#pragma unroll
    for (int i = 0; i < 4; ++i) {
      const float lo = (y[2 * i] * rstd * gg[2 * i] + bb[2 * i] + __uint_as_float(bu[i] << 16)) * __uint_as_float(gu[i] << 16);
      const float hi = (y[2 * i + 1] * rstd * gg[2 * i + 1] + bb[2 * i + 1] + __uint_as_float(bu[i] & 0xffff0000u)) * __uint_as_float(gu[i] & 0xffff0000u);
      w[i] = pk2(lo, hi);
    }
    *(uint4*)(orw + o) = make_uint4(w[0], w[1], w[2], w[3]);
  }
}

#define XB_TMO      128
#define XB_XCNT(j)  (256  + 64 * (j))
#define XB_XSUB(j)  (1280 + 64 * (j))
#define XB_XGEN(j)  (2304 + 64 * (j))
#define XB_TOP      3328
#define XB_TOPGEN   3392
#define XCD_BAR_WORDS 3456
#define XB_SPIN_CAP (1u << 18)
#define LAS __attribute__((address_space(3)))
DEV unsigned xb_ld(unsigned* p)              { return __hip_atomic_load(p, __ATOMIC_RELAXED, __HIP_MEMORY_SCOPE_AGENT); }
DEV unsigned xb_add(unsigned* p, unsigned v) { return __hip_atomic_fetch_add(p, v, __ATOMIC_RELAXED, __HIP_MEMORY_SCOPE_AGENT); }
DEV unsigned xb_xcc_id() { return (unsigned)__builtin_amdgcn_s_getreg((3 << 11) | 20) & 0xFu; }
#define XB_SPIN(cond, bar) do { unsigned _sp = 0; while (cond) { __builtin_amdgcn_s_sleep(1); \
    if ((++_sp & 255u) == 0u) { if (xb_ld(&(bar)[XB_TMO])) break; if (_sp > XB_SPIN_CAP) { atomicAdd(&(bar)[XB_TMO], 1u); break; } } } } while (0)
struct XcdBarrier { unsigned* bar; unsigned x; volatile LAS unsigned* st; };
DEV XcdBarrier xcd_barrier_post(unsigned* bar, volatile LAS unsigned* st) {
  XcdBarrier b; b.bar = bar; b.x = xb_xcc_id(); b.st = st;
  if (threadIdx.x == 0) (void)xb_add(&bar[XB_XCNT(b.x)], 1u);
  return b;
}
DEV void xcd_barrier_complete(unsigned* bar, unsigned x, unsigned& nloc, unsigned& nx) {
  const unsigned G = gridDim.x * gridDim.y * gridDim.z;
  unsigned sum, cnt, mine, sp = 0u;
  for (;;) {
    sum = 0u; cnt = 0u; mine = 0u;
#pragma unroll
    for (unsigned j = 0; j < 16; ++j) { const unsigned c = xb_ld(&bar[XB_XCNT(j)]); sum += c; cnt += (c > 0u) ? 1u : 0u; mine = (j == x) ? c : mine; }
    if (sum == G) break;
    __builtin_amdgcn_s_sleep(1);
    if ((++sp & 255u) == 0u) { if (xb_ld(&bar[XB_TMO])) break; if (sp > XB_SPIN_CAP) { atomicAdd(&bar[XB_TMO], 1u); break; } }
  }
  nloc = mine > 0u ? mine : 1u; nx = cnt > 0u ? cnt : 1u;
}
DEV void xcd_barrier(const XcdBarrier& b) {
  asm volatile("s_waitcnt vmcnt(0)" ::: "memory");
  __syncthreads();
  if (threadIdx.x == 0) {
    unsigned* bar = b.bar;
    __builtin_amdgcn_s_waitcnt(0);
    unsigned nloc = b.st[0], nx = b.st[1];
    if (nloc == 0u) { xcd_barrier_complete(bar, b.x, nloc, nx); b.st[0] = nloc; b.st[1] = nx; }
    const unsigned old = xb_add(&bar[XB_XSUB(b.x)], 1u);
    const unsigned gen = old / nloc;
    if (old + 1u == (gen + 1u) * nloc) {
      __builtin_amdgcn_fence(__ATOMIC_RELEASE, "agent");
      asm volatile("s_waitcnt vmcnt(0)" ::: "memory");
      const unsigned og = xb_add(&bar[XB_TOP], 1u);
      const unsigned tg = og / nx;
      if (og + 1u == (tg + 1u) * nx) xb_add(&bar[XB_TOPGEN], 1u);
      else XB_SPIN(xb_ld(&bar[XB_TOPGEN]) == tg, bar);
      __builtin_amdgcn_fence(__ATOMIC_ACQUIRE, "agent");
      xb_add(&bar[XB_XGEN(b.x)], 1u);
      asm volatile("s_waitcnt vmcnt(0)" ::: "memory");
    } else {
      XB_SPIN(xb_ld(&bar[XB_XGEN(b.x)]) == gen, bar);
      __builtin_amdgcn_fence(__ATOMIC_ACQUIRE, "agent");
      asm volatile("s_waitcnt vmcnt(0)" ::: "memory");
    }
  }
  __syncthreads();
}

__global__ void __launch_bounds__(NTHR, 2) fwd_megakernel(Params p) {
  extern __shared__ __attribute__((aligned(16))) unsigned char smem[];
  __shared__ __attribute__((aligned(16))) unsigned sh_ctl[8];
  cg::grid_group grid = cg::this_grid();
  const int bid = blockIdx.x, nb = gridDim.x;
  if (threadIdx.x < 8) sh_ctl[threadIdx.x] = 0u;
  __syncthreads();
  const XcdBarrier xb = xcd_barrier_post((unsigned*)(p.ws + OFF_CTL), (volatile LAS unsigned*)sh_ctl);
  int* s_item_p = (int*)&sh_ctl[4];
  if (p.ph_hi > 1000) grid.sync();
#define GSYNC() xcd_barrier(xb)
#ifndef DUP
#define DUP -1
#endif
#define PH(n, body) if (p.ph_lo <= n && n < p.ph_hi) { { const int rep = 0; (void)rep; body; } if (DUP == n) { GSYNC(); const int rep = 1; (void)rep; body; } if (n + 1 < p.ph_hi) GSYNC(); }
  PH(0, phase0(p, smem, bid, nb, rep))
  PH(1, phase_normmod<0>(p, bid, nb))
  PH(2, reset_tiles(s_item_p); phase_gemm_in(p, smem, s_item_p))
  PH(3, phase_prep(p, smem, s_item_p, rep))
  PH(4, phase_scan_attn(p, smem, s_item_p, rep))
  PH(5, phase_finalize_rw(p, bid, nb))
  PH(6, reset_tiles(s_item_p); phase_gemm_merge(p, smem, s_item_p))
  PH(7, reset_tiles(s_item_p); phase_gemm_out(p, smem, s_item_p))
  PH(8, phase_normmod<1>(p, bid, nb))
  PH(9, reset_tiles(s_item_p); phase_gemm_ffn_up(p, smem, s_item_p))
  PH(10, reset_tiles(s_item_p); phase_gemm_ffn_down(p, smem, s_item_p))
}

extern "C" void kernel_launch(void* const* d_in, const int* in_sizes, int n_in, void* d_out, int out_size, void* d_ws, size_t ws_size,
                              hipStream_t stream) {
  static int grid_blocks = 0;
  if (grid_blocks == 0) {
    if (n_in != 32 || ws_size < WS_END) { fprintf(stderr, "kernel_launch: unexpected n_in %d / ws_size %zu (need %zu)\n", n_in, ws_size, (size_t)WS_END); grid_blocks = -1; return; }
    int dev = 0, cus = 0, per_cu = 0;
    hipGetDevice(&dev);
    hipDeviceGetAttribute(&cus, hipDeviceAttributeMultiprocessorCount, dev);
    if (hipFuncSetAttribute((const void*)fwd_megakernel, hipFuncAttributeMaxDynamicSharedMemorySize, LDS_BYTES) != hipSuccess) { fprintf(stderr, "hipFuncSetAttribute failed\n"); grid_blocks = -1; return; }
    if (hipOccupancyMaxActiveBlocksPerMultiprocessor(&per_cu, (const void*)fwd_megakernel, NTHR, LDS_BYTES) != hipSuccess || per_cu < 1) { fprintf(stderr, "occupancy query failed (%d)\n", per_cu); grid_blocks = -1; return; }
    if (per_cu > 2) per_cu = 2;
    grid_blocks = cus * per_cu;
    fprintf(stderr, "kernel_launch: cus %d per_cu %d grid %d\n", cus, per_cu, grid_blocks);
  }
  if (grid_blocks < 0) return;
  hipMemsetAsync((char*)d_ws + OFF_CTL, 0, CTL_ZERO_BYTES, stream);
  Params p{};
  for (int i = 0; i < 32; ++i) p.in[i] = (const float*)d_in[i];
  p.out = (float*)d_out; p.ws = (unsigned char*)d_ws; p.ph_lo = 0; p.ph_hi = 11;
  void* args[] = {&p};
  hipError_t e = hipLaunchCooperativeKernel((const void*)fwd_megakernel, dim3(grid_blocks), dim3(NTHR), args, LDS_BYTES, stream);
  if (e != hipSuccess) fprintf(stderr, "cooperative launch failed: %s (grid %d)\n", hipGetErrorString(e), grid_blocks);
}
```

```cpp
#include <hip/hip_runtime.h>
#include <hip/hip_cooperative_groups.h>
#include <cstdio>
#include <cstdint>
namespace cg = cooperative_groups;

#define DEV __device__ __forceinline__
typedef unsigned short bf16_t;
typedef short bf16x8 __attribute__((ext_vector_type(8)));
typedef short bf16x4 __attribute__((ext_vector_type(4)));
typedef float f32x4 __attribute__((ext_vector_type(4)));

constexpr int D = 1024, NTOK = 6144, NCTX = 4096, RW = 512, FF = 2816, INC = 5504, RWC = 1920;
constexpr int NTHR = 256;
constexpr int LDS_BYTES = 65536;

constexpr size_t OFF_CTL = 0;
constexpr size_t OFF_MOD = 16384;
constexpr size_t CTL_ZERO_BYTES = 16384 + 3 * 6144 * 4;
constexpr size_t OFF_WIN = 90112;
constexpr size_t OFF_WORW = OFF_WIN + 11272192;
constexpr size_t OFF_WONA = OFF_WORW + 1048576;
constexpr size_t OFF_WOUT = OFF_WONA + 1048576;
constexpr size_t OFF_W13 = OFF_WOUT + 2097152;
constexpr size_t OFF_W2 = OFF_W13 + 11534336;
constexpr size_t OFF_H = OFF_W2 + 5767168;
constexpr size_t OFF_URW = OFF_H + 12582912;
constexpr size_t OFF_UNA = OFF_URW + 47185920;
constexpr size_t OFF_OPS = OFF_UNA + 37748736;
constexpr size_t OPS_ARR = 12582912;
constexpr size_t OFF_BG = OFF_OPS + 9 * OPS_ARR;
constexpr size_t OFF_VT = OFF_BG + 12582912;
constexpr size_t OFF_CKB = OFF_VT + 6291456;
constexpr size_t OFF_CVT = OFF_CKB + 524288;
constexpr size_t OFF_LORA = OFF_CVT + 524288;
constexpr size_t WS_END = OFF_LORA + 393216;
constexpr size_t OFF_QB = OFF_UNA + 12582912, OFF_KB = OFF_UNA + 18874368;
constexpr size_t OFF_YF = OFF_URW, OFF_YB = OFF_URW + 12582912;
constexpr size_t OFF_ORW = OFF_UNA, OFF_ONA = OFF_UNA + 6291456;
constexpr size_t OFF_MERGED = OFF_OPS;
constexpr size_t OFF_HID = OFF_URW;
constexpr size_t OUT_STATE = 6291456, OUT_K = 7340032, OUT_V = 9437184;

struct Params {
  const float* in[32];
  float* out;
  unsigned char* ws;
  int ph_lo, ph_hi;
};

DEV unsigned short f2bf(float f) { unsigned u = __float_as_uint(f); u += 0x7fffu + ((u >> 16) & 1u); return (unsigned short)(u >> 16); }
DEV unsigned pk2(float lo, float hi) { return (unsigned)f2bf(lo) | ((unsigned)f2bf(hi) << 16); }
DEV float bf2f(unsigned short b) { return __uint_as_float(((unsigned)b) << 16); }
DEV float sigmoidf_(float x) { return 1.f / (1.f + __expf(-x)); }
DEV float wave_sum(float x) {
#pragma unroll
  for (int o = 32; o > 0; o >>= 1) x += __shfl_xor(x, o);
  return x;
}
template <int CTRL> DEV float dpp_mov(float x) { return __int_as_float(__builtin_amdgcn_update_dpp(0, __float_as_int(x), CTRL, 0xf, 0xf, true)); }
DEV float row16_sum(float x) {
  x += dpp_mov<0xB1>(x); x += dpp_mov<0x4E>(x); x += dpp_mov<0x141>(x); x += dpp_mov<0x140>(x);
  return x;
}
#define BAR_LDS() do { asm volatile("s_waitcnt lgkmcnt(0)" ::: "memory"); __builtin_amdgcn_s_barrier(); asm volatile("" ::: "memory"); } while (0)
DEV float4 ldnt4(const float* p_) { const f32x4 t_ = __builtin_nontemporal_load((const f32x4*)p_); return make_float4(t_[0], t_[1], t_[2], t_[3]); }
DEV const float* xrow(const Params& p, int t) { return t < NCTX ? p.in[0] + (size_t)t * D : p.in[1] + (size_t)(t - NCTX) * D; }
DEV int modidx(int t) { return t < NCTX ? 0 : 1 + ((t - NCTX) >> 10); }

DEV void conv_job(const Params& p, int j, const float*& src, bf16_t*& dst, int& K, int& N, int& mode, int& base) {
  if (j < 1376) { src = p.in[11]; dst = (bf16_t*)(p.ws + OFF_WIN); K = 1024; N = 5504; mode = 0; base = 0; }
  else if (j < 1504) { src = p.in[26]; dst = (bf16_t*)(p.ws + OFF_WORW); K = 512; N = 1024; mode = 0; base = 1376; }
  else if (j < 1632) { src = p.in[27]; dst = (bf16_t*)(p.ws + OFF_WONA); K = 512; N = 1024; mode = 0; base = 1504; }
  else if (j < 1888) { src = p.in[28]; dst = (bf16_t*)(p.ws + OFF_WOUT); K = 1024; N = 1024; mode = 0; base = 1632; }
  else if (j < 2592) { src = p.in[29]; dst = (bf16_t*)(p.ws + OFF_W13); K = 1024; N = 2816; mode = 1; base = 1888; }
  else if (j < 3296) { src = p.in[30]; dst = (bf16_t*)(p.ws + OFF_W13); K = 1024; N = 2816; mode = 2; base = 2592; }
  else if (j < 4000) { src = p.in[31]; dst = (bf16_t*)(p.ws + OFF_W2); K = 2816; N = 1024; mode = 0; base = 3296; }
  else if (j < 4016) { const int e = (j - 4000) >> 3; src = p.in[14] + e * 32768; dst = (bf16_t*)(p.ws + OFF_LORA) + e * 32768; K = 64; N = 512; mode = 0; base = 4000 + e * 8; }
  else if (j < 4032) { const int e = (j - 4016) >> 3; src = p.in[16] + e * 32768; dst = (bf16_t*)(p.ws + OFF_LORA) + 65536 + e * 32768; K = 64; N = 512; mode = 0; base = 4016 + e * 8; }
  else { src = p.in[17]; dst = (bf16_t*)(p.ws + OFF_LORA) + 131072; K = 128; N = 512; mode = 0; base = 4032; }
}
constexpr int N_CONV_TILES = 4048, N_MOD_TILES = 768;

DEV void phase0(const Params& p, unsigned char* smem, int bid, int nb, int rep) {
  const int tid = threadIdx.x;
  float* T = (float*)smem;
  for (int tile = bid; tile < N_MOD_TILES && rep == 0; tile += nb) {
    const int cgp = tile % 24, kc = tile / 24;
    if (tid < 96) {
      const int m = tid >> 5, kk = tid & 31, k = kc * 32 + kk;
      const float c = (m == 0) ? p.in[6][k] : p.in[5][(m - 1) * D + k];
      T[tid] = c * sigmoidf_(c);
    }
    __syncthreads();
    const int col = cgp * 256 + tid;
    const float* w = p.in[9] + (size_t)(kc * 32) * 6144 + col;
    float a0 = 0.f, a1 = 0.f, a2 = 0.f;
#pragma unroll
    for (int kk = 0; kk < 32; ++kk) {
      const float wv = __builtin_nontemporal_load(w + (size_t)kk * 6144);
      a0 += T[kk] * wv; a1 += T[32 + kk] * wv; a2 += T[64 + kk] * wv;
    }
    if (kc == 0) { const float b = p.in[10][col]; a0 += b; a1 += b; a2 += b; }
    float* mod = (float*)(p.ws + OFF_MOD);
    atomicAdd(mod + col, a0); atomicAdd(mod + 6144 + col, a1); atomicAdd(mod + 12288 + col, a2);
    __syncthreads();
  }
  const int r_ = tid >> 4, c4_ = tid & 15;
  float4 v[4];
  const float* src; bf16_t* dst; int K, N, mode, base;
  int tile = bid;
  if (tile < N_CONV_TILES) {
    conv_job(p, tile, src, dst, K, N, mode, base);
    const int lt = tile - base, nN = N >> 6, k0 = (lt / nN) * 64, n0 = (lt % nN) * 64;
#pragma unroll
    for (int i = 0; i < 4; ++i) { const f32x4 t_ = __builtin_nontemporal_load((const f32x4*)(src + (size_t)(k0 + r_ + 16 * i) * N + n0 + c4_ * 4)); v[i] = make_float4(t_[0], t_[1], t_[2], t_[3]); }
  }
  while (tile < N_CONV_TILES) {
    const int lt = tile - base, nN = N >> 6, k0 = (lt / nN) * 64, n0 = (lt % nN) * 64;
    bf16_t* cdst = dst; const int cK = K, cmode = mode;
#pragma unroll
    for (int i = 0; i < 4; ++i) {
      float* tp = T + (r_ + 16 * i) * 65 + c4_ * 4;
      tp[0] = v[i].x; tp[1] = v[i].y; tp[2] = v[i].z; tp[3] = v[i].w;
    }
    BAR_LDS();
    tile += nb;
    if (tile < N_CONV_TILES) {
      conv_job(p, tile, src, dst, K, N, mode, base);
      const int lt2 = tile - base, nN2 = N >> 6, k2 = (lt2 / nN2) * 64, n2 = (lt2 % nN2) * 64;
#pragma unroll
      for (int i = 0; i < 4; ++i) { const f32x4 t_ = __builtin_nontemporal_load((const f32x4*)(src + (size_t)(k2 + r_ + 16 * i) * N + n2 + c4_ * 4)); v[i] = make_float4(t_[0], t_[1], t_[2], t_[3]); }
    }
    const int n = tid >> 2, kp = tid & 3;
    unsigned w[8];
#pragma unroll
    for (int i = 0; i < 8; ++i) w[i] = pk2(T[(kp * 16 + 2 * i) * 65 + n], T[(kp * 16 + 2 * i + 1) * 65 + n]);
    const int ng = n0 + n;
    int drow = ng;
    if (cmode == 1) drow = (ng >> 4) * 32 + (ng & 15);
    else if (cmode == 2) drow = (ng >> 4) * 32 + 16 + (ng & 15);
    uint4* dp = (uint4*)(cdst + (size_t)drow * cK + k0 + kp * 16);
    dp[0] = make_uint4(w[0], w[1], w[2], w[3]);
    dp[1] = make_uint4(w[4], w[5], w[6], w[7]);
    BAR_LDS();
  }
}

template <int WHICH>
DEV void phase_normmod(const Params& p, int bid, int nb) {
  const int lane = threadIdx.x & 63, gw = bid * 4 + (threadIdx.x >> 6), nw = nb * 4;
  const float* g = WHICH == 0 ? p.in[7] : p.in[8];
  const float* mod = (const float*)(p.ws + OFF_MOD);
  const int sh_off = WHICH == 0 ? 0 : 3072, sc_off = WHICH == 0 ? 1024 : 4096;
  bf16_t* dst = (bf16_t*)(p.ws + OFF_H);
#pragma unroll 3
  for (int t = gw; t < NTOK; t += nw) {
    const float* xp = WHICH == 0 ? xrow(p, t) : p.out + (size_t)t * D;
    const float* mm = mod + modidx(t) * 6144;
    float4 v[4];
    float ss = 0.f;
#pragma unroll
    for (int i = 0; i < 4; ++i) {
      v[i] = ldnt4(xp + (i * 64 + lane) * 4);
      ss += v[i].x * v[i].x + v[i].y * v[i].y + v[i].z * v[i].z + v[i].w * v[i].w;
    }
    ss = wave_sum(ss);
    const float rstd = rsqrtf(ss * (1.f / 1024.f) + 1e-6f);
#pragma unroll
    for (int i = 0; i < 4; ++i) {
      const int col = (i * 64 + lane) * 4;
      const float4 g4 = *(const float4*)(g + col);
      const float4 sc = *(const float4*)(mm + sc_off + col);
      const float4 sh = *(const float4*)(mm + sh_off + col);
      const float y0 = v[i].x * rstd * g4.x * (1.f + sc.x) + sh.x;
      const float y1 = v[i].y * rstd * g4.y * (1.f + sc.y) + sh.y;
      const float y2 = v[i].z * rstd * g4.z * (1.f + sc.z) + sh.z;
      const float y3 = v[i].w * rstd * g4.w * (1.f + sc.w) + sh.w;
      *(uint2*)(dst + (size_t)t * D + col) = make_uint2(pk2(y0, y1), pk2(y2, y3));
    }
  }
}

template <int MI>
DEV void gemm_tile_acc(f32x4 (&acc)[MI][4], const bf16_t* __restrict__ A, int lda, const bf16_t* __restrict__ Bt, int ldb,
                       int m0, int n0, int K, unsigned char* smem) {
  constexpr int AT = 2 * MI * 16 * 128, BT = 16384, STG = AT + BT;
  const int tid = threadIdx.x, lane = tid & 63, wid = tid >> 6, wr = wid >> 1, wc = wid & 1, fr = lane & 15, fq = lane >> 4;
  const int gkc = (tid & 7) ^ ((tid >> 4) & 7);
  const bf16_t* ga = A + (size_t)(m0 + (tid >> 3)) * lda + gkc * 8;
  const bf16_t* gb = Bt + (size_t)(n0 + (tid >> 3)) * ldb + gkc * 8;
  const int swz = (fr >> 1) & 7;
  const int nk = K >> 6;
#define GLDS_TILE(kt_, buf_) do { unsigned char* sb_ = smem + (buf_) * STG; const int k0_ = (kt_) * 64; \
    _Pragma("unroll") for (int i_ = 0; i_ < (2 * MI * 16) / 32; ++i_) \
      __builtin_amdgcn_global_load_lds((const unsigned*)(ga + (size_t)i_ * 32 * lda + k0_), (__attribute__((address_space(3))) unsigned*)(sb_ + (i_ * 256 + tid) * 16), 16, 0, 0); \
    _Pragma("unroll") for (int i_ = 0; i_ < 4; ++i_) \
      __builtin_amdgcn_global_load_lds((const unsigned*)(gb + (size_t)i_ * 32 * ldb + k0_), (__attribute__((address_space(3))) unsigned*)(sb_ + AT + (i_ * 256 + tid) * 16), 16, 0, 0); \
  } while (0)
  GLDS_TILE(0, 0);
  asm volatile("s_waitcnt vmcnt(0)" ::: "memory");
  __syncthreads();
  for (int kt = 0; kt < nk; ++kt) {
    if (kt + 1 < nk) GLDS_TILE(kt + 1, (kt + 1) & 1);
    const unsigned char* cur = smem + (kt & 1) * STG;
#pragma unroll
    for (int ks = 0; ks < 2; ++ks) {
      bf16x8 af[MI], bf[4];
      const int co = ((ks * 4 + fq) ^ swz) << 4;
#pragma unroll
      for (int mi = 0; mi < MI; ++mi) af[mi] = *(const bf16x8*)(cur + (wr * MI * 16 + mi * 16 + fr) * 128 + co);
#pragma unroll
      for (int ni = 0; ni < 4; ++ni) bf[ni] = *(const bf16x8*)(cur + AT + (wc * 64 + ni * 16 + fr) * 128 + co);
      __builtin_amdgcn_s_setprio(1);
#pragma unroll
      for (int mi = 0; mi < MI; ++mi)
#pragma unroll
        for (int ni = 0; ni < 4; ++ni) acc[mi][ni] = __builtin_amdgcn_mfma_f32_16x16x32_bf16(bf[ni], af[mi], acc[mi][ni], 0, 0, 0);
      __builtin_amdgcn_s_setprio(0);
    }
    asm volatile("s_waitcnt vmcnt(0)" ::: "memory");
    __syncthreads();
  }
#undef GLDS_TILE
}

template <int MI>
DEV void zero_acc(f32x4 (&acc)[MI][4]) {
#pragma unroll
  for (int i = 0; i < MI; ++i)
#pragma unroll
    for (int j = 0; j < 4; ++j) acc[i][j] = (f32x4){0.f, 0.f, 0.f, 0.f};
}

#ifndef DYN_TILES
#define DYN_TILES 0
#endif
DEV int grab_tile(const Params& p, int word, int* slot) {
#if DYN_TILES
  if (threadIdx.x == 0) *slot = (int)atomicAdd((unsigned*)(p.ws + OFF_CTL) + word, 1u);
  __syncthreads();
  const int t = *slot;
  __syncthreads();
  return t;
#else
  const int t = slot[1];
  __syncthreads();
  if (threadIdx.x == 0) slot[1] = t + gridDim.x;
  __syncthreads();
  return t;
#endif
}
DEV void reset_tiles(int* slot) { if (threadIdx.x == 0) slot[1] = blockIdx.x; __syncthreads(); }

#define EPI_COORDS const int lane = threadIdx.x & 63, wid = threadIdx.x >> 6, wr = wid >> 1, wc = wid & 1, fr = lane & 15, fq = lane >> 4

DEV void phase_gemm_in(const Params& p, unsigned char* smem, int* slot) {
  EPI_COORDS;
  const bf16_t* A = (const bf16_t*)(p.ws + OFF_H);
  const bf16_t* Bt = (const bf16_t*)(p.ws + OFF_WIN);
  float* urw = (float*)(p.ws + OFF_URW);
  float* una = (float*)(p.ws + OFF_UNA);
  bf16_t* gates = (bf16_t*)p.out;
  for (;;) {
    const int tile = grab_tile(p, 8, slot);
    if (tile >= 48 * 43) break;
    const int tm = tile % 48, tn = tile / 48, m0 = tm * 128, n0 = tn * 128;
    f32x4 acc[4][4];
    zero_acc<4>(acc);
    gemm_tile_acc<4>(acc, A, D, Bt, D, m0, n0, D, smem);
    if (n0 >= 1920 && n0 < 3456) {
      const int sec = (n0 - 1920) >> 9;
      const int h = (((n0 - 1920) & 511) >> 6) + wc;
      bf16_t* qb = (bf16_t*)(p.ws + OFF_QB); bf16_t* kb = (bf16_t*)(p.ws + OFF_KB); bf16_t* vT = (bf16_t*)(p.ws + OFF_VT);
#pragma unroll
      for (int mi = 0; mi < 4; ++mi) {
        const int row = m0 + wr * 64 + mi * 16 + fr;
        if (sec < 2) {
          float ss = 0.f;
#pragma unroll
          for (int ni = 0; ni < 4; ++ni) { const f32x4 v = acc[mi][ni]; ss += v[0] * v[0] + v[1] * v[1] + v[2] * v[2] + v[3] * v[3]; }
          ss += __shfl_xor(ss, 16); ss += __shfl_xor(ss, 32);
          const float rs = rsqrtf(ss * (1.f / 64.f) + 1e-6f) * (sec == 0 ? 0.125f : 1.f);
          const float* gv = sec == 0 ? p.in[23] : p.in[24];
          bf16_t* dstb = (sec == 0 ? qb : kb) + (size_t)row * 512 + h * 64;
#pragma unroll
          for (int ni = 0; ni < 4; ++ni) {
            const int d = ni * 16 + fq * 4;
            const f32x4 x = acc[mi][ni] * rs * (*(const f32x4*)(gv + d));
            *(uint2*)(dstb + d) = make_uint2(pk2(x[0], x[1]), pk2(x[2], x[3]));
            if (sec == 1 && row < NCTX) __builtin_nontemporal_store(x, (f32x4*)(p.out + OUT_K + (size_t)row * 512 + h * 64 + d));
          }
        } else {
#pragma unroll
          for (int ni = 0; ni < 4; ++ni) {
            const int d = ni * 16 + fq * 4;
            const f32x4 x = acc[mi][ni];
            if (row < NCTX) __builtin_nontemporal_store(x, (f32x4*)(p.out + OUT_V + (size_t)row * 512 + h * 64 + d));
#pragma unroll
            for (int e2 = 0; e2 < 4; ++e2) *(bf16_t*)(smem + (wc * 64 + d + e2) * 272 + (wr * 64 + mi * 16 + fr) * 2) = f2bf(x[e2]);
          }
        }
      }
      if (sec == 2) {
        __syncthreads();
        const int dd = threadIdx.x >> 1, hf = threadIdx.x & 1;
        const int hb = ((n0 - 1920) & 511) >> 6;
        bf16_t* vrow = vT + (size_t)(hb * 64 + dd) * NTOK + m0 + hf * 64;
#pragma unroll
        for (int j = 0; j < 8; ++j) *(uint4*)(vrow + j * 8) = *(const uint4*)(smem + dd * 272 + hf * 128 + j * 16);
        __syncthreads();
      }
    } else {
#pragma unroll
      for (int mi = 0; mi < 4; ++mi) {
        const int row = m0 + wr * 64 + mi * 16 + fr;
#pragma unroll
        for (int ni = 0; ni < 4; ++ni) {
          const int col = n0 + wc * 64 + ni * 16 + fq * 4;
          const f32x4 v = acc[mi][ni];
          if (n0 < 1920) *(f32x4*)(urw + (size_t)row * 1920 + col) = v;
          else *(uint2*)(gates + (size_t)row * 2048 + (col - 3456)) = make_uint2(pk2(sigmoidf_(v[0]), sigmoidf_(v[1])), pk2(sigmoidf_(v[2]), sigmoidf_(v[3])));
        }
      }
    }
  }
}

DEV void phase_gemm_merge(const Params& p, unsigned char* smem, int* slot) {
  EPI_COORDS;
  const bf16_t* orw = (const bf16_t*)(p.ws + OFF_ORW);
  const bf16_t* ona = (const bf16_t*)(p.ws + OFF_ONA);
  const bf16_t* w1 = (const bf16_t*)(p.ws + OFF_WORW);
  const bf16_t* w2 = (const bf16_t*)(p.ws + OFF_WONA);
  const bf16_t* gates = (const bf16_t*)p.out;
  bf16_t* merged = (bf16_t*)(p.ws + OFF_MERGED);
  float* mtmp = (float*)(p.ws + OFF_MERGED + 16777216);
  for (;;) {
    const int tile = grab_tile(p, 9, slot);
    if (tile >= 64 * 8) break;
    const int tm = tile % 64, tn = tile / 64, m0 = tm * 96, n0 = tn * 128;
    f32x4 acc[3][4];
    zero_acc<3>(acc);
    gemm_tile_acc<3>(acc, orw, RW, w1, RW, m0, n0, RW, smem);
#pragma unroll
    for (int mi = 0; mi < 3; ++mi) {
      const int row = m0 + wr * 48 + mi * 16 + fr;
#pragma unroll
      for (int ni = 0; ni < 4; ++ni) {
        const int col = n0 + wc * 64 + ni * 16 + fq * 4;
        const uint2 g = *(const uint2*)(gates + (size_t)row * 2048 + col);
        f32x4 r;
        r[0] = acc[mi][ni][0] * bf2f((unsigned short)(g.x & 0xffff));
        r[1] = acc[mi][ni][1] * bf2f((unsigned short)(g.x >> 16));
        r[2] = acc[mi][ni][2] * bf2f((unsigned short)(g.y & 0xffff));
        r[3] = acc[mi][ni][3] * bf2f((unsigned short)(g.y >> 16));
        *(f32x4*)(mtmp + (size_t)row * D + col) = r;
      }
    }
    zero_acc<3>(acc);
    gemm_tile_acc<3>(acc, ona, RW, w2, RW, m0, n0, RW, smem);
#pragma unroll
    for (int mi = 0; mi < 3; ++mi) {
      const int row = m0 + wr * 48 + mi * 16 + fr;
#pragma unroll
      for (int ni = 0; ni < 4; ++ni) {
        const int col = n0 + wc * 64 + ni * 16 + fq * 4;
        const uint2 g = *(const uint2*)(gates + (size_t)row * 2048 + 1024 + col);
        const f32x4 mg = *(const f32x4*)(mtmp + (size_t)row * D + col);
        const float r0 = mg[0] + acc[mi][ni][0] * bf2f((unsigned short)(g.x & 0xffff));
        const float r1 = mg[1] + acc[mi][ni][1] * bf2f((unsigned short)(g.x >> 16));
        const float r2 = mg[2] + acc[mi][ni][2] * bf2f((unsigned short)(g.y & 0xffff));
        const float r3 = mg[3] + acc[mi][ni][3] * bf2f((unsigned short)(g.y >> 16));
        *(uint2*)(merged + (size_t)row * D + col) = make_uint2(pk2(r0, r1), pk2(r2, r3));
      }
    }
  }
}

DEV void phase_gemm_out(const Params& p, unsigned char* smem, int* slot) {
  EPI_COORDS;
  const bf16_t* A = (const bf16_t*)(p.ws + OFF_MERGED);
  const bf16_t* Bt = (const bf16_t*)(p.ws + OFF_WOUT);
  const float* mod = (const float*)(p.ws + OFF_MOD);
  for (;;) {
    const int tile = grab_tile(p, 10, slot);
    if (tile >= 64 * 8) break;
    const int tm = tile % 64, tn = tile / 64, m0 = tm * 96, n0 = tn * 128;
    f32x4 acc[3][4];
    zero_acc<3>(acc);
    gemm_tile_acc<3>(acc, A, D, Bt, D, m0, n0, D, smem);
#pragma unroll
    for (int mi = 0; mi < 3; ++mi) {
      const int row = m0 + wr * 48 + mi * 16 + fr;
      const float* xp = xrow(p, row);
      const float* g1 = mod + modidx(row) * 6144 + 2048;
#pragma unroll
      for (int ni = 0; ni < 4; ++ni) {
        const int col = n0 + wc * 64 + ni * 16 + fq * 4;
        const f32x4 x = __builtin_nontemporal_load((const f32x4*)(xp + col));
        const f32x4 g = *(const f32x4*)(g1 + col);
        *(f32x4*)(p.out + (size_t)row * D + col) = x + g * acc[mi][ni];
      }
    }
  }
}

DEV void phase_gemm_ffn_up(const Params& p, unsigned char* smem, int* slot) {
  EPI_COORDS;
  const bf16_t* A = (const bf16_t*)(p.ws + OFF_H);
  const bf16_t* Bt = (const bf16_t*)(p.ws + OFF_W13);
  bf16_t* hid = (bf16_t*)(p.ws + OFF_HID);
  for (;;) {
    const int tile = grab_tile(p, 11, slot);
    if (tile >= 48 * 44) break;
    const int tm = tile % 48, tn = tile / 48, m0 = tm * 128, n0 = tn * 128;
    f32x4 acc[4][4];
    zero_acc<4>(acc);
    gemm_tile_acc<4>(acc, A, D, Bt, D, m0, n0, D, smem);
#pragma unroll
    for (int mi = 0; mi < 4; ++mi) {
      const int row = m0 + wr * 64 + mi * 16 + fr;
#pragma unroll
      for (int gp = 0; gp < 2; ++gp) {
        const int hcol = ((n0 + wc * 64) >> 1) + gp * 16 + fq * 4;
        const f32x4 a = acc[mi][2 * gp], b = acc[mi][2 * gp + 1];
        float r[4];
#pragma unroll
        for (int e = 0; e < 4; ++e) r[e] = a[e] * sigmoidf_(a[e]) * b[e];
        *(uint2*)(hid + (size_t)row * FF + hcol) = make_uint2(pk2(r[0], r[1]), pk2(r[2], r[3]));
      }
    }
  }
}

DEV void phase_gemm_ffn_down(const Params& p, unsigned char* smem, int* slot) {
  EPI_COORDS;
  const bf16_t* A = (const bf16_t*)(p.ws + OFF_HID);
  const bf16_t* Bt = (const bf16_t*)(p.ws + OFF_W2);
  const float* mod = (const float*)(p.ws + OFF_MOD);
  for (;;) {
    const int tile = grab_tile(p, 12, slot);
    if (tile >= 64 * 8) break;
    const int tm = tile % 64, tn = tile / 64, m0 = tm * 96, n0 = tn * 128;
    f32x4 acc[3][4];
    zero_acc<3>(acc);
    gemm_tile_acc<3>(acc, A, FF, Bt, FF, m0, n0, FF, smem);
#pragma unroll
    for (int mi = 0; mi < 3; ++mi) {
      const int row = m0 + wr * 48 + mi * 16 + fr;
      const float* g2 = mod + modidx(row) * 6144 + 5120;
#pragma unroll
      for (int ni = 0; ni < 4; ++ni) {
        const int col = n0 + wc * 64 + ni * 16 + fq * 4;
        float* op = p.out + (size_t)row * D + col;
        const f32x4 x = __builtin_nontemporal_load((const f32x4*)op);
        const f32x4 g = *(const f32x4*)(g2 + col);
        __builtin_nontemporal_store(x + g * acc[mi][ni], (f32x4*)op);
      }
    }
  }
}

DEV void phase_qkprep(const Params& p, unsigned char* smem, int item_) {
  const int tid = threadIdx.x;
  bf16_t* Vs = (bf16_t*)smem;
  bf16_t* qb = (bf16_t*)(p.ws + OFF_QB);
  bf16_t* kb = (bf16_t*)(p.ws + OFF_KB);
  bf16_t* vT = (bf16_t*)(p.ws + OFF_VT);
  bf16_t* ckb = (bf16_t*)(p.ws + OFF_CKB);
  bf16_t* cvT = (bf16_t*)(p.ws + OFF_CVT);
  const float* una = (const float*)(p.ws + OFF_UNA);
  const int tok = tid >> 2, part = tid & 3;
  for (int item = item_; item < item_ + 1; ++item) {
    if (item < 768) {
      const int tt = item >> 3, h = item & 7, t0 = tt * 64, t = t0 + tok;
      const float* src = una + (size_t)t * 1536 + h * 64 + part * 16;
      {
        float x[16]; float ss = 0.f;
#pragma unroll
        for (int i = 0; i < 4; ++i) { const float4 v = *(const float4*)(src + i * 4); x[4 * i] = v.x; x[4 * i + 1] = v.y; x[4 * i + 2] = v.z; x[4 * i + 3] = v.w; }
#pragma unroll
        for (int i = 0; i < 16; ++i) ss += x[i] * x[i];
        ss += __shfl_xor(ss, 1); ss += __shfl_xor(ss, 2);
        const float rs = rsqrtf(ss * (1.f / 64.f) + 1e-6f) * 0.125f;
        unsigned w[8];
#pragma unroll
        for (int i = 0; i < 8; ++i) w[i] = pk2(x[2 * i] * rs * p.in[23][part * 16 + 2 * i], x[2 * i + 1] * rs * p.in[23][part * 16 + 2 * i + 1]);
        uint4* dp = (uint4*)(qb + (size_t)t * 512 + h * 64 + part * 16);
        dp[0] = make_uint4(w[0], w[1], w[2], w[3]); dp[1] = make_uint4(w[4], w[5], w[6], w[7]);
      }
      {
        float x[16]; float ss = 0.f;
#pragma unroll
        for (int i = 0; i < 4; ++i) { const float4 v = *(const float4*)(src + 512 + i * 4); x[4 * i] = v.x; x[4 * i + 1] = v.y; x[4 * i + 2] = v.z; x[4 * i + 3] = v.w; }
#pragma unroll
        for (int i = 0; i < 16; ++i) ss += x[i] * x[i];
        ss += __shfl_xor(ss, 1); ss += __shfl_xor(ss, 2);
        const float rs = rsqrtf(ss * (1.f / 64.f) + 1e-6f);
#pragma unroll
        for (int i = 0; i < 16; ++i) x[i] = x[i] * rs * p.in[24][part * 16 + i];
        if (t < NCTX) {
          float4* op = (float4*)(p.out + OUT_K + (size_t)t * 512 + h * 64 + part * 16);
#pragma unroll
          for (int i = 0; i < 4; ++i) op[i] = make_float4(x[4 * i], x[4 * i + 1], x[4 * i + 2], x[4 * i + 3]);
        }
        unsigned w[8];
#pragma unroll
        for (int i = 0; i < 8; ++i) w[i] = pk2(x[2 * i], x[2 * i + 1]);
        uint4* dp = (uint4*)(kb + (size_t)t * 512 + h * 64 + part * 16);
        dp[0] = make_uint4(w[0], w[1], w[2], w[3]); dp[1] = make_uint4(w[4], w[5], w[6], w[7]);
      }
      {
        float x[16];
#pragma unroll
        for (int i = 0; i < 4; ++i) { const float4 v = *(const float4*)(src + 1024 + i * 4); x[4 * i] = v.x; x[4 * i + 1] = v.y; x[4 * i + 2] = v.z; x[4 * i + 3] = v.w; }
        if (t < NCTX) {
          float4* op = (float4*)(p.out + OUT_V + (size_t)t * 512 + h * 64 + part * 16);
#pragma unroll
          for (int i = 0; i < 4; ++i) op[i] = make_float4(x[4 * i], x[4 * i + 1], x[4 * i + 2], x[4 * i + 3]);
        }
#pragma unroll
        for (int i = 0; i < 16; ++i) Vs[tok * 72 + part * 16 + i] = f2bf(x[i]);
      }
      __syncthreads();
      {
        const int d = tid >> 2;
        unsigned w[8];
#pragma unroll
        for (int i = 0; i < 8; ++i) w[i] = (unsigned)Vs[(part * 16 + 2 * i) * 72 + d] | ((unsigned)Vs[(part * 16 + 2 * i + 1) * 72 + d] << 16);
        uint4* dp = (uint4*)(vT + (size_t)(h * 64 + d) * NTOK + t0 + part * 16);
        dp[0] = make_uint4(w[0], w[1], w[2], w[3]); dp[1] = make_uint4(w[4], w[5], w[6], w[7]);
      }
      __syncthreads();
    } else {
      const int ci = item - 768, b = ci >> 5, rem = ci & 31, tt = rem >> 3, h = rem & 7, t0 = tt * 64, t = t0 + tok;
      const size_t sidx = (size_t)(b * 256 + t) * 512 + h * 64 + part * 16;
      {
        float x[16];
#pragma unroll
        for (int i = 0; i < 4; ++i) { const float4 v = *(const float4*)(p.in[3] + sidx + i * 4); x[4 * i] = v.x; x[4 * i + 1] = v.y; x[4 * i + 2] = v.z; x[4 * i + 3] = v.w; }
        unsigned w[8];
#pragma unroll
        for (int i = 0; i < 8; ++i) w[i] = pk2(x[2 * i], x[2 * i + 1]);
        uint4* dp = (uint4*)(ckb + sidx);
        dp[0] = make_uint4(w[0], w[1], w[2], w[3]); dp[1] = make_uint4(w[4], w[5], w[6], w[7]);
      }
      {
        float x[16];
#pragma unroll
        for (int i = 0; i < 4; ++i) { const float4 v = *(const float4*)(p.in[4] + sidx + i * 4); x[4 * i] = v.x; x[4 * i + 1] = v.y; x[4 * i + 2] = v.z; x[4 * i + 3] = v.w; }
#pragma unroll
        for (int i = 0; i < 16; ++i) Vs[tok * 72 + part * 16 + i] = f2bf(x[i]);
      }
      __syncthreads();
      {
        const int d = tid >> 2;
        unsigned w[8];
#pragma unroll
        for (int i = 0; i < 8; ++i) w[i] = (unsigned)Vs[(part * 16 + 2 * i) * 72 + d] | ((unsigned)Vs[(part * 16 + 2 * i + 1) * 72 + d] << 16);
        uint4* dp = (uint4*)(cvT + (size_t)((b * 8 + h) * 64 + d) * 256 + t0 + part * 16);
        dp[0] = make_uint4(w[0], w[1], w[2], w[3]); dp[1] = make_uint4(w[4], w[5], w[6], w[7]);
      }
      __syncthreads();
    }
  }
}

DEV float* ops_arr(const Params& p, int i) { return (float*)(p.ws + OFF_OPS + (size_t)i * OPS_ARR); }

DEV f32x4 shiftvec(f32x4 cur, f32x4 hal, f32x4 mu0, f32x4 mu1, int fr) {
  f32x4 prev, next;
#pragma unroll
  for (int i = 0; i < 4; ++i) {
    prev[i] = dpp_mov<0x111>(cur[i]);
    next[i] = dpp_mov<0x101>(cur[i]);
  }
  if (fr == 0) prev = hal;
  if (fr == 15) next = hal;
  return cur + mu0 * (prev - cur) + mu1 * (next - cur);
}
DEV float quad_sum(float x) { x += __shfl_xor(x, 16); x += __shfl_xor(x, 32); return x; }
DEV f32x4 ld4(const float* p) { return *(const f32x4*)p; }
DEV f32x4 ld4nt(const float* p) { return __builtin_nontemporal_load((const f32x4*)p); }

constexpr int LROWB = 392;
template <bool HALF>
DEV void phase_rwprep(const Params& p, unsigned char* smem, int item_) {
  const int tid = threadIdx.x, lane = tid & 63, w = tid >> 6, fr = lane & 15, fq = lane >> 4;
  bf16_t* Lb = (bf16_t*)smem;
  const float* urw = (const float*)(p.ws + OFF_URW);
  const float* mu = p.in[12];
  bf16_t* bonus = (bf16_t*)(p.ws + OFF_BG);
  bf16_t* gate = (bf16_t*)(p.ws + OFF_BG + 6291456);
  const bf16_t* WUPT = (const bf16_t*)(p.ws + OFF_LORA);
  const bf16_t* AUPT = WUPT + 65536;
  const bf16_t* GUPT = WUPT + 131072;
  float* o_r = ops_arr(p, 0); float* o_v = ops_arr(p, 1); float* o_a = ops_arr(p, 2);
  for (int item = item_; item < item_ + 1; ++item) {
    const int t0 = HALF ? (256 + (item >> 2)) * 16 : (item >> 1) * 16;
    const int h = HALF ? (item & 3) * 2 + (w >> 1) : (item & 1) * 4 + w;
    const int ni_lo = HALF ? (w & 1) * 2 : 0, ni_hi = HALF ? ni_lo + 2 : 4;
    float* xs = (float*)(smem + 16384);
    int s_lo, s_hi;
    if (t0 < NCTX) { s_lo = t0 & ~255; s_hi = s_lo + 256; } else { s_lo = NCTX + ((t0 - NCTX) & ~1023); s_hi = s_lo + 1024; }
    {
      const int tl = tid >> 4, g16 = tid & 15, tt = t0 + tl;
      const float* up = urw + (size_t)tt * RWC + 1536;
      const bool hp = tt > s_lo, hn = tt + 1 < s_hi;
#pragma unroll
      for (int j = 0; j < 6; ++j) {
        const int col = (g16 + 16 * j) * 4;
        const f32x4 c = ld4(up + col);
        const f32x4 z = (f32x4){0.f, 0.f, 0.f, 0.f};
        const f32x4 pv = hp ? ld4(up - RWC + col) : z;
        const f32x4 nx = hn ? ld4(up + RWC + col) : z;
        const f32x4 m0 = ld4(mu + 1536 + col), m1 = ld4(mu + RWC + 1536 + col);
        const f32x4 us = c + m0 * (pv - c) + m1 * (nx - c);
        const int kind = col >> 7;
        float o4[4];
#pragma unroll
        for (int i = 0; i < 4; ++i) o4[i] = kind == 0 ? (1.f - 2.f / (1.f + __expf(2.f * us[i]))) : (kind == 1 ? us[i] : sigmoidf_(us[i]));
        *(uint2*)(Lb + tl * LROWB + col) = make_uint2(pk2(o4[0], o4[1]), pk2(o4[2], o4[3]));
      }
    }
    __syncthreads();
    const int t = t0 + fr;
    const bool lo_ok = (fr == 0) && (t > s_lo), hi_ok = (fr == 15) && (t + 1 < s_hi);
    const float* urow = urw + (size_t)t * RWC;
    const float* hrow = lo_ok ? urow - RWC : (hi_ok ? urow + RWC : urow);
    const bool hal_ok = lo_ok || hi_ok;
    const f32x4 z4 = (f32x4){0.f, 0.f, 0.f, 0.f};
    float ss = 0.f;
#pragma unroll
    for (int ni = ni_lo; ni < ni_hi; ++ni) {
      const int c = h * 64 + ni * 16 + fq * 4;
      const f32x4 kx = shiftvec(ld4(urow + 512 + c), hal_ok ? ld4(hrow + 512 + c) : z4, ld4(mu + 512 + c), ld4(mu + RWC + 512 + c), fr) * ld4(p.in[18] + c);
      ss += kx[0] * kx[0] + kx[1] * kx[1] + kx[2] * kx[2] + kx[3] * kx[3];
    }
    ss = quad_sum(ss);
    if (HALF) { if (fq == 0) xs[w * 16 + fr] = ss; __syncthreads(); ss += xs[(w ^ 1) * 16 + fr]; }
    const float rn = rsqrtf(ss + 1e-12f);
    float bs = 0.f;
#pragma unroll 1
    for (int ni = ni_lo; ni < ni_hi; ++ni) {
      const int c = h * 64 + ni * 16 + fq * 4;
      const size_t o = (size_t)t * 512 + c;
      const f32x4 r4 = shiftvec(ld4nt(urow + c), hal_ok ? ld4nt(hrow + c) : z4, ld4(mu + c), ld4(mu + RWC + c), fr);
      const f32x4 k4 = shiftvec(ld4nt(urow + 512 + c), hal_ok ? ld4nt(hrow + 512 + c) : z4, ld4(mu + 512 + c), ld4(mu + RWC + 512 + c), fr);
      const f32x4 v4 = shiftvec(ld4nt(urow + 1024 + c), hal_ok ? ld4nt(hrow + 1024 + c) : z4, ld4(mu + 1024 + c), ld4(mu + RWC + 1024 + c), fr);
      const f32x4 kk4 = k4 * ld4(p.in[18] + c) * rn;
      *(f32x4*)(o_r + o) = r4; *(f32x4*)(o_v + o) = v4; *(f32x4*)(o_a + o) = -kk4;
      const f32x4 ka = ld4(p.in[19] + c);
      f32x4 bacc = z4;
#pragma unroll
      for (int e = 0; e < 2; ++e) {
        float* o_k = ops_arr(p, 5 + e); float* o_b = ops_arr(p, 7 + e); float* o_w = ops_arr(p, 3 + e);
        f32x4 acc = z4, acw = z4;
#pragma unroll
        for (int ks = 0; ks < 2; ++ks) {
          const bf16x8 wa = *(const bf16x8*)(AUPT + (size_t)(e * 512 + h * 64 + ni * 16 + fr) * 64 + ks * 32 + fq * 8);
          const bf16x8 la = *(const bf16x8*)(Lb + fr * LROWB + 128 + e * 64 + ks * 32 + fq * 8);
          acc = __builtin_amdgcn_mfma_f32_16x16x32_bf16(wa, la, acc, 0, 0, 0);
          const bf16x8 ww = *(const bf16x8*)(WUPT + (size_t)(e * 512 + h * 64 + ni * 16 + fr) * 64 + ks * 32 + fq * 8);
          const bf16x8 lw = *(const bf16x8*)(Lb + fr * LROWB + e * 64 + ks * 32 + fq * 8);
          acw = __builtin_amdgcn_mfma_f32_16x16x32_bf16(ww, lw, acw, 0, 0, 0);
        }
        const f32x4 a0 = ld4(p.in[15] + e * 512 + c), w0 = ld4(p.in[13] + e * 512 + c);
        f32x4 kd, bb, dec;
#pragma unroll
        for (int i = 0; i < 4; ++i) {
          const float ic = sigmoidf_(a0[i] + acc[i]);
          kd[i] = k4[i] * (1.f + (ic - 1.f) * ka[i]);
          bb[i] = kk4[i] * ic;
          const float z = w0[i] + acw[i];
          const float sp = fmaxf(-z, 0.f) + __logf(1.f + __expf(-fabsf(z)));
          dec[i] = __expf(-__expf(-sp - 0.5f));
        }
        bacc += kd;
        *(f32x4*)(o_k + o) = kd; *(f32x4*)(o_b + o) = bb; *(f32x4*)(o_w + o) = dec;
      }
      const f32x4 rk = ld4(p.in[20] + c);
#pragma unroll
      for (int i = 0; i < 4; ++i) bs += r4[i] * 0.5f * bacc[i] * rk[i];
      f32x4 acc = z4;
#pragma unroll
      for (int ks = 0; ks < 4; ++ks) {
        const bf16x8 wg = *(const bf16x8*)(GUPT + (size_t)(h * 64 + ni * 16 + fr) * 128 + ks * 32 + fq * 8);
        const bf16x8 lg = *(const bf16x8*)(Lb + fr * LROWB + 256 + ks * 32 + fq * 8);
        acc = __builtin_amdgcn_mfma_f32_16x16x32_bf16(wg, lg, acc, 0, 0, 0);
      }
      *(uint2*)(gate + o) = make_uint2(pk2(acc[0], acc[1]), pk2(acc[2], acc[3]));
    }
    bs = quad_sum(bs);
    if (HALF) { if (fq == 0) xs[64 + w * 16 + fr] = bs; __syncthreads(); bs += xs[64 + (w ^ 1) * 16 + fr]; }
#pragma unroll
    for (int ni = ni_lo; ni < ni_hi; ++ni) {
      const size_t o = (size_t)t * 512 + h * 64 + ni * 16 + fq * 4;
      const f32x4 v4 = *(const f32x4*)(o_v + o);
      *(uint2*)(bonus + o) = make_uint2(pk2(bs * v4[0], bs * v4[1]), pk2(bs * v4[2], bs * v4[3]));
    }
    __syncthreads();
  }
}

DEV void phase_prep(const Params& p, unsigned char* smem, int* s_item, int rep) {
  unsigned* counter = (unsigned*)(p.ws + OFF_CTL) + 16 + rep;
  for (;;) {
    if (threadIdx.x == 0) *s_item = (int)atomicAdd(counter, 1u);
    __syncthreads();
    const int item = *s_item;
    __syncthreads();
    if (item >= 1024 + 64) break;
    if (item < 512) phase_rwprep<false>(p, smem, item);
    else if (item < 1024) phase_rwprep<true>(p, smem, item - 512);
    else phase_qkprep(p, smem, item - 256);
  }
}

constexpr int TC = 16;
typedef float f32x2 __attribute__((ext_vector_type(2)));
template <int EPL, int R, int PD>
DEV void scan_item(const Params& p, unsigned char* smem, int seq, int h, int dir, int rg) {
  constexpr int LPR = 64 / EPL, RPW = 64 / LPR, RPB = 4 * RPW * R, NV = RPB / 16, NP = EPL / 2;
  constexpr int STG = 20480 + 16 * RPB * 4, YOFF = 2 * STG, YSZ = 16 * RPB * 4;
  const int tid = threadIdx.x, lane = tid & 63, w = tid >> 6, riw = lane / LPR, kq = lane % LPR;
  const int T = seq < 16 ? 256 : 1024;
  const int tok0 = seq < 16 ? seq * 256 : NCTX + (seq - 16) * 1024;
  const int vrow_l = (w * RPW + riw) * R;
  const int vrow = rg * RPB + vrow_l;
  f32x2 S[R][NP];
#pragma unroll
  for (int rr = 0; rr < R; ++rr) {
    if (seq >= 16) {
      const float* sp = p.in[2] + ((size_t)(((seq - 16) * 2 + dir) * 8 + h) * 64 + vrow + rr) * 64 + kq * EPL;
#pragma unroll
      for (int i = 0; i < NP; ++i) S[rr][i] = *(const f32x2*)(sp + 2 * i);
    } else {
#pragma unroll
      for (int i = 0; i < NP; ++i) S[rr][i] = (f32x2){0.f, 0.f};
    }
  }
  const int lstep = tid >> 4, l16 = tid & 15;
  const float* pr = ops_arr(p, 0) + h * 64 + l16 * 4;
  const float* pw = ops_arr(p, 3 + dir) + h * 64 + l16 * 4;
  const float* pk = ops_arr(p, 5 + dir) + h * 64 + l16 * 4;
  const float* pa = ops_arr(p, 2) + h * 64 + l16 * 4;
  const float* pb = ops_arr(p, 7 + dir) + h * 64 + l16 * 4;
  const float* pv = ops_arr(p, 1) + h * 64 + rg * RPB + l16;
  float* yout = (float*)(p.ws + (dir ? OFF_YB : OFF_YF)) + h * 64 + rg * RPB + l16;
  const int nc = T / TC;
  float4 g_r, g_w, g_k, g_a, g_b; float rv[NV];
#define gload(c) do { const int ts_ = (c) * TC + lstep; const size_t t_ = (size_t)(tok0 + (dir ? T - 1 - ts_ : ts_)) * 512; \
    if (R == 4) { g_r = ldnt4(pr + t_); g_w = ldnt4(pw + t_); g_k = ldnt4(pk + t_); g_a = ldnt4(pa + t_); g_b = ldnt4(pb + t_); } else { \
    g_r = *(const float4*)(pr + t_); g_w = *(const float4*)(pw + t_); g_k = *(const float4*)(pk + t_); \
    g_a = *(const float4*)(pa + t_); g_b = *(const float4*)(pb + t_); } \
    _Pragma("unroll") for (int q_ = 0; q_ < NV; ++q_) rv[q_] = pv[t_ + 16 * q_]; } while (0)
#define ywrite(c) do { const float* yb_ = (const float*)(smem + YOFF + ((c) & 1) * YSZ); const int ts_ = (c) * TC + lstep; \
    const size_t t_ = (size_t)(tok0 + (dir ? T - 1 - ts_ : ts_)) * 512; \
    _Pragma("unroll") for (int q_ = 0; q_ < NV; ++q_) yout[t_ + 16 * q_] = yb_[lstep * RPB + l16 + 16 * q_]; } while (0)
  gload(0);
  for (int c = 0; c < nc; ++c) {
    unsigned char* st = smem + (c & 1) * STG;
    *(float4*)(st + 0 * 4096 + lstep * 256 + l16 * 16) = g_r;
    *(float4*)(st + 1 * 4096 + lstep * 256 + l16 * 16) = g_w;
    *(float4*)(st + 2 * 4096 + lstep * 256 + l16 * 16) = g_k;
    *(float4*)(st + 3 * 4096 + lstep * 256 + l16 * 16) = g_a;
    *(float4*)(st + 4 * 4096 + lstep * 256 + l16 * 16) = g_b;
#pragma unroll
    for (int q = 0; q < NV; ++q) *(float*)(st + 20480 + (lstep * RPB + l16 + 16 * q) * 4) = rv[q];
    __syncthreads();
    if (c > 0) ywrite(c - 1);
    if (c + 1 < nc) gload(c + 1);
    float* ybw = (float*)(smem + YOFF + (c & 1) * YSZ);
    constexpr int NS = PD + 1;
    f32x2 o_r[NS][NP], o_w[NS][NP], o_k[NS][NP], o_a[NS][NP], o_b[NS][NP]; float o_v[NS][R];
    float ykeep[R][TC / LPR];
#define LDOPS(bi, s_) do { \
      _Pragma("unroll") for (int i_ = 0; i_ < NP; ++i_) { \
        o_r[bi][i_] = *(const f32x2*)(st + 0 * 4096 + (s_) * 256 + kq * EPL * 4 + i_ * 8); \
        o_w[bi][i_] = *(const f32x2*)(st + 1 * 4096 + (s_) * 256 + kq * EPL * 4 + i_ * 8); \
        o_k[bi][i_] = *(const f32x2*)(st + 2 * 4096 + (s_) * 256 + kq * EPL * 4 + i_ * 8); \
        o_a[bi][i_] = *(const f32x2*)(st + 3 * 4096 + (s_) * 256 + kq * EPL * 4 + i_ * 8); \
        o_b[bi][i_] = *(const f32x2*)(st + 4 * 4096 + (s_) * 256 + kq * EPL * 4 + i_ * 8); } \
      _Pragma("unroll") for (int rr_ = 0; rr_ < R; ++rr_) o_v[bi][rr_] = *(const float*)(st + 20480 + ((s_) * RPB + vrow_l + rr_) * 4); } while (0)
#pragma unroll
    for (int s = 0; s < PD; ++s) LDOPS(s, s);
#pragma unroll
    for (int s = 0; s < TC; ++s) {
      const int bi = s % NS;
      if (s + PD < TC) LDOPS((s + PD) % NS, s + PD);
#pragma unroll
      for (int rr = 0; rr < R; ++rr) {
        const f32x2 vv2 = (f32x2){o_v[bi][rr], o_v[bi][rr]};
        f32x2 pa2 = S[rr][0] * o_a[bi][0];
        f32x2 tt[NP];
        tt[0] = S[rr][0] * o_w[bi][0] + vv2 * o_k[bi][0];
#pragma unroll
        for (int i = 1; i < NP; ++i) { pa2 += S[rr][i] * o_a[bi][i]; tt[i] = S[rr][i] * o_w[bi][i] + vv2 * o_k[bi][i]; }
        float sa = pa2[0] + pa2[1];
        sa += dpp_mov<0xB1>(sa); sa += dpp_mov<0x4E>(sa); sa += dpp_mov<0x141>(sa);
        if (LPR == 16) sa += dpp_mov<0x140>(sa);
        const f32x2 sa2 = (f32x2){sa, sa};
        f32x2 py = (f32x2){0.f, 0.f};
#pragma unroll
        for (int i = 0; i < NP; ++i) { S[rr][i] = sa2 * o_b[bi][i] + tt[i]; py += S[rr][i] * o_r[bi][i]; }
        float y = py[0] + py[1];
        y += dpp_mov<0xB1>(y); y += dpp_mov<0x4E>(y); y += dpp_mov<0x141>(y);
        if (LPR == 16) y += dpp_mov<0x140>(y);
        if ((s % LPR) == 0) ykeep[rr][s / LPR] = y; else ykeep[rr][s / LPR] = (kq == (s % LPR)) ? y : ykeep[rr][s / LPR];
      }
    }
#undef LDOPS
#pragma unroll
    for (int rr = 0; rr < R; ++rr)
#pragma unroll
      for (int q = 0; q < TC / LPR; ++q) ybw[(q * LPR + kq) * RPB + vrow_l + rr] = ykeep[rr][q];
  }
  __syncthreads();
  ywrite(nc - 1);
  if (seq < 16) {
#pragma unroll
    for (int rr = 0; rr < R; ++rr) {
      float* so = p.out + OUT_STATE + ((size_t)((seq * 2 + dir) * 8 + h) * 64 + vrow + rr) * 64 + kq * EPL;
#pragma unroll
      for (int i = 0; i < NP; ++i) *(f32x2*)(so + 2 * i) = S[rr][i];
    }
  }
  __syncthreads();
#undef gload
#undef ywrite
}

DEV void attn_wave_item(const Params& p, int witem) {
  const int lane = threadIdx.x & 63, fr = lane & 15, fq = lane >> 4;
  const bf16_t* qb = (const bf16_t*)(p.ws + OFF_QB);
  const bf16_t* kb = (const bf16_t*)(p.ws + OFF_KB);
  const bf16_t* vT = (const bf16_t*)(p.ws + OFF_VT);
  const bf16_t* ckb = (const bf16_t*)(p.ws + OFF_CKB);
  const bf16_t* cvT = (const bf16_t*)(p.ws + OFF_CVT);
  bf16_t* ona = (bf16_t*)(p.ws + OFF_ONA);
  int h, tq0, nsub;
  bool latent;
  int b = 0, r = 0, jb = 0, row_start = 0, band = 0, seq = 0;
  {
    const int bi = witem >> 2, wv = witem & 3;
    if (bi < 256) {
      latent = true;
      b = bi >> 7; const int rem = bi & 127; r = rem >> 3; h = rem & 7; jb = wv;
      tq0 = NCTX + b * 1024 + r * 64 + jb * 16;
      row_start = min(max(r - 4, 0), 8); band = min(max(jb * 16 - 8, 0), 32);
      nsub = 4;
    } else {
      latent = false;
      const int c2 = bi - 256; seq = c2 >> 5; const int rem = c2 & 31; h = rem >> 2; const int qg = rem & 3;
      tq0 = seq * 256 + (qg * 4 + wv) * 16; nsub = 2;
    }
  }
  const bf16_t* qp = qb + (size_t)(tq0 + fr) * 512 + h * 64 + fq * 8;
  const bf16x8 qf0 = *(const bf16x8*)qp, qf1 = *(const bf16x8*)(qp + 32);
  float m = -INFINITY, l = 0.f;
  f32x4 O[4];
#pragma unroll
  for (int i = 0; i < 4; ++i) O[i] = (f32x4){0.f, 0.f, 0.f, 0.f};
#define SUBDESC(sc_, kbase_, vbase_, KS_, ldv_, win_) do { const int half_ = (sc_) & 1; win_ = latent && (sc_) < 2; \
    if (win_) { const int tb_ = NCTX + b * 1024 + (row_start + half_ * 4) * 64 + band; \
      kbase_ = kb + (size_t)tb_ * 512 + h * 64; vbase_ = vT + (size_t)(h * 64) * NTOK + tb_; KS_ = 64; ldv_ = NTOK; } \
    else if (latent) { kbase_ = ckb + (size_t)(b * 256 + half_ * 128) * 512 + h * 64; vbase_ = cvT + (size_t)((b * 8 + h) * 64) * 256 + half_ * 128; KS_ = 32; ldv_ = 256; } \
    else { const int tb_ = seq * 256 + half_ * 128; kbase_ = kb + (size_t)tb_ * 512 + h * 64; vbase_ = vT + (size_t)(h * 64) * NTOK + tb_; KS_ = 32; ldv_ = NTOK; } } while (0)
#define KLOAD(kbase_, KS_) do { _Pragma("unroll") for (int i_ = 0; i_ < 8; ++i_) { \
      const bf16_t* kp_ = kbase_ + (size_t)((i_ >> 1) * KS_ + (fr >> 2) * 8 + (i_ & 1) * 4 + (fr & 3)) * 512 + fq * 8; \
      kf[2 * i_] = *(const bf16x8*)kp_; kf[2 * i_ + 1] = *(const bf16x8*)(kp_ + 32); } } while (0)
  bf16x8 kf[16];
#pragma unroll 1
  for (int sc = 0; sc < nsub; ++sc) {
    const int half = sc & 1;
    const bf16_t* kbase; const bf16_t* vbase; int KS, ldv; bool win;
    SUBDESC(sc, kbase, vbase, KS, ldv, win);
    KLOAD(kbase, KS);
    bf16x8 vf[4][4];
#pragma unroll
    for (int s = 0; s < 4; ++s)
#pragma unroll
      for (int dt = 0; dt < 4; ++dt) {
        vf[s][dt] = *(const bf16x8*)(vbase + (size_t)(dt * 16 + fr) * ldv + s * KS + fq * 8);
      }
    f32x4 st[8];
#pragma unroll
    for (int i = 0; i < 8; ++i) {
      f32x4 z = (f32x4){0.f, 0.f, 0.f, 0.f};
      z = __builtin_amdgcn_mfma_f32_16x16x32_bf16(kf[2 * i], qf0, z, 0, 0, 0);
      st[i] = __builtin_amdgcn_mfma_f32_16x16x32_bf16(kf[2 * i + 1], qf1, z, 0, 0, 0);
    }
    const bool cwin = win;
    if (cwin) {
      const int q_col = jb * 16 + fr;
      const int win_start = min(max(q_col - 8, 0), 48);
      const float* rpb = p.in[25] + h * 465;
#pragma unroll
      for (int i = 0; i < 8; ++i) {
        const int dr = row_start + half * 4 + (i >> 1) - r + 7;
#pragma unroll
        for (int e = 0; e < 4; ++e) {
          const int k_col = band + fq * 8 + (i & 1) * 4 + e;
          const bool valid = (k_col >= win_start) && (k_col < win_start + 16);
          const int dc = min(max(k_col - q_col, -15), 15) + 15;
          st[i][e] = valid ? st[i][e] + rpb[dr * 31 + dc] : -1e30f;
        }
      }
    }
    float cmax = -1e30f;
#pragma unroll
    for (int i = 0; i < 8; ++i)
#pragma unroll
      for (int e = 0; e < 4; ++e) cmax = fmaxf(cmax, st[i][e]);
    cmax = fmaxf(cmax, __shfl_xor(cmax, 16)); cmax = fmaxf(cmax, __shfl_xor(cmax, 32));
    const float mnew = fmaxf(m, cmax);
    const float alpha = __expf(m - mnew);
    float psum = 0.f;
#pragma unroll
    for (int i = 0; i < 8; ++i)
#pragma unroll
      for (int e = 0; e < 4; ++e) { const float pv = __expf(st[i][e] - mnew); st[i][e] = pv; psum += pv; }
    psum += __shfl_xor(psum, 16); psum += __shfl_xor(psum, 32);
    l = l * alpha + psum;
#pragma unroll
    for (int i = 0; i < 4; ++i) O[i] = O[i] * alpha;
    m = mnew;
#pragma unroll
    for (int s = 0; s < 4; ++s) {
      union { bf16x8 v; unsigned u[4]; } pb;
      pb.u[0] = pk2(st[2 * s][0], st[2 * s][1]); pb.u[1] = pk2(st[2 * s][2], st[2 * s][3]);
      pb.u[2] = pk2(st[2 * s + 1][0], st[2 * s + 1][1]); pb.u[3] = pk2(st[2 * s + 1][2], st[2 * s + 1][3]);
#pragma unroll
      for (int dt = 0; dt < 4; ++dt) {
        O[dt] = __builtin_amdgcn_mfma_f32_16x16x32_bf16(vf[s][dt], pb.v, O[dt], 0, 0, 0);
      }
    }
  }
#undef SUBDESC
#undef KLOAD
  const float inv = 1.f / l;
#pragma unroll
  for (int dt = 0; dt < 4; ++dt) {
    bf16_t* op = ona + (size_t)(tq0 + fr) * 512 + h * 64 + dt * 16 + fq * 4;
    *(uint2*)op = make_uint2(pk2(O[dt][0] * inv, O[dt][1] * inv), pk2(O[dt][2] * inv, O[dt][3] * inv));
  }
}

constexpr int N_SCAN_ITEMS = 128 + 256, N_ATTN_BLK = 768;
DEV void phase_scan_attn(const Params& p, unsigned char* smem, int* s_item, int rep) {
  unsigned* counter = (unsigned*)(p.ws + OFF_CTL) + rep;
  for (;;) {
    if (threadIdx.x == 0) *s_item = (int)atomicAdd(counter, 1u);
    __syncthreads();
    const int item = *s_item;
    __syncthreads();
    if (item >= N_SCAN_ITEMS + N_ATTN_BLK) break;
    if (item < 128) { const int rem = item & 63; scan_item<4, 1, 3>(p, smem, 16 + (item >> 6), rem >> 3, (rem >> 2) & 1, rem & 3); }
    else if (item >= N_SCAN_ITEMS) attn_wave_item(p, (item - N_SCAN_ITEMS) * 4 + (threadIdx.x >> 6));
    else { const int i2 = item - 128, rem = i2 & 15; scan_item<4, 4, 1>(p, smem, i2 >> 4, rem >> 1, rem & 1, 0); }
  }
}

DEV void phase_finalize_rw(const Params& p, int bid, int nb) {
  const int lane = threadIdx.x & 63, gw = bid * 4 + (threadIdx.x >> 6), nw = nb * 4;
  const float* yf = (const float*)(p.ws + OFF_YF);
  const float* yb = (const float*)(p.ws + OFF_YB);
  const bf16_t* bonus = (const bf16_t*)(p.ws + OFF_BG);
  const bf16_t* gate = (const bf16_t*)(p.ws + OFF_BG + 6291456);
  bf16_t* orw = (bf16_t*)(p.ws + OFF_ORW);
  const float4 g0 = *(const float4*)(p.in[21] + lane * 8), g1 = *(const float4*)(p.in[21] + lane * 8 + 4);
  const float4 b0 = *(const float4*)(p.in[22] + lane * 8), b1 = *(const float4*)(p.in[22] + lane * 8 + 4);
  const float gg[8] = {g0.x, g0.y, g0.z, g0.w, g1.x, g1.y, g1.z, g1.w};
  const float bb[8] = {b0.x, b0.y, b0.z, b0.w, b1.x, b1.y, b1.z, b1.w};
#pragma unroll 3
  for (int t = gw; t < NTOK; t += nw) {
    const size_t o = (size_t)t * 512 + lane * 8;
    const float4 a0 = ldnt4(yf + o), a1 = ldnt4(yf + o + 4);
    const float4 c0 = ldnt4(yb + o), c1 = ldnt4(yb + o + 4);
    const uint4 bo = *(const uint4*)(bonus + o), ga = *(const uint4*)(gate + o);
    float y[8] = {a0.x + c0.x, a0.y + c0.y, a0.z + c0.z, a0.w + c0.w, a1.x + c1.x, a1.y + c1.y, a1.z + c1.z, a1.w + c1.w};
    float s = 0.f;
#pragma unroll
    for (int i = 0; i < 8; ++i) s += y[i];
    s += dpp_mov<0xB1>(s); s += dpp_mov<0x4E>(s); s += dpp_mov<0x141>(s);
    const float mean = s * (1.f / 64.f);
    float q = 0.f;
#pragma unroll
    for (int i = 0; i < 8; ++i) { y[i] -= mean; q += y[i] * y[i]; }
    q += dpp_mov<0xB1>(q); q += dpp_mov<0x4E>(q); q += dpp_mov<0x141>(q);
    const float rstd = rsqrtf(q * (1.f / 64.f) + 64e-5f);
    const unsigned bu[4] = {bo.x, bo.y, bo.z, bo.w}, gu[4] = {ga.x, ga.y, ga.z, ga.w};
    unsigned w[4];
#pragma unroll
    for (int i = 0; i < 4; ++i) {
      const float lo = (y[2 * i] * rstd * gg[2 * i] + bb[2 * i] + __uint_as_float(bu[i] << 16)) * __uint_as_float(gu[i] << 16);
      const float hi = (y[2 * i + 1] * rstd * gg[2 * i + 1] + bb[2 * i + 1] + __uint_as_float(bu[i] & 0xffff0000u)) * __uint_as_float(gu[i] & 0xffff0000u);
      w[i] = pk2(lo, hi);
    }
    *(uint4*)(orw + o) = make_uint4(w[0], w[1], w[2], w[3]);
  }
}

#define XB_TMO      128
#define XB_XCNT(j)  (256  + 64 * (j))
#define XB_XSUB(j)  (1280 + 64 * (j))
#define XB_XGEN(j)  (2304 + 64 * (j))
#define XB_TOP      3328
#define XB_TOPGEN   3392
#define XCD_BAR_WORDS 3456
#define XB_SPIN_CAP (1u << 18)
#define LAS __attribute__((address_space(3)))
DEV unsigned xb_ld(unsigned* p)              { return __hip_atomic_load(p, __ATOMIC_RELAXED, __HIP_MEMORY_SCOPE_AGENT); }
DEV unsigned xb_add(unsigned* p, unsigned v) { return __hip_atomic_fetch_add(p, v, __ATOMIC_RELAXED, __HIP_MEMORY_SCOPE_AGENT); }
DEV unsigned xb_xcc_id() { return (unsigned)__builtin_amdgcn_s_getreg((3 << 11) | 20) & 0xFu; }
#define XB_SPIN(cond, bar) do { unsigned _sp = 0; while (cond) { __builtin_amdgcn_s_sleep(1); \
    if ((++_sp & 255u) == 0u) { if (xb_ld(&(bar)[XB_TMO])) break; if (_sp > XB_SPIN_CAP) { atomicAdd(&(bar)[XB_TMO], 1u); break; } } } } while (0)
struct XcdBarrier { unsigned* bar; unsigned x; volatile LAS unsigned* st; };
DEV XcdBarrier xcd_barrier_post(unsigned* bar, volatile LAS unsigned* st) {
  XcdBarrier b; b.bar = bar; b.x = xb_xcc_id(); b.st = st;
  if (threadIdx.x == 0) (void)xb_add(&bar[XB_XCNT(b.x)], 1u);
  return b;
}
DEV void xcd_barrier_complete(unsigned* bar, unsigned x, unsigned& nloc, unsigned& nx) {
  const unsigned G = gridDim.x * gridDim.y * gridDim.z;
  unsigned sum, cnt, mine, sp = 0u;
  for (;;) {
    sum = 0u; cnt = 0u; mine = 0u;
#pragma unroll
    for (unsigned j = 0; j < 16; ++j) { const unsigned c = xb_ld(&bar[XB_XCNT(j)]); sum += c; cnt += (c > 0u) ? 1u : 0u; mine = (j == x) ? c : mine; }
    if (sum == G) break;
    __builtin_amdgcn_s_sleep(1);
    if ((++sp & 255u) == 0u) { if (xb_ld(&bar[XB_TMO])) break; if (sp > XB_SPIN_CAP) { atomicAdd(&bar[XB_TMO], 1u); break; } }
  }
  nloc = mine > 0u ? mine : 1u; nx = cnt > 0u ? cnt : 1u;
}
DEV void xcd_barrier(const XcdBarrier& b) {
  asm volatile("s_waitcnt vmcnt(0)" ::: "memory");
  __syncthreads();
  if (threadIdx.x == 0) {
    unsigned* bar = b.bar;
    __builtin_amdgcn_s_waitcnt(0);
    unsigned nloc = b.st[0], nx = b.st[1];
    if (nloc == 0u) { xcd_barrier_complete(bar, b.x, nloc, nx); b.st[0] = nloc; b.st[1] = nx; }
    const unsigned old = xb_add(&bar[XB_XSUB(b.x)], 1u);
    const unsigned gen = old / nloc;
    if (old + 1u == (gen + 1u) * nloc) {
      __builtin_amdgcn_fence(__ATOMIC_RELEASE, "agent");
      asm volatile("s_waitcnt vmcnt(0)" ::: "memory");
      const unsigned og = xb_add(&bar[XB_TOP], 1u);
      const unsigned tg = og / nx;
      if (og + 1u == (tg + 1u) * nx) xb_add(&bar[XB_TOPGEN], 1u);
      else XB_SPIN(xb_ld(&bar[XB_TOPGEN]) == tg, bar);
      __builtin_amdgcn_fence(__ATOMIC_ACQUIRE, "agent");
      xb_add(&bar[XB_XGEN(b.x)], 1u);
      asm volatile("s_waitcnt vmcnt(0)" ::: "memory");
    } else {
      XB_SPIN(xb_ld(&bar[XB_XGEN(b.x)]) == gen, bar);
      __builtin_amdgcn_fence(__ATOMIC_ACQUIRE, "agent");
      asm volatile("s_waitcnt vmcnt(0)" ::: "memory");
    }
  }
  __syncthreads();
}

__global__ void __launch_bounds__(NTHR, 2) fwd_megakernel(Params p) {
  extern __shared__ __attribute__((aligned(16))) unsigned char smem[];
  __shared__ __attribute__((aligned(16))) unsigned sh_ctl[8];
  cg::grid_group grid = cg::this_grid();
  const int bid = blockIdx.x, nb = gridDim.x;
  if (threadIdx.x < 8) sh_ctl[threadIdx.x] = 0u;
  __syncthreads();
  const XcdBarrier xb = xcd_barrier_post((unsigned*)(p.ws + OFF_CTL), (volatile LAS unsigned*)sh_ctl);
  int* s_item_p = (int*)&sh_ctl[4];
  if (p.ph_hi > 1000) grid.sync();
#define GSYNC() xcd_barrier(xb)
#ifndef DUP
#define DUP -1
#endif
#define PH(n, body) if (p.ph_lo <= n && n < p.ph_hi) { { const int rep = 0; (void)rep; body; } if (DUP == n) { GSYNC(); const int rep = 1; (void)rep; body; } if (n + 1 < p.ph_hi) GSYNC(); }
  PH(0, phase0(p, smem, bid, nb, rep))
  PH(1, phase_normmod<0>(p, bid, nb))
  PH(2, reset_tiles(s_item_p); phase_gemm_in(p, smem, s_item_p))
  PH(3, phase_prep(p, smem, s_item_p, rep))
  PH(4, phase_scan_attn(p, smem, s_item_p, rep))
  PH(5, phase_finalize_rw(p, bid, nb))
  PH(6, reset_tiles(s_item_p); phase_gemm_merge(p, smem, s_item_p))
  PH(7, reset_tiles(s_item_p); phase_gemm_out(p, smem, s_item_p))
  PH(8, phase_normmod<1>(p, bid, nb))
  PH(9, reset_tiles(s_item_p); phase_gemm_ffn_up(p, smem, s_item_p))
  PH(10, reset_tiles(s_item_p); phase_gemm_ffn_down(p, smem, s_item_p))
}

extern "C" void kernel_launch(void* const* d_in, const int* in_sizes, int n_in, void* d_out, int out_size, void* d_ws, size_t ws_size,
                              hipStream_t stream) {
  static int grid_blocks = 0;
  if (grid_blocks == 0) {
    if (n_in != 32 || ws_size < WS_END) { fprintf(stderr, "kernel_launch: unexpected n_in %d / ws_size %zu (need %zu)\n", n_in, ws_size, (size_t)WS_END); grid_blocks = -1; return; }
    int dev = 0, cus = 0, per_cu = 0;
    hipGetDevice(&dev);
    hipDeviceGetAttribute(&cus, hipDeviceAttributeMultiprocessorCount, dev);
    if (hipFuncSetAttribute((const void*)fwd_megakernel, hipFuncAttributeMaxDynamicSharedMemorySize, LDS_BYTES) != hipSuccess) { fprintf(stderr, "hipFuncSetAttribute failed\n"); grid_blocks = -1; return; }
    if (hipOccupancyMaxActiveBlocksPerMultiprocessor(&per_cu, (const void*)fwd_megakernel, NTHR, LDS_BYTES) != hipSuccess || per_cu < 1) { fprintf(stderr, "occupancy query failed (%d)\n", per_cu); grid_blocks = -1; return; }
    if (per_cu > 2) per_cu = 2;
    grid_blocks = cus * per_cu;
    fprintf(stderr, "kernel_launch: cus %d per_cu %d grid %d\n", cus, per_cu, grid_blocks);
  }
  if (grid_blocks < 0) return;
  hipMemsetAsync((char*)d_ws + OFF_CTL, 0, CTL_ZERO_BYTES, stream);
  Params p{};
  for (int i = 0; i < 32; ++i) p.in[i] = (const float*)d_in[i];
  p.out = (float*)d_out; p.ws = (unsigned char*)d_ws; p.ph_lo = 0; p.ph_hi = 11;
  void* args[] = {&p};
  hipError_t e = hipLaunchCooperativeKernel((const void*)fwd_megakernel, dim3(grid_blocks), dim3(NTHR), args, LDS_BYTES, stream);
  if (e != hipSuccess) fprintf(stderr, "cooperative launch failed: %s (grid %d)\n", hipGetErrorString(e), grid_blocks);
}
```

```cpp
#include <hip/hip_runtime.h>
#include <hip/hip_cooperative_groups.h>
#include <cstdio>
#include <cstdint>
namespace cg = cooperative_groups;

#define DEV __device__ __forceinline__
typedef unsigned short bf16_t;
typedef short bf16x8 __attribute__((ext_vector_type(8)));
typedef short bf16x4 __attribute__((ext_vector_type(4)));
typedef float f32x4 __attribute__((ext_vector_type(4)));

constexpr int D = 1024, NTOK = 6144, NCTX = 4096, RW = 512, FF = 2816, INC = 5504, RWC = 1920;
constexpr int NTHR = 256;
constexpr int LDS_BYTES = 65536;

constexpr size_t OFF_CTL = 0;
constexpr size_t OFF_MOD = 16384;
constexpr size_t CTL_ZERO_BYTES = 16384 + 3 * 6144 * 4;
constexpr size_t OFF_WIN = 90112;
constexpr size_t OFF_WORW = OFF_WIN + 11272192;
constexpr size_t OFF_WONA = OFF_WORW + 1048576;
constexpr size_t OFF_WOUT = OFF_WONA + 1048576;
constexpr size_t OFF_W13 = OFF_WOUT + 2097152;
constexpr size_t OFF_W2 = OFF_W13 + 11534336;
constexpr size_t OFF_H = OFF_W2 + 5767168;
constexpr size_t OFF_URW = OFF_H + 12582912;
constexpr size_t OFF_UNA = OFF_URW + 47185920;
constexpr size_t OFF_OPS = OFF_UNA + 37748736;
constexpr size_t OPS_ARR = 12582912;
constexpr size_t OFF_BG = OFF_OPS + 9 * OPS_ARR;
constexpr size_t OFF_VT = OFF_BG + 12582912;
constexpr size_t OFF_CKB = OFF_VT + 6291456;
constexpr size_t OFF_CVT = OFF_CKB + 524288;
constexpr size_t OFF_LORA = OFF_CVT + 524288;
constexpr size_t WS_END = OFF_LORA + 393216;
constexpr size_t OFF_QB = OFF_UNA + 12582912, OFF_KB = OFF_UNA + 18874368;
constexpr size_t OFF_YF = OFF_URW, OFF_YB = OFF_URW + 12582912;
constexpr size_t OFF_ORW = OFF_UNA, OFF_ONA = OFF_UNA + 6291456;
constexpr size_t OFF_MERGED = OFF_OPS;
constexpr size_t OFF_HID = OFF_URW;
constexpr size_t OUT_STATE = 6291456, OUT_K = 7340032, OUT_V = 9437184;

struct Params {
  const float* in[32];
  float* out;
  unsigned char* ws;
  int ph_lo, ph_hi;
};

DEV unsigned short f2bf(float f) { unsigned u = __float_as_uint(f); u += 0x7fffu + ((u >> 16) & 1u); return (unsigned short)(u >> 16); }
DEV unsigned pk2(float lo, float hi) { return (unsigned)f2bf(lo) | ((unsigned)f2bf(hi) << 16); }
DEV float bf2f(unsigned short b) { return __uint_as_float(((unsigned)b) << 16); }
DEV float sigmoidf_(float x) { return 1.f / (1.f + __expf(-x)); }
DEV float wave_sum(float x) {
#pragma unroll
  for (int o = 32; o > 0; o >>= 1) x += __shfl_xor(x, o);
  return x;
}
template <int CTRL> DEV float dpp_mov(float x) { return __int_as_float(__builtin_amdgcn_update_dpp(0, __float_as_int(x), CTRL, 0xf, 0xf, true)); }
DEV float row16_sum(float x) {
  x += dpp_mov<0xB1>(x); x += dpp_mov<0x4E>(x); x += dpp_mov<0x141>(x); x += dpp_mov<0x140>(x);
  return x;
}
#define BAR_LDS() do { asm volatile("s_waitcnt lgkmcnt(0)" ::: "memory"); __builtin_amdgcn_s_barrier(); asm volatile("" ::: "memory"); } while (0)
DEV float4 ldnt4(const float* p_) { const f32x4 t_ = __builtin_nontemporal_load((const f32x4*)p_); return make_float4(t_[0], t_[1], t_[2], t_[3]); }
DEV const float* xrow(const Params& p, int t) { return t < NCTX ? p.in[0] + (size_t)t * D : p.in[1] + (size_t)(t - NCTX) * D; }
DEV int modidx(int t) { return t < NCTX ? 0 : 1 + ((t - NCTX) >> 10); }

DEV void conv_job(const Params& p, int j, const float*& src, bf16_t*& dst, int& K, int& N, int& mode, int& base) {
  if (j < 1376) { src = p.in[11]; dst = (bf16_t*)(p.ws + OFF_WIN); K = 1024; N = 5504; mode = 0; base = 0; }
  else if (j < 1504) { src = p.in[26]; dst = (bf16_t*)(p.ws + OFF_WORW); K = 512; N = 1024; mode = 0; base = 1376; }
  else if (j < 1632) { src = p.in[27]; dst = (bf16_t*)(p.ws + OFF_WONA); K = 512; N = 1024; mode = 0; base = 1504; }
  else if (j < 1888) { src = p.in[28]; dst = (bf16_t*)(p.ws + OFF_WOUT); K = 1024; N = 1024; mode = 0; base = 1632; }
  else if (j < 2592) { src = p.in[29]; dst = (bf16_t*)(p.ws + OFF_W13); K = 1024; N = 2816; mode = 1; base = 1888; }
  else if (j < 3296) { src = p.in[30]; dst = (bf16_t*)(p.ws + OFF_W13); K = 1024; N = 2816; mode = 2; base = 2592; }
  else if (j < 4000) { src = p.in[31]; dst = (bf16_t*)(p.ws + OFF_W2); K = 2816; N = 1024; mode = 0; base = 3296; }
  else if (j < 4016) { const int e = (j - 4000) >> 3; src = p.in[14] + e * 32768; dst = (bf16_t*)(p.ws + OFF_LORA) + e * 32768; K = 64; N = 512; mode = 0; base = 4000 + e * 8; }
  else if (j < 4032) { const int e = (j - 4016) >> 3; src = p.in[16] + e * 32768; dst = (bf16_t*)(p.ws + OFF_LORA) + 65536 + e * 32768; K = 64; N = 512; mode = 0; base = 4016 + e * 8; }
  else { src = p.in[17]; dst = (bf16_t*)(p.ws + OFF_LORA) + 131072; K = 128; N = 512; mode = 0; base = 4032; }
}
constexpr int N_CONV_TILES = 4048, N_MOD_TILES = 768;

DEV void phase0(const Params& p, unsigned char* smem, int bid, int nb, int rep) {
  const int tid = threadIdx.x;
  float* T = (float*)smem;
  for (int tile = bid; tile < N_MOD_TILES && rep == 0; tile += nb) {
    const int cgp = tile % 24, kc = tile / 24;
    if (tid < 96) {
      const int m = tid >> 5, kk = tid & 31, k = kc * 32 + kk;
      const float c = (m == 0) ? p.in[6][k] : p.in[5][(m - 1) * D + k];
      T[tid] = c * sigmoidf_(c);
    }
    __syncthreads();
    const int col = cgp * 256 + tid;
    const float* w = p.in[9] + (size_t)(kc * 32) * 6144 + col;
    float a0 = 0.f, a1 = 0.f, a2 = 0.f;
#pragma unroll
    for (int kk = 0; kk < 32; ++kk) {
      const float wv = __builtin_nontemporal_load(w + (size_t)kk * 6144);
      a0 += T[kk] * wv; a1 += T[32 + kk] * wv; a2 += T[64 + kk] * wv;
    }
    if (kc == 0) { const float b = p.in[10][col]; a0 += b; a1 += b; a2 += b; }
    float* mod = (float*)(p.ws + OFF_MOD);
    atomicAdd(mod + col, a0); atomicAdd(mod + 6144 + col, a1); atomicAdd(mod + 12288 + col, a2);
    __syncthreads();
  }
  const int r_ = tid >> 4, c4_ = tid & 15;
  float4 v[4];
  const float* src; bf16_t* dst; int K, N, mode, base;
  int tile = bid;
  if (tile < N_CONV_TILES) {
    conv_job(p, tile, src, dst, K, N, mode, base);
    const int lt = tile - base, nN = N >> 6, k0 = (lt / nN) * 64, n0 = (lt % nN) * 64;
#pragma unroll
    for (int i = 0; i < 4; ++i) { const f32x4 t_ = __builtin_nontemporal_load((const f32x4*)(src + (size_t)(k0 + r_ + 16 * i) * N + n0 + c4_ * 4)); v[i] = make_float4(t_[0], t_[1], t_[2], t_[3]); }
  }
  while (tile < N_CONV_TILES) {
    const int lt = tile - base, nN = N >> 6, k0 = (lt / nN) * 64, n0 = (lt % nN) * 64;
    bf16_t* cdst = dst; const int cK = K, cmode = mode;
#pragma unroll
    for (int i = 0; i < 4; ++i) {
      float* tp = T + (r_ + 16 * i) * 65 + c4_ * 4;
      tp[0] = v[i].x; tp[1] = v[i].y; tp[2] = v[i].z; tp[3] = v[i].w;
    }
    BAR_LDS();
    tile += nb;
    if (tile < N_CONV_TILES) {
      conv_job(p, tile, src, dst, K, N, mode, base);
      const int lt2 = tile - base, nN2 = N >> 6, k2 = (lt2 / nN2) * 64, n2 = (lt2 % nN2) * 64;
#pragma unroll
      for (int i = 0; i < 4; ++i) { const f32x4 t_ = __builtin_nontemporal_load((const f32x4*)(src + (size_t)(k2 + r_ + 16 * i) * N + n2 + c4_ * 4)); v[i] = make_float4(t_[0], t_[1], t_[2], t_[3]); }
    }
    const int n = tid >> 2, kp = tid & 3;
    unsigned w[8];
#pragma unroll
    for (int i = 0; i < 8; ++i) w[i] = pk2(T[(kp * 16 + 2 * i) * 65 + n], T[(kp * 16 + 2 * i + 1) * 65 + n]);
    const int ng = n0 + n;
    int drow = ng;
    if (cmode == 1) drow = (ng >> 4) * 32 + (ng & 15);
    else if (cmode == 2) drow = (ng >> 4) * 32 + 16 + (ng & 15);
    uint4* dp = (uint4*)(cdst + (size_t)drow * cK + k0 + kp * 16);
    dp[0] = make_uint4(w[0], w[1], w[2], w[3]);
    dp[1] = make_uint4(w[4], w[5], w[6], w[7]);
    BAR_LDS();
  }
}

template <int WHICH>
DEV void phase_normmod(const Params& p, int bid, int nb) {
  const int lane = threadIdx.x & 63, gw = bid * 4 + (threadIdx.x >> 6), nw = nb * 4;
  const float* g = WHICH == 0 ? p.in[7] : p.in[8];
  const float* mod = (const float*)(p.ws + OFF_MOD);
  const int sh_off = WHICH == 0 ? 0 : 3072, sc_off = WHICH == 0 ? 1024 : 4096;
  bf16_t* dst = (bf16_t*)(p.ws + OFF_H);
#pragma unroll 3
  for (int t = gw; t < NTOK; t += nw) {
    const float* xp = WHICH == 0 ? xrow(p, t) : p.out + (size_t)t * D;
    const float* mm = mod + modidx(t) * 6144;
    float4 v[4];
    float ss = 0.f;
#pragma unroll
    for (int i = 0; i < 4; ++i) {
      v[i] = WHICH == 0 ? ldnt4(xp + (i * 64 + lane) * 4) : *(const float4*)(xp + (i * 64 + lane) * 4);
      ss += v[i].x * v[i].x + v[i].y * v[i].y + v[i].z * v[i].z + v[i].w * v[i].w;
    }
    ss = wave_sum(ss);
    const float rstd = rsqrtf(ss * (1.f / 1024.f) + 1e-6f);
#pragma unroll
    for (int i = 0; i < 4; ++i) {
      const int col = (i * 64 + lane) * 4;
      const float4 g4 = *(const float4*)(g + col);
      const float4 sc = *(const float4*)(mm + sc_off + col);
      const float4 sh = *(const float4*)(mm + sh_off + col);
      const float y0 = v[i].x * rstd * g4.x * (1.f + sc.x) + sh.x;
      const float y1 = v[i].y * rstd * g4.y * (1.f + sc.y) + sh.y;
      const float y2 = v[i].z * rstd * g4.z * (1.f + sc.z) + sh.z;
      const float y3 = v[i].w * rstd * g4.w * (1.f + sc.w) + sh.w;
      *(uint2*)(dst + (size_t)t * D + col) = make_uint2(pk2(y0, y1), pk2(y2, y3));
    }
  }
}

template <int MI>
DEV void gemm_tile_acc(f32x4 (&acc)[MI][4], const bf16_t* __restrict__ A, int lda, const bf16_t* __restrict__ Bt, int ldb,
                       int m0, int n0, int K, unsigned char* smem) {
  constexpr int AT = 2 * MI * 16 * 128, BT = 16384, STG = AT + BT;
  const int tid = threadIdx.x, lane = tid & 63, wid = tid >> 6, wr = wid >> 1, wc = wid & 1, fr = lane & 15, fq = lane >> 4;
  const int gkc = (tid & 7) ^ ((tid >> 4) & 7);
  const bf16_t* ga = A + (size_t)(m0 + (tid >> 3)) * lda + gkc * 8;
  const bf16_t* gb = Bt + (size_t)(n0 + (tid >> 3)) * ldb + gkc * 8;
  const int swz = (fr >> 1) & 7;
  const int nk = K >> 6;
#define GLDS_TILE(kt_, buf_) do { unsigned char* sb_ = smem + (buf_) * STG; const int k0_ = (kt_) * 64; \
    _Pragma("unroll") for (int i_ = 0; i_ < (2 * MI * 16) / 32; ++i_) \
      __builtin_amdgcn_global_load_lds((const unsigned*)(ga + (size_t)i_ * 32 * lda + k0_), (__attribute__((address_space(3))) unsigned*)(sb_ + (i_ * 256 + tid) * 16), 16, 0, 0); \
    _Pragma("unroll") for (int i_ = 0; i_ < 4; ++i_) \
      __builtin_amdgcn_global_load_lds((const unsigned*)(gb + (size_t)i_ * 32 * ldb + k0_), (__attribute__((address_space(3))) unsigned*)(sb_ + AT + (i_ * 256 + tid) * 16), 16, 0, 0); \
  } while (0)
  GLDS_TILE(0, 0);
  asm volatile("s_waitcnt vmcnt(0)" ::: "memory");
  __syncthreads();
  for (int kt = 0; kt < nk; ++kt) {
    if (kt + 1 < nk) GLDS_TILE(kt + 1, (kt + 1) & 1);
    const unsigned char* cur = smem + (kt & 1) * STG;
#pragma unroll
    for (int ks = 0; ks < 2; ++ks) {
      bf16x8 af[MI], bf[4];
      const int co = ((ks * 4 + fq) ^ swz) << 4;
#pragma unroll
      for (int mi = 0; mi < MI; ++mi) af[mi] = *(const bf16x8*)(cur + (wr * MI * 16 + mi * 16 + fr) * 128 + co);
#pragma unroll
      for (int ni = 0; ni < 4; ++ni) bf[ni] = *(const bf16x8*)(cur + AT + (wc * 64 + ni * 16 + fr) * 128 + co);
      __builtin_amdgcn_s_setprio(1);
#pragma unroll
      for (int mi = 0; mi < MI; ++mi)
#pragma unroll
        for (int ni = 0; ni < 4; ++ni) acc[mi][ni] = __builtin_amdgcn_mfma_f32_16x16x32_bf16(bf[ni], af[mi], acc[mi][ni], 0, 0, 0);
      __builtin_amdgcn_s_setprio(0);
    }
    asm volatile("s_waitcnt vmcnt(0)" ::: "memory");
    __syncthreads();
  }
#undef GLDS_TILE
}

template <int MI>
DEV void zero_acc(f32x4 (&acc)[MI][4]) {
#pragma unroll
  for (int i = 0; i < MI; ++i)
#pragma unroll
    for (int j = 0; j < 4; ++j) acc[i][j] = (f32x4){0.f, 0.f, 0.f, 0.f};
}

#ifndef DYN_TILES
#define DYN_TILES 0
#endif
DEV int grab_tile(const Params& p, int word, int* slot) {
#if DYN_TILES
  if (threadIdx.x == 0) *slot = (int)atomicAdd((unsigned*)(p.ws + OFF_CTL) + word, 1u);
  __syncthreads();
  const int t = *slot;
  __syncthreads();
  return t;
#else
  const int t = slot[1];
  __syncthreads();
  if (threadIdx.x == 0) slot[1] = t + gridDim.x;
  __syncthreads();
  return t;
#endif
}
DEV void reset_tiles(int* slot) { if (threadIdx.x == 0) slot[1] = blockIdx.x; __syncthreads(); }

#define EPI_COORDS const int lane = threadIdx.x & 63, wid = threadIdx.x >> 6, wr = wid >> 1, wc = wid & 1, fr = lane & 15, fq = lane >> 4

DEV void phase_gemm_in(const Params& p, unsigned char* smem, int* slot) {
  EPI_COORDS;
  const bf16_t* A = (const bf16_t*)(p.ws + OFF_H);
  const bf16_t* Bt = (const bf16_t*)(p.ws + OFF_WIN);
  float* urw = (float*)(p.ws + OFF_URW);
  float* una = (float*)(p.ws + OFF_UNA);
  bf16_t* gates = (bf16_t*)p.out;
  for (;;) {
    const int tile = grab_tile(p, 8, slot);
    if (tile >= 48 * 43) break;
    const int tm = tile % 48, tn = tile / 48, m0 = tm * 128, n0 = tn * 128;
    f32x4 acc[4][4];
    zero_acc<4>(acc);
    gemm_tile_acc<4>(acc, A, D, Bt, D, m0, n0, D, smem);
    if (n0 >= 1920 && n0 < 3456) {
      const int sec = (n0 - 1920) >> 9;
      const int h = (((n0 - 1920) & 511) >> 6) + wc;
      bf16_t* qb = (bf16_t*)(p.ws + OFF_QB); bf16_t* kb = (bf16_t*)(p.ws + OFF_KB); bf16_t* vT = (bf16_t*)(p.ws + OFF_VT);
#pragma unroll
      for (int mi = 0; mi < 4; ++mi) {
        const int row = m0 + wr * 64 + mi * 16 + fr;
        if (sec < 2) {
          float ss = 0.f;
#pragma unroll
          for (int ni = 0; ni < 4; ++ni) { const f32x4 v = acc[mi][ni]; ss += v[0] * v[0] + v[1] * v[1] + v[2] * v[2] + v[3] * v[3]; }
          ss += __shfl_xor(ss, 16); ss += __shfl_xor(ss, 32);
          const float rs = rsqrtf(ss * (1.f / 64.f) + 1e-6f) * (sec == 0 ? 0.125f : 1.f);
          const float* gv = sec == 0 ? p.in[23] : p.in[24];
          bf16_t* dstb = (sec == 0 ? qb : kb) + (size_t)row * 512 + h * 64;
#pragma unroll
          for (int ni = 0; ni < 4; ++ni) {
            const int d = ni * 16 + fq * 4;
            const f32x4 x = acc[mi][ni] * rs * (*(const f32x4*)(gv + d));
            *(uint2*)(dstb + d) = make_uint2(pk2(x[0], x[1]), pk2(x[2], x[3]));
            if (sec == 1 && row < NCTX) __builtin_nontemporal_store(x, (f32x4*)(p.out + OUT_K + (size_t)row * 512 + h * 64 + d));
          }
        } else {
#pragma unroll
          for (int ni = 0; ni < 4; ++ni) {
            const int d = ni * 16 + fq * 4;
            const f32x4 x = acc[mi][ni];
            if (row < NCTX) __builtin_nontemporal_store(x, (f32x4*)(p.out + OUT_V + (size_t)row * 512 + h * 64 + d));
#pragma unroll
            for (int e2 = 0; e2 < 4; ++e2) *(bf16_t*)(smem + (wc * 64 + d + e2) * 272 + (wr * 64 + mi * 16 + fr) * 2) = f2bf(x[e2]);
          }
        }
      }
      if (sec == 2) {
        __syncthreads();
        const int dd = threadIdx.x >> 1, hf = threadIdx.x & 1;
        const int hb = ((n0 - 1920) & 511) >> 6;
        bf16_t* vrow = vT + (size_t)(hb * 64 + dd) * NTOK + m0 + hf * 64;
#pragma unroll
        for (int j = 0; j < 8; ++j) *(uint4*)(vrow + j * 8) = *(const uint4*)(smem + dd * 272 + hf * 128 + j * 16);
        __syncthreads();
      }
    } else {
#pragma unroll
      for (int mi = 0; mi < 4; ++mi) {
        const int row = m0 + wr * 64 + mi * 16 + fr;
#pragma unroll
        for (int ni = 0; ni < 4; ++ni) {
          const int col = n0 + wc * 64 + ni * 16 + fq * 4;
          const f32x4 v = acc[mi][ni];
          if (n0 < 1920) *(f32x4*)(urw + (size_t)row * 1920 + col) = v;
          else *(uint2*)(gates + (size_t)row * 2048 + (col - 3456)) = make_uint2(pk2(sigmoidf_(v[0]), sigmoidf_(v[1])), pk2(sigmoidf_(v[2]), sigmoidf_(v[3])));
        }
      }
    }
  }
}

DEV void phase_gemm_merge(const Params& p, unsigned char* smem, int* slot) {
  EPI_COORDS;
  const bf16_t* orw = (const bf16_t*)(p.ws + OFF_ORW);
  const bf16_t* ona = (const bf16_t*)(p.ws + OFF_ONA);
  const bf16_t* w1 = (const bf16_t*)(p.ws + OFF_WORW);
  const bf16_t* w2 = (const bf16_t*)(p.ws + OFF_WONA);
  const bf16_t* gates = (const bf16_t*)p.out;
  bf16_t* merged = (bf16_t*)(p.ws + OFF_MERGED);
  float* mtmp = (float*)(p.ws + OFF_MERGED + 16777216);
  for (;;) {
    const int tile = grab_tile(p, 9, slot);
    if (tile >= 64 * 8) break;
    const int tm = tile % 64, tn = tile / 64, m0 = tm * 96, n0 = tn * 128;
    f32x4 acc[3][4];
    zero_acc<3>(acc);
    gemm_tile_acc<3>(acc, orw, RW, w1, RW, m0, n0, RW, smem);
#pragma unroll
    for (int mi = 0; mi < 3; ++mi) {
      const int row = m0 + wr * 48 + mi * 16 + fr;
#pragma unroll
      for (int ni = 0; ni < 4; ++ni) {
        const int col = n0 + wc * 64 + ni * 16 + fq * 4;
        const uint2 g = *(const uint2*)(gates + (size_t)row * 2048 + col);
        f32x4 r;
        r[0] = acc[mi][ni][0] * bf2f((unsigned short)(g.x & 0xffff));
        r[1] = acc[mi][ni][1] * bf2f((unsigned short)(g.x >> 16));
        r[2] = acc[mi][ni][2] * bf2f((unsigned short)(g.y & 0xffff));
        r[3] = acc[mi][ni][3] * bf2f((unsigned short)(g.y >> 16));
        *(f32x4*)(mtmp + (size_t)row * D + col) = r;
      }
    }
    zero_acc<3>(acc);
    gemm_tile_acc<3>(acc, ona, RW, w2, RW, m0, n0, RW, smem);
#pragma unroll
    for (int mi = 0; mi < 3; ++mi) {
      const int row = m0 + wr * 48 + mi * 16 + fr;
#pragma unroll
      for (int ni = 0; ni < 4; ++ni) {
        const int col = n0 + wc * 64 + ni * 16 + fq * 4;
        const uint2 g = *(const uint2*)(gates + (size_t)row * 2048 + 1024 + col);
        const f32x4 mg = *(const f32x4*)(mtmp + (size_t)row * D + col);
        const float r0 = mg[0] + acc[mi][ni][0] * bf2f((unsigned short)(g.x & 0xffff));
        const float r1 = mg[1] + acc[mi][ni][1] * bf2f((unsigned short)(g.x >> 16));
        const float r2 = mg[2] + acc[mi][ni][2] * bf2f((unsigned short)(g.y & 0xffff));
        const float r3 = mg[3] + acc[mi][ni][3] * bf2f((unsigned short)(g.y >> 16));
        *(uint2*)(merged + (size_t)row * D + col) = make_uint2(pk2(r0, r1), pk2(r2, r3));
      }
    }
  }
}

DEV void phase_gemm_out(const Params& p, unsigned char* smem, int* slot) {
  EPI_COORDS;
  const bf16_t* A = (const bf16_t*)(p.ws + OFF_MERGED);
  const bf16_t* Bt = (const bf16_t*)(p.ws + OFF_WOUT);
  const float* mod = (const float*)(p.ws + OFF_MOD);
  for (;;) {
    const int tile = grab_tile(p, 10, slot);
    if (tile >= 64 * 8) break;
    const int tm = tile % 64, tn = tile / 64, m0 = tm * 96, n0 = tn * 128;
    f32x4 acc[3][4];
    zero_acc<3>(acc);
    gemm_tile_acc<3>(acc, A, D, Bt, D, m0, n0, D, smem);
#pragma unroll
    for (int mi = 0; mi < 3; ++mi) {
      const int row = m0 + wr * 48 + mi * 16 + fr;
      const float* xp = xrow(p, row);
      const float* g1 = mod + modidx(row) * 6144 + 2048;
#pragma unroll
      for (int ni = 0; ni < 4; ++ni) {
        const int col = n0 + wc * 64 + ni * 16 + fq * 4;
        const f32x4 x = __builtin_nontemporal_load((const f32x4*)(xp + col));
        const f32x4 g = *(const f32x4*)(g1 + col);
        *(f32x4*)(p.out + (size_t)row * D + col) = x + g * acc[mi][ni];
      }
    }
  }
}

DEV void phase_gemm_ffn_up(const Params& p, unsigned char* smem, int* slot) {
  EPI_COORDS;
  const bf16_t* A = (const bf16_t*)(p.ws + OFF_H);
  const bf16_t* Bt = (const bf16_t*)(p.ws + OFF_W13);
  bf16_t* hid = (bf16_t*)(p.ws + OFF_HID);
  for (;;) {
    const int tile = grab_tile(p, 11, slot);
    if (tile >= 48 * 44) break;
    const int tm = tile % 48, tn = tile / 48, m0 = tm * 128, n0 = tn * 128;
    f32x4 acc[4][4];
    zero_acc<4>(acc);
    gemm_tile_acc<4>(acc, A, D, Bt, D, m0, n0, D, smem);
#pragma unroll
    for (int mi = 0; mi < 4; ++mi) {
      const int row = m0 + wr * 64 + mi * 16 + fr;
#pragma unroll
      for (int gp = 0; gp < 2; ++gp) {
        const int hcol = ((n0 + wc * 64) >> 1) + gp * 16 + fq * 4;
        const f32x4 a = acc[mi][2 * gp], b = acc[mi][2 * gp + 1];
        float r[4];
#pragma unroll
        for (int e = 0; e < 4; ++e) r[e] = a[e] * sigmoidf_(a[e]) * b[e];
        *(uint2*)(hid + (size_t)row * FF + hcol) = make_uint2(pk2(r[0], r[1]), pk2(r[2], r[3]));
      }
    }
  }
}

DEV void phase_gemm_ffn_down(const Params& p, unsigned char* smem, int* slot) {
  EPI_COORDS;
  const bf16_t* A = (const bf16_t*)(p.ws + OFF_HID);
  const bf16_t* Bt = (const bf16_t*)(p.ws + OFF_W2);
  const float* mod = (const float*)(p.ws + OFF_MOD);
  for (;;) {
    const int tile = grab_tile(p, 12, slot);
    if (tile >= 64 * 8) break;
    const int tm = tile % 64, tn = tile / 64, m0 = tm * 96, n0 = tn * 128;
    f32x4 acc[3][4];
    zero_acc<3>(acc);
    gemm_tile_acc<3>(acc, A, FF, Bt, FF, m0, n0, FF, smem);
#pragma unroll
    for (int mi = 0; mi < 3; ++mi) {
      const int row = m0 + wr * 48 + mi * 16 + fr;
      const float* g2 = mod + modidx(row) * 6144 + 5120;
#pragma unroll
      for (int ni = 0; ni < 4; ++ni) {
        const int col = n0 + wc * 64 + ni * 16 + fq * 4;
        float* op = p.out + (size_t)row * D + col;
        const f32x4 x = __builtin_nontemporal_load((const f32x4*)op);
        const f32x4 g = *(const f32x4*)(g2 + col);
        __builtin_nontemporal_store(x + g * acc[mi][ni], (f32x4*)op);
      }
    }
  }
}

DEV void phase_qkprep(const Params& p, unsigned char* smem, int item_) {
  const int tid = threadIdx.x;
  bf16_t* Vs = (bf16_t*)smem;
  bf16_t* qb = (bf16_t*)(p.ws + OFF_QB);
  bf16_t* kb = (bf16_t*)(p.ws + OFF_KB);
  bf16_t* vT = (bf16_t*)(p.ws + OFF_VT);
  bf16_t* ckb = (bf16_t*)(p.ws + OFF_CKB);
  bf16_t* cvT = (bf16_t*)(p.ws + OFF_CVT);
  const float* una = (const float*)(p.ws + OFF_UNA);
  const int tok = tid >> 2, part = tid & 3;
  for (int item = item_; item < item_ + 1; ++item) {
    if (item < 768) {
      const int tt = item >> 3, h = item & 7, t0 = tt * 64, t = t0 + tok;
      const float* src = una + (size_t)t * 1536 + h * 64 + part * 16;
      {
        float x[16]; float ss = 0.f;
#pragma unroll
        for (int i = 0; i < 4; ++i) { const float4 v = *(const float4*)(src + i * 4); x[4 * i] = v.x; x[4 * i + 1] = v.y; x[4 * i + 2] = v.z; x[4 * i + 3] = v.w; }
#pragma unroll
        for (int i = 0; i < 16; ++i) ss += x[i] * x[i];
        ss += __shfl_xor(ss, 1); ss += __shfl_xor(ss, 2);
        const float rs = rsqrtf(ss * (1.f / 64.f) + 1e-6f) * 0.125f;
        unsigned w[8];
#pragma unroll
        for (int i = 0; i < 8; ++i) w[i] = pk2(x[2 * i] * rs * p.in[23][part * 16 + 2 * i], x[2 * i + 1] * rs * p.in[23][part * 16 + 2 * i + 1]);
        uint4* dp = (uint4*)(qb + (size_t)t * 512 + h * 64 + part * 16);
        dp[0] = make_uint4(w[0], w[1], w[2], w[3]); dp[1] = make_uint4(w[4], w[5], w[6], w[7]);
      }
      {
        float x[16]; float ss = 0.f;
#pragma unroll
        for (int i = 0; i < 4; ++i) { const float4 v = *(const float4*)(src + 512 + i * 4); x[4 * i] = v.x; x[4 * i + 1] = v.y; x[4 * i + 2] = v.z; x[4 * i + 3] = v.w; }
#pragma unroll
        for (int i = 0; i < 16; ++i) ss += x[i] * x[i];
        ss += __shfl_xor(ss, 1); ss += __shfl_xor(ss, 2);
        const float rs = rsqrtf(ss * (1.f / 64.f) + 1e-6f);
#pragma unroll
        for (int i = 0; i < 16; ++i) x[i] = x[i] * rs * p.in[24][part * 16 + i];
        if (t < NCTX) {
          float4* op = (float4*)(p.out + OUT_K + (size_t)t * 512 + h * 64 + part * 16);
#pragma unroll
          for (int i = 0; i < 4; ++i) op[i] = make_float4(x[4 * i], x[4 * i + 1], x[4 * i + 2], x[4 * i + 3]);
        }
        unsigned w[8];
#pragma unroll
        for (int i = 0; i < 8; ++i) w[i] = pk2(x[2 * i], x[2 * i + 1]);
        uint4* dp = (uint4*)(kb + (size_t)t * 512 + h * 64 + part * 16);
        dp[0] = make_uint4(w[0], w[1], w[2], w[3]); dp[1] = make_uint4(w[4], w[5], w[6], w[7]);
      }
      {
        float x[16];
#pragma unroll
        for (int i = 0; i < 4; ++i) { const float4 v = *(const float4*)(src + 1024 + i * 4); x[4 * i] = v.x; x[4 * i + 1] = v.y; x[4 * i + 2] = v.z; x[4 * i + 3] = v.w; }
        if (t < NCTX) {
          float4* op = (float4*)(p.out + OUT_V + (size_t)t * 512 + h * 64 + part * 16);
#pragma unroll
          for (int i = 0; i < 4; ++i) op[i] = make_float4(x[4 * i], x[4 * i + 1], x[4 * i + 2], x[4 * i + 3]);
        }
#pragma unroll
        for (int i = 0; i < 16; ++i) Vs[tok * 72 + part * 16 + i] = f2bf(x[i]);
      }
      __syncthreads();
      {
        const int d = tid >> 2;
        unsigned w[8];
#pragma unroll
        for (int i = 0; i < 8; ++i) w[i] = (unsigned)Vs[(part * 16 + 2 * i) * 72 + d] | ((unsigned)Vs[(part * 16 + 2 * i + 1) * 72 + d] << 16);
        uint4* dp = (uint4*)(vT + (size_t)(h * 64 + d) * NTOK + t0 + part * 16);
        dp[0] = make_uint4(w[0], w[1], w[2], w[3]); dp[1] = make_uint4(w[4], w[5], w[6], w[7]);
      }
      __syncthreads();
    } else {
      const int ci = item - 768, b = ci >> 5, rem = ci & 31, tt = rem >> 3, h = rem & 7, t0 = tt * 64, t = t0 + tok;
      const size_t sidx = (size_t)(b * 256 + t) * 512 + h * 64 + part * 16;
      {
        float x[16];
#pragma unroll
        for (int i = 0; i < 4; ++i) { const float4 v = *(const float4*)(p.in[3] + sidx + i * 4); x[4 * i] = v.x; x[4 * i + 1] = v.y; x[4 * i + 2] = v.z; x[4 * i + 3] = v.w; }
        unsigned w[8];
#pragma unroll
        for (int i = 0; i < 8; ++i) w[i] = pk2(x[2 * i], x[2 * i + 1]);
        uint4* dp = (uint4*)(ckb + sidx);
        dp[0] = make_uint4(w[0], w[1], w[2], w[3]); dp[1] = make_uint4(w[4], w[5], w[6], w[7]);
      }
      {
        float x[16];
#pragma unroll
        for (int i = 0; i < 4; ++i) { const float4 v = *(const float4*)(p.in[4] + sidx + i * 4); x[4 * i] = v.x; x[4 * i + 1] = v.y; x[4 * i + 2] = v.z; x[4 * i + 3] = v.w; }
#pragma unroll
        for (int i = 0; i < 16; ++i) Vs[tok * 72 + part * 16 + i] = f2bf(x[i]);
      }
      __syncthreads();
      {
        const int d = tid >> 2;
        unsigned w[8];
#pragma unroll
        for (int i = 0; i < 8; ++i) w[i] = (unsigned)Vs[(part * 16 + 2 * i) * 72 + d] | ((unsigned)Vs[(part * 16 + 2 * i + 1) * 72 + d] << 16);
        uint4* dp = (uint4*)(cvT + (size_t)((b * 8 + h) * 64 + d) * 256 + t0 + part * 16);
        dp[0] = make_uint4(w[0], w[1], w[2], w[3]); dp[1] = make_uint4(w[4], w[5], w[6], w[7]);
      }
      __syncthreads();
    }
  }
}

DEV float* ops_arr(const Params& p, int i) { return (float*)(p.ws + OFF_OPS + (size_t)i * OPS_ARR); }

DEV f32x4 shiftvec(f32x4 cur, f32x4 hal, f32x4 mu0, f32x4 mu1, int fr) {
  f32x4 prev, next;
#pragma unroll
  for (int i = 0; i < 4; ++i) {
    prev[i] = dpp_mov<0x111>(cur[i]);
    next[i] = dpp_mov<0x101>(cur[i]);
  }
  if (fr == 0) prev = hal;
  if (fr == 15) next = hal;
  return cur + mu0 * (prev - cur) + mu1 * (next - cur);
}
DEV float quad_sum(float x) { x += __shfl_xor(x, 16); x += __shfl_xor(x, 32); return x; }
DEV f32x4 ld4(const float* p) { return *(const f32x4*)p; }
DEV f32x4 ld4nt(const float* p) { return __builtin_nontemporal_load((const f32x4*)p); }

constexpr int LROWB = 392;
template <bool HALF>
DEV void phase_rwprep(const Params& p, unsigned char* smem, int item_) {
  const int tid = threadIdx.x, lane = tid & 63, w = tid >> 6, fr = lane & 15, fq = lane >> 4;
  bf16_t* Lb = (bf16_t*)smem;
  const float* urw = (const float*)(p.ws + OFF_URW);
  const float* mu = p.in[12];
  bf16_t* bonus = (bf16_t*)(p.ws + OFF_BG);
  bf16_t* gate = (bf16_t*)(p.ws + OFF_BG + 6291456);
  const bf16_t* WUPT = (const bf16_t*)(p.ws + OFF_LORA);
  const bf16_t* AUPT = WUPT + 65536;
  const bf16_t* GUPT = WUPT + 131072;
  float* o_r = ops_arr(p, 0); float* o_v = ops_arr(p, 1); float* o_a = ops_arr(p, 2);
  for (int item = item_; item < item_ + 1; ++item) {
    const int t0 = HALF ? (256 + (item >> 2)) * 16 : (item >> 1) * 16;
    const int h = HALF ? (item & 3) * 2 + (w >> 1) : (item & 1) * 4 + w;
    const int ni_lo = HALF ? (w & 1) * 2 : 0, ni_hi = HALF ? ni_lo + 2 : 4;
    float* xs = (float*)(smem + 16384);
    int s_lo, s_hi;
    if (t0 < NCTX) { s_lo = t0 & ~255; s_hi = s_lo + 256; } else { s_lo = NCTX + ((t0 - NCTX) & ~1023); s_hi = s_lo + 1024; }
    {
      const int tl = tid >> 4, g16 = tid & 15, tt = t0 + tl;
      const float* up = urw + (size_t)tt * RWC + 1536;
      const bool hp = tt > s_lo, hn = tt + 1 < s_hi;
#pragma unroll
      for (int j = 0; j < 6; ++j) {
        const int col = (g16 + 16 * j) * 4;
        const f32x4 c = ld4(up + col);
        const f32x4 z = (f32x4){0.f, 0.f, 0.f, 0.f};
        const f32x4 pv = hp ? ld4(up - RWC + col) : z;
        const f32x4 nx = hn ? ld4(up + RWC + col) : z;
        const f32x4 m0 = ld4(mu + 1536 + col), m1 = ld4(mu + RWC + 1536 + col);
        const f32x4 us = c + m0 * (pv - c) + m1 * (nx - c);
        const int kind = col >> 7;
        float o4[4];
#pragma unroll
        for (int i = 0; i < 4; ++i) o4[i] = kind == 0 ? (1.f - 2.f / (1.f + __expf(2.f * us[i]))) : (kind == 1 ? us[i] : sigmoidf_(us[i]));
        *(uint2*)(Lb + tl * LROWB + col) = make_uint2(pk2(o4[0], o4[1]), pk2(o4[2], o4[3]));
      }
    }
    __syncthreads();
    const int t = t0 + fr;
    const bool lo_ok = (fr == 0) && (t > s_lo), hi_ok = (fr == 15) && (t + 1 < s_hi);
    const float* urow = urw + (size_t)t * RWC;
    const float* hrow = lo_ok ? urow - RWC : (hi_ok ? urow + RWC : urow);
    const bool hal_ok = lo_ok || hi_ok;
    const f32x4 z4 = (f32x4){0.f, 0.f, 0.f, 0.f};
    float ss = 0.f;
#pragma unroll
    for (int ni = ni_lo; ni < ni_hi; ++ni) {
      const int c = h * 64 + ni * 16 + fq * 4;
      const f32x4 kx = shiftvec(ld4(urow + 512 + c), hal_ok ? ld4(hrow + 512 + c) : z4, ld4(mu + 512 + c), ld4(mu + RWC + 512 + c), fr) * ld4(p.in[18] + c);
      ss += kx[0] * kx[0] + kx[1] * kx[1] + kx[2] * kx[2] + kx[3] * kx[3];
    }
    ss = quad_sum(ss);
    if (HALF) { if (fq == 0) xs[w * 16 + fr] = ss; __syncthreads(); ss += xs[(w ^ 1) * 16 + fr]; }
    const float rn = rsqrtf(ss + 1e-12f);
    float bs = 0.f;
#pragma unroll 1
    for (int ni = ni_lo; ni < ni_hi; ++ni) {
      const int c = h * 64 + ni * 16 + fq * 4;
      const size_t o = (size_t)t * 512 + c;
      const f32x4 r4 = shiftvec(ld4nt(urow + c), hal_ok ? ld4nt(hrow + c) : z4, ld4(mu + c), ld4(mu + RWC + c), fr);
      const f32x4 k4 = shiftvec(ld4nt(urow + 512 + c), hal_ok ? ld4nt(hrow + 512 + c) : z4, ld4(mu + 512 + c), ld4(mu + RWC + 512 + c), fr);
      const f32x4 v4 = shiftvec(ld4nt(urow + 1024 + c), hal_ok ? ld4nt(hrow + 1024 + c) : z4, ld4(mu + 1024 + c), ld4(mu + RWC + 1024 + c), fr);
      const f32x4 kk4 = k4 * ld4(p.in[18] + c) * rn;
      *(f32x4*)(o_r + o) = r4; *(f32x4*)(o_v + o) = v4; *(f32x4*)(o_a + o) = -kk4;
      const f32x4 ka = ld4(p.in[19] + c);
      f32x4 bacc = z4;
#pragma unroll
      for (int e = 0; e < 2; ++e) {
        float* o_k = ops_arr(p, 5 + e); float* o_b = ops_arr(p, 7 + e); float* o_w = ops_arr(p, 3 + e);
        f32x4 acc = z4, acw = z4;
#pragma unroll
        for (int ks = 0; ks < 2; ++ks) {
          const bf16x8 wa = *(const bf16x8*)(AUPT + (size_t)(e * 512 + h * 64 + ni * 16 + fr) * 64 + ks * 32 + fq * 8);
          const bf16x8 la = *(const bf16x8*)(Lb + fr * LROWB + 128 + e * 64 + ks * 32 + fq * 8);
          acc = __builtin_amdgcn_mfma_f32_16x16x32_bf16(wa, la, acc, 0, 0, 0);
          const bf16x8 ww = *(const bf16x8*)(WUPT + (size_t)(e * 512 + h * 64 + ni * 16 + fr) * 64 + ks * 32 + fq * 8);
          const bf16x8 lw = *(const bf16x8*)(Lb + fr * LROWB + e * 64 + ks * 32 + fq * 8);
          acw = __builtin_amdgcn_mfma_f32_16x16x32_bf16(ww, lw, acw, 0, 0, 0);
        }
        const f32x4 a0 = ld4(p.in[15] + e * 512 + c), w0 = ld4(p.in[13] + e * 512 + c);
        f32x4 kd, bb, dec;
#pragma unroll
        for (int i = 0; i < 4; ++i) {
          const float ic = sigmoidf_(a0[i] + acc[i]);
          kd[i] = k4[i] * (1.f + (ic - 1.f) * ka[i]);
          bb[i] = kk4[i] * ic;
          const float z = w0[i] + acw[i];
          const float sp = fmaxf(-z, 0.f) + __logf(1.f + __expf(-fabsf(z)));
          dec[i] = __expf(-__expf(-sp - 0.5f));
        }
        bacc += kd;
        *(f32x4*)(o_k + o) = kd; *(f32x4*)(o_b + o) = bb; *(f32x4*)(o_w + o) = dec;
      }
      const f32x4 rk = ld4(p.in[20] + c);
#pragma unroll
      for (int i = 0; i < 4; ++i) bs += r4[i] * 0.5f * bacc[i] * rk[i];
      f32x4 acc = z4;
#pragma unroll
      for (int ks = 0; ks < 4; ++ks) {
        const bf16x8 wg = *(const bf16x8*)(GUPT + (size_t)(h * 64 + ni * 16 + fr) * 128 + ks * 32 + fq * 8);
        const bf16x8 lg = *(const bf16x8*)(Lb + fr * LROWB + 256 + ks * 32 + fq * 8);
        acc = __builtin_amdgcn_mfma_f32_16x16x32_bf16(wg, lg, acc, 0, 0, 0);
      }
      *(uint2*)(gate + o) = make_uint2(pk2(acc[0], acc[1]), pk2(acc[2], acc[3]));
    }
    bs = quad_sum(bs);
    if (HALF) { if (fq == 0) xs[64 + w * 16 + fr] = bs; __syncthreads(); bs += xs[64 + (w ^ 1) * 16 + fr]; }
#pragma unroll
    for (int ni = ni_lo; ni < ni_hi; ++ni) {
      const size_t o = (size_t)t * 512 + h * 64 + ni * 16 + fq * 4;
      const f32x4 v4 = *(const f32x4*)(o_v + o);
      *(uint2*)(bonus + o) = make_uint2(pk2(bs * v4[0], bs * v4[1]), pk2(bs * v4[2], bs * v4[3]));
    }
    __syncthreads();
  }
}

DEV void phase_prep(const Params& p, unsigned char* smem, int* s_item, int rep) {
  unsigned* counter = (unsigned*)(p.ws + OFF_CTL) + 16 + rep;
  for (;;) {
    if (threadIdx.x == 0) *s_item = (int)atomicAdd(counter, 1u);
    __syncthreads();
    const int item = *s_item;
    __syncthreads();
    if (item >= 1024 + 64) break;
    if (item < 512) phase_rwprep<false>(p, smem, item);
    else if (item < 1024) phase_rwprep<true>(p, smem, item - 512);
    else phase_qkprep(p, smem, item - 256);
  }
}

constexpr int TC = 16;
typedef float f32x2 __attribute__((ext_vector_type(2)));
template <int EPL, int R, int PD>
DEV void scan_item(const Params& p, unsigned char* smem, int seq, int h, int dir, int rg) {
  constexpr int LPR = 64 / EPL, RPW = 64 / LPR, RPB = 4 * RPW * R, NV = RPB / 16, NP = EPL / 2;
  constexpr int STG = 20480 + 16 * RPB * 4, YOFF = 2 * STG, YSZ = 16 * RPB * 4;
  const int tid = threadIdx.x, lane = tid & 63, w = tid >> 6, riw = lane / LPR, kq = lane % LPR;
  const int T = seq < 16 ? 256 : 1024;
  const int tok0 = seq < 16 ? seq * 256 : NCTX + (seq - 16) * 1024;
  const int vrow_l = (w * RPW + riw) * R;
  const int vrow = rg * RPB + vrow_l;
  f32x2 S[R][NP];
#pragma unroll
  for (int rr = 0; rr < R; ++rr) {
    if (seq >= 16) {
      const float* sp = p.in[2] + ((size_t)(((seq - 16) * 2 + dir) * 8 + h) * 64 + vrow + rr) * 64 + kq * EPL;
#pragma unroll
      for (int i = 0; i < NP; ++i) S[rr][i] = *(const f32x2*)(sp + 2 * i);
    } else {
#pragma unroll
      for (int i = 0; i < NP; ++i) S[rr][i] = (f32x2){0.f, 0.f};
    }
  }
  const int lstep = tid >> 4, l16 = tid & 15;
  const float* pr = ops_arr(p, 0) + h * 64 + l16 * 4;
  const float* pw = ops_arr(p, 3 + dir) + h * 64 + l16 * 4;
  const float* pk = ops_arr(p, 5 + dir) + h * 64 + l16 * 4;
  const float* pa = ops_arr(p, 2) + h * 64 + l16 * 4;
  const float* pb = ops_arr(p, 7 + dir) + h * 64 + l16 * 4;
  const float* pv = ops_arr(p, 1) + h * 64 + rg * RPB + l16;
  float* yout = (float*)(p.ws + (dir ? OFF_YB : OFF_YF)) + h * 64 + rg * RPB + l16;
  const int nc = T / TC;
  float4 g_r, g_w, g_k, g_a, g_b; float rv[NV];
#define gload(c) do { const int ts_ = (c) * TC + lstep; const size_t t_ = (size_t)(tok0 + (dir ? T - 1 - ts_ : ts_)) * 512; \
    if (R == 4) { g_r = ldnt4(pr + t_); g_w = ldnt4(pw + t_); g_k = ldnt4(pk + t_); g_a = ldnt4(pa + t_); g_b = ldnt4(pb + t_); } else { \
    g_r = *(const float4*)(pr + t_); g_w = *(const float4*)(pw + t_); g_k = *(const float4*)(pk + t_); \
    g_a = *(const float4*)(pa + t_); g_b = *(const float4*)(pb + t_); } \
    _Pragma("unroll") for (int q_ = 0; q_ < NV; ++q_) rv[q_] = pv[t_ + 16 * q_]; } while (0)
#define ywrite(c) do { const float* yb_ = (const float*)(smem + YOFF + ((c) & 1) * YSZ); const int ts_ = (c) * TC + lstep; \
    const size_t t_ = (size_t)(tok0 + (dir ? T - 1 - ts_ : ts_)) * 512; \
    _Pragma("unroll") for (int q_ = 0; q_ < NV; ++q_) yout[t_ + 16 * q_] = yb_[lstep * RPB + l16 + 16 * q_]; } while (0)
  gload(0);
  for (int c = 0; c < nc; ++c) {
    unsigned char* st = smem + (c & 1) * STG;
    *(float4*)(st + 0 * 4096 + lstep * 256 + l16 * 16) = g_r;
    *(float4*)(st + 1 * 4096 + lstep * 256 + l16 * 16) = g_w;
    *(float4*)(st + 2 * 4096 + lstep * 256 + l16 * 16) = g_k;
    *(float4*)(st + 3 * 4096 + lstep * 256 + l16 * 16) = g_a;
    *(float4*)(st + 4 * 4096 + lstep * 256 + l16 * 16) = g_b;
#pragma unroll
    for (int q = 0; q < NV; ++q) *(float*)(st + 20480 + (lstep * RPB + l16 + 16 * q) * 4) = rv[q];
    __syncthreads();
    if (c > 0) ywrite(c - 1);
    if (c + 1 < nc) gload(c + 1);
    float* ybw = (float*)(smem + YOFF + (c & 1) * YSZ);
    constexpr int NS = PD + 1;
    f32x2 o_r[NS][NP], o_w[NS][NP], o_k[NS][NP], o_a[NS][NP], o_b[NS][NP]; float o_v[NS][R];
    float ykeep[R][TC / LPR];
#define LDOPS(bi, s_) do { \
      _Pragma("unroll") for (int i_ = 0; i_ < NP; ++i_) { \
        o_r[bi][i_] = *(const f32x2*)(st + 0 * 4096 + (s_) * 256 + kq * EPL * 4 + i_ * 8); \
        o_w[bi][i_] = *(const f32x2*)(st + 1 * 4096 + (s_) * 256 + kq * EPL * 4 + i_ * 8); \
        o_k[bi][i_] = *(const f32x2*)(st + 2 * 4096 + (s_) * 256 + kq * EPL * 4 + i_ * 8); \
        o_a[bi][i_] = *(const f32x2*)(st + 3 * 4096 + (s_) * 256 + kq * EPL * 4 + i_ * 8); \
        o_b[bi][i_] = *(const f32x2*)(st + 4 * 4096 + (s_) * 256 + kq * EPL * 4 + i_ * 8); } \
      _Pragma("unroll") for (int rr_ = 0; rr_ < R; ++rr_) o_v[bi][rr_] = *(const float*)(st + 20480 + ((s_) * RPB + vrow_l + rr_) * 4); } while (0)
#pragma unroll
    for (int s = 0; s < PD; ++s) LDOPS(s, s);
#pragma unroll
    for (int s = 0; s < TC; ++s) {
      const int bi = s % NS;
      if (s + PD < TC) LDOPS((s + PD) % NS, s + PD);
#pragma unroll
      for (int rr = 0; rr < R; ++rr) {
        const f32x2 vv2 = (f32x2){o_v[bi][rr], o_v[bi][rr]};
        f32x2 pa2 = S[rr][0] * o_a[bi][0];
        f32x2 tt[NP];
        tt[0] = S[rr][0] * o_w[bi][0] + vv2 * o_k[bi][0];
#pragma unroll
        for (int i = 1; i < NP; ++i) { pa2 += S[rr][i] * o_a[bi][i]; tt[i] = S[rr][i] * o_w[bi][i] + vv2 * o_k[bi][i]; }
        float sa = pa2[0] + pa2[1];
        sa += dpp_mov<0xB1>(sa); sa += dpp_mov<0x4E>(sa); sa += dpp_mov<0x141>(sa);
        if (LPR == 16) sa += dpp_mov<0x140>(sa);
        const f32x2 sa2 = (f32x2){sa, sa};
        f32x2 py = (f32x2){0.f, 0.f};
#pragma unroll
        for (int i = 0; i < NP; ++i) { S[rr][i] = sa2 * o_b[bi][i] + tt[i]; py += S[rr][i] * o_r[bi][i]; }
        float y = py[0] + py[1];
        y += dpp_mov<0xB1>(y); y += dpp_mov<0x4E>(y); y += dpp_mov<0x141>(y);
        if (LPR == 16) y += dpp_mov<0x140>(y);
        if ((s % LPR) == 0) ykeep[rr][s / LPR] = y; else ykeep[rr][s / LPR] = (kq == (s % LPR)) ? y : ykeep[rr][s / LPR];
      }
    }
#undef LDOPS
#pragma unroll
    for (int rr = 0; rr < R; ++rr)
#pragma unroll
      for (int q = 0; q < TC / LPR; ++q) ybw[(q * LPR + kq) * RPB + vrow_l + rr] = ykeep[rr][q];
  }
  __syncthreads();
  ywrite(nc - 1);
  if (seq < 16) {
#pragma unroll
    for (int rr = 0; rr < R; ++rr) {
      float* so = p.out + OUT_STATE + ((size_t)((seq * 2 + dir) * 8 + h) * 64 + vrow + rr) * 64 + kq * EPL;
#pragma unroll
      for (int i = 0; i < NP; ++i) *(f32x2*)(so + 2 * i) = S[rr][i];
    }
  }
  __syncthreads();
#undef gload
#undef ywrite
}

DEV void attn_wave_item(const Params& p, int witem) {
  const int lane = threadIdx.x & 63, fr = lane & 15, fq = lane >> 4;
  const bf16_t* qb = (const bf16_t*)(p.ws + OFF_QB);
  const bf16_t* kb = (const bf16_t*)(p.ws + OFF_KB);
  const bf16_t* vT = (const bf16_t*)(p.ws + OFF_VT);
  const bf16_t* ckb = (const bf16_t*)(p.ws + OFF_CKB);
  const bf16_t* cvT = (const bf16_t*)(p.ws + OFF_CVT);
  bf16_t* ona = (bf16_t*)(p.ws + OFF_ONA);
  int h, tq0, nsub;
  bool latent;
  int b = 0, r = 0, jb = 0, row_start = 0, band = 0, seq = 0;
  {
    const int bi = witem >> 2, wv = witem & 3;
    if (bi < 256) {
      latent = true;
      b = bi >> 7; const int rem = bi & 127; r = rem >> 3; h = rem & 7; jb = wv;
      tq0 = NCTX + b * 1024 + r * 64 + jb * 16;
      row_start = min(max(r - 4, 0), 8); band = min(max(jb * 16 - 8, 0), 32);
      nsub = 4;
    } else {
      latent = false;
      const int c2 = bi - 256; seq = c2 >> 5; const int rem = c2 & 31; h = rem >> 2; const int qg = rem & 3;
      tq0 = seq * 256 + (qg * 4 + wv) * 16; nsub = 2;
    }
  }
  const bf16_t* qp = qb + (size_t)(tq0 + fr) * 512 + h * 64 + fq * 8;
  const bf16x8 qf0 = *(const bf16x8*)qp, qf1 = *(const bf16x8*)(qp + 32);
  float m = -INFINITY, l = 0.f;
  f32x4 O[4];
#pragma unroll
  for (int i = 0; i < 4; ++i) O[i] = (f32x4){0.f, 0.f, 0.f, 0.f};
#define SUBDESC(sc_, kbase_, vbase_, KS_, ldv_, win_) do { const int half_ = (sc_) & 1; win_ = latent && (sc_) < 2; \
    if (win_) { const int tb_ = NCTX + b * 1024 + (row_start + half_ * 4) * 64 + band; \
      kbase_ = kb + (size_t)tb_ * 512 + h * 64; vbase_ = vT + (size_t)(h * 64) * NTOK + tb_; KS_ = 64; ldv_ = NTOK; } \
    else if (latent) { kbase_ = ckb + (size_t)(b * 256 + half_ * 128) * 512 + h * 64; vbase_ = cvT + (size_t)((b * 8 + h) * 64) * 256 + half_ * 128; KS_ = 32; ldv_ = 256; } \
    else { const int tb_ = seq * 256 + half_ * 128; kbase_ = kb + (size_t)tb_ * 512 + h * 64; vbase_ = vT + (size_t)(h * 64) * NTOK + tb_; KS_ = 32; ldv_ = NTOK; } } while (0)
#define KLOAD(kbase_, KS_) do { _Pragma("unroll") for (int i_ = 0; i_ < 8; ++i_) { \
      const bf16_t* kp_ = kbase_ + (size_t)((i_ >> 1) * KS_ + (fr >> 2) * 8 + (i_ & 1) * 4 + (fr & 3)) * 512 + fq * 8; \
      kf[2 * i_] = *(const bf16x8*)kp_; kf[2 * i_ + 1] = *(const bf16x8*)(kp_ + 32); } } while (0)
  bf16x8 kf[16];
#pragma unroll 1
  for (int sc = 0; sc < nsub; ++sc) {
    const int half = sc & 1;
    const bf16_t* kbase; const bf16_t* vbase; int KS, ldv; bool win;
    SUBDESC(sc, kbase, vbase, KS, ldv, win);
    KLOAD(kbase, KS);
    bf16x8 vf[4][4];
#pragma unroll
    for (int s = 0; s < 4; ++s)
#pragma unroll
      for (int dt = 0; dt < 4; ++dt) {
        vf[s][dt] = *(const bf16x8*)(vbase + (size_t)(dt * 16 + fr) * ldv + s * KS + fq * 8);
      }
    f32x4 st[8];
#pragma unroll
    for (int i = 0; i < 8; ++i) {
      f32x4 z = (f32x4){0.f, 0.f, 0.f, 0.f};
      z = __builtin_amdgcn_mfma_f32_16x16x32_bf16(kf[2 * i], qf0, z, 0, 0, 0);
      st[i] = __builtin_amdgcn_mfma_f32_16x16x32_bf16(kf[2 * i + 1], qf1, z, 0, 0, 0);
    }
    const bool cwin = win;
    if (cwin) {
      const int q_col = jb * 16 + fr;
      const int win_start = min(max(q_col - 8, 0), 48);
      const float* rpb = p.in[25] + h * 465;
#pragma unroll
      for (int i = 0; i < 8; ++i) {
        const int dr = row_start + half * 4 + (i >> 1) - r + 7;
#pragma unroll
        for (int e = 0; e < 4; ++e) {
          const int k_col = band + fq * 8 + (i & 1) * 4 + e;
          const bool valid = (k_col >= win_start) && (k_col < win_start + 16);
          const int dc = min(max(k_col - q_col, -15), 15) + 15;
          st[i][e] = valid ? st[i][e] + rpb[dr * 31 + dc] : -1e30f;
        }
      }
    }
    float cmax = -1e30f;
#pragma unroll
    for (int i = 0; i < 8; ++i)
#pragma unroll
      for (int e = 0; e < 4; ++e) cmax = fmaxf(cmax, st[i][e]);
    cmax = fmaxf(cmax, __shfl_xor(cmax, 16)); cmax = fmaxf(cmax, __shfl_xor(cmax, 32));
    const float mnew = fmaxf(m, cmax);
    const float alpha = __expf(m - mnew);
    float psum = 0.f;
#pragma unroll
    for (int i = 0; i < 8; ++i)
#pragma unroll
      for (int e = 0; e < 4; ++e) { const float pv = __expf(st[i][e] - mnew); st[i][e] = pv; psum += pv; }
    psum += __shfl_xor(psum, 16); psum += __shfl_xor(psum, 32);
    l = l * alpha + psum;
#pragma unroll
    for (int i = 0; i < 4; ++i) O[i] = O[i] * alpha;
    m = mnew;
#pragma unroll
    for (int s = 0; s < 4; ++s) {
      union { bf16x8 v; unsigned u[4]; } pb;
      pb.u[0] = pk2(st[2 * s][0], st[2 * s][1]); pb.u[1] = pk2(st[2 * s][2], st[2 * s][3]);
      pb.u[2] = pk2(st[2 * s + 1][0], st[2 * s + 1][1]); pb.u[3] = pk2(st[2 * s + 1][2], st[2 * s + 1][3]);
#pragma unroll
      for (int dt = 0; dt < 4; ++dt) {
        O[dt] = __builtin_amdgcn_mfma_f32_16x16x32_bf16(vf[s][dt], pb.v, O[dt], 0, 0, 0);
      }
    }
  }
#undef SUBDESC
#undef KLOAD
  const float inv = 1.f / l;
#pragma unroll
  for (int dt = 0; dt < 4; ++dt) {
    bf16_t* op = ona + (size_t)(tq0 + fr) * 512 + h * 64 + dt * 16 + fq * 4;
    *(uint2*)op = make_uint2(pk2(O[dt][0] * inv, O[dt][1] * inv), pk2(O[dt][2] * inv, O[dt][3] * inv));
  }
}

constexpr int N_SCAN_ITEMS = 128 + 256, N_ATTN_BLK = 768;
DEV void phase_scan_attn(const Params& p, unsigned char* smem, int* s_item, int rep) {
  unsigned* counter = (unsigned*)(p.ws + OFF_CTL) + rep;
  for (;;) {
    if (threadIdx.x == 0) *s_item = (int)atomicAdd(counter, 1u);
    __syncthreads();
    const int item = *s_item;
    __syncthreads();
    if (item >= N_SCAN_ITEMS + N_ATTN_BLK) break;
    if (item < 128) { const int rem = item & 63; scan_item<4, 1, 3>(p, smem, 16 + (item >> 6), rem >> 3, (rem >> 2) & 1, rem & 3); }
    else if (item >= N_SCAN_ITEMS) attn_wave_item(p, (item - N_SCAN_ITEMS) * 4 + (threadIdx.x >> 6));
    else { const int i2 = item - 128, rem = i2 & 15; scan_item<4, 4, 1>(p, smem, i2 >> 4, rem >> 1, rem & 1, 0); }
  }
}

DEV void phase_finalize_rw(const Params& p, int bid, int nb) {
  const int lane = threadIdx.x & 63, gw = bid * 4 + (threadIdx.x >> 6), nw = nb * 4;
  const float* yf = (const float*)(p.ws + OFF_YF);
  const float* yb = (const float*)(p.ws + OFF_YB);
  const bf16_t* bonus = (const bf16_t*)(p.ws + OFF_BG);
  const bf16_t* gate = (const bf16_t*)(p.ws + OFF_BG + 6291456);
  bf16_t* orw = (bf16_t*)(p.ws + OFF_ORW);
  const float4 g0 = *(const float4*)(p.in[21] + lane * 8), g1 = *(const float4*)(p.in[21] + lane * 8 + 4);
  const float4 b0 = *(const float4*)(p.in[22] + lane * 8), b1 = *(const float4*)(p.in[22] + lane * 8 + 4);
  const float gg[8] = {g0.x, g0.y, g0.z, g0.w, g1.x, g1.y, g1.z, g1.w};
  const float bb[8] = {b0.x, b0.y, b0.z, b0.w, b1.x, b1.y, b1.z, b1.w};
#pragma unroll 3
  for (int t = gw; t < NTOK; t += nw) {
    const size_t o = (size_t)t * 512 + lane * 8;
    const float4 a0 = ldnt4(yf + o), a1 = ldnt4(yf + o + 4);
    const float4 c0 = ldnt4(yb + o), c1 = ldnt4(yb + o + 4);
    const uint4 bo = *(const uint4*)(bonus + o), ga = *(const uint4*)(gate + o);
    float y[8] = {a0.x + c0.x, a0.y + c0.y, a0.z + c0.z, a0.w + c0.w, a1.x + c1.x, a1.y + c1.y, a1.z + c1.z, a1.w + c1.w};
    float s = 0.f;
#pragma unroll
    for (int i = 0; i < 8; ++i) s += y[i];
    s += dpp_mov<0xB1>(s); s += dpp_mov<0x4E>(s); s += dpp_mov<0x141>(s);
    const float mean = s * (1.f / 64.f);
    float q = 0.f;
#pragma unroll
    for (int i = 0; i < 8; ++i) { y[i] -= mean; q += y[i] * y[i]; }
    q += dpp_mov<0xB1>(q); q += dpp_mov<0x4E>(q); q += dpp_mov<0x141>(q);
    const float rstd = rsqrtf(q * (1.f / 64.f) + 64e-5f);
    const unsigned bu[4] = {bo.x, bo.y, bo.z, bo.w}, gu[4] = {ga.x, ga.y, ga.z, ga.w};
    unsigned w[4];
#pragma unroll
    for (int i = 0; i < 4; ++i) {
      const float lo = (y[2 * i] * rstd * gg[2 * i] + bb[2 * i] + __uint_as_float(bu[i] << 16)) * __uint_as_float(gu[i] << 16);
      const float hi = (y[2 * i + 1] * rstd * gg[2 * i + 1] + bb[2 * i + 1] + __uint_as_float(bu[i] & 0xffff0000u)) * __uint_as_float(gu[i] & 0xffff0000u);
      w[i] = pk2(lo, hi);
    }
    *(uint4*)(orw + o) = make_uint4(w[0], w[1], w[2], w[3]);
  }
}

#define XB_TMO      128
#define XB_XCNT(j)  (256  + 64 * (j))
#define XB_XSUB(j)  (1280 + 64 * (j))
#define XB_XGEN(j)  (2304 + 64 * (j))
#define XB_TOP      3328
#define XB_TOPGEN   3392
#define XCD_BAR_WORDS 3456
#define XB_SPIN_CAP (1u << 18)
#define LAS __attribute__((address_space(3)))
DEV unsigned xb_ld(unsigned* p)              { return __hip_atomic_load(p, __ATOMIC_RELAXED, __HIP_MEMORY_SCOPE_AGENT); }
DEV unsigned xb_add(unsigned* p, unsigned v) { return __hip_atomic_fetch_add(p, v, __ATOMIC_RELAXED, __HIP_MEMORY_SCOPE_AGENT); }
DEV unsigned xb_xcc_id() { return (unsigned)__builtin_amdgcn_s_getreg((3 << 11) | 20) & 0xFu; }
#define XB_SPIN(cond, bar) do { unsigned _sp = 0; while (cond) { __builtin_amdgcn_s_sleep(1); \
    if ((++_sp & 255u) == 0u) { if (xb_ld(&(bar)[XB_TMO])) break; if (_sp > XB_SPIN_CAP) { atomicAdd(&(bar)[XB_TMO], 1u); break; } } } } while (0)
struct XcdBarrier { unsigned* bar; unsigned x; volatile LAS unsigned* st; };
DEV XcdBarrier xcd_barrier_post(unsigned* bar, volatile LAS unsigned* st) {
  XcdBarrier b; b.bar = bar; b.x = xb_xcc_id(); b.st = st;
  if (threadIdx.x == 0) (void)xb_add(&bar[XB_XCNT(b.x)], 1u);
  return b;
}
DEV void xcd_barrier_complete(unsigned* bar, unsigned x, unsigned& nloc, unsigned& nx) {
  const unsigned G = gridDim.x * gridDim.y * gridDim.z;
  unsigned sum, cnt, mine, sp = 0u;
  for (;;) {
    sum = 0u; cnt = 0u; mine = 0u;
#pragma unroll
    for (unsigned j = 0; j < 16; ++j) { const unsigned c = xb_ld(&bar[XB_XCNT(j)]); sum += c; cnt += (c > 0u) ? 1u : 0u; mine = (j == x) ? c : mine; }
    if (sum == G) break;
    __builtin_amdgcn_s_sleep(1);
    if ((++sp & 255u) == 0u) { if (xb_ld(&bar[XB_TMO])) break; if (sp > XB_SPIN_CAP) { atomicAdd(&bar[XB_TMO], 1u); break; } }
  }
  nloc = mine > 0u ? mine : 1u; nx = cnt > 0u ? cnt : 1u;
}
DEV void xcd_barrier(const XcdBarrier& b) {
  asm volatile("s_waitcnt vmcnt(0)" ::: "memory");
  __syncthreads();
  if (threadIdx.x == 0) {
    unsigned* bar = b.bar;
    __builtin_amdgcn_s_waitcnt(0);
    unsigned nloc = b.st[0], nx = b.st[1];
    if (nloc == 0u) { xcd_barrier_complete(bar, b.x, nloc, nx); b.st[0] = nloc; b.st[1] = nx; }
    const unsigned old = xb_add(&bar[XB_XSUB(b.x)], 1u);
    const unsigned gen = old / nloc;
    if (old + 1u == (gen + 1u) * nloc) {
      __builtin_amdgcn_fence(__ATOMIC_RELEASE, "agent");
      asm volatile("s_waitcnt vmcnt(0)" ::: "memory");
      const unsigned og = xb_add(&bar[XB_TOP], 1u);
      const unsigned tg = og / nx;
      if (og + 1u == (tg + 1u) * nx) xb_add(&bar[XB_TOPGEN], 1u);
      else XB_SPIN(xb_ld(&bar[XB_TOPGEN]) == tg, bar);
      __builtin_amdgcn_fence(__ATOMIC_ACQUIRE, "agent");
      xb_add(&bar[XB_XGEN(b.x)], 1u);
      asm volatile("s_waitcnt vmcnt(0)" ::: "memory");
    } else {
      XB_SPIN(xb_ld(&bar[XB_XGEN(b.x)]) == gen, bar);
      __builtin_amdgcn_fence(__ATOMIC_ACQUIRE, "agent");
      asm volatile("s_waitcnt vmcnt(0)" ::: "memory");
    }
  }
  __syncthreads();
}

__global__ void __launch_bounds__(NTHR, 2) fwd_megakernel(Params p) {
  extern __shared__ __attribute__((aligned(16))) unsigned char smem[];
  __shared__ __attribute__((aligned(16))) unsigned sh_ctl[8];
  cg::grid_group grid = cg::this_grid();
  const int bid = blockIdx.x, nb = gridDim.x;
  if (threadIdx.x < 8) sh_ctl[threadIdx.x] = 0u;
  __syncthreads();
  const XcdBarrier xb = xcd_barrier_post((unsigned*)(p.ws + OFF_CTL), (volatile LAS unsigned*)sh_ctl);
  int* s_item_p = (int*)&sh_ctl[4];
  if (p.ph_hi > 1000) grid.sync();
#define GSYNC() xcd_barrier(xb)
#ifndef DUP
#define DUP -1
#endif
#define PH(n, body) if (p.ph_lo <= n && n < p.ph_hi) { { const int rep = 0; (void)rep; body; } if (DUP == n) { GSYNC(); const int rep = 1; (void)rep; body; } if (n + 1 < p.ph_hi) GSYNC(); }
  PH(0, phase0(p, smem, bid, nb, rep))
  PH(1, phase_normmod<0>(p, bid, nb))
  PH(2, reset_tiles(s_item_p); phase_gemm_in(p, smem, s_item_p))
  PH(3, phase_prep(p, smem, s_item_p, rep))
  PH(4, phase_scan_attn(p, smem, s_item_p, rep))
  PH(5, phase_finalize_rw(p, bid, nb))
  PH(6, reset_tiles(s_item_p); phase_gemm_merge(p, smem, s_item_p))
  PH(7, reset_tiles(s_item_p); phase_gemm_out(p, smem, s_item_p))
  PH(8, phase_normmod<1>(p, bid, nb))
  PH(9, reset_tiles(s_item_p); phase_gemm_ffn_up(p, smem, s_item_p))
  PH(10, reset_tiles(s_item_p); phase_gemm_ffn_down(p, smem, s_item_p))
}

extern "C" void kernel_launch(void* const* d_in, const int* in_sizes, int n_in, void* d_out, int out_size, void* d_ws, size_t ws_size,
                              hipStream_t stream) {
  static int grid_blocks = 0;
  if (grid_blocks == 0) {
    if (n_in != 32 || ws_size < WS_END) { fprintf(stderr, "kernel_launch: unexpected n_in %d / ws_size %zu (need %zu)\n", n_in, ws_size, (size_t)WS_END); grid_blocks = -1; return; }
    int dev = 0, cus = 0, per_cu = 0;
    hipGetDevice(&dev);
    hipDeviceGetAttribute(&cus, hipDeviceAttributeMultiprocessorCount, dev);
    if (hipFuncSetAttribute((const void*)fwd_megakernel, hipFuncAttributeMaxDynamicSharedMemorySize, LDS_BYTES) != hipSuccess) { fprintf(stderr, "hipFuncSetAttribute failed\n"); grid_blocks = -1; return; }
    if (hipOccupancyMaxActiveBlocksPerMultiprocessor(&per_cu, (const void*)fwd_megakernel, NTHR, LDS_BYTES) != hipSuccess || per_cu < 1) { fprintf(stderr, "occupancy query failed (%d)\n", per_cu); grid_blocks = -1; return; }
    if (per_cu > 2) per_cu = 2;
    grid_blocks = cus * per_cu;
    fprintf(stderr, "kernel_launch: cus %d per_cu %d grid %d\n", cus, per_cu, grid_blocks);
  }
  if (grid_blocks < 0) return;
  hipMemsetAsync((char*)d_ws + OFF_CTL, 0, CTL_ZERO_BYTES, stream);
  Params p{};
  for (int i = 0; i < 32; ++i) p.in[i] = (const float*)d_in[i];
  p.out = (float*)d_out; p.ws = (unsigned char*)d_ws; p.ph_lo = 0; p.ph_hi = 11;
  void* args[] = {&p};
  hipError_t e = hipLaunchCooperativeKernel((const void*)fwd_megakernel, dim3(grid_blocks), dim3(NTHR), args, LDS_BYTES, stream);
  if (e != hipSuccess) fprintf(stderr, "cooperative launch failed: %s (grid %d)\n", hipGetErrorString(e), grid_blocks);
}
```

```cpp
#include <hip/hip_runtime.h>
#include <hip/hip_cooperative_groups.h>
#include <cstdio>
#include <cstdint>
namespace cg = cooperative_groups;

#define DEV __device__ __forceinline__
typedef unsigned short bf16_t;
typedef short bf16x8 __attribute__((ext_vector_type(8)));
typedef short bf16x4 __attribute__((ext_vector_type(4)));
typedef float f32x4 __attribute__((ext_vector_type(4)));

constexpr int D = 1024, NTOK = 6144, NCTX = 4096, RW = 512, FF = 2816, INC = 5504, RWC = 1920;
constexpr int NTHR = 256;
constexpr int LDS_BYTES = 65536;

constexpr size_t OFF_CTL = 0;
constexpr size_t OFF_MOD = 16384;
constexpr size_t CTL_ZERO_BYTES = 16384 + 3 * 6144 * 4;
constexpr size_t OFF_WIN = 90112;
constexpr size_t OFF_WORW = OFF_WIN + 11272192;
constexpr size_t OFF_WONA = OFF_WORW + 1048576;
constexpr size_t OFF_WOUT = OFF_WONA + 1048576;
constexpr size_t OFF_W13 = OFF_WOUT + 2097152;
constexpr size_t OFF_W2 = OFF_W13 + 11534336;
constexpr size_t OFF_H = OFF_W2 + 5767168;
constexpr size_t OFF_URW = OFF_H + 12582912;
constexpr size_t OFF_UNA = OFF_URW + 47185920;
constexpr size_t OFF_OPS = OFF_UNA + 37748736;
constexpr size_t OPS_ARR = 12582912;
constexpr size_t OFF_BG = OFF_OPS + 9 * OPS_ARR;
constexpr size_t OFF_VT = OFF_BG + 12582912;
constexpr size_t OFF_CKB = OFF_VT + 6291456;
constexpr size_t OFF_CVT = OFF_CKB + 524288;
constexpr size_t OFF_LORA = OFF_CVT + 524288;
constexpr size_t WS_END = OFF_LORA + 393216;
constexpr size_t OFF_QB = OFF_UNA + 12582912, OFF_KB = OFF_UNA + 18874368;
constexpr size_t OFF_YF = OFF_URW, OFF_YB = OFF_URW + 12582912;
constexpr size_t OFF_ORW = OFF_UNA, OFF_ONA = OFF_UNA + 6291456;
constexpr size_t OFF_MERGED = OFF_OPS;
constexpr size_t OFF_HID = OFF_URW;
constexpr size_t OUT_STATE = 6291456, OUT_K = 7340032, OUT_V = 9437184;

struct Params {
  const float* in[32];
  float* out;
  unsigned char* ws;
  int ph_lo, ph_hi;
};

DEV unsigned short f2bf(float f) { unsigned u = __float_as_uint(f); u += 0x7fffu + ((u >> 16) & 1u); return (unsigned short)(u >> 16); }
DEV unsigned pk2(float lo, float hi) { return (unsigned)f2bf(lo) | ((unsigned)f2bf(hi) << 16); }
DEV float bf2f(unsigned short b) { return __uint_as_float(((unsigned)b) << 16); }
DEV float sigmoidf_(float x) { return 1.f / (1.f + __expf(-x)); }
DEV float wave_sum(float x) {
#pragma unroll
  for (int o = 32; o > 0; o >>= 1) x += __shfl_xor(x, o);
  return x;
}
template <int CTRL> DEV float dpp_mov(float x) { return __int_as_float(__builtin_amdgcn_update_dpp(0, __float_as_int(x), CTRL, 0xf, 0xf, true)); }
DEV float row16_sum(float x) {
  x += dpp_mov<0xB1>(x); x += dpp_mov<0x4E>(x); x += dpp_mov<0x141>(x); x += dpp_mov<0x140>(x);
  return x;
}
#define BAR_LDS() do { asm volatile("s_waitcnt lgkmcnt(0)" ::: "memory"); __builtin_amdgcn_s_barrier(); asm volatile("" ::: "memory"); } while (0)
DEV float4 ldnt4(const float* p_) { const f32x4 t_ = __builtin_nontemporal_load((const f32x4*)p_); return make_float4(t_[0], t_[1], t_[2], t_[3]); }
DEV const float* xrow(const Params& p, int t) { return t < NCTX ? p.in[0] + (size_t)t * D : p.in[1] + (size_t)(t - NCTX) * D; }
DEV int modidx(int t) { return t < NCTX ? 0 : 1 + ((t - NCTX) >> 10); }

DEV void conv_job(const Params& p, int j, const float*& src, bf16_t*& dst, int& K, int& N, int& mode, int& base) {
  if (j < 1376) { src = p.in[11]; dst = (bf16_t*)(p.ws + OFF_WIN); K = 1024; N = 5504; mode = 0; base = 0; }
  else if (j < 1504) { src = p.in[26]; dst = (bf16_t*)(p.ws + OFF_WORW); K = 512; N = 1024; mode = 0; base = 1376; }
  else if (j < 1632) { src = p.in[27]; dst = (bf16_t*)(p.ws + OFF_WONA); K = 512; N = 1024; mode = 0; base = 1504; }
  else if (j < 1888) { src = p.in[28]; dst = (bf16_t*)(p.ws + OFF_WOUT); K = 1024; N = 1024; mode = 0; base = 1632; }
  else if (j < 2592) { src = p.in[29]; dst = (bf16_t*)(p.ws + OFF_W13); K = 1024; N = 2816; mode = 1; base = 1888; }
  else if (j < 3296) { src = p.in[30]; dst = (bf16_t*)(p.ws + OFF_W13); K = 1024; N = 2816; mode = 2; base = 2592; }
  else if (j < 4000) { src = p.in[31]; dst = (bf16_t*)(p.ws + OFF_W2); K = 2816; N = 1024; mode = 0; base = 3296; }
  else if (j < 4016) { const int e = (j - 4000) >> 3; src = p.in[14] + e * 32768; dst = (bf16_t*)(p.ws + OFF_LORA) + e * 32768; K = 64; N = 512; mode = 0; base = 4000 + e * 8; }
  else if (j < 4032) { const int e = (j - 4016) >> 3; src = p.in[16] + e * 32768; dst = (bf16_t*)(p.ws + OFF_LORA) + 65536 + e * 32768; K = 64; N = 512; mode = 0; base = 4016 + e * 8; }
  else { src = p.in[17]; dst = (bf16_t*)(p.ws + OFF_LORA) + 131072; K = 128; N = 512; mode = 0; base = 4032; }
}
constexpr int N_CONV_TILES = 4048, N_MOD_TILES = 768;

DEV void phase0(const Params& p, unsigned char* smem, int bid, int nb, int rep) {
  const int tid = threadIdx.x;
  float* T = (float*)smem;
  for (int tile = bid; tile < N_MOD_TILES && rep == 0; tile += nb) {
    const int cgp = tile % 24, kc = tile / 24;
    if (tid < 96) {
      const int m = tid >> 5, kk = tid & 31, k = kc * 32 + kk;
      const float c = (m == 0) ? p.in[6][k] : p.in[5][(m - 1) * D + k];
      T[tid] = c * sigmoidf_(c);
    }
    __syncthreads();
    const int col = cgp * 256 + tid;
    const float* w = p.in[9] + (size_t)(kc * 32) * 6144 + col;
    float a0 = 0.f, a1 = 0.f, a2 = 0.f;
#pragma unroll
    for (int kk = 0; kk < 32; ++kk) {
      const float wv = __builtin_nontemporal_load(w + (size_t)kk * 6144);
      a0 += T[kk] * wv; a1 += T[32 + kk] * wv; a2 += T[64 + kk] * wv;
    }
    if (kc == 0) { const float b = p.in[10][col]; a0 += b; a1 += b; a2 += b; }
    float* mod = (float*)(p.ws + OFF_MOD);
    atomicAdd(mod + col, a0); atomicAdd(mod + 6144 + col, a1); atomicAdd(mod + 12288 + col, a2);
    __syncthreads();
  }
  const int r_ = tid >> 4, c4_ = tid & 15;
  float4 v[4];
  const float* src; bf16_t* dst; int K, N, mode, base;
  int tile = bid;
  if (tile < N_CONV_TILES) {
    conv_job(p, tile, src, dst, K, N, mode, base);
    const int lt = tile - base, nN = N >> 6, k0 = (lt / nN) * 64, n0 = (lt % nN) * 64;
#pragma unroll
    for (int i = 0; i < 4; ++i) { const f32x4 t_ = __builtin_nontemporal_load((const f32x4*)(src + (size_t)(k0 + r_ + 16 * i) * N + n0 + c4_ * 4)); v[i] = make_float4(t_[0], t_[1], t_[2], t_[3]); }
  }
  while (tile < N_CONV_TILES) {
    const int lt = tile - base, nN = N >> 6, k0 = (lt / nN) * 64, n0 = (lt % nN) * 64;
    bf16_t* cdst = dst; const int cK = K, cmode = mode;
#pragma unroll
    for (int i = 0; i < 4; ++i) {
      float* tp = T + (r_ + 16 * i) * 65 + c4_ * 4;
      tp[0] = v[i].x; tp[1] = v[i].y; tp[2] = v[i].z; tp[3] = v[i].w;
    }
    BAR_LDS();
    tile += nb;
    if (tile < N_CONV_TILES) {
      conv_job(p, tile, src, dst, K, N, mode, base);
      const int lt2 = tile - base, nN2 = N >> 6, k2 = (lt2 / nN2) * 64, n2 = (lt2 % nN2) * 64;
#pragma unroll
      for (int i = 0; i < 4; ++i) { const f32x4 t_ = __builtin_nontemporal_load((const f32x4*)(src + (size_t)(k2 + r_ + 16 * i) * N + n2 + c4_ * 4)); v[i] = make_float4(t_[0], t_[1], t_[2], t_[3]); }
    }
    const int n = tid >> 2, kp = tid & 3;
    unsigned w[8];
#pragma unroll
    for (int i = 0; i < 8; ++i) w[i] = pk2(T[(kp * 16 + 2 * i) * 65 + n], T[(kp * 16 + 2 * i + 1) * 65 + n]);
    const int ng = n0 + n;
    int drow = ng;
    if (cmode == 1) drow = (ng >> 4) * 32 + (ng & 15);
    else if (cmode == 2) drow = (ng >> 4) * 32 + 16 + (ng & 15);
    uint4* dp = (uint4*)(cdst + (size_t)drow * cK + k0 + kp * 16);
    dp[0] = make_uint4(w[0], w[1], w[2], w[3]);
    dp[1] = make_uint4(w[4], w[5], w[6], w[7]);
    BAR_LDS();
  }
}

template <int WHICH>
DEV void phase_normmod(const Params& p, int bid, int nb) {
  const int lane = threadIdx.x & 63, gw = bid * 4 + (threadIdx.x >> 6), nw = nb * 4;
  const float* g = WHICH == 0 ? p.in[7] : p.in[8];
  const float* mod = (const float*)(p.ws + OFF_MOD);
  const int sh_off = WHICH == 0 ? 0 : 3072, sc_off = WHICH == 0 ? 1024 : 4096;
  bf16_t* dst = (bf16_t*)(p.ws + OFF_H);
#pragma unroll 3
  for (int t = gw; t < NTOK; t += nw) {
    const float* xp = WHICH == 0 ? xrow(p, t) : p.out + (size_t)t * D;
    const float* mm = mod + modidx(t) * 6144;
    float4 v[4];
    float ss = 0.f;
#pragma unroll
    for (int i = 0; i < 4; ++i) {
      v[i] = WHICH == 0 ? ldnt4(xp + (i * 64 + lane) * 4) : *(const float4*)(xp + (i * 64 + lane) * 4);
      ss += v[i].x * v[i].x + v[i].y * v[i].y + v[i].z * v[i].z + v[i].w * v[i].w;
    }
    ss = wave_sum(ss);
    const float rstd = rsqrtf(ss * (1.f / 1024.f) + 1e-6f);
#pragma unroll
    for (int i = 0; i < 4; ++i) {
      const int col = (i * 64 + lane) * 4;
      const float4 g4 = *(const float4*)(g + col);
      const float4 sc = *(const float4*)(mm + sc_off + col);
      const float4 sh = *(const float4*)(mm + sh_off + col);
      const float y0 = v[i].x * rstd * g4.x * (1.f + sc.x) + sh.x;
      const float y1 = v[i].y * rstd * g4.y * (1.f + sc.y) + sh.y;
      const float y2 = v[i].z * rstd * g4.z * (1.f + sc.z) + sh.z;
      const float y3 = v[i].w * rstd * g4.w * (1.f + sc.w) + sh.w;
      *(uint2*)(dst + (size_t)t * D + col) = make_uint2(pk2(y0, y1), pk2(y2, y3));
    }
  }
}

template <int MI>
DEV void gemm_tile_acc(f32x4 (&acc)[MI][4], const bf16_t* __restrict__ A, int lda, const bf16_t* __restrict__ Bt, int ldb,
                       int m0, int n0, int K, unsigned char* smem) {
  constexpr int AT = 2 * MI * 16 * 128, BT = 16384, STG = AT + BT;
  const int tid = threadIdx.x, lane = tid & 63, wid = tid >> 6, wr = wid >> 1, wc = wid & 1, fr = lane & 15, fq = lane >> 4;
  const int gkc = (tid & 7) ^ ((tid >> 4) & 7);
  const bf16_t* ga = A + (size_t)(m0 + (tid >> 3)) * lda + gkc * 8;
  const bf16_t* gb = Bt + (size_t)(n0 + (tid >> 3)) * ldb + gkc * 8;
  const int swz = (fr >> 1) & 7;
  const int nk = K >> 6;
#define GLDS_TILE(kt_, buf_) do { unsigned char* sb_ = smem + (buf_) * STG; const int k0_ = (kt_) * 64; \
    _Pragma("unroll") for (int i_ = 0; i_ < (2 * MI * 16) / 32; ++i_) \
      __builtin_amdgcn_global_load_lds((const unsigned*)(ga + (size_t)i_ * 32 * lda + k0_), (__attribute__((address_space(3))) unsigned*)(sb_ + (i_ * 256 + tid) * 16), 16, 0, 0); \
    _Pragma("unroll") for (int i_ = 0; i_ < 4; ++i_) \
      __builtin_amdgcn_global_load_lds((const unsigned*)(gb + (size_t)i_ * 32 * ldb + k0_), (__attribute__((address_space(3))) unsigned*)(sb_ + AT + (i_ * 256 + tid) * 16), 16, 0, 0); \
  } while (0)
  GLDS_TILE(0, 0);
  asm volatile("s_waitcnt vmcnt(0)" ::: "memory");
  __syncthreads();
  for (int kt = 0; kt < nk; ++kt) {
    if (kt + 1 < nk) GLDS_TILE(kt + 1, (kt + 1) & 1);
    const unsigned char* cur = smem + (kt & 1) * STG;
#pragma unroll
    for (int ks = 0; ks < 2; ++ks) {
      bf16x8 af[MI], bf[4];
      const int co = ((ks * 4 + fq) ^ swz) << 4;
#pragma unroll
      for (int mi = 0; mi < MI; ++mi) af[mi] = *(const bf16x8*)(cur + (wr * MI * 16 + mi * 16 + fr) * 128 + co);
#pragma unroll
      for (int ni = 0; ni < 4; ++ni) bf[ni] = *(const bf16x8*)(cur + AT + (wc * 64 + ni * 16 + fr) * 128 + co);
      __builtin_amdgcn_s_setprio(1);
#pragma unroll
      for (int mi = 0; mi < MI; ++mi)
#pragma unroll
        for (int ni = 0; ni < 4; ++ni) acc[mi][ni] = __builtin_amdgcn_mfma_f32_16x16x32_bf16(bf[ni], af[mi], acc[mi][ni], 0, 0, 0);
      __builtin_amdgcn_s_setprio(0);
    }
    asm volatile("s_waitcnt vmcnt(0)" ::: "memory");
    __syncthreads();
  }
#undef GLDS_TILE
}

template <int MI>
DEV void zero_acc(f32x4 (&acc)[MI][4]) {
#pragma unroll
  for (int i = 0; i < MI; ++i)
#pragma unroll
    for (int j = 0; j < 4; ++j) acc[i][j] = (f32x4){0.f, 0.f, 0.f, 0.f};
}

#ifndef DYN_TILES
#define DYN_TILES 0
#endif
DEV int grab_tile(const Params& p, int word, int* slot) {
#if DYN_TILES
  if (threadIdx.x == 0) *slot = (int)atomicAdd((unsigned*)(p.ws + OFF_CTL) + word, 1u);
  __syncthreads();
  const int t = *slot;
  __syncthreads();
  return t;
#else
  const int t = slot[1];
  __syncthreads();
  if (threadIdx.x == 0) slot[1] = t + gridDim.x;
  __syncthreads();
  return t;
#endif
}
DEV void reset_tiles(int* slot) { if (threadIdx.x == 0) slot[1] = blockIdx.x; __syncthreads(); }

#define EPI_COORDS const int lane = threadIdx.x & 63, wid = threadIdx.x >> 6, wr = wid >> 1, wc = wid & 1, fr = lane & 15, fq = lane >> 4

DEV void phase_gemm_in(const Params& p, unsigned char* smem, int* slot) {
  EPI_COORDS;
  const bf16_t* A = (const bf16_t*)(p.ws + OFF_H);
  const bf16_t* Bt = (const bf16_t*)(p.ws + OFF_WIN);
  float* urw = (float*)(p.ws + OFF_URW);
  float* una = (float*)(p.ws + OFF_UNA);
  bf16_t* gates = (bf16_t*)p.out;
  for (;;) {
    const int tile = grab_tile(p, 8, slot);
    if (tile >= 48 * 43) break;
    const int tm = tile % 48, tn = tile / 48, m0 = tm * 128, n0 = tn * 128;
    f32x4 acc[4][4];
    zero_acc<4>(acc);
    gemm_tile_acc<4>(acc, A, D, Bt, D, m0, n0, D, smem);
    if (n0 >= 1920 && n0 < 3456) {
      const int sec = (n0 - 1920) >> 9;
      const int h = (((n0 - 1920) & 511) >> 6) + wc;
      bf16_t* qb = (bf16_t*)(p.ws + OFF_QB); bf16_t* kb = (bf16_t*)(p.ws + OFF_KB); bf16_t* vT = (bf16_t*)(p.ws + OFF_VT);
#pragma unroll
      for (int mi = 0; mi < 4; ++mi) {
        const int row = m0 + wr * 64 + mi * 16 + fr;
        if (sec < 2) {
          float ss = 0.f;
#pragma unroll
          for (int ni = 0; ni < 4; ++ni) { const f32x4 v = acc[mi][ni]; ss += v[0] * v[0] + v[1] * v[1] + v[2] * v[2] + v[3] * v[3]; }
          ss += __shfl_xor(ss, 16); ss += __shfl_xor(ss, 32);
          const float rs = rsqrtf(ss * (1.f / 64.f) + 1e-6f) * (sec == 0 ? 0.125f : 1.f);
          const float* gv = sec == 0 ? p.in[23] : p.in[24];
          bf16_t* dstb = (sec == 0 ? qb : kb) + (size_t)row * 512 + h * 64;
#pragma unroll
          for (int ni = 0; ni < 4; ++ni) {
            const int d = ni * 16 + fq * 4;
            const f32x4 x = acc[mi][ni] * rs * (*(const f32x4*)(gv + d));
            *(uint2*)(dstb + d) = make_uint2(pk2(x[0], x[1]), pk2(x[2], x[3]));
            if (sec == 1 && row < NCTX) __builtin_nontemporal_store(x, (f32x4*)(p.out + OUT_K + (size_t)row * 512 + h * 64 + d));
          }
        } else {
#pragma unroll
          for (int ni = 0; ni < 4; ++ni) {
            const int d = ni * 16 + fq * 4;
            const f32x4 x = acc[mi][ni];
            if (row < NCTX) __builtin_nontemporal_store(x, (f32x4*)(p.out + OUT_V + (size_t)row * 512 + h * 64 + d));
#pragma unroll
            for (int e2 = 0; e2 < 4; ++e2) *(bf16_t*)(smem + (wc * 64 + d + e2) * 272 + (wr * 64 + mi * 16 + fr) * 2) = f2bf(x[e2]);
          }
        }
      }
      if (sec == 2) {
        __syncthreads();
        const int dd = threadIdx.x >> 1, hf = threadIdx.x & 1;
        const int hb = ((n0 - 1920) & 511) >> 6;
        bf16_t* vrow = vT + (size_t)(hb * 64 + dd) * NTOK + m0 + hf * 64;
#pragma unroll
        for (int j = 0; j < 8; ++j) *(uint4*)(vrow + j * 8) = *(const uint4*)(smem + dd * 272 + hf * 128 + j * 16);
        __syncthreads();
      }
    } else {
#pragma unroll
      for (int mi = 0; mi < 4; ++mi) {
        const int row = m0 + wr * 64 + mi * 16 + fr;
#pragma unroll
        for (int ni = 0; ni < 4; ++ni) {
          const int col = n0 + wc * 64 + ni * 16 + fq * 4;
          const f32x4 v = acc[mi][ni];
          if (n0 < 1920) *(f32x4*)(urw + (size_t)row * 1920 + col) = v;
          else *(uint2*)(gates + (size_t)row * 2048 + (col - 3456)) = make_uint2(pk2(sigmoidf_(v[0]), sigmoidf_(v[1])), pk2(sigmoidf_(v[2]), sigmoidf_(v[3])));
        }
      }
    }
  }
}

DEV void phase_gemm_merge(const Params& p, unsigned char* smem, int* slot) {
  EPI_COORDS;
  const bf16_t* orw = (const bf16_t*)(p.ws + OFF_ORW);
  const bf16_t* ona = (const bf16_t*)(p.ws + OFF_ONA);
  const bf16_t* w1 = (const bf16_t*)(p.ws + OFF_WORW);
  const bf16_t* w2 = (const bf16_t*)(p.ws + OFF_WONA);
  const bf16_t* gates = (const bf16_t*)p.out;
  bf16_t* merged = (bf16_t*)(p.ws + OFF_MERGED);
  float* mtmp = (float*)(p.ws + OFF_MERGED + 16777216);
  for (;;) {
    const int tile = grab_tile(p, 9, slot);
    if (tile >= 64 * 8) break;
    const int tm = tile % 64, tn = tile / 64, m0 = tm * 96, n0 = tn * 128;
    f32x4 acc[3][4];
    uint2 mgp[3][4];
    zero_acc<3>(acc);
    gemm_tile_acc<3>(acc, orw, RW, w1, RW, m0, n0, RW, smem);
#pragma unroll
    for (int mi = 0; mi < 3; ++mi) {
      const int row = m0 + wr * 48 + mi * 16 + fr;
#pragma unroll
      for (int ni = 0; ni < 4; ++ni) {
        const int col = n0 + wc * 64 + ni * 16 + fq * 4;
        const uint2 g = *(const uint2*)(gates + (size_t)row * 2048 + col);
        f32x4 r;
        r[0] = acc[mi][ni][0] * bf2f((unsigned short)(g.x & 0xffff));
        r[1] = acc[mi][ni][1] * bf2f((unsigned short)(g.x >> 16));
        r[2] = acc[mi][ni][2] * bf2f((unsigned short)(g.y & 0xffff));
        r[3] = acc[mi][ni][3] * bf2f((unsigned short)(g.y >> 16));
        mgp[mi][ni] = make_uint2(pk2(r[0], r[1]), pk2(r[2], r[3]));
      }
    }
    zero_acc<3>(acc);
    gemm_tile_acc<3>(acc, ona, RW, w2, RW, m0, n0, RW, smem);
#pragma unroll
    for (int mi = 0; mi < 3; ++mi) {
      const int row = m0 + wr * 48 + mi * 16 + fr;
#pragma unroll
      for (int ni = 0; ni < 4; ++ni) {
        const int col = n0 + wc * 64 + ni * 16 + fq * 4;
        const uint2 g = *(const uint2*)(gates + (size_t)row * 2048 + 1024 + col);
        const float mg[4] = {__uint_as_float(mgp[mi][ni].x << 16), __uint_as_float(mgp[mi][ni].x & 0xffff0000u), __uint_as_float(mgp[mi][ni].y << 16), __uint_as_float(mgp[mi][ni].y & 0xffff0000u)};
        const float r0 = mg[0] + acc[mi][ni][0] * bf2f((unsigned short)(g.x & 0xffff));
        const float r1 = mg[1] + acc[mi][ni][1] * bf2f((unsigned short)(g.x >> 16));
        const float r2 = mg[2] + acc[mi][ni][2] * bf2f((unsigned short)(g.y & 0xffff));
        const float r3 = mg[3] + acc[mi][ni][3] * bf2f((unsigned short)(g.y >> 16));
        *(uint2*)(merged + (size_t)row * D + col) = make_uint2(pk2(r0, r1), pk2(r2, r3));
      }
    }
  }
}

DEV void phase_gemm_out(const Params& p, unsigned char* smem, int* slot) {
  EPI_COORDS;
  const bf16_t* A = (const bf16_t*)(p.ws + OFF_MERGED);
  const bf16_t* Bt = (const bf16_t*)(p.ws + OFF_WOUT);
  const float* mod = (const float*)(p.ws + OFF_MOD);
  for (;;) {
    const int tile = grab_tile(p, 10, slot);
    if (tile >= 64 * 8) break;
    const int tm = tile % 64, tn = tile / 64, m0 = tm * 96, n0 = tn * 128;
    f32x4 acc[3][4];
    zero_acc<3>(acc);
    gemm_tile_acc<3>(acc, A, D, Bt, D, m0, n0, D, smem);
#pragma unroll
    for (int mi = 0; mi < 3; ++mi) {
      const int row = m0 + wr * 48 + mi * 16 + fr;
      const float* xp = xrow(p, row);
      const float* g1 = mod + modidx(row) * 6144 + 2048;
#pragma unroll
      for (int ni = 0; ni < 4; ++ni) {
        const int col = n0 + wc * 64 + ni * 16 + fq * 4;
        const f32x4 x = __builtin_nontemporal_load((const f32x4*)(xp + col));
        const f32x4 g = *(const f32x4*)(g1 + col);
        *(f32x4*)(p.out + (size_t)row * D + col) = x + g * acc[mi][ni];
      }
    }
  }
}

DEV void phase_gemm_ffn_up(const Params& p, unsigned char* smem, int* slot) {
  EPI_COORDS;
  const bf16_t* A = (const bf16_t*)(p.ws + OFF_H);
  const bf16_t* Bt = (const bf16_t*)(p.ws + OFF_W13);
  bf16_t* hid = (bf16_t*)(p.ws + OFF_HID);
  for (;;) {
    const int tile = grab_tile(p, 11, slot);
    if (tile >= 48 * 44) break;
    const int tm = tile % 48, tn = tile / 48, m0 = tm * 128, n0 = tn * 128;
    f32x4 acc[4][4];
    zero_acc<4>(acc);
    gemm_tile_acc<4>(acc, A, D, Bt, D, m0, n0, D, smem);
#pragma unroll
    for (int mi = 0; mi < 4; ++mi) {
      const int row = m0 + wr * 64 + mi * 16 + fr;
#pragma unroll
      for (int gp = 0; gp < 2; ++gp) {
        const int hcol = ((n0 + wc * 64) >> 1) + gp * 16 + fq * 4;
        const f32x4 a = acc[mi][2 * gp], b = acc[mi][2 * gp + 1];
        float r[4];
#pragma unroll
        for (int e = 0; e < 4; ++e) r[e] = a[e] * sigmoidf_(a[e]) * b[e];
        *(uint2*)(hid + (size_t)row * FF + hcol) = make_uint2(pk2(r[0], r[1]), pk2(r[2], r[3]));
      }
    }
  }
}

DEV void phase_gemm_ffn_down(const Params& p, unsigned char* smem, int* slot) {
  EPI_COORDS;
  const bf16_t* A = (const bf16_t*)(p.ws + OFF_HID);
  const bf16_t* Bt = (const bf16_t*)(p.ws + OFF_W2);
  const float* mod = (const float*)(p.ws + OFF_MOD);
  for (;;) {
    const int tile = grab_tile(p, 12, slot);
    if (tile >= 64 * 8) break;
    const int tm = tile % 64, tn = tile / 64, m0 = tm * 96, n0 = tn * 128;
    f32x4 acc[3][4];
    zero_acc<3>(acc);
    gemm_tile_acc<3>(acc, A, FF, Bt, FF, m0, n0, FF, smem);
#pragma unroll
    for (int mi = 0; mi < 3; ++mi) {
      const int row = m0 + wr * 48 + mi * 16 + fr;
      const float* g2 = mod + modidx(row) * 6144 + 5120;
#pragma unroll
      for (int ni = 0; ni < 4; ++ni) {
        const int col = n0 + wc * 64 + ni * 16 + fq * 4;
        float* op = p.out + (size_t)row * D + col;
        const f32x4 x = __builtin_nontemporal_load((const f32x4*)op);
        const f32x4 g = *(const f32x4*)(g2 + col);
        __builtin_nontemporal_store(x + g * acc[mi][ni], (f32x4*)op);
      }
    }
  }
}

DEV void phase_qkprep(const Params& p, unsigned char* smem, int item_) {
  const int tid = threadIdx.x;
  bf16_t* Vs = (bf16_t*)smem;
  bf16_t* qb = (bf16_t*)(p.ws + OFF_QB);
  bf16_t* kb = (bf16_t*)(p.ws + OFF_KB);
  bf16_t* vT = (bf16_t*)(p.ws + OFF_VT);
  bf16_t* ckb = (bf16_t*)(p.ws + OFF_CKB);
  bf16_t* cvT = (bf16_t*)(p.ws + OFF_CVT);
  const float* una = (const float*)(p.ws + OFF_UNA);
  const int tok = tid >> 2, part = tid & 3;
  for (int item = item_; item < item_ + 1; ++item) {
    if (item < 768) {
      const int tt = item >> 3, h = item & 7, t0 = tt * 64, t = t0 + tok;
      const float* src = una + (size_t)t * 1536 + h * 64 + part * 16;
      {
        float x[16]; float ss = 0.f;
#pragma unroll
        for (int i = 0; i < 4; ++i) { const float4 v = *(const float4*)(src + i * 4); x[4 * i] = v.x; x[4 * i + 1] = v.y; x[4 * i + 2] = v.z; x[4 * i + 3] = v.w; }
#pragma unroll
        for (int i = 0; i < 16; ++i) ss += x[i] * x[i];
        ss += __shfl_xor(ss, 1); ss += __shfl_xor(ss, 2);
        const float rs = rsqrtf(ss * (1.f / 64.f) + 1e-6f) * 0.125f;
        unsigned w[8];
#pragma unroll
        for (int i = 0; i < 8; ++i) w[i] = pk2(x[2 * i] * rs * p.in[23][part * 16 + 2 * i], x[2 * i + 1] * rs * p.in[23][part * 16 + 2 * i + 1]);
        uint4* dp = (uint4*)(qb + (size_t)t * 512 + h * 64 + part * 16);
        dp[0] = make_uint4(w[0], w[1], w[2], w[3]); dp[1] = make_uint4(w[4], w[5], w[6], w[7]);
      }
      {
        float x[16]; float ss = 0.f;
#pragma unroll
        for (int i = 0; i < 4; ++i) { const float4 v = *(const float4*)(src + 512 + i * 4); x[4 * i] = v.x; x[4 * i + 1] = v.y; x[4 * i + 2] = v.z; x[4 * i + 3] = v.w; }
#pragma unroll
        for (int i = 0; i < 16; ++i) ss += x[i] * x[i];
        ss += __shfl_xor(ss, 1); ss += __shfl_xor(ss, 2);
        const float rs = rsqrtf(ss * (1.f / 64.f) + 1e-6f);
#pragma unroll
        for (int i = 0; i < 16; ++i) x[i] = x[i] * rs * p.in[24][part * 16 + i];
        if (t < NCTX) {
          float4* op = (float4*)(p.out + OUT_K + (size_t)t * 512 + h * 64 + part * 16);
#pragma unroll
          for (int i = 0; i < 4; ++i) op[i] = make_float4(x[4 * i], x[4 * i + 1], x[4 * i + 2], x[4 * i + 3]);
        }
        unsigned w[8];
#pragma unroll
        for (int i = 0; i < 8; ++i) w[i] = pk2(x[2 * i], x[2 * i + 1]);
        uint4* dp = (uint4*)(kb + (size_t)t * 512 + h * 64 + part * 16);
        dp[0] = make_uint4(w[0], w[1], w[2], w[3]); dp[1] = make_uint4(w[4], w[5], w[6], w[7]);
      }
      {
        float x[16];
#pragma unroll
        for (int i = 0; i < 4; ++i) { const float4 v = *(const float4*)(src + 1024 + i * 4); x[4 * i] = v.x; x[4 * i + 1] = v.y; x[4 * i + 2] = v.z; x[4 * i + 3] = v.w; }
        if (t < NCTX) {
          float4* op = (float4*)(p.out + OUT_V + (size_t)t * 512 + h * 64 + part * 16);
#pragma unroll
          for (int i = 0; i < 4; ++i) op[i] = make_float4(x[4 * i], x[4 * i + 1], x[4 * i + 2], x[4 * i + 3]);
        }
#pragma unroll
        for (int i = 0; i < 16; ++i) Vs[tok * 72 + part * 16 + i] = f2bf(x[i]);
      }
      __syncthreads();
      {
        const int d = tid >> 2;
        unsigned w[8];
#pragma unroll
        for (int i = 0; i < 8; ++i) w[i] = (unsigned)Vs[(part * 16 + 2 * i) * 72 + d] | ((unsigned)Vs[(part * 16 + 2 * i + 1) * 72 + d] << 16);
        uint4* dp = (uint4*)(vT + (size_t)(h * 64 + d) * NTOK + t0 + part * 16);
        dp[0] = make_uint4(w[0], w[1], w[2], w[3]); dp[1] = make_uint4(w[4], w[5], w[6], w[7]);
      }
      __syncthreads();
    } else {
      const int ci = item - 768, b = ci >> 5, rem = ci & 31, tt = rem >> 3, h = rem & 7, t0 = tt * 64, t = t0 + tok;
      const size_t sidx = (size_t)(b * 256 + t) * 512 + h * 64 + part * 16;
      {
        float x[16];
#pragma unroll
        for (int i = 0; i < 4; ++i) { const float4 v = *(const float4*)(p.in[3] + sidx + i * 4); x[4 * i] = v.x; x[4 * i + 1] = v.y; x[4 * i + 2] = v.z; x[4 * i + 3] = v.w; }
        unsigned w[8];
#pragma unroll
        for (int i = 0; i < 8; ++i) w[i] = pk2(x[2 * i], x[2 * i + 1]);
        uint4* dp = (uint4*)(ckb + sidx);
        dp[0] = make_uint4(w[0], w[1], w[2], w[3]); dp[1] = make_uint4(w[4], w[5], w[6], w[7]);
      }
      {
        float x[16];
#pragma unroll
        for (int i = 0; i < 4; ++i) { const float4 v = *(const float4*)(p.in[4] + sidx + i * 4); x[4 * i] = v.x; x[4 * i + 1] = v.y; x[4 * i + 2] = v.z; x[4 * i + 3] = v.w; }
#pragma unroll
        for (int i = 0; i < 16; ++i) Vs[tok * 72 + part * 16 + i] = f2bf(x[i]);
      }
      __syncthreads();
      {
        const int d = tid >> 2;
        unsigned w[8];
#pragma unroll
        for (int i = 0; i < 8; ++i) w[i] = (unsigned)Vs[(part * 16 + 2 * i) * 72 + d] | ((unsigned)Vs[(part * 16 + 2 * i + 1) * 72 + d] << 16);
        uint4* dp = (uint4*)(cvT + (size_t)((b * 8 + h) * 64 + d) * 256 + t0 + part * 16);
        dp[0] = make_uint4(w[0], w[1], w[2], w[3]); dp[1] = make_uint4(w[4], w[5], w[6], w[7]);
      }
      __syncthreads();
    }
  }
}

DEV float* ops_arr(const Params& p, int i) { return (float*)(p.ws + OFF_OPS + (size_t)i * OPS_ARR); }

DEV f32x4 shiftvec(f32x4 cur, f32x4 hal, f32x4 mu0, f32x4 mu1, int fr) {
  f32x4 prev, next;
#pragma unroll
  for (int i = 0; i < 4; ++i) {
    prev[i] = dpp_mov<0x111>(cur[i]);
    next[i] = dpp_mov<0x101>(cur[i]);
  }
  if (fr == 0) prev = hal;
  if (fr == 15) next = hal;
  return cur + mu0 * (prev - cur) + mu1 * (next - cur);
}
DEV float quad_sum(float x) { x += __shfl_xor(x, 16); x += __shfl_xor(x, 32); return x; }
DEV f32x4 ld4(const float* p) { return *(const f32x4*)p; }
DEV f32x4 ld4nt(const float* p) { return __builtin_nontemporal_load((const f32x4*)p); }

constexpr int LROWB = 392;
template <bool HALF>
DEV void phase_rwprep(const Params& p, unsigned char* smem, int item_) {
  const int tid = threadIdx.x, lane = tid & 63, w = tid >> 6, fr = lane & 15, fq = lane >> 4;
  bf16_t* Lb = (bf16_t*)smem;
  const float* urw = (const float*)(p.ws + OFF_URW);
  const float* mu = p.in[12];
  bf16_t* bonus = (bf16_t*)(p.ws + OFF_BG);
  bf16_t* gate = (bf16_t*)(p.ws + OFF_BG + 6291456);
  const bf16_t* WUPT = (const bf16_t*)(p.ws + OFF_LORA);
  const bf16_t* AUPT = WUPT + 65536;
  const bf16_t* GUPT = WUPT + 131072;
  float* o_r = ops_arr(p, 0); float* o_v = ops_arr(p, 1); float* o_a = ops_arr(p, 2);
  for (int item = item_; item < item_ + 1; ++item) {
    const int t0 = HALF ? (256 + (item >> 2)) * 16 : (item >> 1) * 16;
    const int h = HALF ? (item & 3) * 2 + (w >> 1) : (item & 1) * 4 + w;
    const int ni_lo = HALF ? (w & 1) * 2 : 0, ni_hi = HALF ? ni_lo + 2 : 4;
    float* xs = (float*)(smem + 16384);
    int s_lo, s_hi;
    if (t0 < NCTX) { s_lo = t0 & ~255; s_hi = s_lo + 256; } else { s_lo = NCTX + ((t0 - NCTX) & ~1023); s_hi = s_lo + 1024; }
    {
      const int tl = tid >> 4, g16 = tid & 15, tt = t0 + tl;
      const float* up = urw + (size_t)tt * RWC + 1536;
      const bool hp = tt > s_lo, hn = tt + 1 < s_hi;
#pragma unroll
      for (int j = 0; j < 6; ++j) {
        const int col = (g16 + 16 * j) * 4;
        const f32x4 c = ld4(up + col);
        const f32x4 z = (f32x4){0.f, 0.f, 0.f, 0.f};
        const f32x4 pv = hp ? ld4(up - RWC + col) : z;
        const f32x4 nx = hn ? ld4(up + RWC + col) : z;
        const f32x4 m0 = ld4(mu + 1536 + col), m1 = ld4(mu + RWC + 1536 + col);
        const f32x4 us = c + m0 * (pv - c) + m1 * (nx - c);
        const int kind = col >> 7;
        float o4[4];
#pragma unroll
        for (int i = 0; i < 4; ++i) o4[i] = kind == 0 ? (1.f - 2.f / (1.f + __expf(2.f * us[i]))) : (kind == 1 ? us[i] : sigmoidf_(us[i]));
        *(uint2*)(Lb + tl * LROWB + col) = make_uint2(pk2(o4[0], o4[1]), pk2(o4[2], o4[3]));
      }
    }
    __syncthreads();
    const int t = t0 + fr;
    const bool lo_ok = (fr == 0) && (t > s_lo), hi_ok = (fr == 15) && (t + 1 < s_hi);
    const float* urow = urw + (size_t)t * RWC;
    const float* hrow = lo_ok ? urow - RWC : (hi_ok ? urow + RWC : urow);
    const bool hal_ok = lo_ok || hi_ok;
    const f32x4 z4 = (f32x4){0.f, 0.f, 0.f, 0.f};
    float ss = 0.f;
#pragma unroll
    for (int ni = ni_lo; ni < ni_hi; ++ni) {
      const int c = h * 64 + ni * 16 + fq * 4;
      const f32x4 kx = shiftvec(ld4(urow + 512 + c), hal_ok ? ld4(hrow + 512 + c) : z4, ld4(mu + 512 + c), ld4(mu + RWC + 512 + c), fr) * ld4(p.in[18] + c);
      ss += kx[0] * kx[0] + kx[1] * kx[1] + kx[2] * kx[2] + kx[3] * kx[3];
    }
    ss = quad_sum(ss);
    if (HALF) { if (fq == 0) xs[w * 16 + fr] = ss; __syncthreads(); ss += xs[(w ^ 1) * 16 + fr]; }
    const float rn = rsqrtf(ss + 1e-12f);
    float bs = 0.f;
#pragma unroll 1
    for (int ni = ni_lo; ni < ni_hi; ++ni) {
      const int c = h * 64 + ni * 16 + fq * 4;
      const size_t o = (size_t)t * 512 + c;
      const f32x4 r4 = shiftvec(ld4nt(urow + c), hal_ok ? ld4nt(hrow + c) : z4, ld4(mu + c), ld4(mu + RWC + c), fr);
      const f32x4 k4 = shiftvec(ld4nt(urow + 512 + c), hal_ok ? ld4nt(hrow + 512 + c) : z4, ld4(mu + 512 + c), ld4(mu + RWC + 512 + c), fr);
      const f32x4 v4 = shiftvec(ld4nt(urow + 1024 + c), hal_ok ? ld4nt(hrow + 1024 + c) : z4, ld4(mu + 1024 + c), ld4(mu + RWC + 1024 + c), fr);
      const f32x4 kk4 = k4 * ld4(p.in[18] + c) * rn;
      *(f32x4*)(o_r + o) = r4; *(f32x4*)(o_v + o) = v4; *(f32x4*)(o_a + o) = -kk4;
      const f32x4 ka = ld4(p.in[19] + c);
      f32x4 bacc = z4;
#pragma unroll
      for (int e = 0; e < 2; ++e) {
        float* o_k = ops_arr(p, 5 + e); float* o_b = ops_arr(p, 7 + e); float* o_w = ops_arr(p, 3 + e);
        f32x4 acc = z4, acw = z4;
#pragma unroll
        for (int ks = 0; ks < 2; ++ks) {
          const bf16x8 wa = *(const bf16x8*)(AUPT + (size_t)(e * 512 + h * 64 + ni * 16 + fr) * 64 + ks * 32 + fq * 8);
          const bf16x8 la = *(const bf16x8*)(Lb + fr * LROWB + 128 + e * 64 + ks * 32 + fq * 8);
          acc = __builtin_amdgcn_mfma_f32_16x16x32_bf16(wa, la, acc, 0, 0, 0);
          const bf16x8 ww = *(const bf16x8*)(WUPT + (size_t)(e * 512 + h * 64 + ni * 16 + fr) * 64 + ks * 32 + fq * 8);
          const bf16x8 lw = *(const bf16x8*)(Lb + fr * LROWB + e * 64 + ks * 32 + fq * 8);
          acw = __builtin_amdgcn_mfma_f32_16x16x32_bf16(ww, lw, acw, 0, 0, 0);
        }
        const f32x4 a0 = ld4(p.in[15] + e * 512 + c), w0 = ld4(p.in[13] + e * 512 + c);
        f32x4 kd, bb, dec;
#pragma unroll
        for (int i = 0; i < 4; ++i) {
          const float ic = sigmoidf_(a0[i] + acc[i]);
          kd[i] = k4[i] * (1.f + (ic - 1.f) * ka[i]);
          bb[i] = kk4[i] * ic;
          const float z = w0[i] + acw[i];
          const float sp = fmaxf(-z, 0.f) + __logf(1.f + __expf(-fabsf(z)));
          dec[i] = __expf(-__expf(-sp - 0.5f));
        }
        bacc += kd;
        *(f32x4*)(o_k + o) = kd; *(f32x4*)(o_b + o) = bb; *(f32x4*)(o_w + o) = dec;
      }
      const f32x4 rk = ld4(p.in[20] + c);
#pragma unroll
      for (int i = 0; i < 4; ++i) bs += r4[i] * 0.5f * bacc[i] * rk[i];
      f32x4 acc = z4;
#pragma unroll
      for (int ks = 0; ks < 4; ++ks) {
        const bf16x8 wg = *(const bf16x8*)(GUPT + (size_t)(h * 64 + ni * 16 + fr) * 128 + ks * 32 + fq * 8);
        const bf16x8 lg = *(const bf16x8*)(Lb + fr * LROWB + 256 + ks * 32 + fq * 8);
        acc = __builtin_amdgcn_mfma_f32_16x16x32_bf16(wg, lg, acc, 0, 0, 0);
      }
      *(uint2*)(gate + o) = make_uint2(pk2(acc[0], acc[1]), pk2(acc[2], acc[3]));
    }
    bs = quad_sum(bs);
    if (HALF) { if (fq == 0) xs[64 + w * 16 + fr] = bs; __syncthreads(); bs += xs[64 + (w ^ 1) * 16 + fr]; }
#pragma unroll
    for (int ni = ni_lo; ni < ni_hi; ++ni) {
      const size_t o = (size_t)t * 512 + h * 64 + ni * 16 + fq * 4;
      const f32x4 v4 = *(const f32x4*)(o_v + o);
      *(uint2*)(bonus + o) = make_uint2(pk2(bs * v4[0], bs * v4[1]), pk2(bs * v4[2], bs * v4[3]));
    }
    __syncthreads();
  }
}

DEV void phase_prep(const Params& p, unsigned char* smem, int* s_item, int rep) {
  unsigned* counter = (unsigned*)(p.ws + OFF_CTL) + 16 + rep;
  for (;;) {
    if (threadIdx.x == 0) *s_item = (int)atomicAdd(counter, 1u);
    __syncthreads();
    const int item = *s_item;
    __syncthreads();
    if (item >= 1024 + 64) break;
    if (item < 512) phase_rwprep<false>(p, smem, item);
    else if (item < 1024) phase_rwprep<true>(p, smem, item - 512);
    else phase_qkprep(p, smem, item - 256);
  }
}

constexpr int TC = 16;
typedef float f32x2 __attribute__((ext_vector_type(2)));
template <int EPL, int R, int PD>
DEV void scan_item(const Params& p, unsigned char* smem, int seq, int h, int dir, int rg) {
  constexpr int LPR = 64 / EPL, RPW = 64 / LPR, RPB = 4 * RPW * R, NV = RPB / 16, NP = EPL / 2;
  constexpr int STG = 20480 + 16 * RPB * 4, YOFF = 2 * STG, YSZ = 16 * RPB * 4;
  const int tid = threadIdx.x, lane = tid & 63, w = tid >> 6, riw = lane / LPR, kq = lane % LPR;
  const int T = seq < 16 ? 256 : 1024;
  const int tok0 = seq < 16 ? seq * 256 : NCTX + (seq - 16) * 1024;
  const int vrow_l = (w * RPW + riw) * R;
  const int vrow = rg * RPB + vrow_l;
  f32x2 S[R][NP];
#pragma unroll
  for (int rr = 0; rr < R; ++rr) {
    if (seq >= 16) {
      const float* sp = p.in[2] + ((size_t)(((seq - 16) * 2 + dir) * 8 + h) * 64 + vrow + rr) * 64 + kq * EPL;
#pragma unroll
      for (int i = 0; i < NP; ++i) S[rr][i] = *(const f32x2*)(sp + 2 * i);
    } else {
#pragma unroll
      for (int i = 0; i < NP; ++i) S[rr][i] = (f32x2){0.f, 0.f};
    }
  }
  const int lstep = tid >> 4, l16 = tid & 15;
  const float* pr = ops_arr(p, 0) + h * 64 + l16 * 4;
  const float* pw = ops_arr(p, 3 + dir) + h * 64 + l16 * 4;
  const float* pk = ops_arr(p, 5 + dir) + h * 64 + l16 * 4;
  const float* pa = ops_arr(p, 2) + h * 64 + l16 * 4;
  const float* pb = ops_arr(p, 7 + dir) + h * 64 + l16 * 4;
  const float* pv = ops_arr(p, 1) + h * 64 + rg * RPB + l16;
  float* yout = (float*)(p.ws + (dir ? OFF_YB : OFF_YF)) + h * 64 + rg * RPB + l16;
  const int nc = T / TC;
  float4 g_r, g_w, g_k, g_a, g_b; float rv[NV];
#define gload(c) do { const int ts_ = (c) * TC + lstep; const size_t t_ = (size_t)(tok0 + (dir ? T - 1 - ts_ : ts_)) * 512; \
    if (R == 4) { g_r = ldnt4(pr + t_); g_w = ldnt4(pw + t_); g_k = ldnt4(pk + t_); g_a = ldnt4(pa + t_); g_b = ldnt4(pb + t_); } else { \
    g_r = *(const float4*)(pr + t_); g_w = *(const float4*)(pw + t_); g_k = *(const float4*)(pk + t_); \
    g_a = *(const float4*)(pa + t_); g_b = *(const float4*)(pb + t_); } \
    _Pragma("unroll") for (int q_ = 0; q_ < NV; ++q_) rv[q_] = pv[t_ + 16 * q_]; } while (0)
#define ywrite(c) do { const float* yb_ = (const float*)(smem + YOFF + ((c) & 1) * YSZ); const int ts_ = (c) * TC + lstep; \
    const size_t t_ = (size_t)(tok0 + (dir ? T - 1 - ts_ : ts_)) * 512; \
    _Pragma("unroll") for (int q_ = 0; q_ < NV; ++q_) yout[t_ + 16 * q_] = yb_[lstep * RPB + l16 + 16 * q_]; } while (0)
  gload(0);
  for (int c = 0; c < nc; ++c) {
    unsigned char* st = smem + (c & 1) * STG;
    *(float4*)(st + 0 * 4096 + lstep * 256 + l16 * 16) = g_r;
    *(float4*)(st + 1 * 4096 + lstep * 256 + l16 * 16) = g_w;
    *(float4*)(st + 2 * 4096 + lstep * 256 + l16 * 16) = g_k;
    *(float4*)(st + 3 * 4096 + lstep * 256 + l16 * 16) = g_a;
    *(float4*)(st + 4 * 4096 + lstep * 256 + l16 * 16) = g_b;
#pragma unroll
    for (int q = 0; q < NV; ++q) *(float*)(st + 20480 + (lstep * RPB + l16 + 16 * q) * 4) = rv[q];
    __syncthreads();
    if (c > 0) ywrite(c - 1);
    if (c + 1 < nc) gload(c + 1);
    float* ybw = (float*)(smem + YOFF + (c & 1) * YSZ);
    constexpr int NS = PD + 1;
    f32x2 o_r[NS][NP], o_w[NS][NP], o_k[NS][NP], o_a[NS][NP], o_b[NS][NP]; float o_v[NS][R];
    float ykeep[R][TC / LPR];
#define LDOPS(bi, s_) do { \
      _Pragma("unroll") for (int i_ = 0; i_ < NP; ++i_) { \
        o_r[bi][i_] = *(const f32x2*)(st + 0 * 4096 + (s_) * 256 + kq * EPL * 4 + i_ * 8); \
        o_w[bi][i_] = *(const f32x2*)(st + 1 * 4096 + (s_) * 256 + kq * EPL * 4 + i_ * 8); \
        o_k[bi][i_] = *(const f32x2*)(st + 2 * 4096 + (s_) * 256 + kq * EPL * 4 + i_ * 8); \
        o_a[bi][i_] = *(const f32x2*)(st + 3 * 4096 + (s_) * 256 + kq * EPL * 4 + i_ * 8); \
        o_b[bi][i_] = *(const f32x2*)(st + 4 * 4096 + (s_) * 256 + kq * EPL * 4 + i_ * 8); } \
      _Pragma("unroll") for (int rr_ = 0; rr_ < R; ++rr_) o_v[bi][rr_] = *(const float*)(st + 20480 + ((s_) * RPB + vrow_l + rr_) * 4); } while (0)
#pragma unroll
    for (int s = 0; s < PD; ++s) LDOPS(s, s);
#pragma unroll
    for (int s = 0; s < TC; ++s) {
      const int bi = s % NS;
      if (s + PD < TC) LDOPS((s + PD) % NS, s + PD);
#pragma unroll
      for (int rr = 0; rr < R; ++rr) {
        const f32x2 vv2 = (f32x2){o_v[bi][rr], o_v[bi][rr]};
        f32x2 pa2 = S[rr][0] * o_a[bi][0];
        f32x2 tt[NP];
        tt[0] = S[rr][0] * o_w[bi][0] + vv2 * o_k[bi][0];
#pragma unroll
        for (int i = 1; i < NP; ++i) { pa2 += S[rr][i] * o_a[bi][i]; tt[i] = S[rr][i] * o_w[bi][i] + vv2 * o_k[bi][i]; }
        float sa = pa2[0] + pa2[1];
        sa += dpp_mov<0xB1>(sa); sa += dpp_mov<0x4E>(sa); sa += dpp_mov<0x141>(sa);
        if (LPR == 16) sa += dpp_mov<0x140>(sa);
        const f32x2 sa2 = (f32x2){sa, sa};
        f32x2 py = (f32x2){0.f, 0.f};
#pragma unroll
        for (int i = 0; i < NP; ++i) { S[rr][i] = sa2 * o_b[bi][i] + tt[i]; py += S[rr][i] * o_r[bi][i]; }
        float y = py[0] + py[1];
        y += dpp_mov<0xB1>(y); y += dpp_mov<0x4E>(y); y += dpp_mov<0x141>(y);
        if (LPR == 16) y += dpp_mov<0x140>(y);
        if ((s % LPR) == 0) ykeep[rr][s / LPR] = y; else ykeep[rr][s / LPR] = (kq == (s % LPR)) ? y : ykeep[rr][s / LPR];
      }
    }
#undef LDOPS
#pragma unroll
    for (int rr = 0; rr < R; ++rr)
#pragma unroll
      for (int q = 0; q < TC / LPR; ++q) ybw[(q * LPR + kq) * RPB + vrow_l + rr] = ykeep[rr][q];
  }
  __syncthreads();
  ywrite(nc - 1);
  if (seq < 16) {
#pragma unroll
    for (int rr = 0; rr < R; ++rr) {
      float* so = p.out + OUT_STATE + ((size_t)((seq * 2 + dir) * 8 + h) * 64 + vrow + rr) * 64 + kq * EPL;
#pragma unroll
      for (int i = 0; i < NP; ++i) *(f32x2*)(so + 2 * i) = S[rr][i];
    }
  }
  __syncthreads();
#undef gload
#undef ywrite
}

DEV void attn_wave_item(const Params& p, int witem) {
  const int lane = threadIdx.x & 63, fr = lane & 15, fq = lane >> 4;
  const bf16_t* qb = (const bf16_t*)(p.ws + OFF_QB);
  const bf16_t* kb = (const bf16_t*)(p.ws + OFF_KB);
  const bf16_t* vT = (const bf16_t*)(p.ws + OFF_VT);
  const bf16_t* ckb = (const bf16_t*)(p.ws + OFF_CKB);
  const bf16_t* cvT = (const bf16_t*)(p.ws + OFF_CVT);
  bf16_t* ona = (bf16_t*)(p.ws + OFF_ONA);
  int h, tq0, nsub;
  bool latent;
  int b = 0, r = 0, jb = 0, row_start = 0, band = 0, seq = 0;
  {
    const int bi = witem >> 2, wv = witem & 3;
    if (bi < 256) {
      latent = true;
      b = bi >> 7; const int rem = bi & 127; r = rem >> 3; h = rem & 7; jb = wv;
      tq0 = NCTX + b * 1024 + r * 64 + jb * 16;
      row_start = min(max(r - 4, 0), 8); band = min(max(jb * 16 - 8, 0), 32);
      nsub = 4;
    } else {
      latent = false;
      const int c2 = bi - 256; seq = c2 >> 5; const int rem = c2 & 31; h = rem >> 2; const int qg = rem & 3;
      tq0 = seq * 256 + (qg * 4 + wv) * 16; nsub = 2;
    }
  }
  const bf16_t* qp = qb + (size_t)(tq0 + fr) * 512 + h * 64 + fq * 8;
  const bf16x8 qf0 = *(const bf16x8*)qp, qf1 = *(const bf16x8*)(qp + 32);
  float m = -INFINITY, l = 0.f;
  f32x4 O[4];
#pragma unroll
  for (int i = 0; i < 4; ++i) O[i] = (f32x4){0.f, 0.f, 0.f, 0.f};
#define SUBDESC(sc_, kbase_, vbase_, KS_, ldv_, win_) do { const int half_ = (sc_) & 1; win_ = latent && (sc_) < 2; \
    if (win_) { const int tb_ = NCTX + b * 1024 + (row_start + half_ * 4) * 64 + band; \
      kbase_ = kb + (size_t)tb_ * 512 + h * 64; vbase_ = vT + (size_t)(h * 64) * NTOK + tb_; KS_ = 64; ldv_ = NTOK; } \
    else if (latent) { kbase_ = ckb + (size_t)(b * 256 + half_ * 128) * 512 + h * 64; vbase_ = cvT + (size_t)((b * 8 + h) * 64) * 256 + half_ * 128; KS_ = 32; ldv_ = 256; } \
    else { const int tb_ = seq * 256 + half_ * 128; kbase_ = kb + (size_t)tb_ * 512 + h * 64; vbase_ = vT + (size_t)(h * 64) * NTOK + tb_; KS_ = 32; ldv_ = NTOK; } } while (0)
#define KLOAD(kbase_, KS_) do { _Pragma("unroll") for (int i_ = 0; i_ < 8; ++i_) { \
      const bf16_t* kp_ = kbase_ + (size_t)((i_ >> 1) * KS_ + (fr >> 2) * 8 + (i_ & 1) * 4 + (fr & 3)) * 512 + fq * 8; \
      kf[2 * i_] = *(const bf16x8*)kp_; kf[2 * i_ + 1] = *(const bf16x8*)(kp_ + 32); } } while (0)
  bf16x8 kf[16];
#pragma unroll 1
  for (int sc = 0; sc < nsub; ++sc) {
    const int half = sc & 1;
    const bf16_t* kbase; const bf16_t* vbase; int KS, ldv; bool win;
    SUBDESC(sc, kbase, vbase, KS, ldv, win);
    KLOAD(kbase, KS);
    bf16x8 vf[4][4];
#pragma unroll
    for (int s = 0; s < 4; ++s)
#pragma unroll
      for (int dt = 0; dt < 4; ++dt) {
        vf[s][dt] = *(const bf16x8*)(vbase + (size_t)(dt * 16 + fr) * ldv + s * KS + fq * 8);
      }
    f32x4 st[8];
#pragma unroll
    for (int i = 0; i < 8; ++i) {
      f32x4 z = (f32x4){0.f, 0.f, 0.f, 0.f};
      z = __builtin_amdgcn_mfma_f32_16x16x32_bf16(kf[2 * i], qf0, z, 0, 0, 0);
      st[i] = __builtin_amdgcn_mfma_f32_16x16x32_bf16(kf[2 * i + 1], qf1, z, 0, 0, 0);
    }
    const bool cwin = win;
    if (cwin) {
      const int q_col = jb * 16 + fr;
      const int win_start = min(max(q_col - 8, 0), 48);
      const float* rpb = p.in[25] + h * 465;
#pragma unroll
      for (int i = 0; i < 8; ++i) {
        const int dr = row_start + half * 4 + (i >> 1) - r + 7;
#pragma unroll
        for (int e = 0; e < 4; ++e) {
          const int k_col = band + fq * 8 + (i & 1) * 4 + e;
          const bool valid = (k_col >= win_start) && (k_col < win_start + 16);
          const int dc = min(max(k_col - q_col, -15), 15) + 15;
          st[i][e] = valid ? st[i][e] + rpb[dr * 31 + dc] : -1e30f;
        }
      }
    }
    float cmax = -1e30f;
#pragma unroll
    for (int i = 0; i < 8; ++i)
#pragma unroll
      for (int e = 0; e < 4; ++e) cmax = fmaxf(cmax, st[i][e]);
    cmax = fmaxf(cmax, __shfl_xor(cmax, 16)); cmax = fmaxf(cmax, __shfl_xor(cmax, 32));
    const float mnew = fmaxf(m, cmax);
    const float alpha = __expf(m - mnew);
    float psum = 0.f;
#pragma unroll
    for (int i = 0; i < 8; ++i)
#pragma unroll
      for (int e = 0; e < 4; ++e) { const float pv = __expf(st[i][e] - mnew); st[i][e] = pv; psum += pv; }
    psum += __shfl_xor(psum, 16); psum += __shfl_xor(psum, 32);
    l = l * alpha + psum;
#pragma unroll
    for (int i = 0; i < 4; ++i) O[i] = O[i] * alpha;
    m = mnew;
#pragma unroll
    for (int s = 0; s < 4; ++s) {
      union { bf16x8 v; unsigned u[4]; } pb;
      pb.u[0] = pk2(st[2 * s][0], st[2 * s][1]); pb.u[1] = pk2(st[2 * s][2], st[2 * s][3]);
      pb.u[2] = pk2(st[2 * s + 1][0], st[2 * s + 1][1]); pb.u[3] = pk2(st[2 * s + 1][2], st[2 * s + 1][3]);
#pragma unroll
      for (int dt = 0; dt < 4; ++dt) {
        O[dt] = __builtin_amdgcn_mfma_f32_16x16x32_bf16(vf[s][dt], pb.v, O[dt], 0, 0, 0);
      }
    }
  }
#undef SUBDESC
#undef KLOAD
  const float inv = 1.f / l;
#pragma unroll
  for (int dt = 0; dt < 4; ++dt) {
    bf16_t* op = ona + (size_t)(tq0 + fr) * 512 + h * 64 + dt * 16 + fq * 4;
    *(uint2*)op = make_uint2(pk2(O[dt][0] * inv, O[dt][1] * inv), pk2(O[dt][2] * inv, O[dt][3] * inv));
  }
}

constexpr int N_SCAN_ITEMS = 128 + 256, N_ATTN_BLK = 768;
DEV void phase_scan_attn(const Params& p, unsigned char* smem, int* s_item, int rep) {
  unsigned* counter = (unsigned*)(p.ws + OFF_CTL) + rep;
  for (;;) {
    if (threadIdx.x == 0) *s_item = (int)atomicAdd(counter, 1u);
    __syncthreads();
    const int item = *s_item;
    __syncthreads();
    if (item >= N_SCAN_ITEMS + N_ATTN_BLK) break;
    if (item < 128) { const int rem = item & 63; scan_item<4, 1, 3>(p, smem, 16 + (item >> 6), rem >> 3, (rem >> 2) & 1, rem & 3); }
    else if (item >= N_SCAN_ITEMS) attn_wave_item(p, (item - N_SCAN_ITEMS) * 4 + (threadIdx.x >> 6));
    else { const int i2 = item - 128, rem = i2 & 15; scan_item<4, 4, 1>(p, smem, i2 >> 4, rem >> 1, rem & 1, 0); }
  }
}

DEV void phase_finalize_rw(const Params& p, int bid, int nb) {
  const int lane = threadIdx.x & 63, gw = bid * 4 + (threadIdx.x >> 6), nw = nb * 4;
  const float* yf = (const float*)(p.ws + OFF_YF);
  const float* yb = (const float*)(p.ws + OFF_YB);
  const bf16_t* bonus = (const bf16_t*)(p.ws + OFF_BG);
  const bf16_t* gate = (const bf16_t*)(p.ws + OFF_BG + 6291456);
  bf16_t* orw = (bf16_t*)(p.ws + OFF_ORW);
  const float4 g0 = *(const float4*)(p.in[21] + lane * 8), g1 = *(const float4*)(p.in[21] + lane * 8 + 4);
  const float4 b0 = *(const float4*)(p.in[22] + lane * 8), b1 = *(const float4*)(p.in[22] + lane * 8 + 4);
  const float gg[8] = {g0.x, g0.y, g0.z, g0.w, g1.x, g1.y, g1.z, g1.w};
  const float bb[8] = {b0.x, b0.y, b0.z, b0.w, b1.x, b1.y, b1.z, b1.w};
#pragma unroll 3
  for (int t = gw; t < NTOK; t += nw) {
    const size_t o = (size_t)t * 512 + lane * 8;
    const float4 a0 = ldnt4(yf + o), a1 = ldnt4(yf + o + 4);
    const float4 c0 = ldnt4(yb + o), c1 = ldnt4(yb + o + 4);
    const uint4 bo = *(const uint4*)(bonus + o), ga = *(const uint4*)(gate + o);
    float y[8] = {a0.x + c0.x, a0.y + c0.y, a0.z + c0.z, a0.w + c0.w, a1.x + c1.x, a1.y + c1.y, a1.z + c1.z, a1.w + c1.w};
    float s = 0.f;
#pragma unroll
    for (int i = 0; i < 8; ++i) s += y[i];
    s += dpp_mov<0xB1>(s); s += dpp_mov<0x4E>(s); s += dpp_mov<0x141>(s);
    const float mean = s * (1.f / 64.f);
    float q = 0.f;
#pragma unroll
    for (int i = 0; i < 8; ++i) { y[i] -= mean; q += y[i] * y[i]; }
    q += dpp_mov<0xB1>(q); q += dpp_mov<0x4E>(q); q += dpp_mov<0x141>(q);
    const float rstd = rsqrtf(q * (1.f / 64.f) + 64e-5f);
    const unsigned bu[4] = {bo.x, bo.y, bo.z, bo.w}, gu[4] = {ga.x, ga.y, ga.z, ga.w};
    unsigned w[4];
#pragma unroll
    for (int i = 0; i < 4; ++i) {
      const float lo = (y[2 * i] * rstd * gg[2 * i] + bb[2 * i] + __uint_as_float(bu[i] << 16)) * __uint_as_float(gu[i] << 16);
      const float hi = (y[2 * i + 1] * rstd * gg[2 * i + 1] + bb[2 * i + 1] + __uint_as_float(bu[i] & 0xffff0000u)) * __uint_as_float(gu[i] & 0xffff0000u);
      w[i] = pk2(lo, hi);
    }
    *(uint4*)(orw + o) = make_uint4(w[0], w[1], w[2], w[3]);
  }
}

#define XB_TMO      128
#define XB_XCNT(j)  (256  + 64 * (j))
#define XB_XSUB(j)  (1280 + 64 * (j))
#define XB_XGEN(j)  (2304 + 64 * (j))
#define XB_TOP      3328
#define XB_TOPGEN   3392
#define XCD_BAR_WORDS 3456
#define XB_SPIN_CAP (1u << 18)
#define LAS __attribute__((address_space(3)))
DEV unsigned xb_ld(unsigned* p)              { return __hip_atomic_load(p, __ATOMIC_RELAXED, __HIP_MEMORY_SCOPE_AGENT); }
DEV unsigned xb_add(unsigned* p, unsigned v) { return __hip_atomic_fetch_add(p, v, __ATOMIC_RELAXED, __HIP_MEMORY_SCOPE_AGENT); }
DEV unsigned xb_xcc_id() { return (unsigned)__builtin_amdgcn_s_getreg((3 << 11) | 20) & 0xFu; }
#define XB_SPIN(cond, bar) do { unsigned _sp = 0; while (cond) { __builtin_amdgcn_s_sleep(1); \
    if ((++_sp & 255u) == 0u) { if (xb_ld(&(bar)[XB_TMO])) break; if (_sp > XB_SPIN_CAP) { atomicAdd(&(bar)[XB_TMO], 1u); break; } } } } while (0)
struct XcdBarrier { unsigned* bar; unsigned x; volatile LAS unsigned* st; };
DEV XcdBarrier xcd_barrier_post(unsigned* bar, volatile LAS unsigned* st) {
  XcdBarrier b; b.bar = bar; b.x = xb_xcc_id(); b.st = st;
  if (threadIdx.x == 0) (void)xb_add(&bar[XB_XCNT(b.x)], 1u);
  return b;
}
DEV void xcd_barrier_complete(unsigned* bar, unsigned x, unsigned& nloc, unsigned& nx) {
  const unsigned G = gridDim.x * gridDim.y * gridDim.z;
  unsigned sum, cnt, mine, sp = 0u;
  for (;;) {
    sum = 0u; cnt = 0u; mine = 0u;
#pragma unroll
    for (unsigned j = 0; j < 16; ++j) { const unsigned c = xb_ld(&bar[XB_XCNT(j)]); sum += c; cnt += (c > 0u) ? 1u : 0u; mine = (j == x) ? c : mine; }
    if (sum == G) break;
    __builtin_amdgcn_s_sleep(1);
    if ((++sp & 255u) == 0u) { if (xb_ld(&bar[XB_TMO])) break; if (sp > XB_SPIN_CAP) { atomicAdd(&bar[XB_TMO], 1u); break; } }
  }
  nloc = mine > 0u ? mine : 1u; nx = cnt > 0u ? cnt : 1u;
}
DEV void xcd_barrier(const XcdBarrier& b) {
  asm volatile("s_waitcnt vmcnt(0)" ::: "memory");
  __syncthreads();
  if (threadIdx.x == 0) {
    unsigned* bar = b.bar;
    __builtin_amdgcn_s_waitcnt(0);
    unsigned nloc = b.st[0], nx = b.st[1];
    if (nloc == 0u) { xcd_barrier_complete(bar, b.x, nloc, nx); b.st[0] = nloc; b.st[1] = nx; }
    const unsigned old = xb_add(&bar[XB_XSUB(b.x)], 1u);
    const unsigned gen = old / nloc;
    if (old + 1u == (gen + 1u) * nloc) {
      __builtin_amdgcn_fence(__ATOMIC_RELEASE, "agent");
      asm volatile("s_waitcnt vmcnt(0)" ::: "memory");
      const unsigned og = xb_add(&bar[XB_TOP], 1u);
      const unsigned tg = og / nx;
      if (og + 1u == (tg + 1u) * nx) xb_add(&bar[XB_TOPGEN], 1u);
      else XB_SPIN(xb_ld(&bar[XB_TOPGEN]) == tg, bar);
      __builtin_amdgcn_fence(__ATOMIC_ACQUIRE, "agent");
      xb_add(&bar[XB_XGEN(b.x)], 1u);
      asm volatile("s_waitcnt vmcnt(0)" ::: "memory");
    } else {
      XB_SPIN(xb_ld(&bar[XB_XGEN(b.x)]) == gen, bar);
      __builtin_amdgcn_fence(__ATOMIC_ACQUIRE, "agent");
      asm volatile("s_waitcnt vmcnt(0)" ::: "memory");
    }
  }
  __syncthreads();
}

__global__ void __launch_bounds__(NTHR, 2) fwd_megakernel(Params p) {
  extern __shared__ __attribute__((aligned(16))) unsigned char smem[];
  __shared__ __attribute__((aligned(16))) unsigned sh_ctl[8];
  cg::grid_group grid = cg::this_grid();
  const int bid = blockIdx.x, nb = gridDim.x;
  if (threadIdx.x < 8) sh_ctl[threadIdx.x] = 0u;
  __syncthreads();
  const XcdBarrier xb = xcd_barrier_post((unsigned*)(p.ws + OFF_CTL), (volatile LAS unsigned*)sh_ctl);
  int* s_item_p = (int*)&sh_ctl[4];
  if (p.ph_hi > 1000) grid.sync();
#define GSYNC() xcd_barrier(xb)
#ifndef DUP
#define DUP -1
#endif
#define PH(n, body) if (p.ph_lo <= n && n < p.ph_hi) { { const int rep = 0; (void)rep; body; } if (DUP == n) { GSYNC(); const int rep = 1; (void)rep; body; } if (n + 1 < p.ph_hi) GSYNC(); }
  PH(0, phase0(p, smem, bid, nb, rep))
  PH(1, phase_normmod<0>(p, bid, nb))
  PH(2, reset_tiles(s_item_p); phase_gemm_in(p, smem, s_item_p))
  PH(3, phase_prep(p, smem, s_item_p, rep))
  PH(4, phase_scan_attn(p, smem, s_item_p, rep))
  PH(5, phase_finalize_rw(p, bid, nb))
  PH(6, reset_tiles(s_item_p); phase_gemm_merge(p, smem, s_item_p))
  PH(7, reset_tiles(s_item_p); phase_gemm_out(p, smem, s_item_p))
  PH(8, phase_normmod<1>(p, bid, nb))
  PH(9, reset_tiles(s_item_p); phase_gemm_ffn_up(p, smem, s_item_p))
  PH(10, reset_tiles(s_item_p); phase_gemm_ffn_down(p, smem, s_item_p))
}

extern "C" void kernel_launch(void* const* d_in, const int* in_sizes, int n_in, void* d_out, int out_size, void* d_ws, size_t ws_size,
                              hipStream_t stream) {
  static int grid_blocks = 0;
  if (grid_blocks == 0) {
    if (n_in != 32 || ws_size < WS_END) { fprintf(stderr, "kernel_launch: unexpected n_in %d / ws_size %zu (need %zu)\n", n_in, ws_size, (size_t)WS_END); grid_blocks = -1; return; }
    int dev = 0, cus = 0, per_cu = 0;
    hipGetDevice(&dev);
    hipDeviceGetAttribute(&cus, hipDeviceAttributeMultiprocessorCount, dev);
    if (hipFuncSetAttribute((const void*)fwd_megakernel, hipFuncAttributeMaxDynamicSharedMemorySize, LDS_BYTES) != hipSuccess) { fprintf(stderr, "hipFuncSetAttribute failed\n"); grid_blocks = -1; return; }
    if (hipOccupancyMaxActiveBlocksPerMultiprocessor(&per_cu, (const void*)fwd_megakernel, NTHR, LDS_BYTES) != hipSuccess || per_cu < 1) { fprintf(stderr, "occupancy query failed (%d)\n", per_cu); grid_blocks = -1; return; }
    if (per_cu > 2) per_cu = 2;
    grid_blocks = cus * per_cu;
    fprintf(stderr, "kernel_launch: cus %d per_cu %d grid %d\n", cus, per_cu, grid_blocks);
  }
  if (grid_blocks < 0) return;
  hipMemsetAsync((char*)d_ws + OFF_CTL, 0, CTL_ZERO_BYTES, stream);
  Params p{};
  for (int i = 0; i < 32; ++i) p.in[i] = (const float*)d_in[i];
  p.out = (float*)d_out; p.ws = (unsigned char*)d_ws; p.ph_lo = 0; p.ph_hi = 11;
  void* args[] = {&p};
  hipError_t e = hipLaunchCooperativeKernel((const void*)fwd_megakernel, dim3(grid_blocks), dim3(NTHR), args, LDS_BYTES, stream);
  if (e != hipSuccess) fprintf(stderr, "cooperative launch failed: %s (grid %d)\n", hipGetErrorString(e), grid_blocks);
}
```

```cpp
#include <hip/hip_runtime.h>
#include <hip/hip_cooperative_groups.h>
#include <cstdio>
#include <cstdint>
namespace cg = cooperative_groups;

#define DEV __device__ __forceinline__
typedef unsigned short bf16_t;
typedef short bf16x8 __attribute__((ext_vector_type(8)));
typedef short bf16x4 __attribute__((ext_vector_type(4)));
typedef float f32x4 __attribute__((ext_vector_type(4)));

constexpr int D = 1024, NTOK = 6144, NCTX = 4096, RW = 512, FF = 2816, INC = 5504, RWC = 1920;
constexpr int NTHR = 256;
constexpr int LDS_BYTES = 65536;

constexpr size_t OFF_CTL = 0;
constexpr size_t OFF_MOD = 16384;
constexpr size_t CTL_ZERO_BYTES = 16384 + 3 * 6144 * 4;
constexpr size_t OFF_WIN = 90112;
constexpr size_t OFF_WORW = OFF_WIN + 11272192;
constexpr size_t OFF_WONA = OFF_WORW + 1048576;
constexpr size_t OFF_WOUT = OFF_WONA + 1048576;
constexpr size_t OFF_W13 = OFF_WOUT + 2097152;
constexpr size_t OFF_W2 = OFF_W13 + 11534336;
constexpr size_t OFF_H = OFF_W2 + 5767168;
constexpr size_t OFF_URW = OFF_H + 12582912;
constexpr size_t OFF_UNA = OFF_URW + 47185920;
constexpr size_t OFF_OPS = OFF_UNA + 37748736;
constexpr size_t OPS_ARR = 12582912;
constexpr size_t OFF_BG = OFF_OPS + 9 * OPS_ARR;
constexpr size_t OFF_VT = OFF_BG + 12582912;
constexpr size_t OFF_CKB = OFF_VT + 6291456;
constexpr size_t OFF_CVT = OFF_CKB + 524288;
constexpr size_t OFF_LORA = OFF_CVT + 524288;
constexpr size_t WS_END = OFF_LORA + 393216;
constexpr size_t OFF_QB = OFF_UNA + 12582912, OFF_KB = OFF_UNA + 18874368;
constexpr size_t OFF_YF = OFF_URW, OFF_YB = OFF_URW + 12582912;
constexpr size_t OFF_ORW = OFF_UNA, OFF_ONA = OFF_UNA + 6291456;
constexpr size_t OFF_MERGED = OFF_OPS;
constexpr size_t OFF_HID = OFF_URW;
constexpr size_t OUT_STATE = 6291456, OUT_K = 7340032, OUT_V = 9437184;

struct Params {
  const float* in[32];
  float* out;
  unsigned char* ws;
  int ph_lo, ph_hi;
};

DEV unsigned short f2bf(float f) { unsigned u = __float_as_uint(f); u += 0x7fffu + ((u >> 16) & 1u); return (unsigned short)(u >> 16); }
DEV unsigned pk2(float lo, float hi) { return (unsigned)f2bf(lo) | ((unsigned)f2bf(hi) << 16); }
DEV float bf2f(unsigned short b) { return __uint_as_float(((unsigned)b) << 16); }
DEV float sigmoidf_(float x) { return 1.f / (1.f + __expf(-x)); }
DEV float wave_sum(float x) {
#pragma unroll
  for (int o = 32; o > 0; o >>= 1) x += __shfl_xor(x, o);
  return x;
}
template <int CTRL> DEV float dpp_mov(float x) { return __int_as_float(__builtin_amdgcn_update_dpp(0, __float_as_int(x), CTRL, 0xf, 0xf, true)); }
DEV float row16_sum(float x) {
  x += dpp_mov<0xB1>(x); x += dpp_mov<0x4E>(x); x += dpp_mov<0x141>(x); x += dpp_mov<0x140>(x);
  return x;
}
#define BAR_LDS() do { asm volatile("s_waitcnt lgkmcnt(0)" ::: "memory"); __builtin_amdgcn_s_barrier(); asm volatile("" ::: "memory"); } while (0)
DEV float4 ldnt4(const float* p_) { const f32x4 t_ = __builtin_nontemporal_load((const f32x4*)p_); return make_float4(t_[0], t_[1], t_[2], t_[3]); }
DEV const float* xrow(const Params& p, int t) { return t < NCTX ? p.in[0] + (size_t)t * D : p.in[1] + (size_t)(t - NCTX) * D; }
DEV int modidx(int t) { return t < NCTX ? 0 : 1 + ((t - NCTX) >> 10); }

DEV void conv_job(const Params& p, int j, const float*& src, bf16_t*& dst, int& K, int& N, int& mode, int& base) {
  if (j < 1376) { src = p.in[11]; dst = (bf16_t*)(p.ws + OFF_WIN); K = 1024; N = 5504; mode = 0; base = 0; }
  else if (j < 1504) { src = p.in[26]; dst = (bf16_t*)(p.ws + OFF_WORW); K = 512; N = 1024; mode = 0; base = 1376; }
  else if (j < 1632) { src = p.in[27]; dst = (bf16_t*)(p.ws + OFF_WONA); K = 512; N = 1024; mode = 0; base = 1504; }
  else if (j < 1888) { src = p.in[28]; dst = (bf16_t*)(p.ws + OFF_WOUT); K = 1024; N = 1024; mode = 0; base = 1632; }
  else if (j < 2592) { src = p.in[29]; dst = (bf16_t*)(p.ws + OFF_W13); K = 1024; N = 2816; mode = 1; base = 1888; }
  else if (j < 3296) { src = p.in[30]; dst = (bf16_t*)(p.ws + OFF_W13); K = 1024; N = 2816; mode = 2; base = 2592; }
  else if (j < 4000) { src = p.in[31]; dst = (bf16_t*)(p.ws + OFF_W2); K = 2816; N = 1024; mode = 0; base = 3296; }
  else if (j < 4016) { const int e = (j - 4000) >> 3; src = p.in[14] + e * 32768; dst = (bf16_t*)(p.ws + OFF_LORA) + e * 32768; K = 64; N = 512; mode = 0; base = 4000 + e * 8; }
  else if (j < 4032) { const int e = (j - 4016) >> 3; src = p.in[16] + e * 32768; dst = (bf16_t*)(p.ws + OFF_LORA) + 65536 + e * 32768; K = 64; N = 512; mode = 0; base = 4016 + e * 8; }
  else { src = p.in[17]; dst = (bf16_t*)(p.ws + OFF_LORA) + 131072; K = 128; N = 512; mode = 0; base = 4032; }
}
constexpr int N_CONV_TILES = 4048, N_MOD_TILES = 768;

DEV void phase0(const Params& p, unsigned char* smem, int bid, int nb, int rep) {
  const int tid = threadIdx.x;
  float* T = (float*)smem;
  for (int tile = bid; tile < N_MOD_TILES && rep == 0; tile += nb) {
    const int cgp = tile % 24, kc = tile / 24;
    if (tid < 96) {
      const int m = tid >> 5, kk = tid & 31, k = kc * 32 + kk;
      const float c = (m == 0) ? p.in[6][k] : p.in[5][(m - 1) * D + k];
      T[tid] = c * sigmoidf_(c);
    }
    __syncthreads();
    const int col = cgp * 256 + tid;
    const float* w = p.in[9] + (size_t)(kc * 32) * 6144 + col;
    float a0 = 0.f, a1 = 0.f, a2 = 0.f;
#pragma unroll
    for (int kk = 0; kk < 32; ++kk) {
      const float wv = __builtin_nontemporal_load(w + (size_t)kk * 6144);
      a0 += T[kk] * wv; a1 += T[32 + kk] * wv; a2 += T[64 + kk] * wv;
    }
    if (kc == 0) { const float b = p.in[10][col]; a0 += b; a1 += b; a2 += b; }
    float* mod = (float*)(p.ws + OFF_MOD);
    atomicAdd(mod + col, a0); atomicAdd(mod + 6144 + col, a1); atomicAdd(mod + 12288 + col, a2);
    __syncthreads();
  }
  const int r_ = tid >> 4, c4_ = tid & 15;
  float4 v[4];
  const float* src; bf16_t* dst; int K, N, mode, base;
  int tile = bid;
  if (tile < N_CONV_TILES) {
    conv_job(p, tile, src, dst, K, N, mode, base);
    const int lt = tile - base, nN = N >> 6, k0 = (lt / nN) * 64, n0 = (lt % nN) * 64;
#pragma unroll
    for (int i = 0; i < 4; ++i) { const f32x4 t_ = __builtin_nontemporal_load((const f32x4*)(src + (size_t)(k0 + r_ + 16 * i) * N + n0 + c4_ * 4)); v[i] = make_float4(t_[0], t_[1], t_[2], t_[3]); }
  }
  while (tile < N_CONV_TILES) {
    const int lt = tile - base, nN = N >> 6, k0 = (lt / nN) * 64, n0 = (lt % nN) * 64;
    bf16_t* cdst = dst; const int cK = K, cmode = mode;
#pragma unroll
    for (int i = 0; i < 4; ++i) {
      float* tp = T + (r_ + 16 * i) * 65 + c4_ * 4;
      tp[0] = v[i].x; tp[1] = v[i].y; tp[2] = v[i].z; tp[3] = v[i].w;
    }
    BAR_LDS();
    tile += nb;
    if (tile < N_CONV_TILES) {
      conv_job(p, tile, src, dst, K, N, mode, base);
      const int lt2 = tile - base, nN2 = N >> 6, k2 = (lt2 / nN2) * 64, n2 = (lt2 % nN2) * 64;
#pragma unroll
      for (int i = 0; i < 4; ++i) { const f32x4 t_ = __builtin_nontemporal_load((const f32x4*)(src + (size_t)(k2 + r_ + 16 * i) * N + n2 + c4_ * 4)); v[i] = make_float4(t_[0], t_[1], t_[2], t_[3]); }
    }
    const int n = tid >> 2, kp = tid & 3;
    unsigned w[8];
#pragma unroll
    for (int i = 0; i < 8; ++i) w[i] = pk2(T[(kp * 16 + 2 * i) * 65 + n], T[(kp * 16 + 2 * i + 1) * 65 + n]);
    const int ng = n0 + n;
    int drow = ng;
    if (cmode == 1) drow = (ng >> 4) * 32 + (ng & 15);
    else if (cmode == 2) drow = (ng >> 4) * 32 + 16 + (ng & 15);
    uint4* dp = (uint4*)(cdst + (size_t)drow * cK + k0 + kp * 16);
    dp[0] = make_uint4(w[0], w[1], w[2], w[3]);
    dp[1] = make_uint4(w[4], w[5], w[6], w[7]);
    BAR_LDS();
  }
}

template <int WHICH>
DEV void phase_normmod(const Params& p, int bid, int nb) {
  const int lane = threadIdx.x & 63, gw = bid * 4 + (threadIdx.x >> 6), nw = nb * 4;
  const float* g = WHICH == 0 ? p.in[7] : p.in[8];
  const float* mod = (const float*)(p.ws + OFF_MOD);
  const int sh_off = WHICH == 0 ? 0 : 3072, sc_off = WHICH == 0 ? 1024 : 4096;
  bf16_t* dst = (bf16_t*)(p.ws + OFF_H);
#pragma unroll 3
  for (int t = gw; t < NTOK; t += nw) {
    const float* xp = WHICH == 0 ? xrow(p, t) : p.out + (size_t)t * D;
    const float* mm = mod + modidx(t) * 6144;
    float4 v[4];
    float ss = 0.f;
#pragma unroll
    for (int i = 0; i < 4; ++i) {
      v[i] = WHICH == 0 ? ldnt4(xp + (i * 64 + lane) * 4) : *(const float4*)(xp + (i * 64 + lane) * 4);
      ss += v[i].x * v[i].x + v[i].y * v[i].y + v[i].z * v[i].z + v[i].w * v[i].w;
    }
    ss = wave_sum(ss);
    const float rstd = rsqrtf(ss * (1.f / 1024.f) + 1e-6f);
#pragma unroll
    for (int i = 0; i < 4; ++i) {
      const int col = (i * 64 + lane) * 4;
      const float4 g4 = *(const float4*)(g + col);
      const float4 sc = *(const float4*)(mm + sc_off + col);
      const float4 sh = *(const float4*)(mm + sh_off + col);
      const float y0 = v[i].x * rstd * g4.x * (1.f + sc.x) + sh.x;
      const float y1 = v[i].y * rstd * g4.y * (1.f + sc.y) + sh.y;
      const float y2 = v[i].z * rstd * g4.z * (1.f + sc.z) + sh.z;
      const float y3 = v[i].w * rstd * g4.w * (1.f + sc.w) + sh.w;
      *(uint2*)(dst + (size_t)t * D + col) = make_uint2(pk2(y0, y1), pk2(y2, y3));
    }
  }
}

template <int MI>
DEV void gemm_tile_acc(f32x4 (&acc)[MI][4], const bf16_t* __restrict__ A, int lda, const bf16_t* __restrict__ Bt, int ldb,
                       int m0, int n0, int K, unsigned char* smem) {
  constexpr int AT = 2 * MI * 16 * 128, BT = 16384, STG = AT + BT;
  const int tid = threadIdx.x, lane = tid & 63, wid = tid >> 6, wr = wid >> 1, wc = wid & 1, fr = lane & 15, fq = lane >> 4;
  const int gkc = (tid & 7) ^ ((tid >> 4) & 7);
  const bf16_t* ga = A + (size_t)(m0 + (tid >> 3)) * lda + gkc * 8;
  const bf16_t* gb = Bt + (size_t)(n0 + (tid >> 3)) * ldb + gkc * 8;
  const int swz = (fr >> 1) & 7;
  const int nk = K >> 6;
#define GLDS_TILE(kt_, buf_) do { unsigned char* sb_ = smem + (buf_) * STG; const int k0_ = (kt_) * 64; \
    _Pragma("unroll") for (int i_ = 0; i_ < (2 * MI * 16) / 32; ++i_) \
      __builtin_amdgcn_global_load_lds((const unsigned*)(ga + (size_t)i_ * 32 * lda + k0_), (__attribute__((address_space(3))) unsigned*)(sb_ + (i_ * 256 + tid) * 16), 16, 0, 0); \
    _Pragma("unroll") for (int i_ = 0; i_ < 4; ++i_) \
      __builtin_amdgcn_global_load_lds((const unsigned*)(gb + (size_t)i_ * 32 * ldb + k0_), (__attribute__((address_space(3))) unsigned*)(sb_ + AT + (i_ * 256 + tid) * 16), 16, 0, 0); \
  } while (0)
  GLDS_TILE(0, 0);
  asm volatile("s_waitcnt vmcnt(0)" ::: "memory");
  __syncthreads();
  for (int kt = 0; kt < nk; ++kt) {
    if (kt + 1 < nk) GLDS_TILE(kt + 1, (kt + 1) & 1);
    const unsigned char* cur = smem + (kt & 1) * STG;
#pragma unroll
    for (int ks = 0; ks < 2; ++ks) {
      bf16x8 af[MI], bf[4];
      const int co = ((ks * 4 + fq) ^ swz) << 4;
#pragma unroll
      for (int mi = 0; mi < MI; ++mi) af[mi] = *(const bf16x8*)(cur + (wr * MI * 16 + mi * 16 + fr) * 128 + co);
#pragma unroll
      for (int ni = 0; ni < 4; ++ni) bf[ni] = *(const bf16x8*)(cur + AT + (wc * 64 + ni * 16 + fr) * 128 + co);
      __builtin_amdgcn_s_setprio(1);
#pragma unroll
      for (int mi = 0; mi < MI; ++mi)
#pragma unroll
        for (int ni = 0; ni < 4; ++ni) acc[mi][ni] = __builtin_amdgcn_mfma_f32_16x16x32_bf16(bf[ni], af[mi], acc[mi][ni], 0, 0, 0);
      __builtin_amdgcn_s_setprio(0);
    }
    asm volatile("s_waitcnt vmcnt(0)" ::: "memory");
    __syncthreads();
  }
#undef GLDS_TILE
}

template <int MI>
DEV void zero_acc(f32x4 (&acc)[MI][4]) {
#pragma unroll
  for (int i = 0; i < MI; ++i)
#pragma unroll
    for (int j = 0; j < 4; ++j) acc[i][j] = (f32x4){0.f, 0.f, 0.f, 0.f};
}

#ifndef DYN_TILES
#define DYN_TILES 0
#endif
DEV int grab_tile(const Params& p, int word, int* slot) {
#if DYN_TILES
  if (threadIdx.x == 0) *slot = (int)atomicAdd((unsigned*)(p.ws + OFF_CTL) + word, 1u);
  __syncthreads();
  const int t = *slot;
  __syncthreads();
  return t;
#else
  const int t = slot[1];
  __syncthreads();
  if (threadIdx.x == 0) slot[1] = t + gridDim.x;
  __syncthreads();
  return t;
#endif
}
DEV void reset_tiles(int* slot) { if (threadIdx.x == 0) slot[1] = blockIdx.x; __syncthreads(); }

#define EPI_COORDS const int lane = threadIdx.x & 63, wid = threadIdx.x >> 6, wr = wid >> 1, wc = wid & 1, fr = lane & 15, fq = lane >> 4

DEV void phase_gemm_in(const Params& p, unsigned char* smem, int* slot) {
  EPI_COORDS;
  const bf16_t* A = (const bf16_t*)(p.ws + OFF_H);
  const bf16_t* Bt = (const bf16_t*)(p.ws + OFF_WIN);
  float* urw = (float*)(p.ws + OFF_URW);
  float* una = (float*)(p.ws + OFF_UNA);
  bf16_t* gates = (bf16_t*)p.out;
  for (;;) {
    const int tile = grab_tile(p, 8, slot);
    if (tile >= 48 * 43) break;
    const int tm = tile % 48, tn = tile / 48, m0 = tm * 128, n0 = tn * 128;
    f32x4 acc[4][4];
    zero_acc<4>(acc);
    gemm_tile_acc<4>(acc, A, D, Bt, D, m0, n0, D, smem);
    if (n0 >= 1920 && n0 < 3456) {
      const int sec = (n0 - 1920) >> 9;
      const int h = (((n0 - 1920) & 511) >> 6) + wc;
      bf16_t* qb = (bf16_t*)(p.ws + OFF_QB); bf16_t* kb = (bf16_t*)(p.ws + OFF_KB); bf16_t* vT = (bf16_t*)(p.ws + OFF_VT);
#pragma unroll
      for (int mi = 0; mi < 4; ++mi) {
        const int row = m0 + wr * 64 + mi * 16 + fr;
        if (sec < 2) {
          float ss = 0.f;
#pragma unroll
          for (int ni = 0; ni < 4; ++ni) { const f32x4 v = acc[mi][ni]; ss += v[0] * v[0] + v[1] * v[1] + v[2] * v[2] + v[3] * v[3]; }
          ss += __shfl_xor(ss, 16); ss += __shfl_xor(ss, 32);
          const float rs = rsqrtf(ss * (1.f / 64.f) + 1e-6f) * (sec == 0 ? 0.125f : 1.f);
          const float* gv = sec == 0 ? p.in[23] : p.in[24];
          bf16_t* dstb = (sec == 0 ? qb : kb) + (size_t)row * 512 + h * 64;
#pragma unroll
          for (int ni = 0; ni < 4; ++ni) {
            const int d = ni * 16 + fq * 4;
            const f32x4 x = acc[mi][ni] * rs * (*(const f32x4*)(gv + d));
            *(uint2*)(dstb + d) = make_uint2(pk2(x[0], x[1]), pk2(x[2], x[3]));
            if (sec == 1 && row < NCTX) __builtin_nontemporal_store(x, (f32x4*)(p.out + OUT_K + (size_t)row * 512 + h * 64 + d));
          }
        } else {
#pragma unroll
          for (int ni = 0; ni < 4; ++ni) {
            const int d = ni * 16 + fq * 4;
            const f32x4 x = acc[mi][ni];
            if (row < NCTX) __builtin_nontemporal_store(x, (f32x4*)(p.out + OUT_V + (size_t)row * 512 + h * 64 + d));
#pragma unroll
            for (int e2 = 0; e2 < 4; ++e2) *(bf16_t*)(smem + (wc * 64 + d + e2) * 272 + (wr * 64 + mi * 16 + fr) * 2) = f2bf(x[e2]);
          }
        }
      }
      if (sec == 2) {
        __syncthreads();
        const int dd = threadIdx.x >> 1, hf = threadIdx.x & 1;
        const int hb = ((n0 - 1920) & 511) >> 6;
        bf16_t* vrow = vT + (size_t)(hb * 64 + dd) * NTOK + m0 + hf * 64;
#pragma unroll
        for (int j = 0; j < 8; ++j) *(uint4*)(vrow + j * 8) = *(const uint4*)(smem + dd * 272 + hf * 128 + j * 16);
        __syncthreads();
      }
    } else {
#pragma unroll
      for (int mi = 0; mi < 4; ++mi) {
        const int row = m0 + wr * 64 + mi * 16 + fr;
#pragma unroll
        for (int ni = 0; ni < 4; ++ni) {
          const int col = n0 + wc * 64 + ni * 16 + fq * 4;
          const f32x4 v = acc[mi][ni];
          if (n0 < 1920) *(f32x4*)(urw + (size_t)row * 1920 + col) = v;
          else *(uint2*)(gates + (size_t)row * 2048 + (col - 3456)) = make_uint2(pk2(sigmoidf_(v[0]), sigmoidf_(v[1])), pk2(sigmoidf_(v[2]), sigmoidf_(v[3])));
        }
      }
    }
  }
}

DEV void phase_gemm_merge(const Params& p, unsigned char* smem, int* slot) {
  EPI_COORDS;
  const bf16_t* orw = (const bf16_t*)(p.ws + OFF_ORW);
  const bf16_t* ona = (const bf16_t*)(p.ws + OFF_ONA);
  const bf16_t* w1 = (const bf16_t*)(p.ws + OFF_WORW);
  const bf16_t* w2 = (const bf16_t*)(p.ws + OFF_WONA);
  const bf16_t* gates = (const bf16_t*)p.out;
  bf16_t* merged = (bf16_t*)(p.ws + OFF_MERGED);
  float* mtmp = (float*)(p.ws + OFF_MERGED + 16777216);
  for (;;) {
    const int tile = grab_tile(p, 9, slot);
    if (tile >= 64 * 8) break;
    const int tm = tile % 64, tn = tile / 64, m0 = tm * 96, n0 = tn * 128;
    f32x4 acc[3][4];
    uint2 mgp[3][4];
    zero_acc<3>(acc);
    gemm_tile_acc<3>(acc, orw, RW, w1, RW, m0, n0, RW, smem);
#pragma unroll
    for (int mi = 0; mi < 3; ++mi) {
      const int row = m0 + wr * 48 + mi * 16 + fr;
#pragma unroll
      for (int ni = 0; ni < 4; ++ni) {
        const int col = n0 + wc * 64 + ni * 16 + fq * 4;
        const uint2 g = *(const uint2*)(gates + (size_t)row * 2048 + col);
        f32x4 r;
        r[0] = acc[mi][ni][0] * bf2f((unsigned short)(g.x & 0xffff));
        r[1] = acc[mi][ni][1] * bf2f((unsigned short)(g.x >> 16));
        r[2] = acc[mi][ni][2] * bf2f((unsigned short)(g.y & 0xffff));
        r[3] = acc[mi][ni][3] * bf2f((unsigned short)(g.y >> 16));
        mgp[mi][ni] = make_uint2(pk2(r[0], r[1]), pk2(r[2], r[3]));
      }
    }
    zero_acc<3>(acc);
    gemm_tile_acc<3>(acc, ona, RW, w2, RW, m0, n0, RW, smem);
#pragma unroll
    for (int mi = 0; mi < 3; ++mi) {
      const int row = m0 + wr * 48 + mi * 16 + fr;
#pragma unroll
      for (int ni = 0; ni < 4; ++ni) {
        const int col = n0 + wc * 64 + ni * 16 + fq * 4;
        const uint2 g = *(const uint2*)(gates + (size_t)row * 2048 + 1024 + col);
        const float mg[4] = {__uint_as_float(mgp[mi][ni].x << 16), __uint_as_float(mgp[mi][ni].x & 0xffff0000u), __uint_as_float(mgp[mi][ni].y << 16), __uint_as_float(mgp[mi][ni].y & 0xffff0000u)};
        const float r0 = mg[0] + acc[mi][ni][0] * bf2f((unsigned short)(g.x & 0xffff));
        const float r1 = mg[1] + acc[mi][ni][1] * bf2f((unsigned short)(g.x >> 16));
        const float r2 = mg[2] + acc[mi][ni][2] * bf2f((unsigned short)(g.y & 0xffff));
        const float r3 = mg[3] + acc[mi][ni][3] * bf2f((unsigned short)(g.y >> 16));
        *(uint2*)(merged + (size_t)row * D + col) = make_uint2(pk2(r0, r1), pk2(r2, r3));
      }
    }
  }
}

DEV void phase_gemm_out(const Params& p, unsigned char* smem, int* slot) {
  EPI_COORDS;
  const bf16_t* A = (const bf16_t*)(p.ws + OFF_MERGED);
  const bf16_t* Bt = (const bf16_t*)(p.ws + OFF_WOUT);
  const float* mod = (const float*)(p.ws + OFF_MOD);
  for (;;) {
    const int tile = grab_tile(p, 10, slot);
    if (tile >= 64 * 8) break;
    const int tm = tile % 64, tn = tile / 64, m0 = tm * 96, n0 = tn * 128;
    f32x4 acc[3][4];
    zero_acc<3>(acc);
    gemm_tile_acc<3>(acc, A, D, Bt, D, m0, n0, D, smem);
#pragma unroll
    for (int mi = 0; mi < 3; ++mi) {
      const int row = m0 + wr * 48 + mi * 16 + fr;
      const float* xp = xrow(p, row);
      const float* g1 = mod + modidx(row) * 6144 + 2048;
#pragma unroll
      for (int ni = 0; ni < 4; ++ni) {
        const int col = n0 + wc * 64 + ni * 16 + fq * 4;
        const f32x4 x = __builtin_nontemporal_load((const f32x4*)(xp + col));
        const f32x4 g = *(const f32x4*)(g1 + col);
        *(f32x4*)(p.out + (size_t)row * D + col) = x + g * acc[mi][ni];
      }
    }
  }
}

DEV void phase_gemm_ffn_up(const Params& p, unsigned char* smem, int* slot) {
  EPI_COORDS;
  const bf16_t* A = (const bf16_t*)(p.ws + OFF_H);
  const bf16_t* Bt = (const bf16_t*)(p.ws + OFF_W13);
  bf16_t* hid = (bf16_t*)(p.ws + OFF_HID);
  for (;;) {
    const int tile = grab_tile(p, 11, slot);
    if (tile >= 48 * 44) break;
    const int tm = tile % 48, tn = tile / 48, m0 = tm * 128, n0 = tn * 128;
    f32x4 acc[4][4];
    zero_acc<4>(acc);
    gemm_tile_acc<4>(acc, A, D, Bt, D, m0, n0, D, smem);
#pragma unroll
    for (int mi = 0; mi < 4; ++mi) {
      const int row = m0 + wr * 64 + mi * 16 + fr;
#pragma unroll
      for (int gp = 0; gp < 2; ++gp) {
        const int hcol = ((n0 + wc * 64) >> 1) + gp * 16 + fq * 4;
        const f32x4 a = acc[mi][2 * gp], b = acc[mi][2 * gp + 1];
        float r[4];
#pragma unroll
        for (int e = 0; e < 4; ++e) r[e] = a[e] * sigmoidf_(a[e]) * b[e];
        *(uint2*)(hid + (size_t)row * FF + hcol) = make_uint2(pk2(r[0], r[1]), pk2(r[2], r[3]));
      }
    }
  }
}

DEV void phase_gemm_ffn_down(const Params& p, unsigned char* smem, int* slot) {
  EPI_COORDS;
  const bf16_t* A = (const bf16_t*)(p.ws + OFF_HID);
  const bf16_t* Bt = (const bf16_t*)(p.ws + OFF_W2);
  const float* mod = (const float*)(p.ws + OFF_MOD);
  for (;;) {
    const int tile = grab_tile(p, 12, slot);
    if (tile >= 64 * 8) break;
    const int tm = tile % 64, tn = tile / 64, m0 = tm * 96, n0 = tn * 128;
    f32x4 acc[3][4];
    zero_acc<3>(acc);
    gemm_tile_acc<3>(acc, A, FF, Bt, FF, m0, n0, FF, smem);
#pragma unroll
    for (int mi = 0; mi < 3; ++mi) {
      const int row = m0 + wr * 48 + mi * 16 + fr;
      const float* g2 = mod + modidx(row) * 6144 + 5120;
#pragma unroll
      for (int ni = 0; ni < 4; ++ni) {
        const int col = n0 + wc * 64 + ni * 16 + fq * 4;
        float* op = p.out + (size_t)row * D + col;
        const f32x4 x = __builtin_nontemporal_load((const f32x4*)op);
        const f32x4 g = *(const f32x4*)(g2 + col);
        __builtin_nontemporal_store(x + g * acc[mi][ni], (f32x4*)op);
      }
    }
  }
}

DEV void phase_qkprep(const Params& p, unsigned char* smem, int item_) {
  const int tid = threadIdx.x;
  bf16_t* Vs = (bf16_t*)smem;
  bf16_t* qb = (bf16_t*)(p.ws + OFF_QB);
  bf16_t* kb = (bf16_t*)(p.ws + OFF_KB);
  bf16_t* vT = (bf16_t*)(p.ws + OFF_VT);
  bf16_t* ckb = (bf16_t*)(p.ws + OFF_CKB);
  bf16_t* cvT = (bf16_t*)(p.ws + OFF_CVT);
  const float* una = (const float*)(p.ws + OFF_UNA);
  const int tok = tid >> 2, part = tid & 3;
  for (int item = item_; item < item_ + 1; ++item) {
    if (item < 768) {
      const int tt = item >> 3, h = item & 7, t0 = tt * 64, t = t0 + tok;
      const float* src = una + (size_t)t * 1536 + h * 64 + part * 16;
      {
        float x[16]; float ss = 0.f;
#pragma unroll
        for (int i = 0; i < 4; ++i) { const float4 v = *(const float4*)(src + i * 4); x[4 * i] = v.x; x[4 * i + 1] = v.y; x[4 * i + 2] = v.z; x[4 * i + 3] = v.w; }
#pragma unroll
        for (int i = 0; i < 16; ++i) ss += x[i] * x[i];
        ss += __shfl_xor(ss, 1); ss += __shfl_xor(ss, 2);
        const float rs = rsqrtf(ss * (1.f / 64.f) + 1e-6f) * 0.125f;
        unsigned w[8];
#pragma unroll
        for (int i = 0; i < 8; ++i) w[i] = pk2(x[2 * i] * rs * p.in[23][part * 16 + 2 * i], x[2 * i + 1] * rs * p.in[23][part * 16 + 2 * i + 1]);
        uint4* dp = (uint4*)(qb + (size_t)t * 512 + h * 64 + part * 16);
        dp[0] = make_uint4(w[0], w[1], w[2], w[3]); dp[1] = make_uint4(w[4], w[5], w[6], w[7]);
      }
      {
        float x[16]; float ss = 0.f;
#pragma unroll
        for (int i = 0; i < 4; ++i) { const float4 v = *(const float4*)(src + 512 + i * 4); x[4 * i] = v.x; x[4 * i + 1] = v.y; x[4 * i + 2] = v.z; x[4 * i + 3] = v.w; }
#pragma unroll
        for (int i = 0; i < 16; ++i) ss += x[i] * x[i];
        ss += __shfl_xor(ss, 1); ss += __shfl_xor(ss, 2);
        const float rs = rsqrtf(ss * (1.f / 64.f) + 1e-6f);
#pragma unroll
        for (int i = 0; i < 16; ++i) x[i] = x[i] * rs * p.in[24][part * 16 + i];
        if (t < NCTX) {
          float4* op = (float4*)(p.out + OUT_K + (size_t)t * 512 + h * 64 + part * 16);
#pragma unroll
          for (int i = 0; i < 4; ++i) op[i] = make_float4(x[4 * i], x[4 * i + 1], x[4 * i + 2], x[4 * i + 3]);
        }
        unsigned w[8];
#pragma unroll
        for (int i = 0; i < 8; ++i) w[i] = pk2(x[2 * i], x[2 * i + 1]);
        uint4* dp = (uint4*)(kb + (size_t)t * 512 + h * 64 + part * 16);
        dp[0] = make_uint4(w[0], w[1], w[2], w[3]); dp[1] = make_uint4(w[4], w[5], w[6], w[7]);
      }
      {
        float x[16];
#pragma unroll
        for (int i = 0; i < 4; ++i) { const float4 v = *(const float4*)(src + 1024 + i * 4); x[4 * i] = v.x; x[4 * i + 1] = v.y; x[4 * i + 2] = v.z; x[4 * i + 3] = v.w; }
        if (t < NCTX) {
          float4* op = (float4*)(p.out + OUT_V + (size_t)t * 512 + h * 64 + part * 16);
#pragma unroll
          for (int i = 0; i < 4; ++i) op[i] = make_float4(x[4 * i], x[4 * i + 1], x[4 * i + 2], x[4 * i + 3]);
        }
#pragma unroll
        for (int i = 0; i < 16; ++i) Vs[tok * 72 + part * 16 + i] = f2bf(x[i]);
      }
      __syncthreads();
      {
        const int d = tid >> 2;
        unsigned w[8];
#pragma unroll
        for (int i = 0; i < 8; ++i) w[i] = (unsigned)Vs[(part * 16 + 2 * i) * 72 + d] | ((unsigned)Vs[(part * 16 + 2 * i + 1) * 72 + d] << 16);
        uint4* dp = (uint4*)(vT + (size_t)(h * 64 + d) * NTOK + t0 + part * 16);
        dp[0] = make_uint4(w[0], w[1], w[2], w[3]); dp[1] = make_uint4(w[4], w[5], w[6], w[7]);
      }
      __syncthreads();
    } else {
      const int ci = item - 768, b = ci >> 5, rem = ci & 31, tt = rem >> 3, h = rem & 7, t0 = tt * 64, t = t0 + tok;
      const size_t sidx = (size_t)(b * 256 + t) * 512 + h * 64 + part * 16;
      {
        float x[16];
#pragma unroll
        for (int i = 0; i < 4; ++i) { const float4 v = *(const float4*)(p.in[3] + sidx + i * 4); x[4 * i] = v.x; x[4 * i + 1] = v.y; x[4 * i + 2] = v.z; x[4 * i + 3] = v.w; }
        unsigned w[8];
#pragma unroll
        for (int i = 0; i < 8; ++i) w[i] = pk2(x[2 * i], x[2 * i + 1]);
        uint4* dp = (uint4*)(ckb + sidx);
        dp[0] = make_uint4(w[0], w[1], w[2], w[3]); dp[1] = make_uint4(w[4], w[5], w[6], w[7]);
      }
      {
        float x[16];
#pragma unroll
        for (int i = 0; i < 4; ++i) { const float4 v = *(const float4*)(p.in[4] + sidx + i * 4); x[4 * i] = v.x; x[4 * i + 1] = v.y; x[4 * i + 2] = v.z; x[4 * i + 3] = v.w; }
#pragma unroll
        for (int i = 0; i < 16; ++i) Vs[tok * 72 + part * 16 + i] = f2bf(x[i]);
      }
      __syncthreads();
      {
        const int d = tid >> 2;
        unsigned w[8];
#pragma unroll
        for (int i = 0; i < 8; ++i) w[i] = (unsigned)Vs[(part * 16 + 2 * i) * 72 + d] | ((unsigned)Vs[(part * 16 + 2 * i + 1) * 72 + d] << 16);
        uint4* dp = (uint4*)(cvT + (size_t)((b * 8 + h) * 64 + d) * 256 + t0 + part * 16);
        dp[0] = make_uint4(w[0], w[1], w[2], w[3]); dp[1] = make_uint4(w[4], w[5], w[6], w[7]);
      }
      __syncthreads();
    }
  }
}

DEV float* ops_arr(const Params& p, int i) { return (float*)(p.ws + OFF_OPS + (size_t)i * OPS_ARR); }

DEV f32x4 shiftvec(f32x4 cur, f32x4 hal, f32x4 mu0, f32x4 mu1, int fr) {
  f32x4 prev, next;
#pragma unroll
  for (int i = 0; i < 4; ++i) {
    prev[i] = dpp_mov<0x111>(cur[i]);
    next[i] = dpp_mov<0x101>(cur[i]);
  }
  if (fr == 0) prev = hal;
  if (fr == 15) next = hal;
  return cur + mu0 * (prev - cur) + mu1 * (next - cur);
}
DEV float quad_sum(float x) { x += __shfl_xor(x, 16); x += __shfl_xor(x, 32); return x; }
DEV f32x4 ld4(const float* p) { return *(const f32x4*)p; }
DEV f32x4 ld4nt(const float* p) { return __builtin_nontemporal_load((const f32x4*)p); }

constexpr int LROWB = 392;
template <bool HALF>
DEV void phase_rwprep(const Params& p, unsigned char* smem, int item_) {
  const int tid = threadIdx.x, lane = tid & 63, w = tid >> 6, fr = lane & 15, fq = lane >> 4;
  bf16_t* Lb = (bf16_t*)smem;
  const float* urw = (const float*)(p.ws + OFF_URW);
  const float* mu = p.in[12];
  bf16_t* bonus = (bf16_t*)(p.ws + OFF_BG);
  bf16_t* gate = (bf16_t*)(p.ws + OFF_BG + 6291456);
  const bf16_t* WUPT = (const bf16_t*)(p.ws + OFF_LORA);
  const bf16_t* AUPT = WUPT + 65536;
  const bf16_t* GUPT = WUPT + 131072;
  float* o_r = ops_arr(p, 0); float* o_v = ops_arr(p, 1); float* o_a = ops_arr(p, 2);
  for (int item = item_; item < item_ + 1; ++item) {
    const int t0 = HALF ? (256 + (item >> 2)) * 16 : (item >> 1) * 16;
    const int h = HALF ? (item & 3) * 2 + (w >> 1) : (item & 1) * 4 + w;
    const int ni_lo = HALF ? (w & 1) * 2 : 0, ni_hi = HALF ? ni_lo + 2 : 4;
    float* xs = (float*)(smem + 16384);
    int s_lo, s_hi;
    if (t0 < NCTX) { s_lo = t0 & ~255; s_hi = s_lo + 256; } else { s_lo = NCTX + ((t0 - NCTX) & ~1023); s_hi = s_lo + 1024; }
    {
      const int tl = tid >> 4, g16 = tid & 15, tt = t0 + tl;
      const float* up = urw + (size_t)tt * RWC + 1536;
      const bool hp = tt > s_lo, hn = tt + 1 < s_hi;
#pragma unroll
      for (int j = 0; j < 6; ++j) {
        const int col = (g16 + 16 * j) * 4;
        const f32x4 c = ld4(up + col);
        const f32x4 z = (f32x4){0.f, 0.f, 0.f, 0.f};
        const f32x4 pv = hp ? ld4(up - RWC + col) : z;
        const f32x4 nx = hn ? ld4(up + RWC + col) : z;
        const f32x4 m0 = ld4(mu + 1536 + col), m1 = ld4(mu + RWC + 1536 + col);
        const f32x4 us = c + m0 * (pv - c) + m1 * (nx - c);
        const int kind = col >> 7;
        float o4[4];
#pragma unroll
        for (int i = 0; i < 4; ++i) o4[i] = kind == 0 ? (1.f - 2.f / (1.f + __expf(2.f * us[i]))) : (kind == 1 ? us[i] : sigmoidf_(us[i]));
        *(uint2*)(Lb + tl * LROWB + col) = make_uint2(pk2(o4[0], o4[1]), pk2(o4[2], o4[3]));
      }
    }
    __syncthreads();
    const int t = t0 + fr;
    const bool lo_ok = (fr == 0) && (t > s_lo), hi_ok = (fr == 15) && (t + 1 < s_hi);
    const float* urow = urw + (size_t)t * RWC;
    const float* hrow = lo_ok ? urow - RWC : (hi_ok ? urow + RWC : urow);
    const bool hal_ok = lo_ok || hi_ok;
    const f32x4 z4 = (f32x4){0.f, 0.f, 0.f, 0.f};
    float ss = 0.f;
#pragma unroll
    for (int ni = ni_lo; ni < ni_hi; ++ni) {
      const int c = h * 64 + ni * 16 + fq * 4;
      const f32x4 kx = shiftvec(ld4(urow + 512 + c), hal_ok ? ld4(hrow + 512 + c) : z4, ld4(mu + 512 + c), ld4(mu + RWC + 512 + c), fr) * ld4(p.in[18] + c);
      ss += kx[0] * kx[0] + kx[1] * kx[1] + kx[2] * kx[2] + kx[3] * kx[3];
    }
    ss = quad_sum(ss);
    if (HALF) { if (fq == 0) xs[w * 16 + fr] = ss; __syncthreads(); ss += xs[(w ^ 1) * 16 + fr]; }
    const float rn = rsqrtf(ss + 1e-12f);
    float bs = 0.f;
#pragma unroll 1
    for (int ni = ni_lo; ni < ni_hi; ++ni) {
      const int c = h * 64 + ni * 16 + fq * 4;
      const size_t o = (size_t)t * 512 + c;
      const f32x4 r4 = shiftvec(ld4nt(urow + c), hal_ok ? ld4nt(hrow + c) : z4, ld4(mu + c), ld4(mu + RWC + c), fr);
      const f32x4 k4 = shiftvec(ld4nt(urow + 512 + c), hal_ok ? ld4nt(hrow + 512 + c) : z4, ld4(mu + 512 + c), ld4(mu + RWC + 512 + c), fr);
      const f32x4 v4 = shiftvec(ld4(urow + 1024 + c), hal_ok ? ld4(hrow + 1024 + c) : z4, ld4(mu + 1024 + c), ld4(mu + RWC + 1024 + c), fr);
      const f32x4 kk4 = k4 * ld4(p.in[18] + c) * rn;
      *(f32x4*)(o_r + o) = r4; *(f32x4*)(o_v + o) = v4; *(f32x4*)(o_a + o) = -kk4;
      const f32x4 ka = ld4(p.in[19] + c);
      f32x4 bacc = z4;
#pragma unroll
      for (int e = 0; e < 2; ++e) {
        float* o_k = ops_arr(p, 5 + e); float* o_b = ops_arr(p, 7 + e); float* o_w = ops_arr(p, 3 + e);
        f32x4 acc = z4, acw = z4;
#pragma unroll
        for (int ks = 0; ks < 2; ++ks) {
          const bf16x8 wa = *(const bf16x8*)(AUPT + (size_t)(e * 512 + h * 64 + ni * 16 + fr) * 64 + ks * 32 + fq * 8);
          const bf16x8 la = *(const bf16x8*)(Lb + fr * LROWB + 128 + e * 64 + ks * 32 + fq * 8);
          acc = __builtin_amdgcn_mfma_f32_16x16x32_bf16(wa, la, acc, 0, 0, 0);
          const bf16x8 ww = *(const bf16x8*)(WUPT + (size_t)(e * 512 + h * 64 + ni * 16 + fr) * 64 + ks * 32 + fq * 8);
          const bf16x8 lw = *(const bf16x8*)(Lb + fr * LROWB + e * 64 + ks * 32 + fq * 8);
          acw = __builtin_amdgcn_mfma_f32_16x16x32_bf16(ww, lw, acw, 0, 0, 0);
        }
        const f32x4 a0 = ld4(p.in[15] + e * 512 + c), w0 = ld4(p.in[13] + e * 512 + c);
        f32x4 kd, bb, dec;
#pragma unroll
        for (int i = 0; i < 4; ++i) {
          const float ic = sigmoidf_(a0[i] + acc[i]);
          kd[i] = k4[i] * (1.f + (ic - 1.f) * ka[i]);
          bb[i] = kk4[i] * ic;
          const float z = w0[i] + acw[i];
          const float sp = fmaxf(-z, 0.f) + __logf(1.f + __expf(-fabsf(z)));
          dec[i] = __expf(-__expf(-sp - 0.5f));
        }
        bacc += kd;
        *(f32x4*)(o_k + o) = kd; *(f32x4*)(o_b + o) = bb; *(f32x4*)(o_w + o) = dec;
      }
      const f32x4 rk = ld4(p.in[20] + c);
#pragma unroll
      for (int i = 0; i < 4; ++i) bs += r4[i] * 0.5f * bacc[i] * rk[i];
      f32x4 acc = z4;
#pragma unroll
      for (int ks = 0; ks < 4; ++ks) {
        const bf16x8 wg = *(const bf16x8*)(GUPT + (size_t)(h * 64 + ni * 16 + fr) * 128 + ks * 32 + fq * 8);
        const bf16x8 lg = *(const bf16x8*)(Lb + fr * LROWB + 256 + ks * 32 + fq * 8);
        acc = __builtin_amdgcn_mfma_f32_16x16x32_bf16(wg, lg, acc, 0, 0, 0);
      }
      *(uint2*)(gate + o) = make_uint2(pk2(acc[0], acc[1]), pk2(acc[2], acc[3]));
    }
    bs = quad_sum(bs);
    if (HALF) { if (fq == 0) xs[64 + w * 16 + fr] = bs; __syncthreads(); bs += xs[64 + (w ^ 1) * 16 + fr]; }
#pragma unroll
    for (int ni = ni_lo; ni < ni_hi; ++ni) {
      const size_t o = (size_t)t * 512 + h * 64 + ni * 16 + fq * 4;
      const int c3 = h * 64 + ni * 16 + fq * 4;
      const f32x4 v4 = shiftvec(ld4nt(urow + 1024 + c3), hal_ok ? ld4nt(hrow + 1024 + c3) : z4, ld4(mu + 1024 + c3), ld4(mu + RWC + 1024 + c3), fr);
      *(uint2*)(bonus + o) = make_uint2(pk2(bs * v4[0], bs * v4[1]), pk2(bs * v4[2], bs * v4[3]));
    }
    __syncthreads();
  }
}

DEV void phase_prep(const Params& p, unsigned char* smem, int* s_item, int rep) {
  unsigned* counter = (unsigned*)(p.ws + OFF_CTL) + 16 + rep;
  for (;;) {
    if (threadIdx.x == 0) *s_item = (int)atomicAdd(counter, 1u);
    __syncthreads();
    const int item = *s_item;
    __syncthreads();
    if (item >= 1024 + 64) break;
    if (item < 512) phase_rwprep<false>(p, smem, item);
    else if (item < 1024) phase_rwprep<true>(p, smem, item - 512);
    else phase_qkprep(p, smem, item - 256);
  }
}

constexpr int TC = 16;
typedef float f32x2 __attribute__((ext_vector_type(2)));
template <int EPL, int R, int PD>
DEV void scan_item(const Params& p, unsigned char* smem, int seq, int h, int dir, int rg) {
  constexpr int LPR = 64 / EPL, RPW = 64 / LPR, RPB = 4 * RPW * R, NV = RPB / 16, NP = EPL / 2;
  constexpr int STG = 20480 + 16 * RPB * 4, YOFF = 2 * STG, YSZ = 16 * RPB * 4;
  const int tid = threadIdx.x, lane = tid & 63, w = tid >> 6, riw = lane / LPR, kq = lane % LPR;
  const int T = seq < 16 ? 256 : 1024;
  const int tok0 = seq < 16 ? seq * 256 : NCTX + (seq - 16) * 1024;
  const int vrow_l = (w * RPW + riw) * R;
  const int vrow = rg * RPB + vrow_l;
  f32x2 S[R][NP];
#pragma unroll
  for (int rr = 0; rr < R; ++rr) {
    if (seq >= 16) {
      const float* sp = p.in[2] + ((size_t)(((seq - 16) * 2 + dir) * 8 + h) * 64 + vrow + rr) * 64 + kq * EPL;
#pragma unroll
      for (int i = 0; i < NP; ++i) S[rr][i] = *(const f32x2*)(sp + 2 * i);
    } else {
#pragma unroll
      for (int i = 0; i < NP; ++i) S[rr][i] = (f32x2){0.f, 0.f};
    }
  }
  const int lstep = tid >> 4, l16 = tid & 15;
  const float* pr = ops_arr(p, 0) + h * 64 + l16 * 4;
  const float* pw = ops_arr(p, 3 + dir) + h * 64 + l16 * 4;
  const float* pk = ops_arr(p, 5 + dir) + h * 64 + l16 * 4;
  const float* pa = ops_arr(p, 2) + h * 64 + l16 * 4;
  const float* pb = ops_arr(p, 7 + dir) + h * 64 + l16 * 4;
  const float* pv = ops_arr(p, 1) + h * 64 + rg * RPB + l16;
  float* yout = (float*)(p.ws + (dir ? OFF_YB : OFF_YF)) + h * 64 + rg * RPB + l16;
  const int nc = T / TC;
  float4 g_r, g_w, g_k, g_a, g_b; float rv[NV];
#define gload(c) do { const int ts_ = (c) * TC + lstep; const size_t t_ = (size_t)(tok0 + (dir ? T - 1 - ts_ : ts_)) * 512; \
    if (R == 4) { g_r = ldnt4(pr + t_); g_w = ldnt4(pw + t_); g_k = ldnt4(pk + t_); g_a = ldnt4(pa + t_); g_b = ldnt4(pb + t_); } else { \
    g_r = *(const float4*)(pr + t_); g_w = *(const float4*)(pw + t_); g_k = *(const float4*)(pk + t_); \
    g_a = *(const float4*)(pa + t_); g_b = *(const float4*)(pb + t_); } \
    _Pragma("unroll") for (int q_ = 0; q_ < NV; ++q_) rv[q_] = pv[t_ + 16 * q_]; } while (0)
#define ywrite(c) do { const float* yb_ = (const float*)(smem + YOFF + ((c) & 1) * YSZ); const int ts_ = (c) * TC + lstep; \
    const size_t t_ = (size_t)(tok0 + (dir ? T - 1 - ts_ : ts_)) * 512; \
    _Pragma("unroll") for (int q_ = 0; q_ < NV; ++q_) yout[t_ + 16 * q_] = yb_[lstep * RPB + l16 + 16 * q_]; } while (0)
  gload(0);
  for (int c = 0; c < nc; ++c) {
    unsigned char* st = smem + (c & 1) * STG;
    *(float4*)(st + 0 * 4096 + lstep * 256 + l16 * 16) = g_r;
    *(float4*)(st + 1 * 4096 + lstep * 256 + l16 * 16) = g_w;
    *(float4*)(st + 2 * 4096 + lstep * 256 + l16 * 16) = g_k;
    *(float4*)(st + 3 * 4096 + lstep * 256 + l16 * 16) = g_a;
    *(float4*)(st + 4 * 4096 + lstep * 256 + l16 * 16) = g_b;
#pragma unroll
    for (int q = 0; q < NV; ++q) *(float*)(st + 20480 + (lstep * RPB + l16 + 16 * q) * 4) = rv[q];
    __syncthreads();
    if (c > 0) ywrite(c - 1);
    if (c + 1 < nc) gload(c + 1);
    float* ybw = (float*)(smem + YOFF + (c & 1) * YSZ);
    constexpr int NS = PD + 1;
    f32x2 o_r[NS][NP], o_w[NS][NP], o_k[NS][NP], o_a[NS][NP], o_b[NS][NP]; float o_v[NS][R];
    float ykeep[R][TC / LPR];
#define LDOPS(bi, s_) do { \
      _Pragma("unroll") for (int i_ = 0; i_ < NP; ++i_) { \
        o_r[bi][i_] = *(const f32x2*)(st + 0 * 4096 + (s_) * 256 + kq * EPL * 4 + i_ * 8); \
        o_w[bi][i_] = *(const f32x2*)(st + 1 * 4096 + (s_) * 256 + kq * EPL * 4 + i_ * 8); \
        o_k[bi][i_] = *(const f32x2*)(st + 2 * 4096 + (s_) * 256 + kq * EPL * 4 + i_ * 8); \
        o_a[bi][i_] = *(const f32x2*)(st + 3 * 4096 + (s_) * 256 + kq * EPL * 4 + i_ * 8); \
        o_b[bi][i_] = *(const f32x2*)(st + 4 * 4096 + (s_) * 256 + kq * EPL * 4 + i_ * 8); } \
      _Pragma("unroll") for (int rr_ = 0; rr_ < R; ++rr_) o_v[bi][rr_] = *(const float*)(st + 20480 + ((s_) * RPB + vrow_l + rr_) * 4); } while (0)
#pragma unroll
    for (int s = 0; s < PD; ++s) LDOPS(s, s);
#pragma unroll
    for (int s = 0; s < TC; ++s) {
      const int bi = s % NS;
      if (s + PD < TC) LDOPS((s + PD) % NS, s + PD);
#pragma unroll
      for (int rr = 0; rr < R; ++rr) {
        const f32x2 vv2 = (f32x2){o_v[bi][rr], o_v[bi][rr]};
        f32x2 pa2 = S[rr][0] * o_a[bi][0];
        f32x2 tt[NP];
        tt[0] = S[rr][0] * o_w[bi][0] + vv2 * o_k[bi][0];
#pragma unroll
        for (int i = 1; i < NP; ++i) { pa2 += S[rr][i] * o_a[bi][i]; tt[i] = S[rr][i] * o_w[bi][i] + vv2 * o_k[bi][i]; }
        float sa = pa2[0] + pa2[1];
        sa += dpp_mov<0xB1>(sa); sa += dpp_mov<0x4E>(sa); sa += dpp_mov<0x141>(sa);
        if (LPR == 16) sa += dpp_mov<0x140>(sa);
        const f32x2 sa2 = (f32x2){sa, sa};
        f32x2 py = (f32x2){0.f, 0.f};
#pragma unroll
        for (int i = 0; i < NP; ++i) { S[rr][i] = sa2 * o_b[bi][i] + tt[i]; py += S[rr][i] * o_r[bi][i]; }
        float y = py[0] + py[1];
        y += dpp_mov<0xB1>(y); y += dpp_mov<0x4E>(y); y += dpp_mov<0x141>(y);
        if (LPR == 16) y += dpp_mov<0x140>(y);
        if ((s % LPR) == 0) ykeep[rr][s / LPR] = y; else ykeep[rr][s / LPR] = (kq == (s % LPR)) ? y : ykeep[rr][s / LPR];
      }
    }
#undef LDOPS
#pragma unroll
    for (int rr = 0; rr < R; ++rr)
#pragma unroll
      for (int q = 0; q < TC / LPR; ++q) ybw[(q * LPR + kq) * RPB + vrow_l + rr] = ykeep[rr][q];
  }
  __syncthreads();
  ywrite(nc - 1);
  if (seq < 16) {
#pragma unroll
    for (int rr = 0; rr < R; ++rr) {
      float* so = p.out + OUT_STATE + ((size_t)((seq * 2 + dir) * 8 + h) * 64 + vrow + rr) * 64 + kq * EPL;
#pragma unroll
      for (int i = 0; i < NP; ++i) *(f32x2*)(so + 2 * i) = S[rr][i];
    }
  }
  __syncthreads();
#undef gload
#undef ywrite
}

DEV void attn_wave_item(const Params& p, int witem) {
  const int lane = threadIdx.x & 63, fr = lane & 15, fq = lane >> 4;
  const bf16_t* qb = (const bf16_t*)(p.ws + OFF_QB);
  const bf16_t* kb = (const bf16_t*)(p.ws + OFF_KB);
  const bf16_t* vT = (const bf16_t*)(p.ws + OFF_VT);
  const bf16_t* ckb = (const bf16_t*)(p.ws + OFF_CKB);
  const bf16_t* cvT = (const bf16_t*)(p.ws + OFF_CVT);
  bf16_t* ona = (bf16_t*)(p.ws + OFF_ONA);
  int h, tq0, nsub;
  bool latent;
  int b = 0, r = 0, jb = 0, row_start = 0, band = 0, seq = 0;
  {
    const int bi = witem >> 2, wv = witem & 3;
    if (bi < 256) {
      latent = true;
      b = bi >> 7; const int rem = bi & 127; r = rem >> 3; h = rem & 7; jb = wv;
      tq0 = NCTX + b * 1024 + r * 64 + jb * 16;
      row_start = min(max(r - 4, 0), 8); band = min(max(jb * 16 - 8, 0), 32);
      nsub = 4;
    } else {
      latent = false;
      const int c2 = bi - 256; seq = c2 >> 5; const int rem = c2 & 31; h = rem >> 2; const int qg = rem & 3;
      tq0 = seq * 256 + (qg * 4 + wv) * 16; nsub = 2;
    }
  }
  const bf16_t* qp = qb + (size_t)(tq0 + fr) * 512 + h * 64 + fq * 8;
  const bf16x8 qf0 = *(const bf16x8*)qp, qf1 = *(const bf16x8*)(qp + 32);
  float m = -INFINITY, l = 0.f;
  f32x4 O[4];
#pragma unroll
  for (int i = 0; i < 4; ++i) O[i] = (f32x4){0.f, 0.f, 0.f, 0.f};
#define SUBDESC(sc_, kbase_, vbase_, KS_, ldv_, win_) do { const int half_ = (sc_) & 1; win_ = latent && (sc_) < 2; \
    if (win_) { const int tb_ = NCTX + b * 1024 + (row_start + half_ * 4) * 64 + band; \
      kbase_ = kb + (size_t)tb_ * 512 + h * 64; vbase_ = vT + (size_t)(h * 64) * NTOK + tb_; KS_ = 64; ldv_ = NTOK; } \
    else if (latent) { kbase_ = ckb + (size_t)(b * 256 + half_ * 128) * 512 + h * 64; vbase_ = cvT + (size_t)((b * 8 + h) * 64) * 256 + half_ * 128; KS_ = 32; ldv_ = 256; } \
    else { const int tb_ = seq * 256 + half_ * 128; kbase_ = kb + (size_t)tb_ * 512 + h * 64; vbase_ = vT + (size_t)(h * 64) * NTOK + tb_; KS_ = 32; ldv_ = NTOK; } } while (0)
#define KLOAD(kbase_, KS_) do { _Pragma("unroll") for (int i_ = 0; i_ < 8; ++i_) { \
      const bf16_t* kp_ = kbase_ + (size_t)((i_ >> 1) * KS_ + (fr >> 2) * 8 + (i_ & 1) * 4 + (fr & 3)) * 512 + fq * 8; \
      kf[2 * i_] = *(const bf16x8*)kp_; kf[2 * i_ + 1] = *(const bf16x8*)(kp_ + 32); } } while (0)
  bf16x8 kf[16];
#pragma unroll 1
  for (int sc = 0; sc < nsub; ++sc) {
    const int half = sc & 1;
    const bf16_t* kbase; const bf16_t* vbase; int KS, ldv; bool win;
    SUBDESC(sc, kbase, vbase, KS, ldv, win);
    KLOAD(kbase, KS);
    bf16x8 vf[4][4];
#pragma unroll
    for (int s = 0; s < 4; ++s)
#pragma unroll
      for (int dt = 0; dt < 4; ++dt) {
        vf[s][dt] = *(const bf16x8*)(vbase + (size_t)(dt * 16 + fr) * ldv + s * KS + fq * 8);
      }
    f32x4 st[8];
#pragma unroll
    for (int i = 0; i < 8; ++i) {
      f32x4 z = (f32x4){0.f, 0.f, 0.f, 0.f};
      z = __builtin_amdgcn_mfma_f32_16x16x32_bf16(kf[2 * i], qf0, z, 0, 0, 0);
      st[i] = __builtin_amdgcn_mfma_f32_16x16x32_bf16(kf[2 * i + 1], qf1, z, 0, 0, 0);
    }
    const bool cwin = win;
    if (cwin) {
      const int q_col = jb * 16 + fr;
      const int win_start = min(max(q_col - 8, 0), 48);
      const float* rpb = p.in[25] + h * 465;
#pragma unroll
      for (int i = 0; i < 8; ++i) {
        const int dr = row_start + half * 4 + (i >> 1) - r + 7;
#pragma unroll
        for (int e = 0; e < 4; ++e) {
          const int k_col = band + fq * 8 + (i & 1) * 4 + e;
          const bool valid = (k_col >= win_start) && (k_col < win_start + 16);
          const int dc = min(max(k_col - q_col, -15), 15) + 15;
          st[i][e] = valid ? st[i][e] + rpb[dr * 31 + dc] : -1e30f;
        }
      }
    }
    float cmax = -1e30f;
#pragma unroll
    for (int i = 0; i < 8; ++i)
#pragma unroll
      for (int e = 0; e < 4; ++e) cmax = fmaxf(cmax, st[i][e]);
    cmax = fmaxf(cmax, __shfl_xor(cmax, 16)); cmax = fmaxf(cmax, __shfl_xor(cmax, 32));
    const float mnew = fmaxf(m, cmax);
    const float alpha = __expf(m - mnew);
    float psum = 0.f;
#pragma unroll
    for (int i = 0; i < 8; ++i)
#pragma unroll
      for (int e = 0; e < 4; ++e) { const float pv = __expf(st[i][e] - mnew); st[i][e] = pv; psum += pv; }
    psum += __shfl_xor(psum, 16); psum += __shfl_xor(psum, 32);
    l = l * alpha + psum;
#pragma unroll
    for (int i = 0; i < 4; ++i) O[i] = O[i] * alpha;
    m = mnew;
#pragma unroll
    for (int s = 0; s < 4; ++s) {
      union { bf16x8 v; unsigned u[4]; } pb;
      pb.u[0] = pk2(st[2 * s][0], st[2 * s][1]); pb.u[1] = pk2(st[2 * s][2], st[2 * s][3]);
      pb.u[2] = pk2(st[2 * s + 1][0], st[2 * s + 1][1]); pb.u[3] = pk2(st[2 * s + 1][2], st[2 * s + 1][3]);
#pragma unroll
      for (int dt = 0; dt < 4; ++dt) {
        O[dt] = __builtin_amdgcn_mfma_f32_16x16x32_bf16(vf[s][dt], pb.v, O[dt], 0, 0, 0);
      }
    }
  }
#undef SUBDESC
#undef KLOAD
  const float inv = 1.f / l;
#pragma unroll
  for (int dt = 0; dt < 4; ++dt) {
    bf16_t* op = ona + (size_t)(tq0 + fr) * 512 + h * 64 + dt * 16 + fq * 4;
    *(uint2*)op = make_uint2(pk2(O[dt][0] * inv, O[dt][1] * inv), pk2(O[dt][2] * inv, O[dt][3] * inv));
  }
}

constexpr int N_SCAN_ITEMS = 128 + 256, N_ATTN_BLK = 768;
DEV void phase_scan_attn(const Params& p, unsigned char* smem, int* s_item, int rep) {
  unsigned* counter = (unsigned*)(p.ws + OFF_CTL) + rep;
  for (;;) {
    if (threadIdx.x == 0) *s_item = (int)atomicAdd(counter, 1u);
    __syncthreads();
    const int item = *s_item;
    __syncthreads();
    if (item >= N_SCAN_ITEMS + N_ATTN_BLK) break;
    if (item < 128) { const int rem = item & 63; scan_item<4, 1, 3>(p, smem, 16 + (item >> 6), rem >> 3, (rem >> 2) & 1, rem & 3); }
    else if (item >= N_SCAN_ITEMS) attn_wave_item(p, (item - N_SCAN_ITEMS) * 4 + (threadIdx.x >> 6));
    else { const int i2 = item - 128, rem = i2 & 15; scan_item<4, 4, 1>(p, smem, i2 >> 4, rem >> 1, rem & 1, 0); }
  }
}

DEV void phase_finalize_rw(const Params& p, int bid, int nb) {
  const int lane = threadIdx.x & 63, gw = bid * 4 + (threadIdx.x >> 6), nw = nb * 4;
  const float* yf = (const float*)(p.ws + OFF_YF);
  const float* yb = (const float*)(p.ws + OFF_YB);
  const bf16_t* bonus = (const bf16_t*)(p.ws + OFF_BG);
  const bf16_t* gate = (const bf16_t*)(p.ws + OFF_BG + 6291456);
  bf16_t* orw = (bf16_t*)(p.ws + OFF_ORW);
  const float4 g0 = *(const float4*)(p.in[21] + lane * 8), g1 = *(const float4*)(p.in[21] + lane * 8 + 4);
  const float4 b0 = *(const float4*)(p.in[22] + lane * 8), b1 = *(const float4*)(p.in[22] + lane * 8 + 4);
  const float gg[8] = {g0.x, g0.y, g0.z, g0.w, g1.x, g1.y, g1.z, g1.w};
  const float bb[8] = {b0.x, b0.y, b0.z, b0.w, b1.x, b1.y, b1.z, b1.w};
#pragma unroll 3
  for (int t = gw; t < NTOK; t += nw) {
    const size_t o = (size_t)t * 512 + lane * 8;
    const float4 a0 = ldnt4(yf + o), a1 = ldnt4(yf + o + 4);
    const float4 c0 = ldnt4(yb + o), c1 = ldnt4(yb + o + 4);
    const uint4 bo = *(const uint4*)(bonus + o), ga = *(const uint4*)(gate + o);
    float y[8] = {a0.x + c0.x, a0.y + c0.y, a0.z + c0.z, a0.w + c0.w, a1.x + c1.x, a1.y + c1.y, a1.z + c1.z, a1.w + c1.w};
    float s = 0.f;
#pragma unroll
    for (int i = 0; i < 8; ++i) s += y[i];
    s += dpp_mov<0xB1>(s); s += dpp_mov<0x4E>(s); s += dpp_mov<0x141>(s);
    const float mean = s * (1.f / 64.f);
    float q = 0.f;
#pragma unroll
    for (int i = 0; i < 8; ++i) { y[i] -= mean; q += y[i] * y[i]; }
    q += dpp_mov<0xB1>(q); q += dpp_mov<0x4E>(q); q += dpp_mov<0x141>(q);
    const float rstd = rsqrtf(q * (1.f / 64.f) + 64e-5f);
    const unsigned bu[4] = {bo.x, bo.y, bo.z, bo.w}, gu[4] = {ga.x, ga.y, ga.z, ga.w};
    unsigned w[4];
#pragma unroll
    for (int i = 0; i < 4; ++i) {
      const float lo = (y[2 * i] * rstd * gg[2 * i] + bb[2 * i] + __uint_as_float(bu[i] << 16)) * __uint_as_float(gu[i] << 16);
      const float hi = (y[2 * i + 1] * rstd * gg[2 * i + 1] + bb[2 * i + 1] + __uint_as_float(bu[i] & 0xffff0000u)) * __uint_as_float(gu[i] & 0xffff0000u);
      w[i] = pk2(lo, hi);
    }
    *(uint4*)(orw + o) = make_uint4(w[0], w[1], w[2], w[3]);
  }
}

#define XB_TMO      128
#define XB_XCNT(j)  (256  + 64 * (j))
#define XB_XSUB(j)  (1280 + 64 * (j))
#define XB_XGEN(j)  (2304 + 64 * (j))
#define XB_TOP      3328
#define XB_TOPGEN   3392
#define XCD_BAR_WORDS 3456
#define XB_SPIN_CAP (1u << 18)
#define LAS __attribute__((address_space(3)))
DEV unsigned xb_ld(unsigned* p)              { return __hip_atomic_load(p, __ATOMIC_RELAXED, __HIP_MEMORY_SCOPE_AGENT); }
DEV unsigned xb_add(unsigned* p, unsigned v) { return __hip_atomic_fetch_add(p, v, __ATOMIC_RELAXED, __HIP_MEMORY_SCOPE_AGENT); }
DEV unsigned xb_xcc_id() { return (unsigned)__builtin_amdgcn_s_getreg((3 << 11) | 20) & 0xFu; }
#define XB_SPIN(cond, bar) do { unsigned _sp = 0; while (cond) { __builtin_amdgcn_s_sleep(1); \
    if ((++_sp & 255u) == 0u) { if (xb_ld(&(bar)[XB_TMO])) break; if (_sp > XB_SPIN_CAP) { atomicAdd(&(bar)[XB_TMO], 1u); break; } } } } while (0)
struct XcdBarrier { unsigned* bar; unsigned x; volatile LAS unsigned* st; };
DEV XcdBarrier xcd_barrier_post(unsigned* bar, volatile LAS unsigned* st) {
  XcdBarrier b; b.bar = bar; b.x = xb_xcc_id(); b.st = st;
  if (threadIdx.x == 0) (void)xb_add(&bar[XB_XCNT(b.x)], 1u);
  return b;
}
DEV void xcd_barrier_complete(unsigned* bar, unsigned x, unsigned& nloc, unsigned& nx) {
  const unsigned G = gridDim.x * gridDim.y * gridDim.z;
  unsigned sum, cnt, mine, sp = 0u;
  for (;;) {
    sum = 0u; cnt = 0u; mine = 0u;
#pragma unroll
    for (unsigned j = 0; j < 16; ++j) { const unsigned c = xb_ld(&bar[XB_XCNT(j)]); sum += c; cnt += (c > 0u) ? 1u : 0u; mine = (j == x) ? c : mine; }
    if (sum == G) break;
    __builtin_amdgcn_s_sleep(1);
    if ((++sp & 255u) == 0u) { if (xb_ld(&bar[XB_TMO])) break; if (sp > XB_SPIN_CAP) { atomicAdd(&bar[XB_TMO], 1u); break; } }
  }
  nloc = mine > 0u ? mine : 1u; nx = cnt > 0u ? cnt : 1u;
}
DEV void xcd_barrier(const XcdBarrier& b) {
  asm volatile("s_waitcnt vmcnt(0)" ::: "memory");
  __syncthreads();
  if (threadIdx.x == 0) {
    unsigned* bar = b.bar;
    __builtin_amdgcn_s_waitcnt(0);
    unsigned nloc = b.st[0], nx = b.st[1];
    if (nloc == 0u) { xcd_barrier_complete(bar, b.x, nloc, nx); b.st[0] = nloc; b.st[1] = nx; }
    const unsigned old = xb_add(&bar[XB_XSUB(b.x)], 1u);
    const unsigned gen = old / nloc;
    if (old + 1u == (gen + 1u) * nloc) {
      __builtin_amdgcn_fence(__ATOMIC_RELEASE, "agent");
      asm volatile("s_waitcnt vmcnt(0)" ::: "memory");
      const unsigned og = xb_add(&bar[XB_TOP], 1u);
      const unsigned tg = og / nx;
      if (og + 1u == (tg + 1u) * nx) xb_add(&bar[XB_TOPGEN], 1u);
      else XB_SPIN(xb_ld(&bar[XB_TOPGEN]) == tg, bar);
      __builtin_amdgcn_fence(__ATOMIC_ACQUIRE, "agent");
      xb_add(&bar[XB_XGEN(b.x)], 1u);
      asm volatile("s_waitcnt vmcnt(0)" ::: "memory");
    } else {
      XB_SPIN(xb_ld(&bar[XB_XGEN(b.x)]) == gen, bar);
      __builtin_amdgcn_fence(__ATOMIC_ACQUIRE, "agent");
      asm volatile("s_waitcnt vmcnt(0)" ::: "memory");
    }
  }
  __syncthreads();
}

__global__ void __launch_bounds__(NTHR, 2) fwd_megakernel(Params p) {
  extern __shared__ __attribute__((aligned(16))) unsigned char smem[];
  __shared__ __attribute__((aligned(16))) unsigned sh_ctl[8];
  cg::grid_group grid = cg::this_grid();
  const int bid = blockIdx.x, nb = gridDim.x;
  if (threadIdx.x < 8) sh_ctl[threadIdx.x] = 0u;
  __syncthreads();
  const XcdBarrier xb = xcd_barrier_post((unsigned*)(p.ws + OFF_CTL), (volatile LAS unsigned*)sh_ctl);
  int* s_item_p = (int*)&sh_ctl[4];
  if (p.ph_hi > 1000) grid.sync();
#define GSYNC() xcd_barrier(xb)
#ifndef DUP
#define DUP -1
#endif
#define PH(n, body) if (p.ph_lo <= n && n < p.ph_hi) { { const int rep = 0; (void)rep; body; } if (DUP == n) { GSYNC(); const int rep = 1; (void)rep; body; } if (n + 1 < p.ph_hi) GSYNC(); }
  PH(0, phase0(p, smem, bid, nb, rep))
  PH(1, phase_normmod<0>(p, bid, nb))
  PH(2, reset_tiles(s_item_p); phase_gemm_in(p, smem, s_item_p))
  PH(3, phase_prep(p, smem, s_item_p, rep))
  PH(4, phase_scan_attn(p, smem, s_item_p, rep))
  PH(5, phase_finalize_rw(p, bid, nb))
  PH(6, reset_tiles(s_item_p); phase_gemm_merge(p, smem, s_item_p))
  PH(7, reset_tiles(s_item_p); phase_gemm_out(p, smem, s_item_p))
  PH(8, phase_normmod<1>(p, bid, nb))
  PH(9, reset_tiles(s_item_p); phase_gemm_ffn_up(p, smem, s_item_p))
  PH(10, reset_tiles(s_item_p); phase_gemm_ffn_down(p, smem, s_item_p))
}

extern "C" void kernel_launch(void* const* d_in, const int* in_sizes, int n_in, void* d_out, int out_size, void* d_ws, size_t ws_size,
                              hipStream_t stream) {
  static int grid_blocks = 0;
  if (grid_blocks == 0) {
    if (n_in != 32 || ws_size < WS_END) { fprintf(stderr, "kernel_launch: unexpected n_in %d / ws_size %zu (need %zu)\n", n_in, ws_size, (size_t)WS_END); grid_blocks = -1; return; }
    int dev = 0, cus = 0, per_cu = 0;
    hipGetDevice(&dev);
    hipDeviceGetAttribute(&cus, hipDeviceAttributeMultiprocessorCount, dev);
    if (hipFuncSetAttribute((const void*)fwd_megakernel, hipFuncAttributeMaxDynamicSharedMemorySize, LDS_BYTES) != hipSuccess) { fprintf(stderr, "hipFuncSetAttribute failed\n"); grid_blocks = -1; return; }
    if (hipOccupancyMaxActiveBlocksPerMultiprocessor(&per_cu, (const void*)fwd_megakernel, NTHR, LDS_BYTES) != hipSuccess || per_cu < 1) { fprintf(stderr, "occupancy query failed (%d)\n", per_cu); grid_blocks = -1; return; }
    if (per_cu > 2) per_cu = 2;
    grid_blocks = cus * per_cu;
    fprintf(stderr, "kernel_launch: cus %d per_cu %d grid %d\n", cus, per_cu, grid_blocks);
  }
  if (grid_blocks < 0) return;
  hipMemsetAsync((char*)d_ws + OFF_CTL, 0, CTL_ZERO_BYTES, stream);
  Params p{};
  for (int i = 0; i < 32; ++i) p.in[i] = (const float*)d_in[i];
  p.out = (float*)d_out; p.ws = (unsigned char*)d_ws; p.ph_lo = 0; p.ph_hi = 11;
  void* args[] = {&p};
  hipError_t e = hipLaunchCooperativeKernel((const void*)fwd_megakernel, dim3(grid_blocks), dim3(NTHR), args, LDS_BYTES, stream);
  if (e != hipSuccess) fprintf(stderr, "cooperative launch failed: %s (grid %d)\n", hipGetErrorString(e), grid_blocks);
}
```
